# Optimizing an MI355X kernel written in HIP

```python
import math
import jax
import jax.numpy as jnp
from jax import lax
import numpy as np

D_MODEL = 2048
BATCH = 1
SEQ = 16384
DEPTH = 2

N_META = 16
ATTN_HEADS = 8
ATTN_KV_HEADS = 2
ATTN_GROUP = ATTN_HEADS // ATTN_KV_HEADS
HEAD_DIM = 128
WINDOW = 128
BLOCK = 128
ROPE_THETA = 10000.0
Q_DIM = ATTN_HEADS * HEAD_DIM
KV_DIM = ATTN_KV_HEADS * HEAD_DIM
S5_WIDTH = D_MODEL // 2
S5_GROUP = 16
S5_GROUPS = S5_WIDTH // S5_GROUP
S5_STATE = 64
AB_IN_DIM = Q_DIM + 2 * KV_DIM + S5_WIDTH
AB_OUT_DIM = Q_DIM + S5_WIDTH
HG_HEADS = 16
HG_DK = D_MODEL // HG_HEADS
HG_DV = D_MODEL // HG_HEADS
HG_CHUNK = 64
C_IN_DIM = 5 * D_MODEL
N_GROUPS = 8
EXPERTS_PER_GROUP = 8
N_EXPERTS = N_GROUPS * EXPERTS_PER_GROUP
TOP_K = 2
D_EXPERT = 512
MOE_BLOCK = 128
N_AB_LAYERS = (DEPTH + 1) // 2
N_C_LAYERS = DEPTH // 2
DN_ALPHA = (2.0 * DEPTH) ** 0.25
DN_BETA = (8.0 * DEPTH) ** -0.25
LN_EPS = 1e-5
RMS_EPS = 1e-6
NEG_INF = -1e30

kernel_name = 'hybrid_swa_s5_hgrn2_hmoe_encoder'


def layer_norm(x, g, b):
    xf = x.astype(jnp.float32)
    mu = jnp.mean(xf, axis=-1, keepdims=True)
    var = jnp.mean(jnp.square(xf - mu), axis=-1, keepdims=True)
    return ((xf - mu) * lax.rsqrt(var + LN_EPS) * g + b).astype(x.dtype)


def rope(x, pos):
    half = HEAD_DIM // 2
    inv = ROPE_THETA ** (-jnp.arange(half, dtype=jnp.float32) * 2.0 / HEAD_DIM)
    ang = pos.astype(jnp.float32)[:, None] * inv[None, :]
    cos = jnp.cos(ang)[None, :, None, :]
    sin = jnp.sin(ang)[None, :, None, :]
    xf = x.astype(jnp.float32)
    x1, x2 = xf[..., :half], xf[..., half:]
    return jnp.concatenate([x1 * cos - x2 * sin, x2 * cos + x1 * sin], axis=-1).astype(x.dtype)


def to_padded(t, front):
    pad = jnp.zeros((t.shape[0], front - N_META) + t.shape[2:], t.dtype)
    return jnp.concatenate([t[:, :N_META], pad, t[:, N_META:]], axis=1)


def from_padded(t, front):
    return jnp.concatenate([t[:, :N_META], t[:, front:]], axis=1)


def window_attention(q, k, v, sinks):
    B = q.shape[0]
    qp, kp, vp = to_padded(q, BLOCK), to_padded(k, BLOCK), to_padded(v, BLOCK)
    lp = qp.shape[1]
    nb = lp // BLOCK
    slot = jnp.arange(lp)
    lpos = jnp.where(slot < N_META, slot, slot - (BLOCK - N_META))
    is_real = slot >= BLOCK

    def band(t, axis):
        widths = [(0, 0)] * t.ndim
        widths[axis] = (BLOCK, BLOCK)
        tb = jnp.pad(t, widths).reshape(t.shape[:axis] + (nb + 2, BLOCK) + t.shape[axis + 1:])
        parts = [lax.slice_in_dim(tb, s, s + nb, axis=axis) for s in range(3)]
        return jnp.concatenate(parts, axis=axis + 1)

    kn, vn = band(kp, 1), band(vp, 1)
    kpos, kreal = band(lpos, 0), band(is_real, 0)
    qpos = lpos.reshape(nb, BLOCK)
    visible = kreal[:, None, :] & (jnp.abs(qpos[:, :, None] - kpos[:, None, :]) <= WINDOW)

    qb = qp.reshape(B, nb, BLOCK, ATTN_KV_HEADS, ATTN_GROUP, HEAD_DIM)
    km, vm = k[:, :N_META], v[:, :N_META]
    scale = HEAD_DIM ** -0.5
    s_meta = jnp.einsum('bnqgrd,bmgd->bngrqm', qb, km).astype(jnp.float32) * scale
    s_band = jnp.einsum('bnqgrd,bnkgd->bngrqk', qb, kn).astype(jnp.float32) * scale
    s_band = jnp.where(visible[None, :, None, None], s_band, NEG_INF)
    sink = jnp.broadcast_to(sinks.astype(jnp.float32).reshape(1, 1, ATTN_KV_HEADS, ATTN_GROUP, 1, 1),
                            s_meta.shape[:-1] + (1,))
    p = jax.nn.softmax(jnp.concatenate([s_meta, s_band, sink], axis=-1), axis=-1)
    p_meta = p[..., :N_META].astype(v.dtype)
    p_band = p[..., N_META:N_META + 3 * BLOCK].astype(v.dtype)
    o = (jnp.einsum('bngrqm,bmgd->bnqgrd', p_meta, vm)
         + jnp.einsum('bngrqk,bnkgd->bnqgrd', p_band, vn))
    return from_padded(o.reshape(B, lp, Q_DIM), BLOCK)


def _linear_recurrence_op(e1, e2):
    a1, b1 = e1
    a2, b2 = e2
    return a1 * a2, a2 * b1 + b2


def s5_mixer(u, lam_re, lam_im, log_step, b_re, b_im, c_re, c_im, d_skip, w_glu, b_glu):
    f32 = jnp.float32
    B, L, _ = u.shape
    uf = u.astype(f32)
    ug = uf.reshape(B, L, S5_GROUPS, S5_GROUP)
    y = uf * d_skip.astype(f32)
    for direction in range(2):
        lam = lax.complex(jnp.minimum(lam_re[direction].astype(f32), -1e-4), lam_im[direction].astype(f32))
        step = jnp.exp(log_step[direction].astype(f32))[:, None]
        a_bar = jnp.exp(lam * step)
        b_bar = ((a_bar - 1.0) / lam)[..., None] * lax.complex(b_re[direction].astype(f32),
                                                                  b_im[direction].astype(f32))
        bu = lax.complex(jnp.einsum('blgc,gpc->blgp', ug, b_bar.real),
                         jnp.einsum('blgc,gpc->blgp', ug, b_bar.imag))
        _, xs = lax.associative_scan(_linear_recurrence_op, (jnp.broadcast_to(a_bar, bu.shape), bu),
                                     reverse=(direction == 1), axis=1)
        y_dir = (jnp.einsum('blgp,gcp->blgc', xs.real, c_re[direction].astype(f32))
                 - jnp.einsum('blgp,gcp->blgc', xs.imag, c_im[direction].astype(f32)))
        y = y + y_dir.reshape(B, L, S5_WIDTH)
    z = jax.nn.gelu(y)
    out = z * jax.nn.sigmoid(z @ w_glu.astype(f32) + b_glu.astype(f32))
    return out.astype(u.dtype)


def chunk_recurrence(q, k, v, g):
    B, lp = q.shape[:2]
    n = lp // HG_CHUNK

    def to_chunks(t):
        return t.reshape(B, n, HG_CHUNK, HG_HEADS, t.shape[-1]).transpose(1, 0, 3, 2, 4)

    tri = jnp.tril(jnp.ones((HG_CHUNK, HG_CHUNK), dtype=bool))[:, :, None]

    def step(state, chunk):
        qc, kc, vc, gc = chunk
        b = jnp.cumsum(gc, axis=2)
        rel = jnp.where(tri, b[:, :, :, None, :] - b[:, :, None, :, :], -jnp.inf)
        scores = jnp.sum(qc[:, :, :, None, :] * kc[:, :, None, :, :] * jnp.exp(rel), axis=-1)
        out = (jnp.einsum('bhts,bhsv->bhtv', scores, vc)
               + jnp.einsum('bhtk,bhkv->bhtv', qc * jnp.exp(b), state))
        b_end = b[:, :, -1:, :]
        state = (jnp.exp(b_end[:, :, 0, :, None]) * state
                 + jnp.einsum('bhsk,bhsv->bhkv', kc * jnp.exp(b_end - b), vc))
        return state, out

    state0 = jnp.zeros((B, HG_HEADS, HG_DK, HG_DV), q.dtype)
    _, out = lax.scan(step, state0, (to_chunks(q), to_chunks(k), to_chunks(v), to_chunks(g)))
    return out.transpose(1, 0, 3, 2, 4).reshape(B, lp, HG_HEADS, HG_DV)


def hgrn2_mixer(q, i_in, f_fw, f_bw, gate, lower_bound, norm_g):
    f32 = jnp.float32
    B, L, _ = q.shape
    lb = lower_bound.astype(f32).reshape(HG_HEADS, HG_DK)

    def heads(t):
        return t.astype(f32).reshape(B, L, HG_HEADS, -1)

    def forget(fz):
        f = lb + (1.0 - lb) * jax.nn.sigmoid(heads(fz))
        return jnp.log(f), 1.0 - f

    qh, vh = heads(q), heads(i_in)
    g1, k1 = forget(f_fw)
    g2, k2 = forget(f_bw)
    pad = lambda t: to_padded(t, HG_CHUNK)
    rev = lambda t: jnp.flip(t, axis=1)
    qp, vp = pad(qh), pad(vh)
    o_fw = chunk_recurrence(qp, pad(k1), vp, pad(g1))
    o_bw = rev(chunk_recurrence(rev(qp), rev(pad(k2)), rev(vp), rev(pad(g2))))
    o = from_padded(o_fw + o_bw, HG_CHUNK)
    o = o * lax.rsqrt(jnp.mean(o * o, axis=-1, keepdims=True) + RMS_EPS)
    o = o.reshape(B, L, HG_HEADS * HG_DV) * norm_g.astype(f32)
    return (o * jax.nn.sigmoid(gate.astype(f32))).astype(q.dtype)


def hier_moe(x, w_group, b_group, w_expert, b_expert, w_gate_up, w_down):
    f32 = jnp.float32
    B, L, D = x.shape
    T = B * L
    xt = x.reshape(T, D)
    xf = xt.astype(f32)
    g_logits = xf @ w_group.astype(f32) + b_group.astype(f32)
    grp = jnp.argmax(g_logits, axis=-1)
    p_grp = jnp.take_along_axis(jax.nn.softmax(g_logits, axis=-1), grp[:, None], axis=-1)
    e_logits = (xf @ w_expert.astype(f32) + b_expert.astype(f32)).reshape(T, N_GROUPS, EXPERTS_PER_GROUP)
    e_logits = jnp.take_along_axis(e_logits, grp[:, None, None], axis=1)[:, 0]
    top_v, top_i = lax.top_k(e_logits, TOP_K)
    weights = p_grp * jax.nn.softmax(top_v, axis=-1)
    expert = grp[:, None] * EXPERTS_PER_GROUP + top_i

    M = T * TOP_K
    flat_e = expert.reshape(M)
    flat_tok = jnp.repeat(jnp.arange(T), TOP_K)
    flat_w = weights.reshape(M)
    order = jnp.argsort(flat_e)
    e_sorted, tok_sorted, w_sorted = flat_e[order], flat_tok[order], flat_w[order]
    counts = jnp.bincount(flat_e, length=N_EXPERTS)
    padded = (counts + MOE_BLOCK - 1) // MOE_BLOCK * MOE_BLOCK
    start = jnp.cumsum(counts) - counts
    pend = jnp.cumsum(padded)
    pstart = pend - padded
    dest = pstart[e_sorted] + (jnp.arange(M) - start[e_sorted])
    n_blocks = -(-(M + N_EXPERTS * (MOE_BLOCK - 1)) // MOE_BLOCK)
    rows = n_blocks * MOE_BLOCK
    buf = jnp.zeros((rows, D), xt.dtype).at[dest].set(xt[tok_sorted])
    block_expert = jnp.minimum(jnp.searchsorted(pend, jnp.arange(n_blocks) * MOE_BLOCK, side='right'),
                               N_EXPERTS - 1)

    def expert_block(args):
        xb, e = args
        h = xb @ w_gate_up[e]
        return (jax.nn.silu(h[:, :D_EXPERT]) * h[:, D_EXPERT:]) @ w_down[e]

    ybuf = lax.map(expert_block, (buf.reshape(n_blocks, MOE_BLOCK, D), block_expert)).reshape(rows, D)
    y = ybuf[dest].astype(f32) * w_sorted[:, None]
    out = jnp.zeros((T, D), f32).at[tok_sorted].add(y)
    return out.reshape(B, L, D).astype(x.dtype)


def setup_inputs(seed: int = 0) -> dict:
    key = jax.random.key(seed)
    keys = iter(jax.random.split(key, 40))
    f32 = jnp.float32

    def nrm(shape, scale):
        return jax.random.normal(next(keys), shape, f32) * scale

    n_state = jnp.arange(S5_STATE, dtype=f32)
    s5_shape = (N_AB_LAYERS, 2, S5_GROUPS, S5_STATE)
    return {
        'x': nrm((BATCH, SEQ, D_MODEL), 1.0),
        'meta_tokens': nrm((N_META, D_MODEL), 1.0),
        'w_in_ab': nrm((N_AB_LAYERS, D_MODEL, AB_IN_DIM), D_MODEL ** -0.5),
        'w_out_ab': nrm((N_AB_LAYERS, AB_OUT_DIM, D_MODEL), AB_OUT_DIM ** -0.5 * DN_BETA),
        'attn_sinks': nrm((N_AB_LAYERS, ATTN_HEADS), 1.0),
        's5_lam_re': -0.5 + nrm(s5_shape, 0.01),
        's5_lam_im': math.pi * n_state + nrm(s5_shape, 0.01),
        's5_log_step': jax.random.uniform(next(keys), (N_AB_LAYERS, 2, S5_GROUPS), f32,
                                          math.log(1e-3), math.log(1e-1)),
        's5_b_re': nrm((N_AB_LAYERS, 2, S5_GROUPS, S5_STATE, S5_GROUP), (2 * S5_GROUP) ** -0.5),
        's5_b_im': nrm((N_AB_LAYERS, 2, S5_GROUPS, S5_STATE, S5_GROUP), (2 * S5_GROUP) ** -0.5),
        's5_c_re': nrm((N_AB_LAYERS, 2, S5_GROUPS, S5_GROUP, S5_STATE), S5_STATE ** -0.5),
        's5_c_im': nrm((N_AB_LAYERS, 2, S5_GROUPS, S5_GROUP, S5_STATE), S5_STATE ** -0.5),
        's5_d': nrm((N_AB_LAYERS, S5_WIDTH), 1.0),
        's5_w_glu': nrm((N_AB_LAYERS, S5_WIDTH, S5_WIDTH), S5_WIDTH ** -0.5),
        's5_b_glu': nrm((N_AB_LAYERS, S5_WIDTH), 0.01),
        'w_in_c': nrm((N_C_LAYERS, D_MODEL, C_IN_DIM), D_MODEL ** -0.5),
        'w_out_c': nrm((N_C_LAYERS, HG_HEADS * HG_DV, D_MODEL), (HG_HEADS * HG_DV) ** -0.5 * DN_BETA),
        'hgrn_lb_logits': nrm((DEPTH, HG_HEADS * HG_DK), 0.1),
        'hgrn_norm_g': 1.0 + nrm((N_C_LAYERS, HG_HEADS * HG_DV), 0.02),
        'ln_mix_g': 1.0 + nrm((DEPTH, D_MODEL), 0.02),
        'ln_mix_b': nrm((DEPTH, D_MODEL), 0.02),
        'ln_ffn_g': 1.0 + nrm((DEPTH, D_MODEL), 0.02),
        'ln_ffn_b': nrm((DEPTH, D_MODEL), 0.02),
        'moe_w_group': nrm((DEPTH, D_MODEL, N_GROUPS), D_MODEL ** -0.5),
        'moe_b_group': nrm((DEPTH, N_GROUPS), 0.01),
        'moe_w_expert': nrm((DEPTH, D_MODEL, N_EXPERTS), D_MODEL ** -0.5),
        'moe_b_expert': nrm((DEPTH, N_EXPERTS), 0.01),
        'moe_w_gate_up': nrm((DEPTH, N_EXPERTS, D_MODEL, 2 * D_EXPERT), D_MODEL ** -0.5),
        'moe_w_down': nrm((DEPTH, N_EXPERTS, D_EXPERT, D_MODEL), D_EXPERT ** -0.5 * DN_BETA),
    }


def reference(x, meta_tokens, w_in_ab, w_out_ab, attn_sinks, s5_lam_re, s5_lam_im, s5_log_step,
              s5_b_re, s5_b_im, s5_c_re, s5_c_im, s5_d, s5_w_glu, s5_b_glu, w_in_c, w_out_c,
              hgrn_lb_logits, hgrn_norm_g, ln_mix_g, ln_mix_b, ln_ffn_g, ln_ffn_b,
              moe_w_group, moe_b_group, moe_w_expert, moe_b_expert, moe_w_gate_up, moe_w_down):
    B = x.shape[0]
    meta = jnp.broadcast_to(meta_tokens.astype(x.dtype)[None], (B, N_META, D_MODEL))
    h = jnp.concatenate([meta, x], axis=1)
    L = h.shape[1]
    pos = jnp.arange(L)
    lb_probs = jax.nn.softmax(hgrn_lb_logits.astype(jnp.float32), axis=0)
    lb_table = jnp.cumsum(lb_probs, axis=0) - lb_probs[0]
    for layer in range(DEPTH):
        j = layer // 2
        if layer % 2 == 0:
            proj = h @ w_in_ab[j]
            q, k, v, u = jnp.split(proj, [Q_DIM, Q_DIM + KV_DIM, Q_DIM + 2 * KV_DIM], axis=-1)
            q = rope(q.reshape(B, L, ATTN_HEADS, HEAD_DIM), pos)
            k = rope(k.reshape(B, L, ATTN_KV_HEADS, HEAD_DIM), pos)
            v = v.reshape(B, L, ATTN_KV_HEADS, HEAD_DIM)
            a_out = window_attention(q, k, v, attn_sinks[j])
            s_out = s5_mixer(u, s5_lam_re[j], s5_lam_im[j], s5_log_step[j], s5_b_re[j], s5_b_im[j],
                             s5_c_re[j], s5_c_im[j], s5_d[j], s5_w_glu[j], s5_b_glu[j])
            mix = jnp.concatenate([a_out, s_out], axis=-1) @ w_out_ab[j]
        else:
            proj = h @ w_in_c[j]
            q, i_in, f_fw, f_bw, gate = jnp.split(proj, 5, axis=-1)
            mix = hgrn2_mixer(q, i_in, f_fw, f_bw, gate, lb_table[layer], hgrn_norm_g[j]) @ w_out_c[j]
        h = layer_norm(DN_ALPHA * h + mix, ln_mix_g[layer], ln_mix_b[layer])
        ffn = hier_moe(h, moe_w_group[layer], moe_b_group[layer], moe_w_expert[layer],
                       moe_b_expert[layer], moe_w_gate_up[layer], moe_w_down[layer])
        h = layer_norm(DN_ALPHA * h + ffn, ln_ffn_g[layer], ln_ffn_b[layer])
    return h[:, N_META:]
```

```cpp
#include <hip/hip_runtime.h>
#include <cstdio>
#include <cstdint>

namespace pg8 {
#define PG8_LAS __attribute__((address_space(3)))
typedef unsigned short bf16_t;
typedef short bf16x8 __attribute__((ext_vector_type(8)));
typedef float f32x4 __attribute__((ext_vector_type(4)));
typedef unsigned u32x4 __attribute__((ext_vector_type(4)));
constexpr int BM = 256, BK = 64, HALF = 128, HTB = HALF * BK * 2, STAGE_BYTES = 8 * HTB, NXCD = 8, WGM = 8;

__host__ __device__ __forceinline__ int lds_byte(int r, int c) { const int st = (r >> 4) * 2 + (c >> 5), rr = r & 15, cc = c & 31, ob = rr * 64 + cc * 2; return st * 1024 + (ob ^ (((ob >> 9) & 1) << 5)); }
__host__ __device__ __forceinline__ void stage_rc(int b, int& R, int& C) { const int st = b / 1024, sb = b % 1024, swz = sb ^ (((sb >> 9) & 1) << 5); R = (st >> 1) * 16 + swz / 64; C = (st & 1) * 32 + (swz % 64) / 2; }
__host__ __device__ __forceinline__ int perm32(int rho) { const int n = rho >> 4, i = rho & 15; return 8 * (i >> 2) + 4 * n + (i & 3); }

struct Unit { int pm, pn, eb; };
struct Gemm { const bf16_t* A; const bf16_t* Bt; int M, N, K; size_t bstride; };

struct StaticOrder {
    int nM, nN, nwg, G, c;
    __host__ __device__ void init(int M, int N, int G_, int c_) { nM = M / BM; nN = N / BM; nwg = nM * nN; G = G_; c = c_; }
    __host__ __device__ bool next(int i, Unit& u) const {
        const long L = (long)i * G + c; if (L >= nwg) return false;
        int wgid = (int)L; { const int q = nwg / NXCD, r = nwg % NXCD, xcd = wgid % NXCD, off = wgid / NXCD; wgid = (xcd < r ? xcd * (q + 1) : r * (q + 1) + (xcd - r) * q) + off; }
        const int nig = WGM * nN, gid = wgid / nig, fm = gid * WGM, gsz = (nM - fm) < WGM ? (nM - fm) : WGM;
        u.pm = fm + ((wgid % nig) % gsz); u.pn = (wgid % nig) / gsz; u.eb = 0; return true;
    }
    __device__ __forceinline__ void a_ready(const Unit&) const {}
    __device__ __forceinline__ void done(const Unit&) const {}
};
struct GroupedOrder {
    int ntiles, nN, nwg, G, c; const int* tile_expert;
    __device__ void init(const int* plan, int N, int G_, int c_) { ntiles = plan[0]; tile_expert = plan + 128; nN = N / BM; nwg = ntiles * nN; G = G_; c = c_; }
    __device__ bool next(int i, Unit& u) const {
        const long L = (long)i * G + c; if (L >= nwg) return false;
        u.pm = (int)(L / nN); u.pn = (int)(L % nN); u.eb = tile_expert[u.pm]; return true;
    }
    __device__ __forceinline__ void a_ready(const Unit&) const {}
    __device__ __forceinline__ void done(const Unit&) const {}
};

__device__ __forceinline__ unsigned cvt_pk_bf16(float lo, float hi) { unsigned r; asm volatile("v_cvt_pk_bf16_f32 %0, %1, %2" : "=v"(r) : "v"(lo), "v"(hi)); return r; }

struct EpiF32 {
    static constexpr bool PERM = false, AFTER_DRAIN = false;
    float* C; int ldc;
    __device__ __forceinline__ void operator()(const f32x4 (&acc)[2][2][4][2], const Unit& u, int wr, int wc, int fr, int fq) const {
        const int row0 = u.pm * BM + wr * 64 + fr, col0 = u.pn * BM + wc * 32 + 4 * fq;
#pragma unroll
        for (int ai = 0; ai < 2; ++ai)
#pragma unroll
            for (int m = 0; m < 4; ++m) { float* rowp = C + (size_t)(row0 + ai * HALF + m * 16) * ldc + col0;
#pragma unroll
                for (int bj = 0; bj < 2; ++bj)
#pragma unroll
                    for (int n = 0; n < 2; ++n) *(f32x4*)(rowp + bj * HALF + n * 16) = acc[ai][bj][m][n]; }
    }
};
struct EpiSwiGLU {
    static constexpr bool PERM = true, AFTER_DRAIN = false;
    bf16_t* O; int ldc;
    __device__ __forceinline__ void operator()(const f32x4 (&acc)[2][2][4][2], const Unit& u, int wr, int wc, int fr, int fq) const {
        const int row0 = u.pm * BM + wr * 64 + fr, col0 = u.pn * HALF + wc * 32 + 8 * fq;
#pragma unroll
        for (int ai = 0; ai < 2; ++ai)
#pragma unroll
            for (int m = 0; m < 4; ++m) { bf16_t* rowp = O + (size_t)(row0 + ai * HALF + m * 16) * ldc + col0;
                float r[8];
#pragma unroll
                for (int n = 0; n < 2; ++n)
#pragma unroll
                    for (int i = 0; i < 4; ++i) { const float g = acc[ai][0][m][n][i], up = acc[ai][1][m][n][i]; r[n * 4 + i] = g / (1.0f + __expf(-g)) * up; }
                u32x4 w; w.x = cvt_pk_bf16(r[0], r[1]); w.y = cvt_pk_bf16(r[2], r[3]); w.z = cvt_pk_bf16(r[4], r[5]); w.w = cvt_pk_bf16(r[6], r[7]);
                *(u32x4*)rowp = w; }
    }
};

template <class Epi, class Sched>
__device__ __forceinline__ void gemm_phase(PG8_LAS unsigned char* lds, const Gemm g, const Sched& S, const Epi& E) {
    const int tid = threadIdx.x, wid = __builtin_amdgcn_readfirstlane(tid >> 6), lane = tid & 63, wr = wid >> 2, wc = wid & 3, fr = lane & 15, fq = lane >> 4;
    const int K = g.K, nt = K / BK;
    unsigned voffA[2], voffB[2];
#pragma unroll
    for (int i = 0; i < 2; ++i) { int R, C; stage_rc(tid * 16 + i * 8192, R, C); const int Rb = Epi::PERM ? ((R & ~31) + perm32(R & 31)) : R;
        voffA[i] = (unsigned)(R * K + C) * 2u; voffB[i] = (unsigned)(Rb * K + C) * 2u; }
    const size_t kstep = (size_t)(BK * 2);
    const size_t hstep = (size_t)HALF * K * 2;
    const size_t tstep = 2 * hstep;
    const unsigned ldsw = (unsigned)wid * 1024u;
    const int aoff = lds_byte(wr * 64 + fr, fq * 8), boff = lds_byte(wc * 32 + fr, fq * 8);
#define PG8_SA(b, h) (((b) * 2 + (h)) * HTB)
#define PG8_SB(b, h) ((4 + (b) * 2 + (h)) * HTB)
#define PG8_STAGE(bufoff, gbase, voff) do { _Pragma("unroll") for (int _i = 0; _i < 2; ++_i) \
        __builtin_amdgcn_global_load_lds((const unsigned*)((const char*)(gbase) + (voff)[_i]), (PG8_LAS unsigned*)(lds + (bufoff) + ldsw + _i * 8192), 16, 0, 0); } while (0)
#define PG8_LDA(dst, b, h) do { _Pragma("unroll") for (int m = 0; m < 4; ++m) _Pragma("unroll") for (int k = 0; k < 2; ++k) dst[m][k] = *(const PG8_LAS bf16x8*)(lds + PG8_SA(b, h) + aoff + m * 2048 + k * 1024); } while (0)
#define PG8_LDB(dst, b, h) do { _Pragma("unroll") for (int n = 0; n < 2; ++n) _Pragma("unroll") for (int k = 0; k < 2; ++k) dst[n][k] = *(const PG8_LAS bf16x8*)(lds + PG8_SB(b, h) + boff + n * 2048 + k * 1024); } while (0)
#define PG8_MMA(ai, bj, At, Bt) do { __builtin_amdgcn_s_setprio(1); _Pragma("unroll") for (int m = 0; m < 4; ++m) _Pragma("unroll") for (int n = 0; n < 2; ++n) _Pragma("unroll") for (int k = 0; k < 2; ++k) \
        acc[ai][bj][m][n] = __builtin_amdgcn_mfma_f32_16x16x32_bf16(Bt[n][k], At[m][k], acc[ai][bj][m][n], 0, 0, 0); __builtin_amdgcn_s_setprio(0); } while (0)
#define PG8_WAIT_V(n) asm volatile("s_waitcnt vmcnt(" #n ")" ::: "memory")
#define PG8_WAIT_L(n) asm volatile("s_waitcnt lgkmcnt(" #n ")" ::: "memory")
#define PG8_BAR __builtin_amdgcn_s_barrier()
#define PG8_SCHED __builtin_amdgcn_sched_barrier(0)
    Unit cur, nxt; int ui = 0;
    if (!S.next(0, cur)) return;
    f32x4 acc[2][2][4][2];
#pragma unroll
    for (int a = 0; a < 2; ++a)
#pragma unroll
        for (int b = 0; b < 2; ++b)
#pragma unroll
            for (int m = 0; m < 4; ++m)
#pragma unroll
                for (int n = 0; n < 2; ++n) acc[a][b][m][n] = (f32x4){0.f, 0.f, 0.f, 0.f};
    bf16x8 At[4][2], B0[2][2], B1[2][2];
    const char* cA = (const char*)g.A + (size_t)cur.pm * tstep; const char* cB = (const char*)g.Bt + (size_t)cur.eb * g.bstride + (size_t)cur.pn * tstep;
    S.a_ready(cur);
    PG8_STAGE(PG8_SB(0, 0), cB, voffB); PG8_STAGE(PG8_SA(0, 0), cA, voffA); PG8_STAGE(PG8_SB(0, 1), cB + hstep, voffB); PG8_STAGE(PG8_SA(0, 1), cA + hstep, voffA);
    if (wr == 1) PG8_BAR;
    PG8_WAIT_V(4); PG8_BAR;
    PG8_STAGE(PG8_SB(1, 0), cB + kstep, voffB); PG8_STAGE(PG8_SA(1, 0), cA + kstep, voffA); PG8_STAGE(PG8_SB(1, 1), cB + hstep + kstep, voffB);
    PG8_WAIT_V(6); PG8_BAR;
    for (;;) {
        const bool has_next = S.next(ui + 1, nxt);
        const char* nA = has_next ? (const char*)g.A + (size_t)nxt.pm * tstep : cA; const char* nB = has_next ? (const char*)g.Bt + (size_t)nxt.eb * g.bstride + (size_t)nxt.pn * tstep : cB;
        for (int t = 0; t < nt; t += 2) {
            const bool last = (t == nt - 2);
            const char* a1 = cA + (size_t)(t + 1) * kstep;
            const char* a2 = last ? nA : cA + (size_t)(t + 2) * kstep; const char* b2 = last ? nB : cB + (size_t)(t + 2) * kstep;
            const char* a3 = a2 + kstep; const char* b3 = b2 + kstep;
            if (last && has_next) S.a_ready(nxt);
            PG8_LDB(B0, 0, 0); PG8_SCHED; PG8_LDA(At, 0, 0); PG8_STAGE(PG8_SA(1, 1), a1 + hstep, voffA);
            PG8_WAIT_L(8); PG8_BAR; PG8_WAIT_L(0); PG8_MMA(0, 0, At, B0); PG8_BAR; PG8_SCHED;
            PG8_LDB(B1, 0, 1); PG8_STAGE(PG8_SB(0, 0), b2, voffB);
            PG8_BAR; PG8_WAIT_L(0); PG8_MMA(0, 1, At, B1); PG8_BAR;
            PG8_LDA(At, 0, 1); PG8_STAGE(PG8_SA(0, 0), a2, voffA);
            PG8_BAR; PG8_WAIT_L(0); PG8_MMA(1, 0, At, B0); PG8_BAR; PG8_SCHED;
            PG8_STAGE(PG8_SB(0, 1), b2 + hstep, voffB);
            PG8_WAIT_V(6); PG8_BAR; PG8_MMA(1, 1, At, B1); PG8_BAR;
            PG8_LDB(B0, 1, 0); PG8_SCHED; PG8_LDA(At, 1, 0); PG8_STAGE(PG8_SA(0, 1), a2 + hstep, voffA);
            PG8_WAIT_L(8); PG8_BAR; PG8_WAIT_L(0); PG8_MMA(0, 0, At, B0); PG8_BAR; PG8_SCHED;
            PG8_LDB(B1, 1, 1); PG8_STAGE(PG8_SB(1, 0), b3, voffB);
            PG8_BAR; PG8_WAIT_L(0); PG8_MMA(0, 1, At, B1); PG8_BAR;
            PG8_LDA(At, 1, 1); PG8_STAGE(PG8_SA(1, 0), a3, voffA);
            PG8_BAR; PG8_WAIT_L(0); PG8_MMA(1, 0, At, B0); PG8_BAR; PG8_SCHED;
            PG8_STAGE(PG8_SB(1, 1), b3 + hstep, voffB);
            PG8_WAIT_V(6); PG8_BAR; PG8_MMA(1, 1, At, B1); PG8_BAR;
        }
        E(acc, cur, wr, wc, fr, fq); S.done(cur);
        if (!has_next) break;
#pragma unroll
        for (int a = 0; a < 2; ++a)
#pragma unroll
            for (int b = 0; b < 2; ++b)
#pragma unroll
                for (int m = 0; m < 4; ++m)
#pragma unroll
                    for (int n = 0; n < 2; ++n) acc[a][b][m][n] = (f32x4){0.f, 0.f, 0.f, 0.f};
        cur = nxt; cA = nA; cB = nB; ++ui;
    }
    PG8_WAIT_V(0);
    if (wr == 0) PG8_BAR;
    PG8_BAR;
#undef PG8_SA
#undef PG8_SB
#undef PG8_STAGE
#undef PG8_LDA
#undef PG8_LDB
#undef PG8_MMA
#undef PG8_WAIT_V
#undef PG8_WAIT_L
#undef PG8_BAR
#undef PG8_SCHED
}
}

constexpr int D = 2048, SEQ = 16384, NMETA = 16;
constexpr int LP = 16640;
constexpr int ROWV = 240;
constexpr int NVALID = 16400;
constexpr int ABN = 2560, CN = 10240;
constexpr int NEXP = 64, DEXP = 512;
constexpr int MAXTILES = 192, MPAD = MAXTILES * 256;
constexpr float DN_ALPHA = 1.4142135623730951f;
constexpr float LN_EPS = 1e-5f;
constexpr int NWAVES = 8, NTHR = 512;

constexpr size_t al(size_t x) { return (x + 0xFFFFFull) & ~(size_t)0xFFFFFull; }
constexpr size_t WS_CTL = 0, CTL_BYTES = 1u << 20;
constexpr size_t WS_WAB = al(WS_CTL + CTL_BYTES);
constexpr size_t WS_WOAB = al(WS_WAB + (size_t)ABN * D * 2);
constexpr size_t WS_WGLU = al(WS_WOAB + (size_t)D * D * 2);
constexpr size_t WS_WC = al(WS_WGLU + (size_t)1024 * 1024 * 2);
constexpr size_t WS_WOC = al(WS_WC + (size_t)CN * D * 2);
constexpr size_t WS_WGU = al(WS_WOC + (size_t)D * D * 2);
constexpr size_t WS_WD = al(WS_WGU + (size_t)2 * NEXP * 1024 * D * 2);
constexpr size_t WS_HA = al(WS_WD + (size_t)2 * NEXP * D * DEXP * 2);
constexpr size_t WS_HB = al(WS_HA + (size_t)LP * D * 4);
constexpr size_t WS_HBF = al(WS_HB + (size_t)LP * D * 4);
constexpr size_t WS_PROJ0 = al(WS_HBF + (size_t)LP * D * 2);
constexpr size_t WS_MIXIN = al(WS_PROJ0 + (size_t)LP * ABN * 4);
constexpr size_t WS_MIX = al(WS_MIXIN + (size_t)LP * D * 2);
constexpr size_t WS_Z = al(WS_MIX + (size_t)LP * D * 4);
constexpr size_t WS_ZB = al(WS_Z + (size_t)LP * 1024 * 4);
constexpr size_t WS_GLU = al(WS_ZB + (size_t)LP * 1024 * 2);
constexpr size_t WS_S5P = al(WS_GLU + (size_t)LP * 1024 * 4);
constexpr size_t WS_ROPE = al(WS_S5P + (size_t)(2 * 64 * 64 * 8 + 2 * 64 * 64 * 16 * 8));
constexpr size_t WS_ROUTE = al(WS_ROPE + (size_t)LP * 64 * 8);
constexpr size_t WS_R1 = al(WS_ROUTE + (size_t)LP * 32);
constexpr size_t R1_BYTES = (size_t)2 * LP * 4096 * 8;
constexpr size_t WS_END = WS_R1 + R1_BYTES;
constexpr size_t R1_XS = 0;
constexpr size_t R1_PROJ1 = 0;
constexpr size_t R1_OFW = al((size_t)LP * CN * 4);
constexpr size_t R1_OBW = al(R1_OFW + (size_t)LP * D * 4);
constexpr size_t R1_HG_END = R1_OBW + (size_t)LP * D * 4;
constexpr size_t R1_XSRT = 0;
constexpr size_t R1_ACT = al((size_t)MPAD * D * 2);
constexpr size_t R1_Y = al(R1_ACT + (size_t)MPAD * DEXP * 2);
constexpr size_t R1_MOE_END = R1_Y + (size_t)MPAD * D * 4;
static_assert(R1_HG_END <= R1_BYTES && R1_MOE_END <= R1_BYTES, "R1 overlays");
static_assert(WS_END <= (size_t)4 << 30, "workspace map must fit 4 GiB");
constexpr int CW_BAR = 4096;
constexpr int CW_CNT = 16384;
constexpr int CW_PLAN = 32768;

#define LAS __attribute__((address_space(3)))
typedef unsigned short bf16;
typedef unsigned v4u __attribute__((ext_vector_type(4)));
typedef unsigned v2u __attribute__((ext_vector_type(2)));
typedef float f32x4 __attribute__((ext_vector_type(4)));
#define LDS_WAIT() asm volatile("s_waitcnt lgkmcnt(0)" ::: "memory")
__device__ __forceinline__ unsigned f2bf(float f) { unsigned u = __builtin_bit_cast(unsigned, f); return (u + 0x7fffu + ((u >> 16) & 1u)) >> 16; }
__device__ __forceinline__ unsigned pk2(float lo, float hi) { return f2bf(lo) | (f2bf(hi) << 16); }
__device__ __forceinline__ float wave_sum(float v) {
#pragma unroll
    for (int o = 1; o < 64; o <<= 1) v += __shfl_xor(v, o);
    return v;
}
__device__ __forceinline__ float wave_max(float v) {
#pragma unroll
    for (int o = 1; o < 64; o <<= 1) v = fmaxf(v, __shfl_xor(v, o));
    return v;
}
__device__ __forceinline__ float sigmoidf_(float x) { return 1.0f / (1.0f + expf(-x)); }

#define XB_TMO      128
#define XB_XCNT(j)  (256  + 64 * (j))
#define XB_XSUB(j)  (1280 + 64 * (j))
#define XB_XGEN(j)  (2304 + 64 * (j))
#define XB_TOP      3328
#define XB_TOPGEN   3392
#define XCD_BAR_WORDS 3456
#define XB_SPIN_CAP (1u << 18)
__device__ __forceinline__ unsigned xb_ld(unsigned* p)              { return __hip_atomic_load(p, __ATOMIC_RELAXED, __HIP_MEMORY_SCOPE_AGENT); }
__device__ __forceinline__ unsigned xb_add(unsigned* p, unsigned v) { return __hip_atomic_fetch_add(p, v, __ATOMIC_RELAXED, __HIP_MEMORY_SCOPE_AGENT); }
__device__ __forceinline__ unsigned xb_xcc_id() { return (unsigned)__builtin_amdgcn_s_getreg((3 << 11) | 20) & 0xFu; }
#define XB_SPIN(cond, bar) do { unsigned _sp = 0; while (cond) { __builtin_amdgcn_s_sleep(1); \
    if ((++_sp & 255u) == 0u) { if (xb_ld(&(bar)[XB_TMO])) break; if (_sp > XB_SPIN_CAP) { atomicAdd(&(bar)[XB_TMO], 1u); break; } } } } while (0)
struct XcdBarrier { unsigned* bar; unsigned x; volatile LAS unsigned* st; };
__device__ __forceinline__ XcdBarrier xcd_barrier_post(unsigned* bar, volatile LAS unsigned* st) {
    XcdBarrier b; b.bar = bar; b.x = xb_xcc_id(); b.st = st;
    if (threadIdx.x == 0) (void)xb_add(&bar[XB_XCNT(b.x)], 1u);
    return b;
}
__device__ __forceinline__ void xcd_barrier_complete(unsigned* bar, unsigned x, unsigned& nloc, unsigned& nx) {
    const unsigned G = gridDim.x * gridDim.y * gridDim.z;
    unsigned sum, cnt, mine, sp = 0u;
    for (;;) {
        sum = 0u; cnt = 0u; mine = 0u;
#pragma unroll
        for (unsigned j = 0; j < 16; ++j) { const unsigned c = xb_ld(&bar[XB_XCNT(j)]); sum += c; cnt += (c > 0u) ? 1u : 0u; mine = (j == x) ? c : mine; }
        if (sum == G) break;
        __builtin_amdgcn_s_sleep(1);
        if ((++sp & 255u) == 0u) { if (xb_ld(&bar[XB_TMO])) break; if (sp > XB_SPIN_CAP) { atomicAdd(&bar[XB_TMO], 1u); break; } }
    }
    nloc = mine > 0u ? mine : 1u; nx = cnt > 0u ? cnt : 1u;
}
__device__ __forceinline__ void xcd_barrier(const XcdBarrier& b) {
    asm volatile("s_waitcnt vmcnt(0)" ::: "memory");
    __syncthreads();
    if (threadIdx.x == 0) {
        unsigned* bar = b.bar;
        __builtin_amdgcn_s_waitcnt(0);
        unsigned nloc = b.st[0], nx = b.st[1];
        if (nloc == 0u) { xcd_barrier_complete(bar, b.x, nloc, nx); b.st[0] = nloc; b.st[1] = nx; }
        const unsigned old = xb_add(&bar[XB_XSUB(b.x)], 1u);
        const unsigned gen = old / nloc;
        if (old + 1u == (gen + 1u) * nloc) {
            __builtin_amdgcn_fence(__ATOMIC_RELEASE, "agent");
            asm volatile("s_waitcnt vmcnt(0)" ::: "memory");
            const unsigned og = xb_add(&bar[XB_TOP], 1u);
            const unsigned tg = og / nx;
            if (og + 1u == (tg + 1u) * nx) xb_add(&bar[XB_TOPGEN], 1u);
            else XB_SPIN(xb_ld(&bar[XB_TOPGEN]) == tg, bar);
            __builtin_amdgcn_fence(__ATOMIC_ACQUIRE, "agent");
            xb_add(&bar[XB_XGEN(b.x)], 1u);
            asm volatile("s_waitcnt vmcnt(0)" ::: "memory");
        } else {
            XB_SPIN(xb_ld(&bar[XB_XGEN(b.x)]) == gen, bar);
            __builtin_amdgcn_fence(__ATOMIC_ACQUIRE, "agent");
            asm volatile("s_waitcnt vmcnt(0)" ::: "memory");
        }
    }
    __syncthreads();
}

constexpr int RING_BYTES = 131072, MISC_OFF = RING_BYTES + 320, LDS_BYTES = 147456;
struct Args { const float* in[29]; float* out; unsigned char* ws; int ph_lo, ph_hi; };
enum In { I_X = 0, I_META, I_WAB, I_WOAB, I_SINK, I_LRE, I_LIM, I_LSTEP, I_BRE, I_BIM, I_CRE, I_CIM, I_S5D, I_WGLU, I_BGLU, I_WC, I_WOC, I_LB, I_NORMG,
          I_LNMG, I_LNMB, I_LNFG, I_LNFB, I_WGRP, I_BGRP, I_WEXP, I_BEXP, I_WGU, I_WD };
struct Ctx { LAS unsigned char* lds; unsigned char* ldsg; int tid, lane, wave, bid, nblk, gw, ngw; };

__device__ __forceinline__ int rowmap_gu(int n) { return n < 512 ? ((n >> 7) * 256 + (n & 127)) : (((n - 512) >> 7) * 256 + 128 + ((n - 512) & 127)); }
__device__ __forceinline__ void transpose_item(const float* W, int K, int N, bf16* WT, LAS float* scr, int kb, int nb, int lane, int mode) {
    const int k0 = 64 * kb, n0 = 32 * nb;
#pragma unroll 8
    for (int i = 0; i < 32; ++i) { const int kk = 2 * i + (lane >> 5); scr[kk * 33 + (lane & 31)] = W[(size_t)(k0 + kk) * N + n0 + (lane & 31)]; }
    LDS_WAIT(); asm volatile("" ::: "memory");
    const int c = lane & 7;
#pragma unroll
    for (int j = 0; j < 4; ++j) { const int n = (lane >> 3) + 8 * j; const LAS float* s = scr + (8 * c) * 33 + n;
        v4u o; o.x = pk2(s[0 * 33], s[1 * 33]); o.y = pk2(s[2 * 33], s[3 * 33]); o.z = pk2(s[4 * 33], s[5 * 33]); o.w = pk2(s[6 * 33], s[7 * 33]);
        const int nn = n0 + n; const int row = mode ? rowmap_gu(nn) : nn;
        *(v4u*)(WT + (size_t)row * K + k0 + 8 * c) = o; }
    LDS_WAIT(); asm volatile("" ::: "memory");
}
__device__ __forceinline__ void conv_family(const Ctx& c, const float* src, bf16* dst, int B, int K, int N, int mode) {
    LAS float* scr = (LAS float*)(c.lds + c.wave * 16384);
    const int nkb = K / 64, nnb = N / 32; const long per = (long)nkb * nnb, total = per * B;
    for (long it = c.gw; it < total; it += c.ngw) {
        const int b = (int)(it / per); const int r = (int)(it % per); const int kb = r / nnb, nb = r % nnb;
        transpose_item(src + (size_t)b * K * N, K, N, dst + (size_t)b * K * N, scr, kb, nb, c.lane, mode);
    }
}
__device__ __forceinline__ void phase_weights(const Ctx& c, const Args& a) {
    unsigned char* ws = a.ws;
    conv_family(c, a.in[I_WAB], (bf16*)(ws + WS_WAB), 1, D, ABN, 0);
    conv_family(c, a.in[I_WOAB], (bf16*)(ws + WS_WOAB), 1, D, D, 0);
    conv_family(c, a.in[I_WGLU], (bf16*)(ws + WS_WGLU), 1, 1024, 1024, 0);
    conv_family(c, a.in[I_WC], (bf16*)(ws + WS_WC), 1, D, CN, 0);
    conv_family(c, a.in[I_WOC], (bf16*)(ws + WS_WOC), 1, D, D, 0);
    conv_family(c, a.in[I_WGU], (bf16*)(ws + WS_WGU), 2 * NEXP, D, 1024, 1);
    conv_family(c, a.in[I_WD], (bf16*)(ws + WS_WD), 2 * NEXP, DEXP, D, 0);
}
__device__ __forceinline__ void phase_init(const Ctx& c, const Args& a) {
    float* H = (float*)(a.ws + WS_HA); bf16* HB = (bf16*)(a.ws + WS_HBF);
    for (int row = c.gw; row < LP; row += c.ngw) {
        const float* src = row < ROWV ? nullptr : (row < 256 ? a.in[I_META] + (size_t)(row - ROWV) * D : a.in[I_X] + (size_t)(row - 256) * D);
#pragma unroll
        for (int j = 0; j < 8; ++j) { const int idx = (j * 64 + c.lane) * 4; f32x4 v = src ? *(const f32x4*)(src + idx) : (f32x4){0.f, 0.f, 0.f, 0.f};
            *(f32x4*)(H + (size_t)row * D + idx) = v; v2u w; w.x = pk2(v.x, v.y); w.y = pk2(v.z, v.w); *(v2u*)(HB + (size_t)row * D + idx) = w; }
    }
    float2* rope = (float2*)(a.ws + WS_ROPE);
    for (long i = (long)c.bid * NTHR + c.tid; i < (long)LP * 64; i += (long)c.nblk * NTHR) {
        const int row = (int)(i >> 6), k = (int)(i & 63);
        const float inv = powf(10000.0f, -(float)k * 2.0f / 128.0f);
        const float ang = (float)(row - ROWV) * inv;
        float s, co; sincosf(ang, &s, &co); rope[i] = make_float2(co, s);
    }
    float2* abar = (float2*)(a.ws + WS_S5P); float2* bbar = abar + 2 * 64 * 64;
    for (int i = c.bid * NTHR + c.tid; i < 2 * 64 * 64; i += c.nblk * NTHR) {
        const int dg = i >> 6;
        const double lr = fmin((double)a.in[I_LRE][i], -1e-4), li = (double)a.in[I_LIM][i], st = exp((double)a.in[I_LSTEP][dg]);
        const double er = exp(lr * st), ar = er * cos(li * st), ai = er * sin(li * st);
        const double den = lr * lr + li * li, cr = ((ar - 1.0) * lr + ai * li) / den, ci = (ai * lr - (ar - 1.0) * li) / den;
        abar[i] = make_float2((float)ar, (float)ai);
        for (int cc = 0; cc < 16; ++cc) { const double br = a.in[I_BRE][(size_t)i * 16 + cc], bi = a.in[I_BIM][(size_t)i * 16 + cc];
            bbar[(size_t)i * 16 + cc] = make_float2((float)(cr * br - ci * bi), (float)(cr * bi + ci * br)); }
    }
}
__device__ __forceinline__ void phase_rope(const Ctx& c, const Args& a) {
    float* P = (float*)(a.ws + WS_PROJ0); const float2* rope = (const float2*)(a.ws + WS_ROPE);
    for (long i = (long)c.bid * NTHR + c.tid; i < (long)NVALID * 640; i += (long)c.nblk * NTHR) {
        const int row = ROWV + (int)(i / 640), r = (int)(i % 640), hs = r >> 6, k = r & 63;
        const float2 cs = rope[(size_t)row * 64 + k];
        float* p = P + (size_t)row * ABN + hs * 128 + k;
        const float x1 = p[0], x2 = p[64];
        p[0] = x1 * cs.x - x2 * cs.y; p[64] = x2 * cs.x + x1 * cs.y;
    }
}
__device__ __forceinline__ void phase_attn_naive(const Ctx& c, const Args& a) {
    const float* P = (const float*)(a.ws + WS_PROJ0); bf16* MI = (bf16*)(a.ws + WS_MIXIN);
    LAS float* qs = (LAS float*)(c.lds + c.wave * 16384); LAS float* ps = qs + 128;
    const float scale = 0.08838834764831845f;
    for (int T = c.gw; T < NVALID * 8; T += c.ngw) {
        const int row = ROWV + (T >> 3), h = T & 7, g = h >> 2;
        const float* pr = P + (size_t)row * ABN;
        qs[c.lane] = pr[h * 128 + c.lane]; qs[c.lane + 64] = pr[h * 128 + 64 + c.lane];
        LDS_WAIT(); asm volatile("" ::: "memory");
        int lo, hi;
        if (row < 256) { lo = 256; hi = row + 128; } else { lo = row - 128 < 256 ? 256 : row - 128; hi = row + 128 > LP - 1 ? LP - 1 : row + 128; }
        const int nk = 16 + (hi - lo + 1);
        const float sink = a.in[I_SINK][h];
        float sc[5]; float mx = sink;
#pragma unroll
        for (int s = 0; s < 5; ++s) { const int j = s * 64 + c.lane; sc[s] = -3.0e38f;
            if (j < nk) { const int kr = j < 16 ? ROWV + j : lo + j - 16; const float* kp = P + (size_t)kr * ABN + 1024 + g * 128; float d = 0.f;
                for (int e = 0; e < 128; e += 4) { const f32x4 kv = *(const f32x4*)(kp + e); d += kv.x * qs[e] + kv.y * qs[e + 1] + kv.z * qs[e + 2] + kv.w * qs[e + 3]; }
                sc[s] = d * scale; mx = fmaxf(mx, sc[s]); } }
        mx = wave_max(mx);
        float den = 0.f;
#pragma unroll
        for (int s = 0; s < 5; ++s) { const int j = s * 64 + c.lane; if (j < nk) { const float e = expf(sc[s] - mx); den += e; ps[j] = e; } }
        den = wave_sum(den) + expf(sink - mx);
        LDS_WAIT(); asm volatile("" ::: "memory");
        float o0 = 0.f, o1 = 0.f;
        for (int j = 0; j < nk; ++j) { const int kr = j < 16 ? ROWV + j : lo + j - 16; const float* vp = P + (size_t)kr * ABN + 1280 + g * 128; const float p = ps[j];
            o0 += p * vp[c.lane]; o1 += p * vp[c.lane + 64]; }
        const float inv = 1.0f / den;
        MI[(size_t)row * D + h * 128 + c.lane] = (bf16)f2bf(o0 * inv); MI[(size_t)row * D + h * 128 + 64 + c.lane] = (bf16)f2bf(o1 * inv);
        LDS_WAIT(); asm volatile("" ::: "memory");
    }
    for (int i = c.bid * NTHR + c.tid; i < ROWV * D / 8; i += c.nblk * NTHR) ((v4u*)MI)[i] = (v4u){0u, 0u, 0u, 0u};
}
__device__ __forceinline__ void phase_s5_scan_naive(const Ctx& c, const Args& a) {
    if (c.gw >= 128) return;
    const int dir = c.gw >> 6, g = c.gw & 63, p = c.lane;
    const float* P = (const float*)(a.ws + WS_PROJ0);
    const float2* abar = (const float2*)(a.ws + WS_S5P); const float2* bbar = abar + 2 * 64 * 64;
    float2* XS = (float2*)(a.ws + WS_R1 + R1_XS) + (size_t)dir * LP * 4096;
    const int idx = (dir * 64 + g) * 64 + p;
    const float2 ab = abar[idx]; float2 bb[16];
#pragma unroll
    for (int cc = 0; cc < 16; ++cc) bb[cc] = bbar[(size_t)idx * 16 + cc];
    float xr = 0.f, xi = 0.f;
#pragma unroll 4
    for (int st = 0; st < NVALID; ++st) {
        const int row = dir == 0 ? ROWV + st : LP - 1 - st;
        const float* up = P + (size_t)row * ABN + 1536 + g * 16;
        float br = 0.f, bi = 0.f;
#pragma unroll
        for (int q = 0; q < 4; ++q) { const f32x4 u = *(const f32x4*)(up + q * 4);
            br += u.x * bb[q * 4].x + u.y * bb[q * 4 + 1].x + u.z * bb[q * 4 + 2].x + u.w * bb[q * 4 + 3].x;
            bi += u.x * bb[q * 4].y + u.y * bb[q * 4 + 1].y + u.z * bb[q * 4 + 2].y + u.w * bb[q * 4 + 3].y; }
        const float nr = ab.x * xr - ab.y * xi + br, ni = ab.x * xi + ab.y * xr + bi;
        xr = nr; xi = ni;
        XS[(size_t)row * 4096 + g * 64 + p] = make_float2(xr, xi);
    }
}
__device__ __forceinline__ void phase_s5_y_naive(const Ctx& c, const Args& a) {
    const float* P = (const float*)(a.ws + WS_PROJ0);
    const float2* XS = (const float2*)(a.ws + WS_R1 + R1_XS);
    float* Z = (float*)(a.ws + WS_Z); bf16* ZB = (bf16*)(a.ws + WS_ZB);
    for (long i = (long)c.bid * NTHR + c.tid; i < (long)LP * 1024; i += (long)c.nblk * NTHR) {
        const int row = (int)(i >> 10), ch = (int)(i & 1023), g = ch >> 4, cc = ch & 15;
        float z = 0.f;
        if (row >= ROWV) {
            float y = P[(size_t)row * ABN + 1536 + ch] * a.in[I_S5D][ch];
            for (int dir = 0; dir < 2; ++dir) {
                const float2* xp = XS + ((size_t)dir * LP + row) * 4096 + g * 64;
                const float* cr = a.in[I_CRE] + ((size_t)(dir * 64 + g) * 16 + cc) * 64; const float* ci = a.in[I_CIM] + ((size_t)(dir * 64 + g) * 16 + cc) * 64;
                for (int p = 0; p < 64; ++p) { const float2 x = xp[p]; y += x.x * cr[p] - x.y * ci[p]; }
            }
            const float t = tanhf(0.7978845608028654f * (y + 0.044715f * y * y * y));
            z = 0.5f * y * (1.0f + t);
        }
        Z[i] = z; ZB[i] = (bf16)f2bf(z);
    }
}
__device__ __forceinline__ void phase_s5_gate(const Ctx& c, const Args& a) {
    const float* Z = (const float*)(a.ws + WS_Z); const float* G = (const float*)(a.ws + WS_GLU); bf16* MI = (bf16*)(a.ws + WS_MIXIN);
    for (long i = (long)c.bid * NTHR + c.tid; i < (long)LP * 1024; i += (long)c.nblk * NTHR) {
        const int row = (int)(i >> 10), ch = (int)(i & 1023);
        float o = 0.f;
        if (row >= ROWV) o = Z[i] * sigmoidf_(G[i] + a.in[I_BGLU][ch]);
        MI[(size_t)row * D + 1024 + ch] = (bf16)f2bf(o);
    }
}
__device__ __forceinline__ void ln_row(const float* hin, const float* add, const float* y0, float w0, const float* y1, float w1, const float* gam, const float* bet,
                                       float* hout, bf16* hb, float* dout, int lane) {
    f32x4 v[8]; float s = 0.f;
#pragma unroll
    for (int j = 0; j < 8; ++j) { const int idx = (j * 64 + lane) * 4; f32x4 x = *(const f32x4*)(hin + idx) * DN_ALPHA;
        if (add) x += *(const f32x4*)(add + idx);
        if (y0) x += *(const f32x4*)(y0 + idx) * w0 + *(const f32x4*)(y1 + idx) * w1;
        v[j] = x; s += (x.x + x.y) + (x.z + x.w); }
    const float mean = wave_sum(s) * (1.0f / D); float q = 0.f;
#pragma unroll
    for (int j = 0; j < 8; ++j) { v[j] = v[j] - mean; q += (v[j].x * v[j].x + v[j].y * v[j].y) + (v[j].z * v[j].z + v[j].w * v[j].w); }
    const float rstd = 1.0f / sqrtf(wave_sum(q) * (1.0f / D) + LN_EPS);
#pragma unroll
    for (int j = 0; j < 8; ++j) { const int idx = (j * 64 + lane) * 4; const f32x4 o = v[j] * rstd * *(const f32x4*)(gam + idx) + *(const f32x4*)(bet + idx);
        if (hout) *(f32x4*)(hout + idx) = o;
        if (hb) { v2u w; w.x = pk2(o.x, o.y); w.y = pk2(o.z, o.w); *(v2u*)(hb + idx) = w; }
        if (dout) *(f32x4*)(dout + idx) = o; }
}
__device__ __forceinline__ void phase_ln_mix(const Ctx& c, const Args& a, int layer, const float* Hin, float* Hout) {
    const float* MIX = (const float*)(a.ws + WS_MIX); bf16* HB = (bf16*)(a.ws + WS_HBF);
    for (int row = c.gw; row < LP; row += c.ngw)
        ln_row(Hin + (size_t)row * D, MIX + (size_t)row * D, nullptr, 0.f, nullptr, 0.f, a.in[I_LNMG] + layer * D, a.in[I_LNMB] + layer * D, Hout + (size_t)row * D, HB + (size_t)row * D, nullptr, c.lane);
}
__device__ __forceinline__ void phase_ln_ffn(const Ctx& c, const Args& a, int layer, const float* Hin, float* Hout, bool last) {
    const float* Y = (const float*)(a.ws + WS_R1 + R1_Y); bf16* HB = (bf16*)(a.ws + WS_HBF);
    const int* route = (const int*)(a.ws + WS_ROUTE);
    for (int row = c.gw; row < LP; row += c.ngw) {
        const float* y0 = nullptr; const float* y1 = nullptr; float w0 = 0.f, w1 = 0.f;
        if (row >= ROWV) { const int* r = route + (size_t)row * 8; y0 = Y + (size_t)r[4] * D; y1 = Y + (size_t)r[5] * D; w0 = __int_as_float(r[6]); w1 = __int_as_float(r[7]); }
        float* dout = (last && row >= 256) ? a.out + (size_t)(row - 256) * D : nullptr;
        if (row >= ROWV) ln_row(Hin + (size_t)row * D, nullptr, y0, w0, y1, w1, a.in[I_LNFG] + layer * D, a.in[I_LNFB] + layer * D, last ? nullptr : Hout + (size_t)row * D, last ? nullptr : HB + (size_t)row * D, dout, c.lane);
        else if (!last) ln_row(Hin + (size_t)row * D, nullptr, nullptr, 0.f, nullptr, 0.f, a.in[I_LNFG] + layer * D, a.in[I_LNFB] + layer * D, Hout + (size_t)row * D, HB + (size_t)row * D, nullptr, c.lane);
    }
}
__device__ __forceinline__ void phase_router(const Ctx& c, const Args& a, int layer, const float* Hn) {
    LAS float* lg = (LAS float*)c.lds;
    const float* wg = a.in[I_WGRP] + (size_t)layer * D * 8; const float* we = a.in[I_WEXP] + (size_t)layer * D * 64;
    const float* bg = a.in[I_BGRP] + layer * 8; const float* be = a.in[I_BEXP] + layer * 64;
    int* route = (int*)(a.ws + WS_ROUTE); unsigned* cnt = (unsigned*)(a.ws + WS_CTL) + CW_CNT + layer * 64;
    const int ntask = (NVALID + 6) / 7;
    for (int task = c.bid; task < ntask; task += c.nblk) {
        const int rr = c.tid / 72, j = c.tid % 72, row = ROWV + task * 7 + rr;
        if (c.tid < 504 && row < LP) {
            const float* h = Hn + (size_t)row * D; float acc0 = 0.f, acc1 = 0.f, acc2 = 0.f, acc3 = 0.f;
            if (j < 8) { for (int k = 0; k < D; k += 4) { acc0 += h[k] * wg[(size_t)k * 8 + j]; acc1 += h[k + 1] * wg[(size_t)(k + 1) * 8 + j]; acc2 += h[k + 2] * wg[(size_t)(k + 2) * 8 + j]; acc3 += h[k + 3] * wg[(size_t)(k + 3) * 8 + j]; } }
            else { const int e = j - 8; for (int k = 0; k < D; k += 4) { acc0 += h[k] * we[(size_t)k * 64 + e]; acc1 += h[k + 1] * we[(size_t)(k + 1) * 64 + e]; acc2 += h[k + 2] * we[(size_t)(k + 2) * 64 + e]; acc3 += h[k + 3] * we[(size_t)(k + 3) * 64 + e]; } }
            lg[rr * 72 + j] = (acc0 + acc1) + (acc2 + acc3) + (j < 8 ? bg[j] : be[j - 8]);
        }
        __syncthreads();
        if (c.tid < 7) { const int row2 = ROWV + task * 7 + c.tid;
            if (row2 < LP) { const LAS float* l = lg + c.tid * 72;
                int grp = 0; float gm = l[0];
                for (int q = 1; q < 8; ++q) if (l[q] > gm) { gm = l[q]; grp = q; }
                float gs = 0.f; for (int q = 0; q < 8; ++q) gs += expf(l[q] - gm);
                const float pg = 1.0f / gs;
                const LAS float* el = l + 8 + grp * 8;
                int i0 = 0; float v0 = el[0]; for (int q = 1; q < 8; ++q) if (el[q] > v0) { v0 = el[q]; i0 = q; }
                int i1 = -1; float v1 = -3.0e38f; for (int q = 0; q < 8; ++q) if (q != i0 && el[q] > v1) { v1 = el[q]; i1 = q; }
                const float e1 = expf(v1 - v0), w0 = pg / (1.0f + e1), w1 = pg * e1 / (1.0f + e1);
                const int ex0 = grp * 8 + i0, ex1 = grp * 8 + i1;
                const int p0 = (int)atomicAdd(cnt + ex0, 1u), p1 = (int)atomicAdd(cnt + ex1, 1u);
                int* r = route + (size_t)row2 * 8; r[0] = ex0; r[1] = ex1; r[2] = p0; r[3] = p1; r[6] = __float_as_int(w0); r[7] = __float_as_int(w1); } }
        __syncthreads();
    }
}
__device__ __forceinline__ void phase_plan(const Ctx& c, const Args& a, int layer) {
    if (c.bid != 0 || c.tid != 0) return;
    const unsigned* cnt = (const unsigned*)(a.ws + WS_CTL) + CW_CNT + layer * 64; int* plan = (int*)(a.ws + WS_CTL) + CW_PLAN + layer * 512;
    int t = 0;
    for (int e = 0; e < NEXP; ++e) { const int n = (int)cnt[e], nt = (n + 255) / 256; plan[1 + e] = t * 256; for (int q = 0; q < nt; ++q) plan[128 + t + q] = e; t += nt; }
    plan[0] = t;
}
__device__ __forceinline__ void phase_gather(const Ctx& c, const Args& a, int layer) {
    const int* plan = (const int*)(a.ws + WS_CTL) + CW_PLAN + layer * 512; int* route = (int*)(a.ws + WS_ROUTE);
    const bf16* HB = (const bf16*)(a.ws + WS_HBF); bf16* XS = (bf16*)(a.ws + WS_R1 + R1_XSRT);
    for (int T = c.gw; T < NVALID * 2; T += c.ngw) {
        const int row = ROWV + (T >> 1), j = T & 1; int* r = route + (size_t)row * 8;
        const int slot = plan[1 + r[j]] + r[2 + j];
        if (c.lane == 0) r[4 + j] = slot;
        const v4u* s = (const v4u*)(HB + (size_t)row * D); v4u* d = (v4u*)(XS + (size_t)slot * D);
#pragma unroll
        for (int q = 0; q < 4; ++q) d[q * 64 + c.lane] = s[q * 64 + c.lane];
    }
}
__device__ __forceinline__ void phase_hg_prep(const Ctx& c, const Args& a) {
    float* P = (float*)(a.ws + WS_R1 + R1_PROJ1);
    for (long i = (long)c.bid * NTHR + c.tid; i < (long)NVALID * 4096; i += (long)c.nblk * NTHR) {
        const int row = ROWV + (int)(i >> 12), cc = (int)(i & 4095), ch = cc & 2047;
        const float l0 = a.in[I_LB][ch], l1 = a.in[I_LB][D + ch], lb = 1.0f / (1.0f + expf(l0 - l1));
        float* p = P + (size_t)row * CN + 4096 + cc;
        *p = lb + (1.0f - lb) * sigmoidf_(*p);
    }
}
__device__ __forceinline__ void phase_hg_rec_naive(const Ctx& c, const Args& a) {
    if (c.bid >= 32) return;
    const int dir = c.bid >> 4, head = c.bid & 15, v = c.tid >> 2, kq = c.tid & 3;
    const float* P = (const float*)(a.ws + WS_R1 + R1_PROJ1);
    float* O = (float*)(a.ws + WS_R1 + (dir == 0 ? R1_OFW : R1_OBW));
    float S[32];
#pragma unroll
    for (int k = 0; k < 32; ++k) S[k] = 0.f;
    const int fcol = (dir == 0 ? 4096 : 6144) + head * 128 + kq * 32, qcol = head * 128 + kq * 32, vcol = 2048 + head * 128 + v;
    for (int st = 0; st < NVALID; ++st) {
        const int row = dir == 0 ? ROWV + st : LP - 1 - st;
        const float* base = P + (size_t)row * CN;
        const float vv = base[vcol]; float o = 0.f;
#pragma unroll
        for (int k4 = 0; k4 < 8; ++k4) { const f32x4 f = *(const f32x4*)(base + fcol + k4 * 4), q = *(const f32x4*)(base + qcol + k4 * 4);
            S[k4 * 4 + 0] = f.x * S[k4 * 4 + 0] + (1.0f - f.x) * vv; o += S[k4 * 4 + 0] * q.x;
            S[k4 * 4 + 1] = f.y * S[k4 * 4 + 1] + (1.0f - f.y) * vv; o += S[k4 * 4 + 1] * q.y;
            S[k4 * 4 + 2] = f.z * S[k4 * 4 + 2] + (1.0f - f.z) * vv; o += S[k4 * 4 + 2] * q.z;
            S[k4 * 4 + 3] = f.w * S[k4 * 4 + 3] + (1.0f - f.w) * vv; o += S[k4 * 4 + 3] * q.w; }
        o += __shfl_xor(o, 1); o += __shfl_xor(o, 2);
        if (kq == 0) O[(size_t)row * D + head * 128 + v] = o;
    }
}
__device__ __forceinline__ void phase_hg_finish(const Ctx& c, const Args& a) {
    const float* P = (const float*)(a.ws + WS_R1 + R1_PROJ1);
    const float* OF = (const float*)(a.ws + WS_R1 + R1_OFW); const float* OB = (const float*)(a.ws + WS_R1 + R1_OBW); bf16* MI = (bf16*)(a.ws + WS_MIXIN);
    for (int T = c.gw; T < LP * 16; T += c.ngw) {
        const int row = T >> 4, head = T & 15; const size_t off = (size_t)row * D + head * 128;
        float r0 = 0.f, r1 = 0.f;
        if (row >= ROWV) {
            const float o0 = OF[off + c.lane] + OB[off + c.lane], o1 = OF[off + 64 + c.lane] + OB[off + 64 + c.lane];
            const float ss = wave_sum(o0 * o0 + o1 * o1), rs = 1.0f / sqrtf(ss * (1.0f / 128.0f) + 1e-6f);
            const float* gp = P + (size_t)row * CN + 8192 + head * 128; const float* ng = a.in[I_NORMG] + head * 128;
            r0 = o0 * rs * ng[c.lane] * sigmoidf_(gp[c.lane]); r1 = o1 * rs * ng[64 + c.lane] * sigmoidf_(gp[64 + c.lane]);
        }
        MI[off + c.lane] = (bf16)f2bf(r0); MI[off + 64 + c.lane] = (bf16)f2bf(r1);
    }
}

constexpr int NPHASE = 40;
__global__ void __launch_bounds__(NTHR, 2) fwd(Args args) {
    extern __shared__ __attribute__((aligned(16))) unsigned char lds[];
    Ctx c; c.lds = (LAS unsigned char*)lds; c.ldsg = lds; c.tid = threadIdx.x; c.lane = c.tid & 63; c.wave = __builtin_amdgcn_readfirstlane(c.tid >> 6);
    c.bid = blockIdx.x; c.nblk = gridDim.x; c.gw = c.bid * NWAVES + c.wave; c.ngw = c.nblk * NWAVES;
    volatile LAS unsigned* MISC = (volatile LAS unsigned*)(c.lds + MISC_OFF);
    for (int u = c.tid; u < (LDS_BYTES - RING_BYTES) / 4; u += NTHR) ((LAS unsigned*)(c.lds + RING_BYTES))[u] = 0u;
    __syncthreads();
    const int lo = args.ph_lo, hi = args.ph_hi;
    const bool multi = (hi - lo) > 1;
    XcdBarrier bar; bar.bar = (unsigned*)(args.ws + WS_CTL) + CW_BAR; bar.x = 0; bar.st = nullptr;
    if (multi) bar = xcd_barrier_post((unsigned*)(args.ws + WS_CTL) + CW_BAR, MISC + 8);
#define IN(k) (lo <= (k) && (k) < hi)
#define SEAM(k) do { if (IN(k) && IN((k) + 1)) xcd_barrier(bar); } while (0)
    unsigned char* ws = args.ws;
    float* HA = (float*)(ws + WS_HA); float* HBuf = (float*)(ws + WS_HB);
    const pg8::bf16_t* HBF = (const pg8::bf16_t*)(ws + WS_HBF);
    const pg8::bf16_t* MIXIN = (const pg8::bf16_t*)(ws + WS_MIXIN);
    if (IN(0)) { phase_weights(c, args); } SEAM(0);
    if (IN(1)) { phase_init(c, args); } SEAM(1);
    if (IN(2)) { pg8::Gemm g{HBF, (const pg8::bf16_t*)(ws + WS_WAB), LP, ABN, D, 0}; pg8::StaticOrder S; S.init(LP, ABN, c.nblk, c.bid);
        pg8::EpiF32 E{(float*)(ws + WS_PROJ0), ABN}; pg8::gemm_phase(c.lds, g, S, E); } SEAM(2);
    if (IN(3)) { phase_rope(c, args); } SEAM(3);
    if (IN(4)) { phase_attn_naive(c, args); } SEAM(4);
    if (IN(5)) { phase_s5_scan_naive(c, args); } SEAM(5);
    if (IN(6)) { phase_s5_y_naive(c, args); } SEAM(6);
    if (IN(7)) { pg8::Gemm g{(const pg8::bf16_t*)(ws + WS_ZB), (const pg8::bf16_t*)(ws + WS_WGLU), LP, 1024, 1024, 0}; pg8::StaticOrder S; S.init(LP, 1024, c.nblk, c.bid);
        pg8::EpiF32 E{(float*)(ws + WS_GLU), 1024}; pg8::gemm_phase(c.lds, g, S, E); } SEAM(7);
    if (IN(8)) { phase_s5_gate(c, args); } SEAM(8);
    if (IN(9)) { pg8::Gemm g{MIXIN, (const pg8::bf16_t*)(ws + WS_WOAB), LP, D, D, 0}; pg8::StaticOrder S; S.init(LP, D, c.nblk, c.bid);
        pg8::EpiF32 E{(float*)(ws + WS_MIX), D}; pg8::gemm_phase(c.lds, g, S, E); } SEAM(9);
    if (IN(10)) { phase_ln_mix(c, args, 0, HA, HBuf); } SEAM(10);
    if (IN(11)) { phase_router(c, args, 0, HBuf); } SEAM(11);
    if (IN(12)) { phase_plan(c, args, 0); } SEAM(12);
    if (IN(13)) { phase_gather(c, args, 0); } SEAM(13);
    if (IN(14)) { pg8::Gemm g{(const pg8::bf16_t*)(ws + WS_R1 + R1_XSRT), (const pg8::bf16_t*)(ws + WS_WGU), MPAD, 1024, D, (size_t)1024 * D * 2}; pg8::GroupedOrder S; S.init((const int*)(ws + WS_CTL) + CW_PLAN, 1024, c.nblk, c.bid);
        pg8::EpiSwiGLU E{(pg8::bf16_t*)(ws + WS_R1 + R1_ACT), DEXP}; pg8::gemm_phase(c.lds, g, S, E); } SEAM(14);
    if (IN(15)) { pg8::Gemm g{(const pg8::bf16_t*)(ws + WS_R1 + R1_ACT), (const pg8::bf16_t*)(ws + WS_WD), MPAD, D, DEXP, (size_t)D * DEXP * 2}; pg8::GroupedOrder S; S.init((const int*)(ws + WS_CTL) + CW_PLAN, D, c.nblk, c.bid);
        pg8::EpiF32 E{(float*)(ws + WS_R1 + R1_Y), D}; pg8::gemm_phase(c.lds, g, S, E); } SEAM(15);
    if (IN(16)) { phase_ln_ffn(c, args, 0, HBuf, HA, false); } SEAM(16);
    if (IN(17)) { pg8::Gemm g{HBF, (const pg8::bf16_t*)(ws + WS_WC), LP, CN, D, 0}; pg8::StaticOrder S; S.init(LP, CN, c.nblk, c.bid);
        pg8::EpiF32 E{(float*)(ws + WS_R1 + R1_PROJ1), CN}; pg8::gemm_phase(c.lds, g, S, E); } SEAM(17);
    if (IN(18)) { phase_hg_prep(c, args); } SEAM(18);
    if (IN(19)) { phase_hg_rec_naive(c, args); } SEAM(19);
    if (IN(20)) { phase_hg_finish(c, args); } SEAM(20);
    if (IN(21)) { pg8::Gemm g{MIXIN, (const pg8::bf16_t*)(ws + WS_WOC), LP, D, D, 0}; pg8::StaticOrder S; S.init(LP, D, c.nblk, c.bid);
        pg8::EpiF32 E{(float*)(ws + WS_MIX), D}; pg8::gemm_phase(c.lds, g, S, E); } SEAM(21);
    if (IN(22)) { phase_ln_mix(c, args, 1, HA, HBuf); } SEAM(22);
    if (IN(23)) { phase_router(c, args, 1, HBuf); } SEAM(23);
    if (IN(24)) { phase_plan(c, args, 1); } SEAM(24);
    if (IN(25)) { phase_gather(c, args, 1); } SEAM(25);
    if (IN(26)) { pg8::Gemm g{(const pg8::bf16_t*)(ws + WS_R1 + R1_XSRT), (const pg8::bf16_t*)(ws + WS_WGU) + (size_t)NEXP * 1024 * D, MPAD, 1024, D, (size_t)1024 * D * 2}; pg8::GroupedOrder S; S.init((const int*)(ws + WS_CTL) + CW_PLAN + 512, 1024, c.nblk, c.bid);
        pg8::EpiSwiGLU E{(pg8::bf16_t*)(ws + WS_R1 + R1_ACT), DEXP}; pg8::gemm_phase(c.lds, g, S, E); } SEAM(26);
    if (IN(27)) { pg8::Gemm g{(const pg8::bf16_t*)(ws + WS_R1 + R1_ACT), (const pg8::bf16_t*)(ws + WS_WD) + (size_t)NEXP * D * DEXP, MPAD, D, DEXP, (size_t)D * DEXP * 2}; pg8::GroupedOrder S; S.init((const int*)(ws + WS_CTL) + CW_PLAN + 512, D, c.nblk, c.bid);
        pg8::EpiF32 E{(float*)(ws + WS_R1 + R1_Y), D}; pg8::gemm_phase(c.lds, g, S, E); } SEAM(27);
    if (IN(28)) { phase_ln_ffn(c, args, 1, HBuf, HA, true); }
#undef IN
#undef SEAM
}
constexpr int LAST_PHASE = 28;

extern "C" void kernel_launch(void* const* d_in, const int* in_sizes, int n_in, void* d_out, int out_size, void* d_ws, size_t ws_size, hipStream_t stream) {
    static int grid = 0;
    if (grid == 0) {
        if (n_in != 29 || ws_size < WS_END) { fprintf(stderr, "kernel_launch: expected 29 inputs and >= %zu bytes of workspace (got %d, %zu)\n", (size_t)WS_END, n_in, ws_size); grid = -1; return; }
        int dev = 0, cus = 0, per_cu = 0;
        if (hipGetDevice(&dev) != hipSuccess || hipDeviceGetAttribute(&cus, hipDeviceAttributeMultiprocessorCount, dev) != hipSuccess) { grid = -1; return; }
        if (hipFuncSetAttribute((const void*)fwd, hipFuncAttributeMaxDynamicSharedMemorySize, LDS_BYTES) != hipSuccess) { fprintf(stderr, "kernel_launch: hipFuncSetAttribute failed\n"); grid = -1; return; }
        if (hipOccupancyMaxActiveBlocksPerMultiprocessor(&per_cu, (const void*)fwd, NTHR, LDS_BYTES) != hipSuccess || per_cu < 1) fprintf(stderr, "kernel_launch: occupancy query says %d\n", per_cu);
        (void)hipGetLastError();
        grid = cus;
    }
    if (grid < 0) return;
    (void)hipMemsetAsync((char*)d_ws + WS_CTL, 0, CTL_BYTES, stream);
    Args a{};
    for (int i = 0; i < 29; ++i) a.in[i] = (const float*)d_in[i];
    a.out = (float*)d_out; a.ws = (unsigned char*)d_ws;
    for (int p = 0; p <= LAST_PHASE; ++p) {
        a.ph_lo = p; a.ph_hi = p + 1;
        hipLaunchKernelGGL(fwd, dim3(grid), dim3(NTHR), LDS_BYTES, stream, a);
    }
}
```

```cpp
#include <hip/hip_runtime.h>
#include <cstdio>
#include <cstdint>

namespace pg8 {
#define PG8_LAS __attribute__((address_space(3)))
typedef unsigned short bf16_t;
typedef short bf16x8 __attribute__((ext_vector_type(8)));
typedef float f32x4 __attribute__((ext_vector_type(4)));
typedef unsigned u32x4 __attribute__((ext_vector_type(4)));
constexpr int BM = 256, BK = 64, HALF = 128, HTB = HALF * BK * 2, STAGE_BYTES = 8 * HTB, NXCD = 8, WGM = 8;

__host__ __device__ __forceinline__ int lds_byte(int r, int c) { const int st = (r >> 4) * 2 + (c >> 5), rr = r & 15, cc = c & 31, ob = rr * 64 + cc * 2; return st * 1024 + (ob ^ (((ob >> 9) & 1) << 5)); }
__host__ __device__ __forceinline__ void stage_rc(int b, int& R, int& C) { const int st = b / 1024, sb = b % 1024, swz = sb ^ (((sb >> 9) & 1) << 5); R = (st >> 1) * 16 + swz / 64; C = (st & 1) * 32 + (swz % 64) / 2; }
__host__ __device__ __forceinline__ int perm32(int rho) { const int n = rho >> 4, i = rho & 15; return 8 * (i >> 2) + 4 * n + (i & 3); }

struct Unit { int pm, pn, eb; };
struct Gemm { const bf16_t* A; const bf16_t* Bt; int M, N, K; size_t bstride; };

struct StaticOrder {
    int nM, nN, nwg, G, c;
    __host__ __device__ void init(int M, int N, int G_, int c_) { nM = M / BM; nN = N / BM; nwg = nM * nN; G = G_; c = c_; }
    __host__ __device__ bool next(int i, Unit& u) const {
        const long L = (long)i * G + c; if (L >= nwg) return false;
        int wgid = (int)L; { const int q = nwg / NXCD, r = nwg % NXCD, xcd = wgid % NXCD, off = wgid / NXCD; wgid = (xcd < r ? xcd * (q + 1) : r * (q + 1) + (xcd - r) * q) + off; }
        const int nig = WGM * nN, gid = wgid / nig, fm = gid * WGM, gsz = (nM - fm) < WGM ? (nM - fm) : WGM;
        u.pm = fm + ((wgid % nig) % gsz); u.pn = (wgid % nig) / gsz; u.eb = 0; return true;
    }
    __device__ __forceinline__ void a_ready(const Unit&) const {}
    __device__ __forceinline__ void done(const Unit&) const {}
};
struct GroupedOrder {
    int ntiles, nN, nwg, G, c; const int* tile_expert;
    __device__ void init(const int* plan, int N, int G_, int c_) { ntiles = plan[0]; tile_expert = plan + 128; nN = N / BM; nwg = ntiles * nN; G = G_; c = c_; }
    __device__ bool next(int i, Unit& u) const {
        const long L = (long)i * G + c; if (L >= nwg) return false;
        u.pm = (int)(L / nN); u.pn = (int)(L % nN); u.eb = tile_expert[u.pm]; return true;
    }
    __device__ __forceinline__ void a_ready(const Unit&) const {}
    __device__ __forceinline__ void done(const Unit&) const {}
};

__device__ __forceinline__ unsigned cvt_pk_bf16(float lo, float hi) { unsigned r; asm volatile("v_cvt_pk_bf16_f32 %0, %1, %2" : "=v"(r) : "v"(lo), "v"(hi)); return r; }

struct EpiF32 {
    static constexpr bool PERM = false, AFTER_DRAIN = false;
    float* C; int ldc;
    __device__ __forceinline__ void operator()(const f32x4 (&acc)[2][2][4][2], const Unit& u, int wr, int wc, int fr, int fq) const {
        const int row0 = u.pm * BM + wr * 64 + fr, col0 = u.pn * BM + wc * 32 + 4 * fq;
#pragma unroll
        for (int ai = 0; ai < 2; ++ai)
#pragma unroll
            for (int m = 0; m < 4; ++m) { float* rowp = C + (size_t)(row0 + ai * HALF + m * 16) * ldc + col0;
#pragma unroll
                for (int bj = 0; bj < 2; ++bj)
#pragma unroll
                    for (int n = 0; n < 2; ++n) *(f32x4*)(rowp + bj * HALF + n * 16) = acc[ai][bj][m][n]; }
    }
};
struct EpiSwiGLU {
    static constexpr bool PERM = true, AFTER_DRAIN = false;
    bf16_t* O; int ldc;
    __device__ __forceinline__ void operator()(const f32x4 (&acc)[2][2][4][2], const Unit& u, int wr, int wc, int fr, int fq) const {
        const int row0 = u.pm * BM + wr * 64 + fr, col0 = u.pn * HALF + wc * 32 + 8 * fq;
#pragma unroll
        for (int ai = 0; ai < 2; ++ai)
#pragma unroll
            for (int m = 0; m < 4; ++m) { bf16_t* rowp = O + (size_t)(row0 + ai * HALF + m * 16) * ldc + col0;
                float r[8];
#pragma unroll
                for (int n = 0; n < 2; ++n)
#pragma unroll
                    for (int i = 0; i < 4; ++i) { const float g = acc[ai][0][m][n][i], up = acc[ai][1][m][n][i]; r[n * 4 + i] = g / (1.0f + __expf(-g)) * up; }
                u32x4 w; w.x = cvt_pk_bf16(r[0], r[1]); w.y = cvt_pk_bf16(r[2], r[3]); w.z = cvt_pk_bf16(r[4], r[5]); w.w = cvt_pk_bf16(r[6], r[7]);
                *(u32x4*)rowp = w; }
    }
};

template <class Epi, class Sched>
__device__ __forceinline__ void gemm_phase(PG8_LAS unsigned char* lds, const Gemm g, const Sched& S, const Epi& E) {
    const int tid = threadIdx.x, wid = __builtin_amdgcn_readfirstlane(tid >> 6), lane = tid & 63, wr = wid >> 2, wc = wid & 3, fr = lane & 15, fq = lane >> 4;
    const int K = g.K, nt = K / BK;
    unsigned voffA[2], voffB[2];
#pragma unroll
    for (int i = 0; i < 2; ++i) { int R, C; stage_rc(tid * 16 + i * 8192, R, C); const int Rb = Epi::PERM ? ((R & ~31) + perm32(R & 31)) : R;
        voffA[i] = (unsigned)(R * K + C) * 2u; voffB[i] = (unsigned)(Rb * K + C) * 2u; }
    const size_t kstep = (size_t)(BK * 2);
    const size_t hstep = (size_t)HALF * K * 2;
    const size_t tstep = 2 * hstep;
    const unsigned ldsw = (unsigned)wid * 1024u;
    const int aoff = lds_byte(wr * 64 + fr, fq * 8), boff = lds_byte(wc * 32 + fr, fq * 8);
#define PG8_SA(b, h) (((b) * 2 + (h)) * HTB)
#define PG8_SB(b, h) ((4 + (b) * 2 + (h)) * HTB)
#define PG8_STAGE(bufoff, gbase, voff) do { _Pragma("unroll") for (int _i = 0; _i < 2; ++_i) \
        __builtin_amdgcn_global_load_lds((const unsigned*)((const char*)(gbase) + (voff)[_i]), (PG8_LAS unsigned*)(lds + (bufoff) + ldsw + _i * 8192), 16, 0, 0); } while (0)
#define PG8_LDA(dst, b, h) do { _Pragma("unroll") for (int m = 0; m < 4; ++m) _Pragma("unroll") for (int k = 0; k < 2; ++k) dst[m][k] = *(const PG8_LAS bf16x8*)(lds + PG8_SA(b, h) + aoff + m * 2048 + k * 1024); } while (0)
#define PG8_LDB(dst, b, h) do { _Pragma("unroll") for (int n = 0; n < 2; ++n) _Pragma("unroll") for (int k = 0; k < 2; ++k) dst[n][k] = *(const PG8_LAS bf16x8*)(lds + PG8_SB(b, h) + boff + n * 2048 + k * 1024); } while (0)
#define PG8_MMA(ai, bj, At, Bt) do { __builtin_amdgcn_s_setprio(1); _Pragma("unroll") for (int m = 0; m < 4; ++m) _Pragma("unroll") for (int n = 0; n < 2; ++n) _Pragma("unroll") for (int k = 0; k < 2; ++k) \
        acc[ai][bj][m][n] = __builtin_amdgcn_mfma_f32_16x16x32_bf16(Bt[n][k], At[m][k], acc[ai][bj][m][n], 0, 0, 0); __builtin_amdgcn_s_setprio(0); } while (0)
#define PG8_WAIT_V(n) asm volatile("s_waitcnt vmcnt(" #n ")" ::: "memory")
#define PG8_WAIT_L(n) asm volatile("s_waitcnt lgkmcnt(" #n ")" ::: "memory")
#define PG8_BAR __builtin_amdgcn_s_barrier()
#define PG8_SCHED __builtin_amdgcn_sched_barrier(0)
    Unit cur, nxt; int ui = 0;
    if (!S.next(0, cur)) return;
    f32x4 acc[2][2][4][2];
#pragma unroll
    for (int a = 0; a < 2; ++a)
#pragma unroll
        for (int b = 0; b < 2; ++b)
#pragma unroll
            for (int m = 0; m < 4; ++m)
#pragma unroll
                for (int n = 0; n < 2; ++n) acc[a][b][m][n] = (f32x4){0.f, 0.f, 0.f, 0.f};
    bf16x8 At[4][2], B0[2][2], B1[2][2];
    const char* cA = (const char*)g.A + (size_t)cur.pm * tstep; const char* cB = (const char*)g.Bt + (size_t)cur.eb * g.bstride + (size_t)cur.pn * tstep;
    S.a_ready(cur);
    PG8_STAGE(PG8_SB(0, 0), cB, voffB); PG8_STAGE(PG8_SA(0, 0), cA, voffA); PG8_STAGE(PG8_SB(0, 1), cB + hstep, voffB); PG8_STAGE(PG8_SA(0, 1), cA + hstep, voffA);
    if (wr == 1) PG8_BAR;
    PG8_WAIT_V(4); PG8_BAR;
    PG8_STAGE(PG8_SB(1, 0), cB + kstep, voffB); PG8_STAGE(PG8_SA(1, 0), cA + kstep, voffA); PG8_STAGE(PG8_SB(1, 1), cB + hstep + kstep, voffB);
    PG8_WAIT_V(6); PG8_BAR;
    for (;;) {
        const bool has_next = S.next(ui + 1, nxt);
        const char* nA = has_next ? (const char*)g.A + (size_t)nxt.pm * tstep : cA; const char* nB = has_next ? (const char*)g.Bt + (size_t)nxt.eb * g.bstride + (size_t)nxt.pn * tstep : cB;
        for (int t = 0; t < nt; t += 2) {
            const bool last = (t == nt - 2);
            const char* a1 = cA + (size_t)(t + 1) * kstep;
            const char* a2 = last ? nA : cA + (size_t)(t + 2) * kstep; const char* b2 = last ? nB : cB + (size_t)(t + 2) * kstep;
            const char* a3 = a2 + kstep; const char* b3 = b2 + kstep;
            if (last && has_next) S.a_ready(nxt);
            PG8_LDB(B0, 0, 0); PG8_SCHED; PG8_LDA(At, 0, 0); PG8_STAGE(PG8_SA(1, 1), a1 + hstep, voffA);
            PG8_WAIT_L(8); PG8_BAR; PG8_WAIT_L(0); PG8_MMA(0, 0, At, B0); PG8_BAR; PG8_SCHED;
            PG8_LDB(B1, 0, 1); PG8_STAGE(PG8_SB(0, 0), b2, voffB);
            PG8_BAR; PG8_WAIT_L(0); PG8_MMA(0, 1, At, B1); PG8_BAR;
            PG8_LDA(At, 0, 1); PG8_STAGE(PG8_SA(0, 0), a2, voffA);
            PG8_BAR; PG8_WAIT_L(0); PG8_MMA(1, 0, At, B0); PG8_BAR; PG8_SCHED;
            PG8_STAGE(PG8_SB(0, 1), b2 + hstep, voffB);
            PG8_WAIT_V(6); PG8_BAR; PG8_MMA(1, 1, At, B1); PG8_BAR;
            PG8_LDB(B0, 1, 0); PG8_SCHED; PG8_LDA(At, 1, 0); PG8_STAGE(PG8_SA(0, 1), a2 + hstep, voffA);
            PG8_WAIT_L(8); PG8_BAR; PG8_WAIT_L(0); PG8_MMA(0, 0, At, B0); PG8_BAR; PG8_SCHED;
            PG8_LDB(B1, 1, 1); PG8_STAGE(PG8_SB(1, 0), b3, voffB);
            PG8_BAR; PG8_WAIT_L(0); PG8_MMA(0, 1, At, B1); PG8_BAR;
            PG8_LDA(At, 1, 1); PG8_STAGE(PG8_SA(1, 0), a3, voffA);
            PG8_BAR; PG8_WAIT_L(0); PG8_MMA(1, 0, At, B0); PG8_BAR; PG8_SCHED;
            PG8_STAGE(PG8_SB(1, 1), b3 + hstep, voffB);
            PG8_WAIT_V(6); PG8_BAR; PG8_MMA(1, 1, At, B1); PG8_BAR;
        }
        E(acc, cur, wr, wc, fr, fq); S.done(cur);
        if (!has_next) break;
#pragma unroll
        for (int a = 0; a < 2; ++a)
#pragma unroll
            for (int b = 0; b < 2; ++b)
#pragma unroll
                for (int m = 0; m < 4; ++m)
#pragma unroll
                    for (int n = 0; n < 2; ++n) acc[a][b][m][n] = (f32x4){0.f, 0.f, 0.f, 0.f};
        cur = nxt; cA = nA; cB = nB; ++ui;
    }
    PG8_WAIT_V(0);
    if (wr == 0) PG8_BAR;
    PG8_BAR;
#undef PG8_SA
#undef PG8_SB
#undef PG8_STAGE
#undef PG8_LDA
#undef PG8_LDB
#undef PG8_MMA
#undef PG8_WAIT_V
#undef PG8_WAIT_L
#undef PG8_BAR
#undef PG8_SCHED
}
}

constexpr int D = 2048, SEQ = 16384, NMETA = 16;
constexpr int LP = 16640;
constexpr int ROWV = 240;
constexpr int NVALID = 16400;
constexpr int ABN = 2560, CN = 10240;
constexpr int NEXP = 64, DEXP = 512;
constexpr int MAXTILES = 192, MPAD = MAXTILES * 256;
constexpr float DN_ALPHA = 1.4142135623730951f;
constexpr float LN_EPS = 1e-5f;
constexpr int NWAVES = 8, NTHR = 512;

constexpr size_t al(size_t x) { return (x + 0xFFFFFull) & ~(size_t)0xFFFFFull; }
constexpr size_t WS_CTL = 0, CTL_BYTES = 1u << 20;
constexpr size_t WS_WAB = al(WS_CTL + CTL_BYTES);
constexpr size_t WS_WOAB = al(WS_WAB + (size_t)ABN * D * 2);
constexpr size_t WS_WGLU = al(WS_WOAB + (size_t)D * D * 2);
constexpr size_t WS_WC = al(WS_WGLU + (size_t)1024 * 1024 * 2);
constexpr size_t WS_WOC = al(WS_WC + (size_t)CN * D * 2);
constexpr size_t WS_WGU = al(WS_WOC + (size_t)D * D * 2);
constexpr size_t WS_WD = al(WS_WGU + (size_t)2 * NEXP * 1024 * D * 2);
constexpr size_t WS_HA = al(WS_WD + (size_t)2 * NEXP * D * DEXP * 2);
constexpr size_t WS_HB = al(WS_HA + (size_t)LP * D * 4);
constexpr size_t WS_HBF = al(WS_HB + (size_t)LP * D * 4);
constexpr size_t WS_PROJ0 = al(WS_HBF + (size_t)LP * D * 2);
constexpr size_t WS_MIXIN = al(WS_PROJ0 + (size_t)LP * ABN * 4);
constexpr size_t WS_MIX = al(WS_MIXIN + (size_t)LP * D * 2);
constexpr size_t WS_Z = al(WS_MIX + (size_t)LP * D * 4);
constexpr size_t WS_ZB = al(WS_Z + (size_t)LP * 1024 * 4);
constexpr size_t WS_GLU = al(WS_ZB + (size_t)LP * 1024 * 2);
constexpr size_t WS_S5P = al(WS_GLU + (size_t)LP * 1024 * 4);
constexpr size_t WS_ROPE = al(WS_S5P + (size_t)(2 * 64 * 64 * 8 + 2 * 64 * 64 * 16 * 8));
constexpr size_t WS_ROUTE = al(WS_ROPE + (size_t)LP * 64 * 8);
constexpr size_t WS_R1 = al(WS_ROUTE + (size_t)LP * 32);
constexpr size_t R1_BYTES = (size_t)2 * LP * 4096 * 8;
constexpr size_t WS_END = WS_R1 + R1_BYTES;
constexpr size_t R1_XS = 0;
constexpr size_t R1_PROJ1 = 0;
constexpr size_t R1_OFW = al((size_t)LP * CN * 4);
constexpr size_t R1_OBW = al(R1_OFW + (size_t)LP * D * 4);
constexpr size_t R1_HG_END = R1_OBW + (size_t)LP * D * 4;
constexpr size_t R1_XSRT = 0;
constexpr size_t R1_ACT = al((size_t)MPAD * D * 2);
constexpr size_t R1_Y = al(R1_ACT + (size_t)MPAD * DEXP * 2);
constexpr size_t R1_MOE_END = R1_Y + (size_t)MPAD * D * 4;
static_assert(R1_HG_END <= R1_BYTES && R1_MOE_END <= R1_BYTES, "R1 overlays");
static_assert(WS_END <= (size_t)4 << 30, "workspace map must fit 4 GiB");
constexpr int CW_BAR = 4096;
constexpr int CW_CNT = 16384;
constexpr int CW_PLAN = 32768;

#define LAS __attribute__((address_space(3)))
typedef unsigned short bf16;
typedef unsigned v4u __attribute__((ext_vector_type(4)));
typedef unsigned v2u __attribute__((ext_vector_type(2)));
typedef float f32x4 __attribute__((ext_vector_type(4)));
#define LDS_WAIT() asm volatile("s_waitcnt lgkmcnt(0)" ::: "memory")
__device__ __forceinline__ unsigned f2bf(float f) { unsigned u = __builtin_bit_cast(unsigned, f); return (u + 0x7fffu + ((u >> 16) & 1u)) >> 16; }
__device__ __forceinline__ unsigned pk2(float lo, float hi) { return f2bf(lo) | (f2bf(hi) << 16); }
__device__ __forceinline__ float wave_sum(float v) {
#pragma unroll
    for (int o = 1; o < 64; o <<= 1) v += __shfl_xor(v, o);
    return v;
}
__device__ __forceinline__ float wave_max(float v) {
#pragma unroll
    for (int o = 1; o < 64; o <<= 1) v = fmaxf(v, __shfl_xor(v, o));
    return v;
}
__device__ __forceinline__ float sigmoidf_(float x) { return 1.0f / (1.0f + expf(-x)); }

#define XB_TMO      128
#define XB_XCNT(j)  (256  + 64 * (j))
#define XB_XSUB(j)  (1280 + 64 * (j))
#define XB_XGEN(j)  (2304 + 64 * (j))
#define XB_TOP      3328
#define XB_TOPGEN   3392
#define XCD_BAR_WORDS 3456
#define XB_SPIN_CAP (1u << 22)
__device__ __forceinline__ unsigned xb_ld(unsigned* p)              { return __hip_atomic_load(p, __ATOMIC_RELAXED, __HIP_MEMORY_SCOPE_AGENT); }
__device__ __forceinline__ unsigned xb_add(unsigned* p, unsigned v) { return __hip_atomic_fetch_add(p, v, __ATOMIC_RELAXED, __HIP_MEMORY_SCOPE_AGENT); }
__device__ __forceinline__ unsigned xb_xcc_id() { return (unsigned)__builtin_amdgcn_s_getreg((3 << 11) | 20) & 0xFu; }
#define XB_SPIN(cond, bar) do { unsigned _sp = 0; while (cond) { __builtin_amdgcn_s_sleep(1); \
    if ((++_sp & 255u) == 0u) { if (xb_ld(&(bar)[XB_TMO])) break; if (_sp > XB_SPIN_CAP) { atomicAdd(&(bar)[XB_TMO], 1u); break; } } } } while (0)
struct XcdBarrier { unsigned* bar; unsigned x; volatile LAS unsigned* st; };
__device__ __forceinline__ XcdBarrier xcd_barrier_post(unsigned* bar, volatile LAS unsigned* st) {
    XcdBarrier b; b.bar = bar; b.x = xb_xcc_id(); b.st = st;
    if (threadIdx.x == 0) (void)xb_add(&bar[XB_XCNT(b.x)], 1u);
    return b;
}
__device__ __forceinline__ void xcd_barrier_complete(unsigned* bar, unsigned x, unsigned& nloc, unsigned& nx) {
    const unsigned G = gridDim.x * gridDim.y * gridDim.z;
    unsigned sum, cnt, mine, sp = 0u;
    for (;;) {
        sum = 0u; cnt = 0u; mine = 0u;
#pragma unroll
        for (unsigned j = 0; j < 16; ++j) { const unsigned c = xb_ld(&bar[XB_XCNT(j)]); sum += c; cnt += (c > 0u) ? 1u : 0u; mine = (j == x) ? c : mine; }
        if (sum == G) break;
        __builtin_amdgcn_s_sleep(1);
        if ((++sp & 255u) == 0u) { if (xb_ld(&bar[XB_TMO])) break; if (sp > XB_SPIN_CAP) { atomicAdd(&bar[XB_TMO], 1u); break; } }
    }
    nloc = mine > 0u ? mine : 1u; nx = cnt > 0u ? cnt : 1u;
}
__device__ __forceinline__ void xcd_barrier(const XcdBarrier& b) {
    asm volatile("s_waitcnt vmcnt(0)" ::: "memory");
    __syncthreads();
    if (threadIdx.x == 0) {
        unsigned* bar = b.bar;
        __builtin_amdgcn_s_waitcnt(0);
        unsigned nloc = b.st[0], nx = b.st[1];
        if (nloc == 0u) { xcd_barrier_complete(bar, b.x, nloc, nx); b.st[0] = nloc; b.st[1] = nx; }
        const unsigned old = xb_add(&bar[XB_XSUB(b.x)], 1u);
        const unsigned gen = old / nloc;
        if (old + 1u == (gen + 1u) * nloc) {
            __builtin_amdgcn_fence(__ATOMIC_RELEASE, "agent");
            asm volatile("s_waitcnt vmcnt(0)" ::: "memory");
            const unsigned og = xb_add(&bar[XB_TOP], 1u);
            const unsigned tg = og / nx;
            if (og + 1u == (tg + 1u) * nx) xb_add(&bar[XB_TOPGEN], 1u);
            else XB_SPIN(xb_ld(&bar[XB_TOPGEN]) == tg, bar);
            __builtin_amdgcn_fence(__ATOMIC_ACQUIRE, "agent");
            xb_add(&bar[XB_XGEN(b.x)], 1u);
            asm volatile("s_waitcnt vmcnt(0)" ::: "memory");
        } else {
            XB_SPIN(xb_ld(&bar[XB_XGEN(b.x)]) == gen, bar);
            __builtin_amdgcn_fence(__ATOMIC_ACQUIRE, "agent");
            asm volatile("s_waitcnt vmcnt(0)" ::: "memory");
        }
    }
    __syncthreads();
}

constexpr int RING_BYTES = 131072, MISC_OFF = RING_BYTES + 320, LDS_BYTES = 147456;
struct Args { const float* in[29]; float* out; unsigned char* ws; int ph_lo, ph_hi; };
enum In { I_X = 0, I_META, I_WAB, I_WOAB, I_SINK, I_LRE, I_LIM, I_LSTEP, I_BRE, I_BIM, I_CRE, I_CIM, I_S5D, I_WGLU, I_BGLU, I_WC, I_WOC, I_LB, I_NORMG,
          I_LNMG, I_LNMB, I_LNFG, I_LNFB, I_WGRP, I_BGRP, I_WEXP, I_BEXP, I_WGU, I_WD };
struct Ctx { LAS unsigned char* lds; unsigned char* ldsg; int tid, lane, wave, bid, nblk, gw, ngw; };

__device__ __forceinline__ int rowmap_gu(int n) { return n < 512 ? ((n >> 7) * 256 + (n & 127)) : (((n - 512) >> 7) * 256 + 128 + ((n - 512) & 127)); }
__device__ __forceinline__ void transpose_item(const float* W, int K, int N, bf16* WT, LAS float* scr, int kb, int nb, int lane, int mode) {
    const int k0 = 64 * kb, n0 = 32 * nb;
#pragma unroll 8
    for (int i = 0; i < 32; ++i) { const int kk = 2 * i + (lane >> 5); scr[kk * 33 + (lane & 31)] = W[(size_t)(k0 + kk) * N + n0 + (lane & 31)]; }
    LDS_WAIT(); asm volatile("" ::: "memory");
    const int c = lane & 7;
#pragma unroll
    for (int j = 0; j < 4; ++j) { const int n = (lane >> 3) + 8 * j; const LAS float* s = scr + (8 * c) * 33 + n;
        v4u o; o.x = pk2(s[0 * 33], s[1 * 33]); o.y = pk2(s[2 * 33], s[3 * 33]); o.z = pk2(s[4 * 33], s[5 * 33]); o.w = pk2(s[6 * 33], s[7 * 33]);
        const int nn = n0 + n; const int row = mode ? rowmap_gu(nn) : nn;
        *(v4u*)(WT + (size_t)row * K + k0 + 8 * c) = o; }
    LDS_WAIT(); asm volatile("" ::: "memory");
}
__device__ __forceinline__ void conv_family(const Ctx& c, const float* src, bf16* dst, int B, int K, int N, int mode) {
    LAS float* scr = (LAS float*)(c.lds + c.wave * 16384);
    const int nkb = K / 64, nnb = N / 32; const long per = (long)nkb * nnb, total = per * B;
    for (long it = c.gw; it < total; it += c.ngw) {
        const int b = (int)(it / per); const int r = (int)(it % per); const int kb = r / nnb, nb = r % nnb;
        transpose_item(src + (size_t)b * K * N, K, N, dst + (size_t)b * K * N, scr, kb, nb, c.lane, mode);
    }
}
__device__ __forceinline__ void phase_weights(const Ctx& c, const Args& a) {
    unsigned char* ws = a.ws;
    conv_family(c, a.in[I_WAB], (bf16*)(ws + WS_WAB), 1, D, ABN, 0);
    conv_family(c, a.in[I_WOAB], (bf16*)(ws + WS_WOAB), 1, D, D, 0);
    conv_family(c, a.in[I_WGLU], (bf16*)(ws + WS_WGLU), 1, 1024, 1024, 0);
    conv_family(c, a.in[I_WC], (bf16*)(ws + WS_WC), 1, D, CN, 0);
    conv_family(c, a.in[I_WOC], (bf16*)(ws + WS_WOC), 1, D, D, 0);
    conv_family(c, a.in[I_WGU], (bf16*)(ws + WS_WGU), 2 * NEXP, D, 1024, 1);
    conv_family(c, a.in[I_WD], (bf16*)(ws + WS_WD), 2 * NEXP, DEXP, D, 0);
}
__device__ __forceinline__ void phase_init(const Ctx& c, const Args& a) {
    float* H = (float*)(a.ws + WS_HA); bf16* HB = (bf16*)(a.ws + WS_HBF);
    for (int row = c.gw; row < LP; row += c.ngw) {
        const float* src = row < ROWV ? nullptr : (row < 256 ? a.in[I_META] + (size_t)(row - ROWV) * D : a.in[I_X] + (size_t)(row - 256) * D);
#pragma unroll
        for (int j = 0; j < 8; ++j) { const int idx = (j * 64 + c.lane) * 4; f32x4 v = src ? *(const f32x4*)(src + idx) : (f32x4){0.f, 0.f, 0.f, 0.f};
            *(f32x4*)(H + (size_t)row * D + idx) = v; v2u w; w.x = pk2(v.x, v.y); w.y = pk2(v.z, v.w); *(v2u*)(HB + (size_t)row * D + idx) = w; }
    }
    float2* rope = (float2*)(a.ws + WS_ROPE);
    for (long i = (long)c.bid * NTHR + c.tid; i < (long)LP * 64; i += (long)c.nblk * NTHR) {
        const int row = (int)(i >> 6), k = (int)(i & 63);
        const float inv = powf(10000.0f, -(float)k * 2.0f / 128.0f);
        const float ang = (float)(row - ROWV) * inv;
        float s, co; sincosf(ang, &s, &co); rope[i] = make_float2(co, s);
    }
    float2* abar = (float2*)(a.ws + WS_S5P); float2* bbar = abar + 2 * 64 * 64;
    for (int i = c.bid * NTHR + c.tid; i < 2 * 64 * 64; i += c.nblk * NTHR) {
        const int dg = i >> 6;
        const double lr = fmin((double)a.in[I_LRE][i], -1e-4), li = (double)a.in[I_LIM][i], st = exp((double)a.in[I_LSTEP][dg]);
        const double er = exp(lr * st), ar = er * cos(li * st), ai = er * sin(li * st);
        const double den = lr * lr + li * li, cr = ((ar - 1.0) * lr + ai * li) / den, ci = (ai * lr - (ar - 1.0) * li) / den;
        abar[i] = make_float2((float)ar, (float)ai);
        for (int cc = 0; cc < 16; ++cc) { const double br = a.in[I_BRE][(size_t)i * 16 + cc], bi = a.in[I_BIM][(size_t)i * 16 + cc];
            bbar[(size_t)i * 16 + cc] = make_float2((float)(cr * br - ci * bi), (float)(cr * bi + ci * br)); }
    }
}
__device__ __forceinline__ void phase_rope(const Ctx& c, const Args& a) {
    float* P = (float*)(a.ws + WS_PROJ0); const float2* rope = (const float2*)(a.ws + WS_ROPE);
    for (long i = (long)c.bid * NTHR + c.tid; i < (long)NVALID * 640; i += (long)c.nblk * NTHR) {
        const int row = ROWV + (int)(i / 640), r = (int)(i % 640), hs = r >> 6, k = r & 63;
        const float2 cs = rope[(size_t)row * 64 + k];
        float* p = P + (size_t)row * ABN + hs * 128 + k;
        const float x1 = p[0], x2 = p[64];
        p[0] = x1 * cs.x - x2 * cs.y; p[64] = x2 * cs.x + x1 * cs.y;
    }
}
__device__ __forceinline__ void phase_attn_naive(const Ctx& c, const Args& a) {
    const float* P = (const float*)(a.ws + WS_PROJ0); bf16* MI = (bf16*)(a.ws + WS_MIXIN);
    LAS float* qs = (LAS float*)(c.lds + c.wave * 16384); LAS float* ps = qs + 128;
    const float scale = 0.08838834764831845f;
    for (int T = c.gw; T < NVALID * 8; T += c.ngw) {
        const int row = ROWV + (T >> 3), h = T & 7, g = h >> 2;
        const float* pr = P + (size_t)row * ABN;
        qs[c.lane] = pr[h * 128 + c.lane]; qs[c.lane + 64] = pr[h * 128 + 64 + c.lane];
        LDS_WAIT(); asm volatile("" ::: "memory");
        int lo, hi;
        if (row < 256) { lo = 256; hi = row + 128; } else { lo = row - 128 < 256 ? 256 : row - 128; hi = row + 128 > LP - 1 ? LP - 1 : row + 128; }
        const int nk = 16 + (hi - lo + 1);
        const float sink = a.in[I_SINK][h];
        float sc[5]; float mx = sink;
#pragma unroll
        for (int s = 0; s < 5; ++s) { const int j = s * 64 + c.lane; sc[s] = -3.0e38f;
            if (j < nk) { const int kr = j < 16 ? ROWV + j : lo + j - 16; const float* kp = P + (size_t)kr * ABN + 1024 + g * 128; float d = 0.f;
                for (int e = 0; e < 128; e += 4) { const f32x4 kv = *(const f32x4*)(kp + e); d += kv.x * qs[e] + kv.y * qs[e + 1] + kv.z * qs[e + 2] + kv.w * qs[e + 3]; }
                sc[s] = d * scale; mx = fmaxf(mx, sc[s]); } }
        mx = wave_max(mx);
        float den = 0.f;
#pragma unroll
        for (int s = 0; s < 5; ++s) { const int j = s * 64 + c.lane; if (j < nk) { const float e = expf(sc[s] - mx); den += e; ps[j] = e; } }
        den = wave_sum(den) + expf(sink - mx);
        LDS_WAIT(); asm volatile("" ::: "memory");
        float o0 = 0.f, o1 = 0.f;
        for (int j = 0; j < nk; ++j) { const int kr = j < 16 ? ROWV + j : lo + j - 16; const float* vp = P + (size_t)kr * ABN + 1280 + g * 128; const float p = ps[j];
            o0 += p * vp[c.lane]; o1 += p * vp[c.lane + 64]; }
        const float inv = 1.0f / den;
        MI[(size_t)row * D + h * 128 + c.lane] = (bf16)f2bf(o0 * inv); MI[(size_t)row * D + h * 128 + 64 + c.lane] = (bf16)f2bf(o1 * inv);
        LDS_WAIT(); asm volatile("" ::: "memory");
    }
    for (int i = c.bid * NTHR + c.tid; i < ROWV * D / 8; i += c.nblk * NTHR) ((v4u*)MI)[i] = (v4u){0u, 0u, 0u, 0u};
}
__device__ __forceinline__ void phase_s5_scan_naive(const Ctx& c, const Args& a) {
    if (c.gw >= 128) return;
    const int dir = c.gw >> 6, g = c.gw & 63, p = c.lane;
    const float* P = (const float*)(a.ws + WS_PROJ0);
    const float2* abar = (const float2*)(a.ws + WS_S5P); const float2* bbar = abar + 2 * 64 * 64;
    float2* XS = (float2*)(a.ws + WS_R1 + R1_XS) + (size_t)dir * LP * 4096;
    const int idx = (dir * 64 + g) * 64 + p;
    const float2 ab = abar[idx]; float2 bb[16];
#pragma unroll
    for (int cc = 0; cc < 16; ++cc) bb[cc] = bbar[(size_t)idx * 16 + cc];
    float xr = 0.f, xi = 0.f;
#pragma unroll 4
    for (int st = 0; st < NVALID; ++st) {
        const int row = dir == 0 ? ROWV + st : LP - 1 - st;
        const float* up = P + (size_t)row * ABN + 1536 + g * 16;
        float br = 0.f, bi = 0.f;
#pragma unroll
        for (int q = 0; q < 4; ++q) { const f32x4 u = *(const f32x4*)(up + q * 4);
            br += u.x * bb[q * 4].x + u.y * bb[q * 4 + 1].x + u.z * bb[q * 4 + 2].x + u.w * bb[q * 4 + 3].x;
            bi += u.x * bb[q * 4].y + u.y * bb[q * 4 + 1].y + u.z * bb[q * 4 + 2].y + u.w * bb[q * 4 + 3].y; }
        const float nr = ab.x * xr - ab.y * xi + br, ni = ab.x * xi + ab.y * xr + bi;
        xr = nr; xi = ni;
        XS[(size_t)row * 4096 + g * 64 + p] = make_float2(xr, xi);
    }
}
__device__ __forceinline__ void phase_s5_y_naive(const Ctx& c, const Args& a) {
    const float* P = (const float*)(a.ws + WS_PROJ0);
    const float2* XS = (const float2*)(a.ws + WS_R1 + R1_XS);
    float* Z = (float*)(a.ws + WS_Z); bf16* ZB = (bf16*)(a.ws + WS_ZB);
    for (long i = (long)c.bid * NTHR + c.tid; i < (long)LP * 1024; i += (long)c.nblk * NTHR) {
        const int row = (int)(i >> 10), ch = (int)(i & 1023), g = ch >> 4, cc = ch & 15;
        float z = 0.f;
        if (row >= ROWV) {
            float y = P[(size_t)row * ABN + 1536 + ch] * a.in[I_S5D][ch];
            for (int dir = 0; dir < 2; ++dir) {
                const float2* xp = XS + ((size_t)dir * LP + row) * 4096 + g * 64;
                const float* cr = a.in[I_CRE] + ((size_t)(dir * 64 + g) * 16 + cc) * 64; const float* ci = a.in[I_CIM] + ((size_t)(dir * 64 + g) * 16 + cc) * 64;
                for (int p = 0; p < 64; ++p) { const float2 x = xp[p]; y += x.x * cr[p] - x.y * ci[p]; }
            }
            const float t = tanhf(0.7978845608028654f * (y + 0.044715f * y * y * y));
            z = 0.5f * y * (1.0f + t);
        }
        Z[i] = z; ZB[i] = (bf16)f2bf(z);
    }
}
__device__ __forceinline__ void phase_s5_gate(const Ctx& c, const Args& a) {
    const float* Z = (const float*)(a.ws + WS_Z); const float* G = (const float*)(a.ws + WS_GLU); bf16* MI = (bf16*)(a.ws + WS_MIXIN);
    for (long i = (long)c.bid * NTHR + c.tid; i < (long)LP * 1024; i += (long)c.nblk * NTHR) {
        const int row = (int)(i >> 10), ch = (int)(i & 1023);
        float o = 0.f;
        if (row >= ROWV) o = Z[i] * sigmoidf_(G[i] + a.in[I_BGLU][ch]);
        MI[(size_t)row * D + 1024 + ch] = (bf16)f2bf(o);
    }
}
__device__ __forceinline__ void ln_row(const float* hin, const float* add, const float* y0, float w0, const float* y1, float w1, const float* gam, const float* bet,
                                       float* hout, bf16* hb, float* dout, int lane) {
    f32x4 v[8]; float s = 0.f;
#pragma unroll
    for (int j = 0; j < 8; ++j) { const int idx = (j * 64 + lane) * 4; f32x4 x = *(const f32x4*)(hin + idx) * DN_ALPHA;
        if (add) x += *(const f32x4*)(add + idx);
        if (y0) x += *(const f32x4*)(y0 + idx) * w0 + *(const f32x4*)(y1 + idx) * w1;
        v[j] = x; s += (x.x + x.y) + (x.z + x.w); }
    const float mean = wave_sum(s) * (1.0f / D); float q = 0.f;
#pragma unroll
    for (int j = 0; j < 8; ++j) { v[j] = v[j] - mean; q += (v[j].x * v[j].x + v[j].y * v[j].y) + (v[j].z * v[j].z + v[j].w * v[j].w); }
    const float rstd = 1.0f / sqrtf(wave_sum(q) * (1.0f / D) + LN_EPS);
#pragma unroll
    for (int j = 0; j < 8; ++j) { const int idx = (j * 64 + lane) * 4; const f32x4 o = v[j] * rstd * *(const f32x4*)(gam + idx) + *(const f32x4*)(bet + idx);
        if (hout) *(f32x4*)(hout + idx) = o;
        if (hb) { v2u w; w.x = pk2(o.x, o.y); w.y = pk2(o.z, o.w); *(v2u*)(hb + idx) = w; }
        if (dout) *(f32x4*)(dout + idx) = o; }
}
__device__ __forceinline__ void phase_ln_mix(const Ctx& c, const Args& a, int layer, const float* Hin, float* Hout) {
    const float* MIX = (const float*)(a.ws + WS_MIX); bf16* HB = (bf16*)(a.ws + WS_HBF);
    for (int row = c.gw; row < LP; row += c.ngw)
        ln_row(Hin + (size_t)row * D, MIX + (size_t)row * D, nullptr, 0.f, nullptr, 0.f, a.in[I_LNMG] + layer * D, a.in[I_LNMB] + layer * D, Hout + (size_t)row * D, HB + (size_t)row * D, nullptr, c.lane);
}
__device__ __forceinline__ void phase_ln_ffn(const Ctx& c, const Args& a, int layer, const float* Hin, float* Hout, bool last) {
    const float* Y = (const float*)(a.ws + WS_R1 + R1_Y); bf16* HB = (bf16*)(a.ws + WS_HBF);
    const int* route = (const int*)(a.ws + WS_ROUTE);
    for (int row = c.gw; row < LP; row += c.ngw) {
        const float* y0 = nullptr; const float* y1 = nullptr; float w0 = 0.f, w1 = 0.f;
        if (row >= ROWV) { const int* r = route + (size_t)row * 8; y0 = Y + (size_t)r[4] * D; y1 = Y + (size_t)r[5] * D; w0 = __int_as_float(r[6]); w1 = __int_as_float(r[7]); }
        float* dout = (last && row >= 256) ? a.out + (size_t)(row - 256) * D : nullptr;
        if (row >= ROWV) ln_row(Hin + (size_t)row * D, nullptr, y0, w0, y1, w1, a.in[I_LNFG] + layer * D, a.in[I_LNFB] + layer * D, last ? nullptr : Hout + (size_t)row * D, last ? nullptr : HB + (size_t)row * D, dout, c.lane);
        else if (!last) ln_row(Hin + (size_t)row * D, nullptr, nullptr, 0.f, nullptr, 0.f, a.in[I_LNFG] + layer * D, a.in[I_LNFB] + layer * D, Hout + (size_t)row * D, HB + (size_t)row * D, nullptr, c.lane);
    }
}
__device__ __forceinline__ void phase_router(const Ctx& c, const Args& a, int layer, const float* Hn) {
    LAS float* lg = (LAS float*)c.lds;
    const float* wg = a.in[I_WGRP] + (size_t)layer * D * 8; const float* we = a.in[I_WEXP] + (size_t)layer * D * 64;
    const float* bg = a.in[I_BGRP] + layer * 8; const float* be = a.in[I_BEXP] + layer * 64;
    int* route = (int*)(a.ws + WS_ROUTE); unsigned* cnt = (unsigned*)(a.ws + WS_CTL) + CW_CNT + layer * 64;
    const int ntask = (NVALID + 6) / 7;
    for (int task = c.bid; task < ntask; task += c.nblk) {
        const int rr = c.tid / 72, j = c.tid % 72, row = ROWV + task * 7 + rr;
        if (c.tid < 504 && row < LP) {
            const float* h = Hn + (size_t)row * D; float acc0 = 0.f, acc1 = 0.f, acc2 = 0.f, acc3 = 0.f;
            if (j < 8) { for (int k = 0; k < D; k += 4) { acc0 += h[k] * wg[(size_t)k * 8 + j]; acc1 += h[k + 1] * wg[(size_t)(k + 1) * 8 + j]; acc2 += h[k + 2] * wg[(size_t)(k + 2) * 8 + j]; acc3 += h[k + 3] * wg[(size_t)(k + 3) * 8 + j]; } }
            else { const int e = j - 8; for (int k = 0; k < D; k += 4) { acc0 += h[k] * we[(size_t)k * 64 + e]; acc1 += h[k + 1] * we[(size_t)(k + 1) * 64 + e]; acc2 += h[k + 2] * we[(size_t)(k + 2) * 64 + e]; acc3 += h[k + 3] * we[(size_t)(k + 3) * 64 + e]; } }
            lg[rr * 72 + j] = (acc0 + acc1) + (acc2 + acc3) + (j < 8 ? bg[j] : be[j - 8]);
        }
        __syncthreads();
        if (c.tid < 7) { const int row2 = ROWV + task * 7 + c.tid;
            if (row2 < LP) { const LAS float* l = lg + c.tid * 72;
                int grp = 0; float gm = l[0];
                for (int q = 1; q < 8; ++q) if (l[q] > gm) { gm = l[q]; grp = q; }
                float gs = 0.f; for (int q = 0; q < 8; ++q) gs += expf(l[q] - gm);
                const float pg = 1.0f / gs;
                const LAS float* el = l + 8 + grp * 8;
                int i0 = 0; float v0 = el[0]; for (int q = 1; q < 8; ++q) if (el[q] > v0) { v0 = el[q]; i0 = q; }
                int i1 = -1; float v1 = -3.0e38f; for (int q = 0; q < 8; ++q) if (q != i0 && el[q] > v1) { v1 = el[q]; i1 = q; }
                const float e1 = expf(v1 - v0), w0 = pg / (1.0f + e1), w1 = pg * e1 / (1.0f + e1);
                const int ex0 = grp * 8 + i0, ex1 = grp * 8 + i1;
                const int p0 = (int)atomicAdd(cnt + ex0, 1u), p1 = (int)atomicAdd(cnt + ex1, 1u);
                int* r = route + (size_t)row2 * 8; r[0] = ex0; r[1] = ex1; r[2] = p0; r[3] = p1; r[6] = __float_as_int(w0); r[7] = __float_as_int(w1); } }
        __syncthreads();
    }
}
__device__ __forceinline__ void phase_plan(const Ctx& c, const Args& a, int layer) {
    if (c.bid != 0 || c.tid != 0) return;
    const unsigned* cnt = (const unsigned*)(a.ws + WS_CTL) + CW_CNT + layer * 64; int* plan = (int*)(a.ws + WS_CTL) + CW_PLAN + layer * 512;
    int t = 0;
    for (int e = 0; e < NEXP; ++e) { const int n = (int)cnt[e], nt = (n + 255) / 256; plan[1 + e] = t * 256; for (int q = 0; q < nt; ++q) plan[128 + t + q] = e; t += nt; }
    plan[0] = t;
}
__device__ __forceinline__ void phase_gather(const Ctx& c, const Args& a, int layer) {
    const int* plan = (const int*)(a.ws + WS_CTL) + CW_PLAN + layer * 512; int* route = (int*)(a.ws + WS_ROUTE);
    const bf16* HB = (const bf16*)(a.ws + WS_HBF); bf16* XS = (bf16*)(a.ws + WS_R1 + R1_XSRT);
    for (int T = c.gw; T < NVALID * 2; T += c.ngw) {
        const int row = ROWV + (T >> 1), j = T & 1; int* r = route + (size_t)row * 8;
        const int slot = plan[1 + r[j]] + r[2 + j];
        if (c.lane == 0) r[4 + j] = slot;
        const v4u* s = (const v4u*)(HB + (size_t)row * D); v4u* d = (v4u*)(XS + (size_t)slot * D);
#pragma unroll
        for (int q = 0; q < 4; ++q) d[q * 64 + c.lane] = s[q * 64 + c.lane];
    }
}
__device__ __forceinline__ void phase_hg_prep(const Ctx& c, const Args& a) {
    float* P = (float*)(a.ws + WS_R1 + R1_PROJ1);
    for (long i = (long)c.bid * NTHR + c.tid; i < (long)NVALID * 4096; i += (long)c.nblk * NTHR) {
        const int row = ROWV + (int)(i >> 12), cc = (int)(i & 4095), ch = cc & 2047;
        const float l0 = a.in[I_LB][ch], l1 = a.in[I_LB][D + ch], lb = 1.0f / (1.0f + expf(l0 - l1));
        float* p = P + (size_t)row * CN + 4096 + cc;
        *p = lb + (1.0f - lb) * sigmoidf_(*p);
    }
}
__device__ __forceinline__ void phase_hg_rec_naive(const Ctx& c, const Args& a) {
    if (c.bid >= 32) return;
    const int dir = c.bid >> 4, head = c.bid & 15, v = c.tid >> 2, kq = c.tid & 3;
    const float* P = (const float*)(a.ws + WS_R1 + R1_PROJ1);
    float* O = (float*)(a.ws + WS_R1 + (dir == 0 ? R1_OFW : R1_OBW));
    float S[32];
#pragma unroll
    for (int k = 0; k < 32; ++k) S[k] = 0.f;
    const int fcol = (dir == 0 ? 4096 : 6144) + head * 128 + kq * 32, qcol = head * 128 + kq * 32, vcol = 2048 + head * 128 + v;
    for (int st = 0; st < NVALID; ++st) {
        const int row = dir == 0 ? ROWV + st : LP - 1 - st;
        const float* base = P + (size_t)row * CN;
        const float vv = base[vcol]; float o = 0.f;
#pragma unroll
        for (int k4 = 0; k4 < 8; ++k4) { const f32x4 f = *(const f32x4*)(base + fcol + k4 * 4), q = *(const f32x4*)(base + qcol + k4 * 4);
            S[k4 * 4 + 0] = f.x * S[k4 * 4 + 0] + (1.0f - f.x) * vv; o += S[k4 * 4 + 0] * q.x;
            S[k4 * 4 + 1] = f.y * S[k4 * 4 + 1] + (1.0f - f.y) * vv; o += S[k4 * 4 + 1] * q.y;
            S[k4 * 4 + 2] = f.z * S[k4 * 4 + 2] + (1.0f - f.z) * vv; o += S[k4 * 4 + 2] * q.z;
            S[k4 * 4 + 3] = f.w * S[k4 * 4 + 3] + (1.0f - f.w) * vv; o += S[k4 * 4 + 3] * q.w; }
        o += __shfl_xor(o, 1); o += __shfl_xor(o, 2);
        if (kq == 0) O[(size_t)row * D + head * 128 + v] = o;
    }
}
__device__ __forceinline__ void phase_hg_finish(const Ctx& c, const Args& a) {
    const float* P = (const float*)(a.ws + WS_R1 + R1_PROJ1);
    const float* OF = (const float*)(a.ws + WS_R1 + R1_OFW); const float* OB = (const float*)(a.ws + WS_R1 + R1_OBW); bf16* MI = (bf16*)(a.ws + WS_MIXIN);
    for (int T = c.gw; T < LP * 16; T += c.ngw) {
        const int row = T >> 4, head = T & 15; const size_t off = (size_t)row * D + head * 128;
        float r0 = 0.f, r1 = 0.f;
        if (row >= ROWV) {
            const float o0 = OF[off + c.lane] + OB[off + c.lane], o1 = OF[off + 64 + c.lane] + OB[off + 64 + c.lane];
            const float ss = wave_sum(o0 * o0 + o1 * o1), rs = 1.0f / sqrtf(ss * (1.0f / 128.0f) + 1e-6f);
            const float* gp = P + (size_t)row * CN + 8192 + head * 128; const float* ng = a.in[I_NORMG] + head * 128;
            r0 = o0 * rs * ng[c.lane] * sigmoidf_(gp[c.lane]); r1 = o1 * rs * ng[64 + c.lane] * sigmoidf_(gp[64 + c.lane]);
        }
        MI[off + c.lane] = (bf16)f2bf(r0); MI[off + 64 + c.lane] = (bf16)f2bf(r1);
    }
}

constexpr int NPHASE = 40;
__global__ void __launch_bounds__(NTHR, 2) fwd(Args args) {
    extern __shared__ __attribute__((aligned(16))) unsigned char lds[];
    Ctx c; c.lds = (LAS unsigned char*)lds; c.ldsg = lds; c.tid = threadIdx.x; c.lane = c.tid & 63; c.wave = __builtin_amdgcn_readfirstlane(c.tid >> 6);
    c.bid = blockIdx.x; c.nblk = gridDim.x; c.gw = c.bid * NWAVES + c.wave; c.ngw = c.nblk * NWAVES;
    volatile LAS unsigned* MISC = (volatile LAS unsigned*)(c.lds + MISC_OFF);
    for (int u = c.tid; u < (LDS_BYTES - RING_BYTES) / 4; u += NTHR) ((LAS unsigned*)(c.lds + RING_BYTES))[u] = 0u;
    __syncthreads();
    const int lo = args.ph_lo, hi = args.ph_hi;
    const bool multi = (hi - lo) > 1;
    XcdBarrier bar; bar.bar = (unsigned*)(args.ws + WS_CTL) + CW_BAR; bar.x = 0; bar.st = nullptr;
    if (multi) bar = xcd_barrier_post((unsigned*)(args.ws + WS_CTL) + CW_BAR, MISC + 8);
#define IN(k) (lo <= (k) && (k) < hi)
#define SEAM(k) do { if (IN(k) && IN((k) + 1)) xcd_barrier(bar); } while (0)
    unsigned char* ws = args.ws;
    float* HA = (float*)(ws + WS_HA); float* HBuf = (float*)(ws + WS_HB);
    const pg8::bf16_t* HBF = (const pg8::bf16_t*)(ws + WS_HBF);
    const pg8::bf16_t* MIXIN = (const pg8::bf16_t*)(ws + WS_MIXIN);
    if (IN(0)) { phase_weights(c, args); } SEAM(0);
    if (IN(1)) { phase_init(c, args); } SEAM(1);
    if (IN(2)) { pg8::Gemm g{HBF, (const pg8::bf16_t*)(ws + WS_WAB), LP, ABN, D, 0}; pg8::StaticOrder S; S.init(LP, ABN, c.nblk, c.bid);
        pg8::EpiF32 E{(float*)(ws + WS_PROJ0), ABN}; pg8::gemm_phase(c.lds, g, S, E); } SEAM(2);
    if (IN(3)) { phase_rope(c, args); } SEAM(3);
    if (IN(4)) { phase_attn_naive(c, args); } SEAM(4);
    if (IN(5)) { phase_s5_scan_naive(c, args); } SEAM(5);
    if (IN(6)) { phase_s5_y_naive(c, args); } SEAM(6);
    if (IN(7)) { pg8::Gemm g{(const pg8::bf16_t*)(ws + WS_ZB), (const pg8::bf16_t*)(ws + WS_WGLU), LP, 1024, 1024, 0}; pg8::StaticOrder S; S.init(LP, 1024, c.nblk, c.bid);
        pg8::EpiF32 E{(float*)(ws + WS_GLU), 1024}; pg8::gemm_phase(c.lds, g, S, E); } SEAM(7);
    if (IN(8)) { phase_s5_gate(c, args); } SEAM(8);
    if (IN(9)) { pg8::Gemm g{MIXIN, (const pg8::bf16_t*)(ws + WS_WOAB), LP, D, D, 0}; pg8::StaticOrder S; S.init(LP, D, c.nblk, c.bid);
        pg8::EpiF32 E{(float*)(ws + WS_MIX), D}; pg8::gemm_phase(c.lds, g, S, E); } SEAM(9);
    if (IN(10)) { phase_ln_mix(c, args, 0, HA, HBuf); } SEAM(10);
    if (IN(11)) { phase_router(c, args, 0, HBuf); } SEAM(11);
    if (IN(12)) { phase_plan(c, args, 0); } SEAM(12);
    if (IN(13)) { phase_gather(c, args, 0); } SEAM(13);
    if (IN(14)) { pg8::Gemm g{(const pg8::bf16_t*)(ws + WS_R1 + R1_XSRT), (const pg8::bf16_t*)(ws + WS_WGU), MPAD, 1024, D, (size_t)1024 * D * 2}; pg8::GroupedOrder S; S.init((const int*)(ws + WS_CTL) + CW_PLAN, 1024, c.nblk, c.bid);
        pg8::EpiSwiGLU E{(pg8::bf16_t*)(ws + WS_R1 + R1_ACT), DEXP}; pg8::gemm_phase(c.lds, g, S, E); } SEAM(14);
    if (IN(15)) { pg8::Gemm g{(const pg8::bf16_t*)(ws + WS_R1 + R1_ACT), (const pg8::bf16_t*)(ws + WS_WD), MPAD, D, DEXP, (size_t)D * DEXP * 2}; pg8::GroupedOrder S; S.init((const int*)(ws + WS_CTL) + CW_PLAN, D, c.nblk, c.bid);
        pg8::EpiF32 E{(float*)(ws + WS_R1 + R1_Y), D}; pg8::gemm_phase(c.lds, g, S, E); } SEAM(15);
    if (IN(16)) { phase_ln_ffn(c, args, 0, HBuf, HA, false); } SEAM(16);
    if (IN(17)) { pg8::Gemm g{HBF, (const pg8::bf16_t*)(ws + WS_WC), LP, CN, D, 0}; pg8::StaticOrder S; S.init(LP, CN, c.nblk, c.bid);
        pg8::EpiF32 E{(float*)(ws + WS_R1 + R1_PROJ1), CN}; pg8::gemm_phase(c.lds, g, S, E); } SEAM(17);
    if (IN(18)) { phase_hg_prep(c, args); } SEAM(18);
    if (IN(19)) { phase_hg_rec_naive(c, args); } SEAM(19);
    if (IN(20)) { phase_hg_finish(c, args); } SEAM(20);
    if (IN(21)) { pg8::Gemm g{MIXIN, (const pg8::bf16_t*)(ws + WS_WOC), LP, D, D, 0}; pg8::StaticOrder S; S.init(LP, D, c.nblk, c.bid);
        pg8::EpiF32 E{(float*)(ws + WS_MIX), D}; pg8::gemm_phase(c.lds, g, S, E); } SEAM(21);
    if (IN(22)) { phase_ln_mix(c, args, 1, HA, HBuf); } SEAM(22);
    if (IN(23)) { phase_router(c, args, 1, HBuf); } SEAM(23);
    if (IN(24)) { phase_plan(c, args, 1); } SEAM(24);
    if (IN(25)) { phase_gather(c, args, 1); } SEAM(25);
    if (IN(26)) { pg8::Gemm g{(const pg8::bf16_t*)(ws + WS_R1 + R1_XSRT), (const pg8::bf16_t*)(ws + WS_WGU) + (size_t)NEXP * 1024 * D, MPAD, 1024, D, (size_t)1024 * D * 2}; pg8::GroupedOrder S; S.init((const int*)(ws + WS_CTL) + CW_PLAN + 512, 1024, c.nblk, c.bid);
        pg8::EpiSwiGLU E{(pg8::bf16_t*)(ws + WS_R1 + R1_ACT), DEXP}; pg8::gemm_phase(c.lds, g, S, E); } SEAM(26);
    if (IN(27)) { pg8::Gemm g{(const pg8::bf16_t*)(ws + WS_R1 + R1_ACT), (const pg8::bf16_t*)(ws + WS_WD) + (size_t)NEXP * D * DEXP, MPAD, D, DEXP, (size_t)D * DEXP * 2}; pg8::GroupedOrder S; S.init((const int*)(ws + WS_CTL) + CW_PLAN + 512, D, c.nblk, c.bid);
        pg8::EpiF32 E{(float*)(ws + WS_R1 + R1_Y), D}; pg8::gemm_phase(c.lds, g, S, E); } SEAM(27);
    if (IN(28)) { phase_ln_ffn(c, args, 1, HBuf, HA, true); }
#undef IN
#undef SEAM
}
constexpr int LAST_PHASE = 28;

extern "C" void kernel_launch(void* const* d_in, const int* in_sizes, int n_in, void* d_out, int out_size, void* d_ws, size_t ws_size, hipStream_t stream) {
    static int grid = 0;
    if (grid == 0) {
        if (n_in != 29 || ws_size < WS_END) { fprintf(stderr, "kernel_launch: expected 29 inputs and >= %zu bytes of workspace (got %d, %zu)\n", (size_t)WS_END, n_in, ws_size); grid = -1; return; }
        int dev = 0, cus = 0, per_cu = 0;
        if (hipGetDevice(&dev) != hipSuccess || hipDeviceGetAttribute(&cus, hipDeviceAttributeMultiprocessorCount, dev) != hipSuccess) { grid = -1; return; }
        if (hipFuncSetAttribute((const void*)fwd, hipFuncAttributeMaxDynamicSharedMemorySize, LDS_BYTES) != hipSuccess) { fprintf(stderr, "kernel_launch: hipFuncSetAttribute failed\n"); grid = -1; return; }
        if (hipOccupancyMaxActiveBlocksPerMultiprocessor(&per_cu, (const void*)fwd, NTHR, LDS_BYTES) != hipSuccess || per_cu < 1) fprintf(stderr, "kernel_launch: occupancy query says %d\n", per_cu);
        (void)hipGetLastError();
        grid = cus;
    }
    if (grid < 0) return;
    (void)hipMemsetAsync((char*)d_ws + WS_CTL, 0, CTL_BYTES, stream);
    Args a{};
    for (int i = 0; i < 29; ++i) a.in[i] = (const float*)d_in[i];
    a.out = (float*)d_out; a.ws = (unsigned char*)d_ws;
#ifndef MK_N_LAUNCHES
#define MK_N_LAUNCHES 1
#endif
    if (MK_N_LAUNCHES == 1) { a.ph_lo = 0; a.ph_hi = LAST_PHASE + 1; hipLaunchKernelGGL(fwd, dim3(grid), dim3(NTHR), LDS_BYTES, stream, a); }
    else for (int p = 0; p <= LAST_PHASE; ++p) {
        a.ph_lo = p; a.ph_hi = p + 1;
        hipLaunchKernelGGL(fwd, dim3(grid), dim3(NTHR), LDS_BYTES, stream, a);
    }
}
```

```cpp
#include <hip/hip_runtime.h>
#include <cstdio>
#include <cstdint>

namespace pg8 {
#define PG8_LAS __attribute__((address_space(3)))
typedef unsigned short bf16_t;
typedef short bf16x8 __attribute__((ext_vector_type(8)));
typedef float f32x4 __attribute__((ext_vector_type(4)));
typedef unsigned u32x4 __attribute__((ext_vector_type(4)));
constexpr int BM = 256, BK = 64, HALF = 128, HTB = HALF * BK * 2, STAGE_BYTES = 8 * HTB, NXCD = 8, WGM = 8;

__host__ __device__ __forceinline__ int lds_byte(int r, int c) { const int st = (r >> 4) * 2 + (c >> 5), rr = r & 15, cc = c & 31, ob = rr * 64 + cc * 2; return st * 1024 + (ob ^ (((ob >> 9) & 1) << 5)); }
__host__ __device__ __forceinline__ void stage_rc(int b, int& R, int& C) { const int st = b / 1024, sb = b % 1024, swz = sb ^ (((sb >> 9) & 1) << 5); R = (st >> 1) * 16 + swz / 64; C = (st & 1) * 32 + (swz % 64) / 2; }
__host__ __device__ __forceinline__ int perm32(int rho) { const int n = rho >> 4, i = rho & 15; return 8 * (i >> 2) + 4 * n + (i & 3); }

struct Unit { int pm, pn, eb; };
struct Gemm { const bf16_t* A; const bf16_t* Bt; int M, N, K, lda, ldb; size_t astride, bstride; };

struct StaticOrder {
    int nM, nN, nwg, G, c;
    __host__ __device__ void init(int M, int N, int G_, int c_) { nM = M / BM; nN = N / BM; nwg = nM * nN; G = G_; c = c_; }
    __host__ __device__ bool next(int i, Unit& u) const {
        const long L = (long)i * G + c; if (L >= nwg) return false;
        int wgid = (int)L; { const int q = nwg / NXCD, r = nwg % NXCD, xcd = wgid % NXCD, off = wgid / NXCD; wgid = (xcd < r ? xcd * (q + 1) : r * (q + 1) + (xcd - r) * q) + off; }
        const int nig = WGM * nN, gid = wgid / nig, fm = gid * WGM, gsz = (nM - fm) < WGM ? (nM - fm) : WGM;
        u.pm = fm + ((wgid % nig) % gsz); u.pn = (wgid % nig) / gsz; u.eb = 0; return true;
    }
    __device__ __forceinline__ void a_ready(const Unit&) const {}
    __device__ __forceinline__ void done(const Unit&) const {}
};
struct GroupedOrder {
    int ntiles, nN, nwg, G, c; const int* tile_expert;
    __device__ void init(const int* plan, int N, int G_, int c_) { ntiles = plan[0]; tile_expert = plan + 128; nN = N / BM; nwg = ntiles * nN; G = G_; c = c_; }
    __device__ bool next(int i, Unit& u) const {
        const long L = (long)i * G + c; if (L >= nwg) return false;
        u.pm = (int)(L / nN); u.pn = (int)(L % nN); u.eb = tile_expert[u.pm]; return true;
    }
    __device__ __forceinline__ void a_ready(const Unit&) const {}
    __device__ __forceinline__ void done(const Unit&) const {}
};

struct GroupTileOrder {
    int nM, nN, nwg, G, c;
    __device__ void init(int groups, int M, int N, int G_, int c_) { nM = M / BM; nN = N / BM; nwg = groups * nM * nN; G = G_; c = c_; }
    __device__ bool next(int i, Unit& u) const {
        const long L = (long)i * G + c; if (L >= nwg) return false;
        const int per = nM * nN, rem = (int)(L % per); u.eb = (int)(L / per); u.pm = rem % nM; u.pn = rem / nM; return true;
    }
    __device__ __forceinline__ void a_ready(const Unit&) const {}
    __device__ __forceinline__ void done(const Unit&) const {}
};
__device__ __forceinline__ unsigned cvt_pk_bf16(float lo, float hi) { unsigned r; asm volatile("v_cvt_pk_bf16_f32 %0, %1, %2" : "=v"(r) : "v"(lo), "v"(hi)); return r; }

struct EpiF32 {
    static constexpr bool PERM = false, AFTER_DRAIN = false;
    float* C; int ldc; size_t cstride;
    __device__ __forceinline__ void operator()(const f32x4 (&acc)[2][2][4][2], const Unit& u, int wr, int wc, int fr, int fq) const {
        const int row0 = u.pm * BM + wr * 64 + fr, col0 = u.pn * BM + wc * 32 + 4 * fq;
#pragma unroll
        for (int ai = 0; ai < 2; ++ai)
#pragma unroll
            for (int m = 0; m < 4; ++m) { float* rowp = C + (size_t)u.eb * cstride + (size_t)(row0 + ai * HALF + m * 16) * ldc + col0;
#pragma unroll
                for (int bj = 0; bj < 2; ++bj)
#pragma unroll
                    for (int n = 0; n < 2; ++n) *(f32x4*)(rowp + bj * HALF + n * 16) = acc[ai][bj][m][n]; }
    }
};
struct EpiSwiGLU {
    static constexpr bool PERM = true, AFTER_DRAIN = false;
    bf16_t* O; int ldc;
    __device__ __forceinline__ void operator()(const f32x4 (&acc)[2][2][4][2], const Unit& u, int wr, int wc, int fr, int fq) const {
        const int row0 = u.pm * BM + wr * 64 + fr, col0 = u.pn * HALF + wc * 32 + 8 * fq;
#pragma unroll
        for (int ai = 0; ai < 2; ++ai)
#pragma unroll
            for (int m = 0; m < 4; ++m) { bf16_t* rowp = O + (size_t)(row0 + ai * HALF + m * 16) * ldc + col0;
                float r[8];
#pragma unroll
                for (int n = 0; n < 2; ++n)
#pragma unroll
                    for (int i = 0; i < 4; ++i) { const float g = acc[ai][0][m][n][i], up = acc[ai][1][m][n][i]; r[n * 4 + i] = g / (1.0f + __expf(-g)) * up; }
                u32x4 w; w.x = cvt_pk_bf16(r[0], r[1]); w.y = cvt_pk_bf16(r[2], r[3]); w.z = cvt_pk_bf16(r[4], r[5]); w.w = cvt_pk_bf16(r[6], r[7]);
                *(u32x4*)rowp = w; }
    }
};

__host__ __device__ __forceinline__ Gemm mkgemm(const void* A, const void* Bt, int M, int N, int K, size_t bstride = 0) { Gemm g; g.A = (const bf16_t*)A; g.Bt = (const bf16_t*)Bt; g.M = M; g.N = N; g.K = K; g.lda = K; g.ldb = K; g.astride = 0; g.bstride = bstride; return g; }
struct EpiProjAB {
    static constexpr bool PERM = false, AFTER_DRAIN = false;
    float* C; bf16_t* UA;
    __device__ __forceinline__ void operator()(const f32x4 (&acc)[2][2][4][2], const Unit& u, int wr, int wc, int fr, int fq) const {
        const int row0 = u.pm * BM + wr * 64 + fr, col0 = u.pn * BM + wc * 32 + 4 * fq;
        if (u.pn < 6) {
#pragma unroll
            for (int ai = 0; ai < 2; ++ai)
#pragma unroll
                for (int m = 0; m < 4; ++m) { float* rowp = C + (size_t)(row0 + ai * HALF + m * 16) * 2560 + col0;
#pragma unroll
                    for (int bj = 0; bj < 2; ++bj)
#pragma unroll
                        for (int n = 0; n < 2; ++n) *(f32x4*)(rowp + bj * HALF + n * 16) = acc[ai][bj][m][n]; }
        } else {
#pragma unroll
            for (int ai = 0; ai < 2; ++ai)
#pragma unroll
                for (int m = 0; m < 4; ++m) { const int row = row0 + ai * HALF + m * 16;
                    if (row >= 224) { const int chunk = (row - 224) >> 5, t = (row - 224) & 31;
#pragma unroll
                        for (int bj = 0; bj < 2; ++bj)
#pragma unroll
                            for (int n = 0; n < 2; ++n) { const int ch = col0 + bj * HALF + n * 16 - 1536, g = ch >> 4, cc = ch & 15; const f32x4 v = acc[ai][bj][m][n];
                                typedef unsigned u32x2 __attribute__((ext_vector_type(2)));
                                u32x2 w; w.x = cvt_pk_bf16(v[0], v[1]); w.y = cvt_pk_bf16(v[2], v[3]);
                                *(u32x2*)(UA + ((size_t)g * 768 + chunk) * 768 + t * 16 + cc) = w; } } }
        }
    }
};
struct EpiS5Y {
    static constexpr bool PERM = false, AFTER_DRAIN = false;
    bf16_t* ZB;
    __device__ __forceinline__ void operator()(const f32x4 (&acc)[2][2][4][2], const Unit& u, int wr, int wc, int fr, int fq) const {
#pragma unroll
        for (int ai = 0; ai < 2; ++ai)
#pragma unroll
            for (int m = 0; m < 4; ++m) { const int chunk = u.pm * BM + ai * HALF + wr * 64 + m * 16 + fr;
                if (chunk <= 512) {
#pragma unroll
                    for (int bj = 0; bj < 2; ++bj)
#pragma unroll
                        for (int n = 0; n < 2; ++n) { const int t = 16 * u.pn + 8 * bj + 2 * wc + n, row = 224 + 32 * chunk + t; float z[4];
#pragma unroll
                            for (int i = 0; i < 4; ++i) { const float y = acc[ai][bj][m][n][i]; const float x2 = 1.5957691216057308f * (y + 0.044715f * y * y * y);
                                const float th = 1.0f - 2.0f / (1.0f + __expf(x2)); z[i] = 0.5f * y * (1.0f + th); }
                            typedef unsigned u32x2 __attribute__((ext_vector_type(2)));
                            u32x2 w; w.x = cvt_pk_bf16(z[0], z[1]); w.y = cvt_pk_bf16(z[2], z[3]);
                            *(u32x2*)(ZB + (size_t)row * 1024 + 16 * u.eb + 4 * fq) = w; } } }
    }
};
struct EpiGlu {
    static constexpr bool PERM = true, AFTER_DRAIN = false;
    const bf16_t* ZB; const float* bias; bf16_t* O;
    __device__ __forceinline__ void operator()(const f32x4 (&acc)[2][2][4][2], const Unit& u, int wr, int wc, int fr, int fq) const {
        const int row0 = u.pm * BM + wr * 64 + fr, col0 = u.pn * BM + wc * 32 + 8 * fq;
#pragma unroll
        for (int ai = 0; ai < 2; ++ai)
#pragma unroll
            for (int m = 0; m < 4; ++m) { const int row = row0 + ai * HALF + m * 16;
#pragma unroll
                for (int bj = 0; bj < 2; ++bj) { const int col = col0 + bj * HALF;
                    const u32x4 zw = *(const u32x4*)(ZB + (size_t)row * 1024 + col);
                    const f32x4 b0 = *(const f32x4*)(bias + col), b1 = *(const f32x4*)(bias + col + 4);
                    float r[8];
#pragma unroll
                    for (int i = 0; i < 4; ++i) { const unsigned zz = i < 2 ? (i == 0 ? zw.x : zw.y) : (i == 2 ? zw.z : zw.w);
                        const float z0 = __uint_as_float(zz << 16), z1 = __uint_as_float(zz & 0xffff0000u);
                        const int e0 = 2 * i, e1 = 2 * i + 1;
                        const float a0 = (e0 < 4 ? acc[ai][bj][m][0][e0] : acc[ai][bj][m][1][e0 - 4]) + (e0 < 4 ? b0[e0] : b1[e0 - 4]);
                        const float a1 = (e1 < 4 ? acc[ai][bj][m][0][e1] : acc[ai][bj][m][1][e1 - 4]) + (e1 < 4 ? b0[e1] : b1[e1 - 4]);
                        r[e0] = z0 / (1.0f + __expf(-a0)); r[e1] = z1 / (1.0f + __expf(-a1)); }
                    u32x4 w; w.x = cvt_pk_bf16(r[0], r[1]); w.y = cvt_pk_bf16(r[2], r[3]); w.z = cvt_pk_bf16(r[4], r[5]); w.w = cvt_pk_bf16(r[6], r[7]);
                    *(u32x4*)(O + (size_t)row * 2048 + 1024 + col) = w; } }
    }
};

template <class Epi, class Sched>
__device__ __forceinline__ void gemm_phase(PG8_LAS unsigned char* lds, const Gemm g, const Sched& S, const Epi& E) {
    const int tid = threadIdx.x, wid = __builtin_amdgcn_readfirstlane(tid >> 6), lane = tid & 63, wr = wid >> 2, wc = wid & 3, fr = lane & 15, fq = lane >> 4;
    const int K = g.K, nt = K / BK;
    unsigned voffA[2], voffB[2];
#pragma unroll
    for (int i = 0; i < 2; ++i) { int R, C; stage_rc(tid * 16 + i * 8192, R, C); const int Rb = Epi::PERM ? ((R & ~31) + perm32(R & 31)) : R;
        voffA[i] = (unsigned)(R * g.lda + C) * 2u; voffB[i] = (unsigned)(Rb * g.ldb + C) * 2u; }
    const size_t kstep = (size_t)(BK * 2);
    const size_t hstepA = (size_t)HALF * g.lda * 2, hstepB = (size_t)HALF * g.ldb * 2;
    const size_t tstepA = 2 * hstepA, tstepB = 2 * hstepB;
    const unsigned ldsw = (unsigned)wid * 1024u;
    const int aoff = lds_byte(wr * 64 + fr, fq * 8), boff = lds_byte(wc * 32 + fr, fq * 8);
#define PG8_SA(b, h) (((b) * 2 + (h)) * HTB)
#define PG8_SB(b, h) ((4 + (b) * 2 + (h)) * HTB)
#define PG8_STAGE(bufoff, gbase, voff) do { _Pragma("unroll") for (int _i = 0; _i < 2; ++_i) \
        __builtin_amdgcn_global_load_lds((const unsigned*)((const char*)(gbase) + (voff)[_i]), (PG8_LAS unsigned*)(lds + (bufoff) + ldsw + _i * 8192), 16, 0, 0); } while (0)
#define PG8_LDA(dst, b, h) do { _Pragma("unroll") for (int m = 0; m < 4; ++m) _Pragma("unroll") for (int k = 0; k < 2; ++k) dst[m][k] = *(const PG8_LAS bf16x8*)(lds + PG8_SA(b, h) + aoff + m * 2048 + k * 1024); } while (0)
#define PG8_LDB(dst, b, h) do { _Pragma("unroll") for (int n = 0; n < 2; ++n) _Pragma("unroll") for (int k = 0; k < 2; ++k) dst[n][k] = *(const PG8_LAS bf16x8*)(lds + PG8_SB(b, h) + boff + n * 2048 + k * 1024); } while (0)
#define PG8_MMA(ai, bj, At, Bt) do { __builtin_amdgcn_s_setprio(1); _Pragma("unroll") for (int m = 0; m < 4; ++m) _Pragma("unroll") for (int n = 0; n < 2; ++n) _Pragma("unroll") for (int k = 0; k < 2; ++k) \
        acc[ai][bj][m][n] = __builtin_amdgcn_mfma_f32_16x16x32_bf16(Bt[n][k], At[m][k], acc[ai][bj][m][n], 0, 0, 0); __builtin_amdgcn_s_setprio(0); } while (0)
#define PG8_WAIT_V(n) asm volatile("s_waitcnt vmcnt(" #n ")" ::: "memory")
#define PG8_WAIT_L(n) asm volatile("s_waitcnt lgkmcnt(" #n ")" ::: "memory")
#define PG8_BAR __builtin_amdgcn_s_barrier()
#define PG8_SCHED __builtin_amdgcn_sched_barrier(0)
    Unit cur, nxt; int ui = 0;
    if (!S.next(0, cur)) return;
    f32x4 acc[2][2][4][2];
#pragma unroll
    for (int a = 0; a < 2; ++a)
#pragma unroll
        for (int b = 0; b < 2; ++b)
#pragma unroll
            for (int m = 0; m < 4; ++m)
#pragma unroll
                for (int n = 0; n < 2; ++n) acc[a][b][m][n] = (f32x4){0.f, 0.f, 0.f, 0.f};
    bf16x8 At[4][2], B0[2][2], B1[2][2];
    const char* cA = (const char*)g.A + (size_t)cur.eb * g.astride + (size_t)cur.pm * tstepA; const char* cB = (const char*)g.Bt + (size_t)cur.eb * g.bstride + (size_t)cur.pn * tstepB;
    S.a_ready(cur);
    PG8_STAGE(PG8_SB(0, 0), cB, voffB); PG8_STAGE(PG8_SA(0, 0), cA, voffA); PG8_STAGE(PG8_SB(0, 1), cB + hstepB, voffB); PG8_STAGE(PG8_SA(0, 1), cA + hstepA, voffA);
    if (wr == 1) PG8_BAR;
    PG8_WAIT_V(4); PG8_BAR;
    PG8_STAGE(PG8_SB(1, 0), cB + kstep, voffB); PG8_STAGE(PG8_SA(1, 0), cA + kstep, voffA); PG8_STAGE(PG8_SB(1, 1), cB + hstepB + kstep, voffB);
    PG8_WAIT_V(6); PG8_BAR;
    for (;;) {
        const bool has_next = S.next(ui + 1, nxt);
        const char* nA = has_next ? (const char*)g.A + (size_t)nxt.eb * g.astride + (size_t)nxt.pm * tstepA : cA; const char* nB = has_next ? (const char*)g.Bt + (size_t)nxt.eb * g.bstride + (size_t)nxt.pn * tstepB : cB;
        for (int t = 0; t < nt; t += 2) {
            const bool last = (t == nt - 2);
            const char* a1 = cA + (size_t)(t + 1) * kstep;
            const char* a2 = last ? nA : cA + (size_t)(t + 2) * kstep; const char* b2 = last ? nB : cB + (size_t)(t + 2) * kstep;
            const char* a3 = a2 + kstep; const char* b3 = b2 + kstep;
            if (last && has_next) S.a_ready(nxt);
            PG8_LDB(B0, 0, 0); PG8_SCHED; PG8_LDA(At, 0, 0); PG8_STAGE(PG8_SA(1, 1), a1 + hstepA, voffA);
            PG8_WAIT_L(8); PG8_BAR; PG8_WAIT_L(0); PG8_MMA(0, 0, At, B0); PG8_BAR; PG8_SCHED;
            PG8_LDB(B1, 0, 1); PG8_STAGE(PG8_SB(0, 0), b2, voffB);
            PG8_BAR; PG8_WAIT_L(0); PG8_MMA(0, 1, At, B1); PG8_BAR;
            PG8_LDA(At, 0, 1); PG8_STAGE(PG8_SA(0, 0), a2, voffA);
            PG8_BAR; PG8_WAIT_L(0); PG8_MMA(1, 0, At, B0); PG8_BAR; PG8_SCHED;
            PG8_STAGE(PG8_SB(0, 1), b2 + hstepB, voffB);
            PG8_WAIT_V(6); PG8_BAR; PG8_MMA(1, 1, At, B1); PG8_BAR;
            PG8_LDB(B0, 1, 0); PG8_SCHED; PG8_LDA(At, 1, 0); PG8_STAGE(PG8_SA(0, 1), a2 + hstepA, voffA);
            PG8_WAIT_L(8); PG8_BAR; PG8_WAIT_L(0); PG8_MMA(0, 0, At, B0); PG8_BAR; PG8_SCHED;
            PG8_LDB(B1, 1, 1); PG8_STAGE(PG8_SB(1, 0), b3, voffB);
            PG8_BAR; PG8_WAIT_L(0); PG8_MMA(0, 1, At, B1); PG8_BAR;
            PG8_LDA(At, 1, 1); PG8_STAGE(PG8_SA(1, 0), a3, voffA);
            PG8_BAR; PG8_WAIT_L(0); PG8_MMA(1, 0, At, B0); PG8_BAR; PG8_SCHED;
            PG8_STAGE(PG8_SB(1, 1), b3 + hstepB, voffB);
            PG8_WAIT_V(6); PG8_BAR; PG8_MMA(1, 1, At, B1); PG8_BAR;
        }
        E(acc, cur, wr, wc, fr, fq); S.done(cur);
        if (!has_next) break;
#pragma unroll
        for (int a = 0; a < 2; ++a)
#pragma unroll
            for (int b = 0; b < 2; ++b)
#pragma unroll
                for (int m = 0; m < 4; ++m)
#pragma unroll
                    for (int n = 0; n < 2; ++n) acc[a][b][m][n] = (f32x4){0.f, 0.f, 0.f, 0.f};
        cur = nxt; cA = nA; cB = nB; ++ui;
    }
    PG8_WAIT_V(0);
    if (wr == 0) PG8_BAR;
    PG8_BAR;
#undef PG8_SA
#undef PG8_SB
#undef PG8_STAGE
#undef PG8_LDA
#undef PG8_LDB
#undef PG8_MMA
#undef PG8_WAIT_V
#undef PG8_WAIT_L
#undef PG8_BAR
#undef PG8_SCHED
}
}

constexpr int D = 2048, SEQ = 16384, NMETA = 16;
constexpr int LP = 16640;
constexpr int ROWV = 240;
constexpr int NVALID = 16400;
constexpr int ABN = 2560, CN = 10240;
constexpr int NEXP = 64, DEXP = 512;
constexpr int MAXTILES = 192, MPAD = MAXTILES * 256;
constexpr float DN_ALPHA = 1.4142135623730951f;
constexpr float LN_EPS = 1e-5f;
constexpr int NWAVES = 8, NTHR = 512;

constexpr size_t al(size_t x) { return (x + 0xFFFFFull) & ~(size_t)0xFFFFFull; }
constexpr size_t WS_CTL = 0, CTL_BYTES = 1u << 20;
constexpr size_t WS_WAB = al(WS_CTL + CTL_BYTES);
constexpr size_t WS_WOAB = al(WS_WAB + (size_t)ABN * D * 2);
constexpr size_t WS_WGLU = al(WS_WOAB + (size_t)D * D * 2);
constexpr size_t WS_WC = al(WS_WGLU + (size_t)1024 * 1024 * 2);
constexpr size_t WS_WOC = al(WS_WC + (size_t)CN * D * 2);
constexpr size_t WS_WGU = al(WS_WOC + (size_t)D * D * 2);
constexpr size_t WS_WD = al(WS_WGU + (size_t)2 * NEXP * 1024 * D * 2);
constexpr size_t WS_HA = al(WS_WD + (size_t)2 * NEXP * D * DEXP * 2);
constexpr size_t WS_HB = al(WS_HA + (size_t)LP * D * 4);
constexpr size_t WS_HBF = al(WS_HB + (size_t)LP * D * 4);
constexpr size_t WS_PROJ0 = al(WS_HBF + (size_t)LP * D * 2);
constexpr size_t WS_MIXIN = al(WS_PROJ0 + (size_t)LP * ABN * 4);
constexpr size_t WS_MIX = al(WS_MIXIN + (size_t)LP * D * 2);
constexpr size_t WS_Z = al(WS_MIX + (size_t)LP * D * 4);
constexpr size_t WS_ZB = al(WS_Z + (size_t)LP * 1024 * 4);
constexpr size_t WS_GLU = al(WS_ZB + (size_t)LP * 1024 * 2);
constexpr size_t WS_S5P = al(WS_GLU + (size_t)LP * 1024 * 4);
constexpr size_t WS_APOW = al(WS_S5P + (size_t)(2 * 64 * 64 * 8 + 2 * 64 * 64 * 16 * 8));
constexpr size_t WS_KTAB = al(WS_APOW + (size_t)2 * 64 * 64 * 33 * 8);
constexpr size_t WS_MWT = al(WS_KTAB + (size_t)2 * 64 * 32 * 256 * 4);
constexpr size_t WS_WST = al(WS_MWT + (size_t)64 * 512 * 768 * 2);
constexpr size_t WS_ROPE = al(WS_WST + (size_t)64 * 256 * 512 * 2);
constexpr size_t WS_ROUTE = al(WS_ROPE + (size_t)LP * 64 * 8);
constexpr size_t WS_R1 = al(WS_ROUTE + (size_t)LP * 32);
constexpr size_t R1_BYTES = (size_t)2 * LP * 4096 * 8;
constexpr size_t WS_END = WS_R1 + R1_BYTES;
constexpr size_t R1_UA = 0;
constexpr size_t R1_SALL = al((size_t)64 * 768 * 768 * 2);
constexpr size_t R1_PROJ1 = 0;
constexpr size_t R1_OFW = al((size_t)LP * CN * 4);
constexpr size_t R1_OBW = al(R1_OFW + (size_t)LP * D * 4);
constexpr size_t R1_DS = al(R1_OBW + (size_t)LP * D * 4);
constexpr size_t R1_DSEG = al(R1_DS + (size_t)32 * 32 * 16384 * 4);
constexpr size_t R1_HG_END = R1_DSEG + (size_t)32 * 32 * 128 * 4;
constexpr size_t R1_XSRT = 0;
constexpr size_t R1_ACT = al((size_t)MPAD * D * 2);
constexpr size_t R1_Y = al(R1_ACT + (size_t)MPAD * DEXP * 2);
constexpr size_t R1_MOE_END = R1_Y + (size_t)MPAD * D * 4;
static_assert(R1_HG_END <= R1_BYTES && R1_MOE_END <= R1_BYTES, "R1 overlays");
static_assert(WS_END <= (size_t)4 << 30, "workspace map must fit 4 GiB");
constexpr int CW_BAR = 4096;
constexpr int CW_CNT = 16384;
constexpr int CW_PLAN = 32768;

#define LAS __attribute__((address_space(3)))
typedef unsigned short bf16;
typedef unsigned v4u __attribute__((ext_vector_type(4)));
typedef unsigned v2u __attribute__((ext_vector_type(2)));
typedef float f32x4 __attribute__((ext_vector_type(4)));
#define LDS_WAIT() asm volatile("s_waitcnt lgkmcnt(0)" ::: "memory")
__device__ __forceinline__ unsigned f2bf(float f) { unsigned u = __builtin_bit_cast(unsigned, f); return (u + 0x7fffu + ((u >> 16) & 1u)) >> 16; }
__device__ __forceinline__ unsigned pk2(float lo, float hi) { return f2bf(lo) | (f2bf(hi) << 16); }
__device__ __forceinline__ float wave_sum(float v) {
#pragma unroll
    for (int o = 1; o < 64; o <<= 1) v += __shfl_xor(v, o);
    return v;
}
__device__ __forceinline__ float wave_max(float v) {
#pragma unroll
    for (int o = 1; o < 64; o <<= 1) v = fmaxf(v, __shfl_xor(v, o));
    return v;
}
__device__ __forceinline__ float sigmoidf_(float x) { return 1.0f / (1.0f + expf(-x)); }

#define XB_TMO      128
#define XB_XCNT(j)  (256  + 64 * (j))
#define XB_XSUB(j)  (1280 + 64 * (j))
#define XB_XGEN(j)  (2304 + 64 * (j))
#define XB_TOP      3328
#define XB_TOPGEN   3392
#define XCD_BAR_WORDS 3456
#define XB_SPIN_CAP (1u << 22)
__device__ __forceinline__ unsigned xb_ld(unsigned* p)              { return __hip_atomic_load(p, __ATOMIC_RELAXED, __HIP_MEMORY_SCOPE_AGENT); }
__device__ __forceinline__ unsigned xb_add(unsigned* p, unsigned v) { return __hip_atomic_fetch_add(p, v, __ATOMIC_RELAXED, __HIP_MEMORY_SCOPE_AGENT); }
__device__ __forceinline__ unsigned xb_xcc_id() { return (unsigned)__builtin_amdgcn_s_getreg((3 << 11) | 20) & 0xFu; }
#define XB_SPIN(cond, bar) do { unsigned _sp = 0; while (cond) { __builtin_amdgcn_s_sleep(1); \
    if ((++_sp & 255u) == 0u) { if (xb_ld(&(bar)[XB_TMO])) break; if (_sp > XB_SPIN_CAP) { atomicAdd(&(bar)[XB_TMO], 1u); break; } } } } while (0)
struct XcdBarrier { unsigned* bar; unsigned x; volatile LAS unsigned* st; };
__device__ __forceinline__ XcdBarrier xcd_barrier_post(unsigned* bar, volatile LAS unsigned* st) {
    XcdBarrier b; b.bar = bar; b.x = xb_xcc_id(); b.st = st;
    if (threadIdx.x == 0) (void)xb_add(&bar[XB_XCNT(b.x)], 1u);
    return b;
}
__device__ __forceinline__ void xcd_barrier_complete(unsigned* bar, unsigned x, unsigned& nloc, unsigned& nx) {
    const unsigned G = gridDim.x * gridDim.y * gridDim.z;
    unsigned sum, cnt, mine, sp = 0u;
    for (;;) {
        sum = 0u; cnt = 0u; mine = 0u;
#pragma unroll
        for (unsigned j = 0; j < 16; ++j) { const unsigned c = xb_ld(&bar[XB_XCNT(j)]); sum += c; cnt += (c > 0u) ? 1u : 0u; mine = (j == x) ? c : mine; }
        if (sum == G) break;
        __builtin_amdgcn_s_sleep(1);
        if ((++sp & 255u) == 0u) { if (xb_ld(&bar[XB_TMO])) break; if (sp > XB_SPIN_CAP) { atomicAdd(&bar[XB_TMO], 1u); break; } }
    }
    nloc = mine > 0u ? mine : 1u; nx = cnt > 0u ? cnt : 1u;
}
__device__ __forceinline__ void xcd_barrier(const XcdBarrier& b) {
    asm volatile("s_waitcnt vmcnt(0)" ::: "memory");
    __syncthreads();
    if (threadIdx.x == 0) {
        unsigned* bar = b.bar;
        __builtin_amdgcn_s_waitcnt(0);
        unsigned nloc = b.st[0], nx = b.st[1];
        if (nloc == 0u) { xcd_barrier_complete(bar, b.x, nloc, nx); b.st[0] = nloc; b.st[1] = nx; }
        const unsigned old = xb_add(&bar[XB_XSUB(b.x)], 1u);
        const unsigned gen = old / nloc;
        if (old + 1u == (gen + 1u) * nloc) {
            __builtin_amdgcn_fence(__ATOMIC_RELEASE, "agent");
            asm volatile("s_waitcnt vmcnt(0)" ::: "memory");
            const unsigned og = xb_add(&bar[XB_TOP], 1u);
            const unsigned tg = og / nx;
            if (og + 1u == (tg + 1u) * nx) xb_add(&bar[XB_TOPGEN], 1u);
            else XB_SPIN(xb_ld(&bar[XB_TOPGEN]) == tg, bar);
            __builtin_amdgcn_fence(__ATOMIC_ACQUIRE, "agent");
            xb_add(&bar[XB_XGEN(b.x)], 1u);
            asm volatile("s_waitcnt vmcnt(0)" ::: "memory");
        } else {
            XB_SPIN(xb_ld(&bar[XB_XGEN(b.x)]) == gen, bar);
            __builtin_amdgcn_fence(__ATOMIC_ACQUIRE, "agent");
            asm volatile("s_waitcnt vmcnt(0)" ::: "memory");
        }
    }
    __syncthreads();
}

constexpr int RING_BYTES = 131072, MISC_OFF = RING_BYTES + 320, LDS_BYTES = 147456;
struct Args { const float* in[29]; float* out; unsigned char* ws; int ph_lo, ph_hi; };
enum In { I_X = 0, I_META, I_WAB, I_WOAB, I_SINK, I_LRE, I_LIM, I_LSTEP, I_BRE, I_BIM, I_CRE, I_CIM, I_S5D, I_WGLU, I_BGLU, I_WC, I_WOC, I_LB, I_NORMG,
          I_LNMG, I_LNMB, I_LNFG, I_LNFB, I_WGRP, I_BGRP, I_WEXP, I_BEXP, I_WGU, I_WD };
struct Ctx { LAS unsigned char* lds; unsigned char* ldsg; int tid, lane, wave, bid, nblk, gw, ngw; };

__device__ __forceinline__ int rowmap_gu(int n) { return n < 512 ? ((n >> 7) * 256 + (n & 127)) : (((n - 512) >> 7) * 256 + 128 + ((n - 512) & 127)); }
__device__ __forceinline__ void transpose_item(const float* W, int K, int N, bf16* WT, LAS float* scr, int kb, int nb, int lane, int mode) {
    const int k0 = 64 * kb, n0 = 32 * nb;
#pragma unroll 8
    for (int i = 0; i < 32; ++i) { const int kk = 2 * i + (lane >> 5); scr[kk * 33 + (lane & 31)] = W[(size_t)(k0 + kk) * N + n0 + (lane & 31)]; }
    LDS_WAIT(); asm volatile("" ::: "memory");
    const int c = lane & 7;
#pragma unroll
    for (int j = 0; j < 4; ++j) { const int n = (lane >> 3) + 8 * j; const LAS float* s = scr + (8 * c) * 33 + n;
        v4u o; o.x = pk2(s[0 * 33], s[1 * 33]); o.y = pk2(s[2 * 33], s[3 * 33]); o.z = pk2(s[4 * 33], s[5 * 33]); o.w = pk2(s[6 * 33], s[7 * 33]);
        const int nn = n0 + n; const int row = mode ? rowmap_gu(nn) : nn;
        *(v4u*)(WT + (size_t)row * K + k0 + 8 * c) = o; }
    LDS_WAIT(); asm volatile("" ::: "memory");
}
__device__ __forceinline__ void conv_family(const Ctx& c, const float* src, bf16* dst, int B, int K, int N, int mode) {
    LAS float* scr = (LAS float*)(c.lds + c.wave * 16384);
    const int nkb = K / 64, nnb = N / 32; const long per = (long)nkb * nnb, total = per * B;
    for (long it = c.gw; it < total; it += c.ngw) {
        const int b = (int)(it / per); const int r = (int)(it % per); const int kb = r / nnb, nb = r % nnb;
        transpose_item(src + (size_t)b * K * N, K, N, dst + (size_t)b * K * N, scr, kb, nb, c.lane, mode);
    }
}
__device__ __forceinline__ void phase_weights(const Ctx& c, const Args& a) {
    unsigned char* ws = a.ws;
    conv_family(c, a.in[I_WAB], (bf16*)(ws + WS_WAB), 1, D, ABN, 0);
    conv_family(c, a.in[I_WOAB], (bf16*)(ws + WS_WOAB), 1, D, D, 0);
    conv_family(c, a.in[I_WGLU], (bf16*)(ws + WS_WGLU), 1, 1024, 1024, 0);
    conv_family(c, a.in[I_WC], (bf16*)(ws + WS_WC), 1, D, CN, 0);
    conv_family(c, a.in[I_WOC], (bf16*)(ws + WS_WOC), 1, D, D, 0);
    conv_family(c, a.in[I_WGU], (bf16*)(ws + WS_WGU), 2 * NEXP, D, 1024, 1);
    conv_family(c, a.in[I_WD], (bf16*)(ws + WS_WD), 2 * NEXP, DEXP, D, 0);
}
__device__ __forceinline__ void phase_init(const Ctx& c, const Args& a) {
    float* H = (float*)(a.ws + WS_HA); bf16* HB = (bf16*)(a.ws + WS_HBF);
    for (int row = c.gw; row < LP; row += c.ngw) {
        const float* src = row < ROWV ? nullptr : (row < 256 ? a.in[I_META] + (size_t)(row - ROWV) * D : a.in[I_X] + (size_t)(row - 256) * D);
#pragma unroll
        for (int j = 0; j < 8; ++j) { const int idx = (j * 64 + c.lane) * 4; f32x4 v = src ? *(const f32x4*)(src + idx) : (f32x4){0.f, 0.f, 0.f, 0.f};
            *(f32x4*)(H + (size_t)row * D + idx) = v; v2u w; w.x = pk2(v.x, v.y); w.y = pk2(v.z, v.w); *(v2u*)(HB + (size_t)row * D + idx) = w; }
    }
    float2* rope = (float2*)(a.ws + WS_ROPE);
    for (long i = (long)c.bid * NTHR + c.tid; i < (long)LP * 64; i += (long)c.nblk * NTHR) {
        const int row = (int)(i >> 6), k = (int)(i & 63);
        const float inv = powf(10000.0f, -(float)k * 2.0f / 128.0f);
        const float ang = (float)(row - ROWV) * inv;
        float s, co; sincosf(ang, &s, &co); rope[i] = make_float2(co, s);
    }
    float2* abar = (float2*)(a.ws + WS_S5P); float2* bbar = abar + 2 * 64 * 64;
    for (int i = c.bid * NTHR + c.tid; i < 2 * 64 * 64; i += c.nblk * NTHR) {
        const int dg = i >> 6;
        const double lr = fmin((double)a.in[I_LRE][i], -1e-4), li = (double)a.in[I_LIM][i], st = exp((double)a.in[I_LSTEP][dg]);
        const double er = exp(lr * st), ar = er * cos(li * st), ai = er * sin(li * st);
        const double den = lr * lr + li * li, cr = ((ar - 1.0) * lr + ai * li) / den, ci = (ai * lr - (ar - 1.0) * li) / den;
        abar[i] = make_float2((float)ar, (float)ai);
        float2* apw = (float2*)(a.ws + WS_APOW) + (size_t)i * 33;
        for (int tau = 0; tau <= 32; ++tau) { const double m = exp(lr * st * tau); apw[tau] = make_float2((float)(m * cos(li * st * tau)), (float)(m * sin(li * st * tau))); }
        for (int cc = 0; cc < 16; ++cc) { const double br = a.in[I_BRE][(size_t)i * 16 + cc], bi = a.in[I_BIM][(size_t)i * 16 + cc];
            bbar[(size_t)i * 16 + cc] = make_float2((float)(cr * br - ci * bi), (float)(cr * bi + ci * br)); }
    }
}
__device__ __forceinline__ void phase_rope(const Ctx& c, const Args& a) {
    float* P = (float*)(a.ws + WS_PROJ0); const float2* rope = (const float2*)(a.ws + WS_ROPE);
    for (long i = (long)c.bid * NTHR + c.tid; i < (long)NVALID * 640; i += (long)c.nblk * NTHR) {
        const int row = ROWV + (int)(i / 640), r = (int)(i % 640), hs = r >> 6, k = r & 63;
        const float2 cs = rope[(size_t)row * 64 + k];
        float* p = P + (size_t)row * ABN + hs * 128 + k;
        const float x1 = p[0], x2 = p[64];
        p[0] = x1 * cs.x - x2 * cs.y; p[64] = x2 * cs.x + x1 * cs.y;
    }
}
__device__ __forceinline__ void phase_attn_naive(const Ctx& c, const Args& a) {
    const float* P = (const float*)(a.ws + WS_PROJ0); bf16* MI = (bf16*)(a.ws + WS_MIXIN);
    LAS float* qs = (LAS float*)(c.lds + c.wave * 16384); LAS float* ps = qs + 128;
    const float scale = 0.08838834764831845f;
    for (int T = c.gw; T < NVALID * 8; T += c.ngw) {
        const int row = ROWV + (T >> 3), h = T & 7, g = h >> 2;
        const float* pr = P + (size_t)row * ABN;
        qs[c.lane] = pr[h * 128 + c.lane]; qs[c.lane + 64] = pr[h * 128 + 64 + c.lane];
        LDS_WAIT(); asm volatile("" ::: "memory");
        int lo, hi;
        if (row < 256) { lo = 256; hi = row + 128; } else { lo = row - 128 < 256 ? 256 : row - 128; hi = row + 128 > LP - 1 ? LP - 1 : row + 128; }
        const int nk = 16 + (hi - lo + 1);
        const float sink = a.in[I_SINK][h];
        float sc[5]; float mx = sink;
#pragma unroll
        for (int s = 0; s < 5; ++s) { const int j = s * 64 + c.lane; sc[s] = -3.0e38f;
            if (j < nk) { const int kr = j < 16 ? ROWV + j : lo + j - 16; const float* kp = P + (size_t)kr * ABN + 1024 + g * 128; float d = 0.f;
                for (int e = 0; e < 128; e += 4) { const f32x4 kv = *(const f32x4*)(kp + e); d += kv.x * qs[e] + kv.y * qs[e + 1] + kv.z * qs[e + 2] + kv.w * qs[e + 3]; }
                sc[s] = d * scale; mx = fmaxf(mx, sc[s]); } }
        mx = wave_max(mx);
        float den = 0.f;
#pragma unroll
        for (int s = 0; s < 5; ++s) { const int j = s * 64 + c.lane; if (j < nk) { const float e = expf(sc[s] - mx); den += e; ps[j] = e; } }
        den = wave_sum(den) + expf(sink - mx);
        LDS_WAIT(); asm volatile("" ::: "memory");
        float o0 = 0.f, o1 = 0.f;
        for (int j = 0; j < nk; ++j) { const int kr = j < 16 ? ROWV + j : lo + j - 16; const float* vp = P + (size_t)kr * ABN + 1280 + g * 128; const float p = ps[j];
            o0 += p * vp[c.lane]; o1 += p * vp[c.lane + 64]; }
        const float inv = 1.0f / den;
        MI[(size_t)row * D + h * 128 + c.lane] = (bf16)f2bf(o0 * inv); MI[(size_t)row * D + h * 128 + 64 + c.lane] = (bf16)f2bf(o1 * inv);
        LDS_WAIT(); asm volatile("" ::: "memory");
    }
    for (int i = c.bid * NTHR + c.tid; i < ROWV * D / 8; i += c.nblk * NTHR) ((v4u*)MI)[i] = (v4u){0u, 0u, 0u, 0u};
}
__device__ __forceinline__ void phase_s5_ktab(const Ctx& c, const Args& a) {
    const float2* abar = (const float2*)(a.ws + WS_S5P); const float2* bbar = abar + 2 * 64 * 64; const float2* apow = (const float2*)(a.ws + WS_APOW);
    float* KT = (float*)(a.ws + WS_KTAB);
    for (int idx = c.bid * NTHR + c.tid; idx < 2 * 64 * 32 * 256; idx += c.nblk * NTHR) {
        const int c2 = idx & 15, c1 = (idx >> 4) & 15, tau = (idx >> 8) & 31, dg = idx >> 13;
        const float* cr = a.in[I_CRE] + ((size_t)dg * 16 + c1) * 64; const float* ci = a.in[I_CIM] + ((size_t)dg * 16 + c1) * 64;
        float sum = 0.f;
        for (int p = 0; p < 64; ++p) { const int i = dg * 64 + p; const float2 ap = apow[(size_t)i * 33 + tau], bb = bbar[(size_t)i * 16 + c2];
            const float tr = ap.x * bb.x - ap.y * bb.y, ti = ap.x * bb.y + ap.y * bb.x; sum += cr[p] * tr - ci[p] * ti; }
        KT[idx] = sum;
    }
}
__device__ __forceinline__ void phase_s5_fill(const Ctx& c, const Args& a) {
    const float2* abar = (const float2*)(a.ws + WS_S5P); const float2* bbar = abar + 2 * 64 * 64; const float2* apow = (const float2*)(a.ws + WS_APOW);
    const float* KT = (const float*)(a.ws + WS_KTAB); bf16* MWT = (bf16*)(a.ws + WS_MWT); bf16* WST = (bf16*)(a.ws + WS_WST);
    for (long it = (long)c.bid * NTHR + c.tid; it < (long)64 * 512 * 96; it += (long)c.nblk * NTHR) {
        const int kb = (int)(it % 96), n = (int)((it / 96) % 512), g = (int)(it / (96 * 512)), t = n >> 4, c1 = n & 15;
        float v[8];
        if (kb < 64) { const int s2 = kb >> 1, c2 = (kb & 1) * 8;
            if (s2 < t) { const float* k0 = KT + ((((size_t)(0 * 64 + g)) * 32 + (t - s2)) * 16 + c1) * 16 + c2;
#pragma unroll
                for (int i = 0; i < 8; ++i) v[i] = k0[i]; }
            else if (s2 > t) { const float* k0 = KT + ((((size_t)(1 * 64 + g)) * 32 + (s2 - t)) * 16 + c1) * 16 + c2;
#pragma unroll
                for (int i = 0; i < 8; ++i) v[i] = k0[i]; }
            else { const float* k0 = KT + ((((size_t)(0 * 64 + g)) * 32) * 16 + c1) * 16 + c2; const float* k1 = KT + ((((size_t)(1 * 64 + g)) * 32) * 16 + c1) * 16 + c2;
#pragma unroll
                for (int i = 0; i < 8; ++i) v[i] = k0[i] + k1[i] + ((c2 + i) == c1 ? a.in[I_S5D][16 * g + c1] : 0.f); }
        } else { const int j0 = (kb - 64) * 8, qd = j0 >> 6, dir = qd >> 1, p0 = j0 & 63, tau = dir == 0 ? t + 1 : 32 - t;
            const float* cr = a.in[I_CRE] + ((size_t)(dir * 64 + g) * 16 + c1) * 64; const float* ci = a.in[I_CIM] + ((size_t)(dir * 64 + g) * 16 + c1) * 64;
#pragma unroll
            for (int i = 0; i < 8; ++i) { const int p = p0 + i; const float2 ap = apow[((size_t)(dir * 64 + g) * 64 + p) * 33 + tau];
                v[i] = (qd & 1) == 0 ? (cr[p] * ap.x - ci[p] * ap.y) : -(cr[p] * ap.y + ci[p] * ap.x); }
        }
        v4u o; o.x = pk2(v[0], v[1]); o.y = pk2(v[2], v[3]); o.z = pk2(v[4], v[5]); o.w = pk2(v[6], v[7]);
        *(v4u*)(MWT + ((size_t)g * 512 + n) * 768 + kb * 8) = o;
    }
    for (long it = (long)c.bid * NTHR + c.tid; it < (long)64 * 256 * 64; it += (long)c.nblk * NTHR) {
        const int kb = (int)(it & 63), n = (int)((it >> 6) & 255), g = (int)(it >> 14), s2 = kb >> 1, c2 = (kb & 1) * 8, qd = n >> 6, dir = qd >> 1, p = n & 63;
        const int tau = dir == 0 ? 31 - s2 : s2; const size_t i = (size_t)(dir * 64 + g) * 64 + p; const float2 ap = apow[i * 33 + tau];
        float v[8];
#pragma unroll
        for (int e = 0; e < 8; ++e) { const float2 bb = bbar[i * 16 + c2 + e]; v[e] = (qd & 1) == 0 ? (ap.x * bb.x - ap.y * bb.y) : (ap.x * bb.y + ap.y * bb.x); }
        v4u o; o.x = pk2(v[0], v[1]); o.y = pk2(v[2], v[3]); o.z = pk2(v[4], v[5]); o.w = pk2(v[6], v[7]);
        *(v4u*)(WST + ((size_t)g * 256 + n) * 512 + kb * 8) = o;
    }
    bf16* ZB = (bf16*)(a.ws + WS_ZB);
    for (int i = c.bid * NTHR + c.tid; i < 224 * 1024 / 8; i += c.nblk * NTHR) ((v4u*)ZB)[i] = (v4u){0u, 0u, 0u, 0u};
}
__device__ __forceinline__ void phase_s5_chunkscan(const Ctx& c, const Args& a) {
    if (c.bid >= 128) return;
    const int g = c.bid & 63, dir = c.bid >> 6, p = c.lane, w = c.wave;
    const float2 a32 = ((const float2*)(a.ws + WS_APOW))[((size_t)(dir * 64 + g) * 64 + p) * 33 + 32];
    const float* S = (const float*)(a.ws + WS_R1 + R1_SALL) + (size_t)g * 768 * 256 + dir * 128 + p;
    bf16* UA = (bf16*)(a.ws + WS_R1 + R1_UA) + (size_t)g * 768 * 768 + 512 + dir * 128 + p;
    LAS float* E = (LAS float*)c.lds; LAS float* PW = E + 2 * 8 * 64;
    const int j0 = 65 * w, j1 = (j0 + 65) < 513 ? (j0 + 65) : 513, len = j1 - j0;
    float xr = 0.f, xi = 0.f, pr = 1.f, pi = 0.f;
    for (int b = 0; b < 5; ++b) { float sr[13], si[13];
#pragma unroll
        for (int i = 0; i < 13; ++i) { const int o = b * 13 + i; const int j = dir == 0 ? j0 + o : j1 - 1 - o; const bool ok = o < len; sr[i] = ok ? S[(size_t)j * 256] : 0.f; si[i] = ok ? S[(size_t)j * 256 + 64] : 0.f; }
#pragma unroll
        for (int i = 0; i < 13; ++i) { if (b * 13 + i < len) { const float nr = a32.x * xr - a32.y * xi + sr[i], ni = a32.x * xi + a32.y * xr + si[i]; xr = nr; xi = ni;
                const float qr = a32.x * pr - a32.y * pi, qi = a32.x * pi + a32.y * pr; pr = qr; pi = qi; } }
    }
    E[w * 128 + p] = xr; E[w * 128 + 64 + p] = xi; PW[w * 128 + p] = pr; PW[w * 128 + 64 + p] = pi;
    __syncthreads();
    float cr = 0.f, ci = 0.f;
    if (dir == 0) { for (int w2 = 0; w2 < w; ++w2) { const float2 e = make_float2(E[w2 * 128 + p], E[w2 * 128 + 64 + p]), q = make_float2(PW[w2 * 128 + p], PW[w2 * 128 + 64 + p]); const float nr = q.x * cr - q.y * ci + e.x, ni = q.x * ci + q.y * cr + e.y; cr = nr; ci = ni; } }
    else { for (int w2 = 7; w2 > w; --w2) { const float2 e = make_float2(E[w2 * 128 + p], E[w2 * 128 + 64 + p]), q = make_float2(PW[w2 * 128 + p], PW[w2 * 128 + 64 + p]); const float nr = q.x * cr - q.y * ci + e.x, ni = q.x * ci + q.y * cr + e.y; cr = nr; ci = ni; } }
    xr = cr; xi = ci;
    for (int b = 0; b < 5; ++b) { float sr[13], si[13];
#pragma unroll
        for (int i = 0; i < 13; ++i) { const int o = b * 13 + i; const int j = dir == 0 ? j0 + o : j1 - 1 - o; const bool ok = o < len; sr[i] = ok ? S[(size_t)j * 256] : 0.f; si[i] = ok ? S[(size_t)j * 256 + 64] : 0.f; }
#pragma unroll
        for (int i = 0; i < 13; ++i) { const int o = b * 13 + i; if (o < len) { const int j = dir == 0 ? j0 + o : j1 - 1 - o;
                UA[(size_t)j * 768] = (bf16)f2bf(xr); UA[(size_t)j * 768 + 64] = (bf16)f2bf(xi);
                const float nr = a32.x * xr - a32.y * xi + sr[i], ni = a32.x * xi + a32.y * xr + si[i]; xr = nr; xi = ni; } }
    }
}
__device__ __forceinline__ void ln_row(const float* hin, const float* add, const float* y0, float w0, const float* y1, float w1, const float* gam, const float* bet,
                                       float* hout, bf16* hb, float* dout, int lane) {
    f32x4 v[8]; float s = 0.f;
#pragma unroll
    for (int j = 0; j < 8; ++j) { const int idx = (j * 64 + lane) * 4; f32x4 x = *(const f32x4*)(hin + idx) * DN_ALPHA;
        if (add) x += *(const f32x4*)(add + idx);
        if (y0) x += *(const f32x4*)(y0 + idx) * w0 + *(const f32x4*)(y1 + idx) * w1;
        v[j] = x; s += (x.x + x.y) + (x.z + x.w); }
    const float mean = wave_sum(s) * (1.0f / D); float q = 0.f;
#pragma unroll
    for (int j = 0; j < 8; ++j) { v[j] = v[j] - mean; q += (v[j].x * v[j].x + v[j].y * v[j].y) + (v[j].z * v[j].z + v[j].w * v[j].w); }
    const float rstd = 1.0f / sqrtf(wave_sum(q) * (1.0f / D) + LN_EPS);
#pragma unroll
    for (int j = 0; j < 8; ++j) { const int idx = (j * 64 + lane) * 4; const f32x4 o = v[j] * rstd * *(const f32x4*)(gam + idx) + *(const f32x4*)(bet + idx);
        if (hout) *(f32x4*)(hout + idx) = o;
        if (hb) { v2u w; w.x = pk2(o.x, o.y); w.y = pk2(o.z, o.w); *(v2u*)(hb + idx) = w; }
        if (dout) *(f32x4*)(dout + idx) = o; }
}
__device__ __forceinline__ void phase_ln_mix(const Ctx& c, const Args& a, int layer, const float* Hin, float* Hout) {
    const float* MIX = (const float*)(a.ws + WS_MIX); bf16* HB = (bf16*)(a.ws + WS_HBF);
    for (int row = c.gw; row < LP; row += c.ngw)
        ln_row(Hin + (size_t)row * D, MIX + (size_t)row * D, nullptr, 0.f, nullptr, 0.f, a.in[I_LNMG] + layer * D, a.in[I_LNMB] + layer * D, Hout + (size_t)row * D, HB + (size_t)row * D, nullptr, c.lane);
}
__device__ __forceinline__ void phase_ln_ffn(const Ctx& c, const Args& a, int layer, const float* Hin, float* Hout, bool last) {
    const float* Y = (const float*)(a.ws + WS_R1 + R1_Y); bf16* HB = (bf16*)(a.ws + WS_HBF);
    const int* route = (const int*)(a.ws + WS_ROUTE);
    for (int row = c.gw; row < LP; row += c.ngw) {
        const float* y0 = nullptr; const float* y1 = nullptr; float w0 = 0.f, w1 = 0.f;
        if (row >= ROWV) { const int* r = route + (size_t)row * 8; y0 = Y + (size_t)r[4] * D; y1 = Y + (size_t)r[5] * D; w0 = __int_as_float(r[6]); w1 = __int_as_float(r[7]); }
        float* dout = (last && row >= 256) ? a.out + (size_t)(row - 256) * D : nullptr;
        if (row >= ROWV) ln_row(Hin + (size_t)row * D, nullptr, y0, w0, y1, w1, a.in[I_LNFG] + layer * D, a.in[I_LNFB] + layer * D, last ? nullptr : Hout + (size_t)row * D, last ? nullptr : HB + (size_t)row * D, dout, c.lane);
        else if (!last) ln_row(Hin + (size_t)row * D, nullptr, nullptr, 0.f, nullptr, 0.f, a.in[I_LNFG] + layer * D, a.in[I_LNFB] + layer * D, Hout + (size_t)row * D, HB + (size_t)row * D, nullptr, c.lane);
    }
}
__device__ __forceinline__ void phase_router(const Ctx& c, const Args& a, int layer, const float* Hn) {
    LAS float* lg = (LAS float*)c.lds;
    const float* wg = a.in[I_WGRP] + (size_t)layer * D * 8; const float* we = a.in[I_WEXP] + (size_t)layer * D * 64;
    const float* bg = a.in[I_BGRP] + layer * 8; const float* be = a.in[I_BEXP] + layer * 64;
    int* route = (int*)(a.ws + WS_ROUTE); unsigned* cnt = (unsigned*)(a.ws + WS_CTL) + CW_CNT + layer * 64;
    const int ntask = (NVALID + 6) / 7;
    for (int task = c.bid; task < ntask; task += c.nblk) {
        const int rr = c.tid / 72, j = c.tid % 72, row = ROWV + task * 7 + rr;
        if (c.tid < 504 && row < LP) {
            const float* h = Hn + (size_t)row * D; float acc0 = 0.f, acc1 = 0.f, acc2 = 0.f, acc3 = 0.f;
            if (j < 8) { for (int k = 0; k < D; k += 4) { acc0 += h[k] * wg[(size_t)k * 8 + j]; acc1 += h[k + 1] * wg[(size_t)(k + 1) * 8 + j]; acc2 += h[k + 2] * wg[(size_t)(k + 2) * 8 + j]; acc3 += h[k + 3] * wg[(size_t)(k + 3) * 8 + j]; } }
            else { const int e = j - 8; for (int k = 0; k < D; k += 4) { acc0 += h[k] * we[(size_t)k * 64 + e]; acc1 += h[k + 1] * we[(size_t)(k + 1) * 64 + e]; acc2 += h[k + 2] * we[(size_t)(k + 2) * 64 + e]; acc3 += h[k + 3] * we[(size_t)(k + 3) * 64 + e]; } }
            lg[rr * 72 + j] = (acc0 + acc1) + (acc2 + acc3) + (j < 8 ? bg[j] : be[j - 8]);
        }
        __syncthreads();
        if (c.tid < 7) { const int row2 = ROWV + task * 7 + c.tid;
            if (row2 < LP) { const LAS float* l = lg + c.tid * 72;
                int grp = 0; float gm = l[0];
                for (int q = 1; q < 8; ++q) if (l[q] > gm) { gm = l[q]; grp = q; }
                float gs = 0.f; for (int q = 0; q < 8; ++q) gs += expf(l[q] - gm);
                const float pg = 1.0f / gs;
                const LAS float* el = l + 8 + grp * 8;
                int i0 = 0; float v0 = el[0]; for (int q = 1; q < 8; ++q) if (el[q] > v0) { v0 = el[q]; i0 = q; }
                int i1 = -1; float v1 = -3.0e38f; for (int q = 0; q < 8; ++q) if (q != i0 && el[q] > v1) { v1 = el[q]; i1 = q; }
                const float e1 = expf(v1 - v0), w0 = pg / (1.0f + e1), w1 = pg * e1 / (1.0f + e1);
                const int ex0 = grp * 8 + i0, ex1 = grp * 8 + i1;
                const int p0 = (int)atomicAdd(cnt + ex0, 1u), p1 = (int)atomicAdd(cnt + ex1, 1u);
                int* r = route + (size_t)row2 * 8; r[0] = ex0; r[1] = ex1; r[2] = p0; r[3] = p1; r[6] = __float_as_int(w0); r[7] = __float_as_int(w1); } }
        __syncthreads();
    }
}
__device__ __forceinline__ void phase_plan(const Ctx& c, const Args& a, int layer) {
    if (c.bid != 0 || c.tid != 0) return;
    const unsigned* cnt = (const unsigned*)(a.ws + WS_CTL) + CW_CNT + layer * 64; int* plan = (int*)(a.ws + WS_CTL) + CW_PLAN + layer * 512;
    int t = 0;
    for (int e = 0; e < NEXP; ++e) { const int n = (int)cnt[e], nt = (n + 255) / 256; plan[1 + e] = t * 256; for (int q = 0; q < nt; ++q) plan[128 + t + q] = e; t += nt; }
    plan[0] = t;
}
__device__ __forceinline__ void phase_gather(const Ctx& c, const Args& a, int layer) {
    const int* plan = (const int*)(a.ws + WS_CTL) + CW_PLAN + layer * 512; int* route = (int*)(a.ws + WS_ROUTE);
    const bf16* HB = (const bf16*)(a.ws + WS_HBF); bf16* XS = (bf16*)(a.ws + WS_R1 + R1_XSRT);
    for (int T = c.gw; T < NVALID * 2; T += c.ngw) {
        const int row = ROWV + (T >> 1), j = T & 1; int* r = route + (size_t)row * 8;
        const int slot = plan[1 + r[j]] + r[2 + j];
        if (c.lane == 0) r[4 + j] = slot;
        const v4u* s = (const v4u*)(HB + (size_t)row * D); v4u* d = (v4u*)(XS + (size_t)slot * D);
#pragma unroll
        for (int q = 0; q < 4; ++q) d[q * 64 + c.lane] = s[q * 64 + c.lane];
    }
}
__device__ __forceinline__ void phase_hg_prep(const Ctx& c, const Args& a) {
    float* P = (float*)(a.ws + WS_R1 + R1_PROJ1);
    for (long i = (long)c.bid * NTHR + c.tid; i < (long)NVALID * 4096; i += (long)c.nblk * NTHR) {
        const int row = ROWV + (int)(i >> 12), cc = (int)(i & 4095), ch = cc & 2047;
        const float l0 = a.in[I_LB][ch], l1 = a.in[I_LB][D + ch], lb = 1.0f / (1.0f + expf(l0 - l1));
        float* p = P + (size_t)row * CN + 4096 + cc;
        *p = lb + (1.0f - lb) * sigmoidf_(*p);
    }
}
__device__ __forceinline__ void phase_hg_rec_naive(const Ctx& c, const Args& a) {
    if (c.bid >= 32) return;
    const int dir = c.bid >> 4, head = c.bid & 15, v = c.tid >> 2, kq = c.tid & 3;
    const float* P = (const float*)(a.ws + WS_R1 + R1_PROJ1);
    float* O = (float*)(a.ws + WS_R1 + (dir == 0 ? R1_OFW : R1_OBW));
    float S[32];
#pragma unroll
    for (int k = 0; k < 32; ++k) S[k] = 0.f;
    const int fcol = (dir == 0 ? 4096 : 6144) + head * 128 + kq * 32, qcol = head * 128 + kq * 32, vcol = 2048 + head * 128 + v;
    for (int st = 0; st < NVALID; ++st) {
        const int row = dir == 0 ? ROWV + st : LP - 1 - st;
        const float* base = P + (size_t)row * CN;
        const float vv = base[vcol]; float o = 0.f;
#pragma unroll
        for (int k4 = 0; k4 < 8; ++k4) { const f32x4 f = *(const f32x4*)(base + fcol + k4 * 4), q = *(const f32x4*)(base + qcol + k4 * 4);
            S[k4 * 4 + 0] = f.x * S[k4 * 4 + 0] + (1.0f - f.x) * vv; o += S[k4 * 4 + 0] * q.x;
            S[k4 * 4 + 1] = f.y * S[k4 * 4 + 1] + (1.0f - f.y) * vv; o += S[k4 * 4 + 1] * q.y;
            S[k4 * 4 + 2] = f.z * S[k4 * 4 + 2] + (1.0f - f.z) * vv; o += S[k4 * 4 + 2] * q.z;
            S[k4 * 4 + 3] = f.w * S[k4 * 4 + 3] + (1.0f - f.w) * vv; o += S[k4 * 4 + 3] * q.w; }
        o += __shfl_xor(o, 1); o += __shfl_xor(o, 2);
        if (kq == 0) O[(size_t)row * D + head * 128 + v] = o;
    }
}

typedef short bf16x8 __attribute__((ext_vector_type(8)));
constexpr int HG_QT = 0, HG_KT = 17408, HG_KH = 34816, HG_VT = 53248, HG_P = 71680, HG_ST = 80896, HG_T = 115712, HG_DV = 117760;
constexpr int LD_K = 272, LD_T = 144;
__device__ __forceinline__ bf16x8 ldfrag(LAS unsigned char* base, int row, int pitch, int kbyte) { return *(const LAS bf16x8*)(base + row * pitch + kbyte); }
#define MFMA16(a, b, c) __builtin_amdgcn_mfma_f32_16x16x32_bf16((a), (b), (c), 0, 0, 0)
struct HgRaw { float f[16], q[16], v[16]; };
template <bool NEEDQ> __device__ __forceinline__ void hg_load(HgRaw& r, const float* P, int r0, int head, int dir, int k, int tq) {
    const float* base = P + (size_t)(r0 + 16 * tq) * CN + head * 128 + k;
#pragma unroll
    for (int i = 0; i < 16; ++i) { r.f[i] = base[(size_t)i * CN + 4096 + 2048 * dir]; r.v[i] = base[(size_t)i * CN + 2048]; if (NEEDQ) r.q[i] = base[(size_t)i * CN]; }
}
template <bool NEEDQ> __device__ __forceinline__ float hg_prep(const Ctx& c, const HgRaw& r, int r0, int dir, int k, int tq) {
    LAS unsigned char* L = c.lds;
    LAS float* T = (LAS float*)(L + HG_T);
    float g[16], kk[16], cs[16];
#pragma unroll
    for (int i = 0; i < 16; ++i) { const bool valid = (r0 + 16 * tq + i) >= ROWV; g[i] = valid ? logf(r.f[i]) : 0.f; kk[i] = valid ? 1.0f - r.f[i] : 0.f; }
    if (dir == 0) { cs[0] = g[0];
#pragma unroll
        for (int i = 1; i < 16; ++i) cs[i] = cs[i - 1] + g[i]; }
    else { cs[15] = g[15];
#pragma unroll
        for (int i = 14; i >= 0; --i) cs[i] = cs[i + 1] + g[i]; }
    T[tq * 128 + k] = dir == 0 ? cs[15] : cs[0];
    __syncthreads();
    const float t0 = T[k], t1 = T[128 + k], t2 = T[256 + k], t3 = T[384 + k];
    const float btot = (t0 + t1) + (t2 + t3);
    float off;
    if (dir == 0) off = tq == 0 ? 0.f : tq == 1 ? t0 : tq == 2 ? t0 + t1 : t0 + t1 + t2;
    else off = tq == 3 ? 0.f : tq == 2 ? t3 : tq == 1 ? t3 + t2 : t3 + t2 + t1;
    unsigned kh[8], vt[8];
#pragma unroll
    for (int i = 0; i < 16; i += 2) {
        const float b0 = off + cs[i], b1 = off + cs[i + 1];
        const float h0 = kk[i] * __expf(btot - b0), h1 = kk[i + 1] * __expf(btot - b1);
        kh[i >> 1] = pk2(h0, h1); vt[i >> 1] = pk2(r.v[i], r.v[i + 1]);
        if (NEEDQ) {
            const int t = 16 * tq + i;
            *(LAS unsigned short*)(L + HG_QT + t * LD_K + 2 * k) = (unsigned short)f2bf(r.q[i] * __expf(b0));
            *(LAS unsigned short*)(L + HG_QT + (t + 1) * LD_K + 2 * k) = (unsigned short)f2bf(r.q[i + 1] * __expf(b1));
            *(LAS unsigned short*)(L + HG_KT + t * LD_K + 2 * k) = (unsigned short)f2bf(kk[i] * __expf(-b0));
            *(LAS unsigned short*)(L + HG_KT + (t + 1) * LD_K + 2 * k) = (unsigned short)f2bf(kk[i + 1] * __expf(-b1));
        }
    }
    *(LAS v4u*)(L + HG_KH + k * LD_T + 32 * tq) = (v4u){kh[0], kh[1], kh[2], kh[3]};
    *(LAS v4u*)(L + HG_KH + k * LD_T + 32 * tq + 16) = (v4u){kh[4], kh[5], kh[6], kh[7]};
    *(LAS v4u*)(L + HG_VT + k * LD_T + 32 * tq) = (v4u){vt[0], vt[1], vt[2], vt[3]};
    *(LAS v4u*)(L + HG_VT + k * LD_T + 32 * tq + 16) = (v4u){vt[4], vt[5], vt[6], vt[7]};
    if (tq == 0) ((LAS float*)(L + HG_DV))[k] = __expf(btot);
    return btot;
}
__device__ __forceinline__ void hg_update(const Ctx& c, f32x4 (&S)[8]) {
    LAS unsigned char* L = c.lds; const int r = c.lane & 15, q = c.lane >> 4, w = c.wave;
    const LAS float* DV = (const LAS float*)(L + HG_DV);
#pragma unroll
    for (int kt = 0; kt < 8; ++kt) { const float d = DV[16 * kt + r]; S[kt] = S[kt] * d; }
#pragma unroll
    for (int ks = 0; ks < 2; ++ks) { const bf16x8 a = ldfrag(L + HG_VT, 16 * w + r, LD_T, (32 * ks + 8 * q) * 2);
#pragma unroll
        for (int kt = 0; kt < 8; ++kt) { const bf16x8 b = ldfrag(L + HG_KH, 16 * kt + r, LD_T, (32 * ks + 8 * q) * 2); S[kt] = MFMA16(a, b, S[kt]); } }
}
__device__ __forceinline__ void hg_store_st(const Ctx& c, const f32x4 (&S)[8]) {
    LAS unsigned char* L = c.lds; const int r = c.lane & 15, q = c.lane >> 4, w = c.wave;
#pragma unroll
    for (int kt = 0; kt < 8; ++kt)
#pragma unroll
        for (int e = 0; e < 4; ++e) *(LAS unsigned short*)(L + HG_ST + (16 * w + 4 * q + e) * LD_K + 2 * (16 * kt + r)) = (unsigned short)f2bf(S[kt][e]);
}
__device__ __forceinline__ void hg_seg_range(int seg, int& c0, int& n) { if (seg == 0) { c0 = 3; n = 9; } else { c0 = 4 + 8 * seg; n = 8; } }
__device__ __forceinline__ void phase_hg_pass1(const Ctx& c, const Args& a) {
    const float* P = (const float*)(a.ws + WS_R1 + R1_PROJ1);
    float* DS = (float*)(a.ws + WS_R1 + R1_DS); float* DSEG = (float*)(a.ws + WS_R1 + R1_DSEG);
    const int k = c.tid & 127, tq = c.tid >> 7, r = c.lane & 15, q = c.lane >> 4, w = c.wave;
    for (int u = c.bid; u < 1024; u += c.nblk) {
        const int chain = u & 31, seg = u >> 5, dir = chain >> 4, head = chain & 15;
        int c0, n; hg_seg_range(seg, c0, n);
        f32x4 S[8];
#pragma unroll
        for (int kt = 0; kt < 8; ++kt) S[kt] = (f32x4){0.f, 0.f, 0.f, 0.f};
        float bsum = 0.f;
        HgRaw raw; hg_load<false>(raw, P, 64 * (dir == 0 ? c0 : c0 + n - 1), head, dir, k, tq);
        for (int j = 0; j < n; ++j) {
            const int ci = dir == 0 ? c0 + j : c0 + n - 1 - j;
            bsum += hg_prep<false>(c, raw, 64 * ci, dir, k, tq);
            if (j + 1 < n) hg_load<false>(raw, P, 64 * (dir == 0 ? ci + 1 : ci - 1), head, dir, k, tq);
            __syncthreads();
            hg_update(c, S);
            __syncthreads();
        }
        float* dst = DS + ((size_t)seg * 32 + chain) * 16384;
#pragma unroll
        for (int kt = 0; kt < 8; ++kt)
#pragma unroll
            for (int e = 0; e < 4; ++e) dst[(16 * w + 4 * q + e) * 128 + 16 * kt + r] = S[kt][e];
        if (tq == 0) DSEG[((size_t)seg * 32 + chain) * 128 + k] = __expf(bsum);
    }
}
__device__ __forceinline__ void phase_hg_segscan(const Ctx& c, const Args& a) {
    float* DS = (float*)(a.ws + WS_R1 + R1_DS); const float* DSEG = (const float*)(a.ws + WS_R1 + R1_DSEG);
    for (int i = c.bid * NTHR + c.tid; i < 32 * 4096; i += c.nblk * NTHR) {
        const int chain = i >> 12, e4 = i & 4095, k4 = (e4 & 31) * 4, dir = chain >> 4;
        f32x4 run = (f32x4){0.f, 0.f, 0.f, 0.f};
        for (int j = 0; j < 32; ++j) { const int seg = dir == 0 ? j : 31 - j;
            f32x4* p = (f32x4*)(DS + ((size_t)seg * 32 + chain) * 16384) + e4; const f32x4 d = *(const f32x4*)(DSEG + ((size_t)seg * 32 + chain) * 128 + k4);
            const f32x4 ds = *p; *p = run; run = run * d + ds; }
    }
}
__device__ __forceinline__ void phase_hg_pass2(const Ctx& c, const Args& a) {
    const float* P = (const float*)(a.ws + WS_R1 + R1_PROJ1);
    const float* DS = (const float*)(a.ws + WS_R1 + R1_DS);
    LAS unsigned char* L = c.lds;
    const int k = c.tid & 127, tq = c.tid >> 7, r = c.lane & 15, q = c.lane >> 4, w = c.wave;
    const int tr = w >> 1;
    for (int u = c.bid; u < 1024; u += c.nblk) {
        const int chain = u & 31, seg = u >> 5, dir = chain >> 4, head = chain & 15;
        float* O = (float*)(a.ws + WS_R1 + (dir == 0 ? R1_OFW : R1_OBW));
        int c0, n; hg_seg_range(seg, c0, n);
        f32x4 S[8];
        { const float* src = DS + ((size_t)seg * 32 + chain) * 16384;
#pragma unroll
          for (int kt = 0; kt < 8; ++kt)
#pragma unroll
              for (int e = 0; e < 4; ++e) S[kt][e] = src[(16 * w + 4 * q + e) * 128 + 16 * kt + r]; }
        hg_store_st(c, S);
        HgRaw raw; hg_load<true>(raw, P, 64 * (dir == 0 ? c0 : c0 + n - 1), head, dir, k, tq);
        for (int j = 0; j < n; ++j) {
            const int ci = dir == 0 ? c0 + j : c0 + n - 1 - j, r0 = 64 * ci;
            (void)hg_prep<true>(c, raw, r0, dir, k, tq);
            if (j + 1 < n) hg_load<true>(raw, P, 64 * (dir == 0 ? ci + 1 : ci - 1), head, dir, k, tq);
            __syncthreads();
            {
                const int tc0 = (w & 1) * 2; f32x4 sc[2] = {(f32x4){0.f, 0.f, 0.f, 0.f}, (f32x4){0.f, 0.f, 0.f, 0.f}};
#pragma unroll
                for (int ks = 0; ks < 4; ++ks) { const bf16x8 af = ldfrag(L + HG_QT, 16 * tr + r, LD_K, (32 * ks + 8 * q) * 2);
#pragma unroll
                    for (int jj = 0; jj < 2; ++jj) { const bf16x8 bf = ldfrag(L + HG_KT, 16 * (tc0 + jj) + r, LD_K, (32 * ks + 8 * q) * 2); sc[jj] = MFMA16(af, bf, sc[jj]); } }
#pragma unroll
                for (int jj = 0; jj < 2; ++jj) { const int s = 16 * (tc0 + jj) + r;
#pragma unroll
                    for (int e = 0; e < 4; ++e) { const int t = 16 * tr + 4 * q + e; const bool keep = dir == 0 ? (s <= t) : (s >= t);
                        *(LAS unsigned short*)(L + HG_P + t * LD_T + 2 * s) = (unsigned short)f2bf(keep ? sc[jj][e] : 0.f); } }
            }
            __syncthreads();
            {
                const int tc0 = (w & 1) * 4; f32x4 o[4];
#pragma unroll
                for (int jj = 0; jj < 4; ++jj) o[jj] = (f32x4){0.f, 0.f, 0.f, 0.f};
#pragma unroll
                for (int ks = 0; ks < 2; ++ks) { const bf16x8 af = ldfrag(L + HG_P, 16 * tr + r, LD_T, (32 * ks + 8 * q) * 2);
#pragma unroll
                    for (int jj = 0; jj < 4; ++jj) { const bf16x8 bf = ldfrag(L + HG_VT, 16 * (tc0 + jj) + r, LD_T, (32 * ks + 8 * q) * 2); o[jj] = MFMA16(af, bf, o[jj]); } }
#pragma unroll
                for (int ks = 0; ks < 4; ++ks) { const bf16x8 af = ldfrag(L + HG_QT, 16 * tr + r, LD_K, (32 * ks + 8 * q) * 2);
#pragma unroll
                    for (int jj = 0; jj < 4; ++jj) { const bf16x8 bf = ldfrag(L + HG_ST, 16 * (tc0 + jj) + r, LD_K, (32 * ks + 8 * q) * 2); o[jj] = MFMA16(af, bf, o[jj]); } }
#pragma unroll
                for (int jj = 0; jj < 4; ++jj)
#pragma unroll
                    for (int e = 0; e < 4; ++e) O[(size_t)(r0 + 16 * tr + 4 * q + e) * D + head * 128 + 16 * (tc0 + jj) + r] = o[jj][e];
            }
            hg_update(c, S);
            __syncthreads();
            hg_store_st(c, S);
        }
        __syncthreads();
    }
}
__device__ __forceinline__ void phase_hg_finish(const Ctx& c, const Args& a) {
    const float* P = (const float*)(a.ws + WS_R1 + R1_PROJ1);
    const float* OF = (const float*)(a.ws + WS_R1 + R1_OFW); const float* OB = (const float*)(a.ws + WS_R1 + R1_OBW); bf16* MI = (bf16*)(a.ws + WS_MIXIN);
    for (int T = c.gw; T < LP * 16; T += c.ngw) {
        const int row = T >> 4, head = T & 15; const size_t off = (size_t)row * D + head * 128;
        float r0 = 0.f, r1 = 0.f;
        if (row >= ROWV) {
            const float o0 = OF[off + c.lane] + OB[off + c.lane], o1 = OF[off + 64 + c.lane] + OB[off + 64 + c.lane];
            const float ss = wave_sum(o0 * o0 + o1 * o1), rs = 1.0f / sqrtf(ss * (1.0f / 128.0f) + 1e-6f);
            const float* gp = P + (size_t)row * CN + 8192 + head * 128; const float* ng = a.in[I_NORMG] + head * 128;
            r0 = o0 * rs * ng[c.lane] * sigmoidf_(gp[c.lane]); r1 = o1 * rs * ng[64 + c.lane] * sigmoidf_(gp[64 + c.lane]);
        }
        MI[off + c.lane] = (bf16)f2bf(r0); MI[off + 64 + c.lane] = (bf16)f2bf(r1);
    }
}

constexpr int NPHASE = 40;
__global__ void __launch_bounds__(NTHR, 2) fwd(Args args) {
    extern __shared__ __attribute__((aligned(16))) unsigned char lds[];
    Ctx c; c.lds = (LAS unsigned char*)lds; c.ldsg = lds; c.tid = threadIdx.x; c.lane = c.tid & 63; c.wave = __builtin_amdgcn_readfirstlane(c.tid >> 6);
    c.bid = blockIdx.x; c.nblk = gridDim.x; c.gw = c.bid * NWAVES + c.wave; c.ngw = c.nblk * NWAVES;
    volatile LAS unsigned* MISC = (volatile LAS unsigned*)(c.lds + MISC_OFF);
    for (int u = c.tid; u < (LDS_BYTES - RING_BYTES) / 4; u += NTHR) ((LAS unsigned*)(c.lds + RING_BYTES))[u] = 0u;
    __syncthreads();
    const int lo = args.ph_lo, hi = args.ph_hi;
    const bool multi = (hi - lo) > 1;
    XcdBarrier bar; bar.bar = (unsigned*)(args.ws + WS_CTL) + CW_BAR; bar.x = 0; bar.st = nullptr;
    if (multi) bar = xcd_barrier_post((unsigned*)(args.ws + WS_CTL) + CW_BAR, MISC + 8);
#define IN(k) (lo <= (k) && (k) < hi)
#define SEAM(k) do { if (IN(k) && IN((k) + 1)) xcd_barrier(bar); } while (0)
    unsigned char* ws = args.ws;
    float* HA = (float*)(ws + WS_HA); float* HBuf = (float*)(ws + WS_HB);
    const pg8::bf16_t* HBF = (const pg8::bf16_t*)(ws + WS_HBF);
    const pg8::bf16_t* MIXIN = (const pg8::bf16_t*)(ws + WS_MIXIN);
    if (IN(0)) { phase_init(c, args); } SEAM(0);
    if (IN(1)) { phase_s5_ktab(c, args); } SEAM(1);
    if (IN(2)) { phase_weights(c, args); phase_s5_fill(c, args); } SEAM(2);
    if (IN(3)) { pg8::Gemm g = pg8::mkgemm(HBF, ws + WS_WAB, LP, ABN, D); pg8::StaticOrder S; S.init(LP, ABN, c.nblk, c.bid);
        pg8::EpiProjAB E{(float*)(ws + WS_PROJ0), (pg8::bf16_t*)(ws + WS_R1 + R1_UA)}; pg8::gemm_phase(c.lds, g, S, E); } SEAM(3);
    if (IN(4)) { phase_rope(c, args); } SEAM(4);
    if (IN(5)) { phase_attn_naive(c, args); } SEAM(5);
    if (IN(6)) { pg8::Gemm g = pg8::mkgemm(ws + WS_R1 + R1_UA, ws + WS_WST, 768, 256, 512, (size_t)256 * 512 * 2); g.lda = 768; g.astride = (size_t)768 * 768 * 2;
        pg8::GroupTileOrder S; S.init(64, 768, 256, c.nblk, c.bid); pg8::EpiF32 E{(float*)(ws + WS_R1 + R1_SALL), 256, (size_t)768 * 256}; pg8::gemm_phase(c.lds, g, S, E); } SEAM(6);
    if (IN(7)) { phase_s5_chunkscan(c, args); } SEAM(7);
    if (IN(8)) { pg8::Gemm g = pg8::mkgemm(ws + WS_R1 + R1_UA, ws + WS_MWT, 768, 512, 768, (size_t)512 * 768 * 2); g.astride = (size_t)768 * 768 * 2;
        pg8::GroupTileOrder S; S.init(64, 768, 512, c.nblk, c.bid); pg8::EpiS5Y E{(pg8::bf16_t*)(ws + WS_ZB)}; pg8::gemm_phase(c.lds, g, S, E); } SEAM(8);
    if (IN(9)) { pg8::Gemm g = pg8::mkgemm(ws + WS_ZB, ws + WS_WGLU, LP, 1024, 1024); pg8::StaticOrder S; S.init(LP, 1024, c.nblk, c.bid);
        pg8::EpiGlu E{(const pg8::bf16_t*)(ws + WS_ZB), args.in[I_BGLU], (pg8::bf16_t*)(ws + WS_MIXIN)}; pg8::gemm_phase(c.lds, g, S, E); } SEAM(9);
    if (IN(10)) { pg8::Gemm g = pg8::mkgemm(MIXIN, ws + WS_WOAB, LP, D, D); pg8::StaticOrder S; S.init(LP, D, c.nblk, c.bid);
        pg8::EpiF32 E{(float*)(ws + WS_MIX), D, 0}; pg8::gemm_phase(c.lds, g, S, E); } SEAM(10);
    if (IN(11)) { phase_ln_mix(c, args, 0, HA, HBuf); } SEAM(11);
    if (IN(12)) { phase_router(c, args, 0, HBuf); } SEAM(12);
    if (IN(13)) { phase_plan(c, args, 0); } SEAM(13);
    if (IN(14)) { phase_gather(c, args, 0); } SEAM(14);
    if (IN(15)) { pg8::Gemm g = pg8::mkgemm(ws + WS_R1 + R1_XSRT, ws + WS_WGU, MPAD, 1024, D, (size_t)1024 * D * 2); pg8::GroupedOrder S; S.init((const int*)(ws + WS_CTL) + CW_PLAN, 1024, c.nblk, c.bid);
        pg8::EpiSwiGLU E{(pg8::bf16_t*)(ws + WS_R1 + R1_ACT), DEXP}; pg8::gemm_phase(c.lds, g, S, E); } SEAM(15);
    if (IN(16)) { pg8::Gemm g = pg8::mkgemm(ws + WS_R1 + R1_ACT, ws + WS_WD, MPAD, D, DEXP, (size_t)D * DEXP * 2); pg8::GroupedOrder S; S.init((const int*)(ws + WS_CTL) + CW_PLAN, D, c.nblk, c.bid);
        pg8::EpiF32 E{(float*)(ws + WS_R1 + R1_Y), D, 0}; pg8::gemm_phase(c.lds, g, S, E); } SEAM(16);
    if (IN(17)) { phase_ln_ffn(c, args, 0, HBuf, HA, false); } SEAM(17);
    if (IN(18)) { pg8::Gemm g = pg8::mkgemm(HBF, ws + WS_WC, LP, CN, D); pg8::StaticOrder S; S.init(LP, CN, c.nblk, c.bid);
        pg8::EpiF32 E{(float*)(ws + WS_R1 + R1_PROJ1), CN, 0}; pg8::gemm_phase(c.lds, g, S, E); } SEAM(18);
    if (IN(19)) { phase_hg_prep(c, args); } SEAM(19);
    if (IN(20)) { phase_hg_pass1(c, args); xcd_barrier(bar); phase_hg_segscan(c, args); xcd_barrier(bar); phase_hg_pass2(c, args); } SEAM(20);
    if (IN(21)) { phase_hg_finish(c, args); } SEAM(21);
    if (IN(22)) { pg8::Gemm g = pg8::mkgemm(MIXIN, ws + WS_WOC, LP, D, D); pg8::StaticOrder S; S.init(LP, D, c.nblk, c.bid);
        pg8::EpiF32 E{(float*)(ws + WS_MIX), D, 0}; pg8::gemm_phase(c.lds, g, S, E); } SEAM(22);
    if (IN(23)) { phase_ln_mix(c, args, 1, HA, HBuf); } SEAM(23);
    if (IN(24)) { phase_router(c, args, 1, HBuf); } SEAM(24);
    if (IN(25)) { phase_plan(c, args, 1); } SEAM(25);
    if (IN(26)) { phase_gather(c, args, 1); } SEAM(26);
    if (IN(27)) { pg8::Gemm g = pg8::mkgemm(ws + WS_R1 + R1_XSRT, (const pg8::bf16_t*)(ws + WS_WGU) + (size_t)NEXP * 1024 * D, MPAD, 1024, D, (size_t)1024 * D * 2); pg8::GroupedOrder S; S.init((const int*)(ws + WS_CTL) + CW_PLAN + 512, 1024, c.nblk, c.bid);
        pg8::EpiSwiGLU E{(pg8::bf16_t*)(ws + WS_R1 + R1_ACT), DEXP}; pg8::gemm_phase(c.lds, g, S, E); } SEAM(27);
    if (IN(28)) { pg8::Gemm g = pg8::mkgemm(ws + WS_R1 + R1_ACT, (const pg8::bf16_t*)(ws + WS_WD) + (size_t)NEXP * D * DEXP, MPAD, D, DEXP, (size_t)D * DEXP * 2); pg8::GroupedOrder S; S.init((const int*)(ws + WS_CTL) + CW_PLAN + 512, D, c.nblk, c.bid);
        pg8::EpiF32 E{(float*)(ws + WS_R1 + R1_Y), D, 0}; pg8::gemm_phase(c.lds, g, S, E); } SEAM(28);
    if (IN(29)) { phase_ln_ffn(c, args, 1, HBuf, HA, true); }
#undef IN
#undef SEAM
}
constexpr int LAST_PHASE = 29;

extern "C" void kernel_launch(void* const* d_in, const int* in_sizes, int n_in, void* d_out, int out_size, void* d_ws, size_t ws_size, hipStream_t stream) {
    static int grid = 0;
    if (grid == 0) {
        if (n_in != 29 || ws_size < WS_END) { fprintf(stderr, "kernel_launch: expected 29 inputs and >= %zu bytes of workspace (got %d, %zu)\n", (size_t)WS_END, n_in, ws_size); grid = -1; return; }
        int dev = 0, cus = 0, per_cu = 0;
        if (hipGetDevice(&dev) != hipSuccess || hipDeviceGetAttribute(&cus, hipDeviceAttributeMultiprocessorCount, dev) != hipSuccess) { grid = -1; return; }
        if (hipFuncSetAttribute((const void*)fwd, hipFuncAttributeMaxDynamicSharedMemorySize, LDS_BYTES) != hipSuccess) { fprintf(stderr, "kernel_launch: hipFuncSetAttribute failed\n"); grid = -1; return; }
        if (hipOccupancyMaxActiveBlocksPerMultiprocessor(&per_cu, (const void*)fwd, NTHR, LDS_BYTES) != hipSuccess || per_cu < 1) fprintf(stderr, "kernel_launch: occupancy query says %d\n", per_cu);
        (void)hipGetLastError();
        grid = cus;
    }
    if (grid < 0) return;
    (void)hipMemsetAsync((char*)d_ws + WS_CTL, 0, CTL_BYTES, stream);
    Args a{};
    for (int i = 0; i < 29; ++i) a.in[i] = (const float*)d_in[i];
    a.out = (float*)d_out; a.ws = (unsigned char*)d_ws;
#ifndef MK_N_LAUNCHES
#define MK_N_LAUNCHES 1
#endif
    if (MK_N_LAUNCHES == 1) { a.ph_lo = 0; a.ph_hi = LAST_PHASE + 1; hipLaunchKernelGGL(fwd, dim3(grid), dim3(NTHR), LDS_BYTES, stream, a); }
    else for (int p = 0; p <= LAST_PHASE; ++p) {
        a.ph_lo = p; a.ph_hi = p + 1;
        hipLaunchKernelGGL(fwd, dim3(grid), dim3(NTHR), LDS_BYTES, stream, a);
    }
}
```

```cpp
#include <hip/hip_runtime.h>
#include <cstdio>
#include <cstdint>

namespace pg8 {
#define PG8_LAS __attribute__((address_space(3)))
typedef unsigned short bf16_t;
typedef short bf16x8 __attribute__((ext_vector_type(8)));
typedef float f32x4 __attribute__((ext_vector_type(4)));
typedef unsigned u32x4 __attribute__((ext_vector_type(4)));
constexpr int BM = 256, BK = 64, HALF = 128, HTB = HALF * BK * 2, STAGE_BYTES = 8 * HTB, NXCD = 8, WGM = 8;

__host__ __device__ __forceinline__ int lds_byte(int r, int c) { const int st = (r >> 4) * 2 + (c >> 5), rr = r & 15, cc = c & 31, ob = rr * 64 + cc * 2; return st * 1024 + (ob ^ (((ob >> 9) & 1) << 5)); }
__host__ __device__ __forceinline__ void stage_rc(int b, int& R, int& C) { const int st = b / 1024, sb = b % 1024, swz = sb ^ (((sb >> 9) & 1) << 5); R = (st >> 1) * 16 + swz / 64; C = (st & 1) * 32 + (swz % 64) / 2; }
__host__ __device__ __forceinline__ int perm32(int rho) { const int n = rho >> 4, i = rho & 15; return 8 * (i >> 2) + 4 * n + (i & 3); }

struct Unit { int pm, pn, eb; };
struct Gemm { const bf16_t* A; const bf16_t* Bt; int M, N, K, lda, ldb; size_t astride, bstride; };

struct StaticOrder {
    int nM, nN, nwg, G, c;
    __host__ __device__ void init(int M, int N, int G_, int c_) { nM = M / BM; nN = N / BM; nwg = nM * nN; G = G_; c = c_; }
    __host__ __device__ bool next(int i, Unit& u) const {
        const long L = (long)i * G + c; if (L >= nwg) return false;
        int wgid = (int)L; { const int q = nwg / NXCD, r = nwg % NXCD, xcd = wgid % NXCD, off = wgid / NXCD; wgid = (xcd < r ? xcd * (q + 1) : r * (q + 1) + (xcd - r) * q) + off; }
        const int nig = WGM * nN, gid = wgid / nig, fm = gid * WGM, gsz = (nM - fm) < WGM ? (nM - fm) : WGM;
        u.pm = fm + ((wgid % nig) % gsz); u.pn = (wgid % nig) / gsz; u.eb = 0; return true;
    }
    __device__ __forceinline__ void a_ready(const Unit&) const {}
    __device__ __forceinline__ void done(const Unit&) const {}
};
struct GroupedOrder {
    int ntiles, nN, nwg, G, c; const int* tile_expert;
    __device__ void init(const int* plan, int N, int G_, int c_) { ntiles = plan[0]; tile_expert = plan + 128; nN = N / BM; nwg = ntiles * nN; G = G_; c = c_; }
    __device__ bool next(int i, Unit& u) const {
        const long L = (long)i * G + c; if (L >= nwg) return false;
        u.pm = (int)(L / nN); u.pn = (int)(L % nN); u.eb = tile_expert[u.pm]; return true;
    }
    __device__ __forceinline__ void a_ready(const Unit&) const {}
    __device__ __forceinline__ void done(const Unit&) const {}
};

struct GroupTileOrder {
    int nM, nN, nwg, G, c;
    __device__ void init(int groups, int M, int N, int G_, int c_) { nM = M / BM; nN = N / BM; nwg = groups * nM * nN; G = G_; c = c_; }
    __device__ bool next(int i, Unit& u) const {
        const long L = (long)i * G + c; if (L >= nwg) return false;
        const int per = nM * nN, rem = (int)(L % per); u.eb = (int)(L / per); u.pm = rem % nM; u.pn = rem / nM; return true;
    }
    __device__ __forceinline__ void a_ready(const Unit&) const {}
    __device__ __forceinline__ void done(const Unit&) const {}
};
__device__ __forceinline__ unsigned cvt_pk_bf16(float lo, float hi) { unsigned r; asm volatile("v_cvt_pk_bf16_f32 %0, %1, %2" : "=v"(r) : "v"(lo), "v"(hi)); return r; }

struct EpiF32 {
    static constexpr bool PERM = false, AFTER_DRAIN = false;
    float* C; int ldc; size_t cstride;
    __device__ __forceinline__ void operator()(const f32x4 (&acc)[2][2][4][2], const Unit& u, int wr, int wc, int fr, int fq) const {
        const int row0 = u.pm * BM + wr * 64 + fr, col0 = u.pn * BM + wc * 32 + 4 * fq;
#pragma unroll
        for (int ai = 0; ai < 2; ++ai)
#pragma unroll
            for (int m = 0; m < 4; ++m) { float* rowp = C + (size_t)u.eb * cstride + (size_t)(row0 + ai * HALF + m * 16) * ldc + col0;
#pragma unroll
                for (int bj = 0; bj < 2; ++bj)
#pragma unroll
                    for (int n = 0; n < 2; ++n) *(f32x4*)(rowp + bj * HALF + n * 16) = acc[ai][bj][m][n]; }
    }
};
struct EpiSwiGLU {
    static constexpr bool PERM = true, AFTER_DRAIN = false;
    bf16_t* O; int ldc;
    __device__ __forceinline__ void operator()(const f32x4 (&acc)[2][2][4][2], const Unit& u, int wr, int wc, int fr, int fq) const {
        const int row0 = u.pm * BM + wr * 64 + fr, col0 = u.pn * HALF + wc * 32 + 8 * fq;
#pragma unroll
        for (int ai = 0; ai < 2; ++ai)
#pragma unroll
            for (int m = 0; m < 4; ++m) { bf16_t* rowp = O + (size_t)(row0 + ai * HALF + m * 16) * ldc + col0;
                float r[8];
#pragma unroll
                for (int n = 0; n < 2; ++n)
#pragma unroll
                    for (int i = 0; i < 4; ++i) { const float g = acc[ai][0][m][n][i], up = acc[ai][1][m][n][i]; r[n * 4 + i] = g / (1.0f + __expf(-g)) * up; }
                u32x4 w; w.x = cvt_pk_bf16(r[0], r[1]); w.y = cvt_pk_bf16(r[2], r[3]); w.z = cvt_pk_bf16(r[4], r[5]); w.w = cvt_pk_bf16(r[6], r[7]);
                *(u32x4*)rowp = w; }
    }
};

__host__ __device__ __forceinline__ Gemm mkgemm(const void* A, const void* Bt, int M, int N, int K, size_t bstride = 0) { Gemm g; g.A = (const bf16_t*)A; g.Bt = (const bf16_t*)Bt; g.M = M; g.N = N; g.K = K; g.lda = K; g.ldb = K; g.astride = 0; g.bstride = bstride; return g; }
struct EpiProjAB {
    static constexpr bool PERM = false, AFTER_DRAIN = false;
    float* C; bf16_t* UA;
    __device__ __forceinline__ void operator()(const f32x4 (&acc)[2][2][4][2], const Unit& u, int wr, int wc, int fr, int fq) const {
        const int row0 = u.pm * BM + wr * 64 + fr, col0 = u.pn * BM + wc * 32 + 4 * fq;
        if (u.pn < 6) {
#pragma unroll
            for (int ai = 0; ai < 2; ++ai)
#pragma unroll
                for (int m = 0; m < 4; ++m) { float* rowp = C + (size_t)(row0 + ai * HALF + m * 16) * 2560 + col0;
#pragma unroll
                    for (int bj = 0; bj < 2; ++bj)
#pragma unroll
                        for (int n = 0; n < 2; ++n) *(f32x4*)(rowp + bj * HALF + n * 16) = acc[ai][bj][m][n]; }
        } else {
#pragma unroll
            for (int ai = 0; ai < 2; ++ai)
#pragma unroll
                for (int m = 0; m < 4; ++m) { const int row = row0 + ai * HALF + m * 16;
                    if (row >= 224) { const int chunk = (row - 224) >> 5, t = (row - 224) & 31;
#pragma unroll
                        for (int bj = 0; bj < 2; ++bj)
#pragma unroll
                            for (int n = 0; n < 2; ++n) { const int ch = col0 + bj * HALF + n * 16 - 1536, g = ch >> 4, cc = ch & 15; const f32x4 v = acc[ai][bj][m][n];
                                typedef unsigned u32x2 __attribute__((ext_vector_type(2)));
                                u32x2 w; w.x = cvt_pk_bf16(v[0], v[1]); w.y = cvt_pk_bf16(v[2], v[3]);
                                *(u32x2*)(UA + ((size_t)g * 768 + chunk) * 768 + t * 16 + cc) = w; } } }
        }
    }
};
struct EpiS5Y {
    static constexpr bool PERM = false, AFTER_DRAIN = false;
    bf16_t* ZB;
    __device__ __forceinline__ void operator()(const f32x4 (&acc)[2][2][4][2], const Unit& u, int wr, int wc, int fr, int fq) const {
#pragma unroll
        for (int ai = 0; ai < 2; ++ai)
#pragma unroll
            for (int m = 0; m < 4; ++m) { const int chunk = u.pm * BM + ai * HALF + wr * 64 + m * 16 + fr;
                if (chunk <= 512) {
#pragma unroll
                    for (int bj = 0; bj < 2; ++bj)
#pragma unroll
                        for (int n = 0; n < 2; ++n) { const int t = 16 * u.pn + 8 * bj + 2 * wc + n, row = 224 + 32 * chunk + t; float z[4];
#pragma unroll
                            for (int i = 0; i < 4; ++i) { const float y = acc[ai][bj][m][n][i]; const float x2 = 1.5957691216057308f * (y + 0.044715f * y * y * y);
                                const float th = 1.0f - 2.0f / (1.0f + __expf(x2)); z[i] = 0.5f * y * (1.0f + th); }
                            typedef unsigned u32x2 __attribute__((ext_vector_type(2)));
                            u32x2 w; w.x = cvt_pk_bf16(z[0], z[1]); w.y = cvt_pk_bf16(z[2], z[3]);
                            *(u32x2*)(ZB + (size_t)row * 1024 + 16 * u.eb + 4 * fq) = w; } } }
    }
};
struct EpiGlu {
    static constexpr bool PERM = true, AFTER_DRAIN = false;
    const bf16_t* ZB; const float* bias; bf16_t* O;
    __device__ __forceinline__ void operator()(const f32x4 (&acc)[2][2][4][2], const Unit& u, int wr, int wc, int fr, int fq) const {
        const int row0 = u.pm * BM + wr * 64 + fr, col0 = u.pn * BM + wc * 32 + 8 * fq;
#pragma unroll
        for (int ai = 0; ai < 2; ++ai)
#pragma unroll
            for (int m = 0; m < 4; ++m) { const int row = row0 + ai * HALF + m * 16;
#pragma unroll
                for (int bj = 0; bj < 2; ++bj) { const int col = col0 + bj * HALF;
                    const u32x4 zw = *(const u32x4*)(ZB + (size_t)row * 1024 + col);
                    const f32x4 b0 = *(const f32x4*)(bias + col), b1 = *(const f32x4*)(bias + col + 4);
                    float r[8];
#pragma unroll
                    for (int i = 0; i < 4; ++i) { const unsigned zz = i < 2 ? (i == 0 ? zw.x : zw.y) : (i == 2 ? zw.z : zw.w);
                        const float z0 = __uint_as_float(zz << 16), z1 = __uint_as_float(zz & 0xffff0000u);
                        const int e0 = 2 * i, e1 = 2 * i + 1;
                        const float a0 = (e0 < 4 ? acc[ai][bj][m][0][e0] : acc[ai][bj][m][1][e0 - 4]) + (e0 < 4 ? b0[e0] : b1[e0 - 4]);
                        const float a1 = (e1 < 4 ? acc[ai][bj][m][0][e1] : acc[ai][bj][m][1][e1 - 4]) + (e1 < 4 ? b0[e1] : b1[e1 - 4]);
                        r[e0] = z0 / (1.0f + __expf(-a0)); r[e1] = z1 / (1.0f + __expf(-a1)); }
                    u32x4 w; w.x = cvt_pk_bf16(r[0], r[1]); w.y = cvt_pk_bf16(r[2], r[3]); w.z = cvt_pk_bf16(r[4], r[5]); w.w = cvt_pk_bf16(r[6], r[7]);
                    *(u32x4*)(O + (size_t)row * 2048 + 1024 + col) = w; } }
    }
};

template <class Epi, class Sched>
__device__ __forceinline__ void gemm_phase(PG8_LAS unsigned char* lds, const Gemm g, const Sched& S, const Epi& E) {
    const int tid = threadIdx.x, wid = __builtin_amdgcn_readfirstlane(tid >> 6), lane = tid & 63, wr = wid >> 2, wc = wid & 3, fr = lane & 15, fq = lane >> 4;
    const int K = g.K, nt = K / BK;
    unsigned voffA[2], voffB[2];
#pragma unroll
    for (int i = 0; i < 2; ++i) { int R, C; stage_rc(tid * 16 + i * 8192, R, C); const int Rb = Epi::PERM ? ((R & ~31) + perm32(R & 31)) : R;
        voffA[i] = (unsigned)(R * g.lda + C) * 2u; voffB[i] = (unsigned)(Rb * g.ldb + C) * 2u; }
    const size_t kstep = (size_t)(BK * 2);
    const size_t hstepA = (size_t)HALF * g.lda * 2, hstepB = (size_t)HALF * g.ldb * 2;
    const size_t tstepA = 2 * hstepA, tstepB = 2 * hstepB;
    const unsigned ldsw = (unsigned)wid * 1024u;
    const int aoff = lds_byte(wr * 64 + fr, fq * 8), boff = lds_byte(wc * 32 + fr, fq * 8);
#define PG8_SA(b, h) (((b) * 2 + (h)) * HTB)
#define PG8_SB(b, h) ((4 + (b) * 2 + (h)) * HTB)
#define PG8_STAGE(bufoff, gbase, voff) do { _Pragma("unroll") for (int _i = 0; _i < 2; ++_i) \
        __builtin_amdgcn_global_load_lds((const unsigned*)((const char*)(gbase) + (voff)[_i]), (PG8_LAS unsigned*)(lds + (bufoff) + ldsw + _i * 8192), 16, 0, 0); } while (0)
#define PG8_LDA(dst, b, h) do { _Pragma("unroll") for (int m = 0; m < 4; ++m) _Pragma("unroll") for (int k = 0; k < 2; ++k) dst[m][k] = *(const PG8_LAS bf16x8*)(lds + PG8_SA(b, h) + aoff + m * 2048 + k * 1024); } while (0)
#define PG8_LDB(dst, b, h) do { _Pragma("unroll") for (int n = 0; n < 2; ++n) _Pragma("unroll") for (int k = 0; k < 2; ++k) dst[n][k] = *(const PG8_LAS bf16x8*)(lds + PG8_SB(b, h) + boff + n * 2048 + k * 1024); } while (0)
#define PG8_MMA(ai, bj, At, Bt) do { __builtin_amdgcn_s_setprio(1); _Pragma("unroll") for (int m = 0; m < 4; ++m) _Pragma("unroll") for (int n = 0; n < 2; ++n) _Pragma("unroll") for (int k = 0; k < 2; ++k) \
        acc[ai][bj][m][n] = __builtin_amdgcn_mfma_f32_16x16x32_bf16(Bt[n][k], At[m][k], acc[ai][bj][m][n], 0, 0, 0); __builtin_amdgcn_s_setprio(0); } while (0)
#define PG8_WAIT_V(n) asm volatile("s_waitcnt vmcnt(" #n ")" ::: "memory")
#define PG8_WAIT_L(n) asm volatile("s_waitcnt lgkmcnt(" #n ")" ::: "memory")
#define PG8_BAR __builtin_amdgcn_s_barrier()
#define PG8_SCHED __builtin_amdgcn_sched_barrier(0)
    Unit cur, nxt; int ui = 0;
    if (!S.next(0, cur)) return;
    f32x4 acc[2][2][4][2];
#pragma unroll
    for (int a = 0; a < 2; ++a)
#pragma unroll
        for (int b = 0; b < 2; ++b)
#pragma unroll
            for (int m = 0; m < 4; ++m)
#pragma unroll
                for (int n = 0; n < 2; ++n) acc[a][b][m][n] = (f32x4){0.f, 0.f, 0.f, 0.f};
    bf16x8 At[4][2], B0[2][2], B1[2][2];
    const char* cA = (const char*)g.A + (size_t)cur.eb * g.astride + (size_t)cur.pm * tstepA; const char* cB = (const char*)g.Bt + (size_t)cur.eb * g.bstride + (size_t)cur.pn * tstepB;
    S.a_ready(cur);
    PG8_STAGE(PG8_SB(0, 0), cB, voffB); PG8_STAGE(PG8_SA(0, 0), cA, voffA); PG8_STAGE(PG8_SB(0, 1), cB + hstepB, voffB); PG8_STAGE(PG8_SA(0, 1), cA + hstepA, voffA);
    if (wr == 1) PG8_BAR;
    PG8_WAIT_V(4); PG8_BAR;
    PG8_STAGE(PG8_SB(1, 0), cB + kstep, voffB); PG8_STAGE(PG8_SA(1, 0), cA + kstep, voffA); PG8_STAGE(PG8_SB(1, 1), cB + hstepB + kstep, voffB);
    PG8_WAIT_V(6); PG8_BAR;
    for (;;) {
        const bool has_next = S.next(ui + 1, nxt);
        const char* nA = has_next ? (const char*)g.A + (size_t)nxt.eb * g.astride + (size_t)nxt.pm * tstepA : cA; const char* nB = has_next ? (const char*)g.Bt + (size_t)nxt.eb * g.bstride + (size_t)nxt.pn * tstepB : cB;
        for (int t = 0; t < nt; t += 2) {
            const bool last = (t == nt - 2);
            const char* a1 = cA + (size_t)(t + 1) * kstep;
            const char* a2 = last ? nA : cA + (size_t)(t + 2) * kstep; const char* b2 = last ? nB : cB + (size_t)(t + 2) * kstep;
            const char* a3 = a2 + kstep; const char* b3 = b2 + kstep;
            if (last && has_next) S.a_ready(nxt);
            PG8_LDB(B0, 0, 0); PG8_SCHED; PG8_LDA(At, 0, 0); PG8_STAGE(PG8_SA(1, 1), a1 + hstepA, voffA);
            PG8_WAIT_L(8); PG8_BAR; PG8_WAIT_L(0); PG8_MMA(0, 0, At, B0); PG8_BAR; PG8_SCHED;
            PG8_LDB(B1, 0, 1); PG8_STAGE(PG8_SB(0, 0), b2, voffB);
            PG8_BAR; PG8_WAIT_L(0); PG8_MMA(0, 1, At, B1); PG8_BAR;
            PG8_LDA(At, 0, 1); PG8_STAGE(PG8_SA(0, 0), a2, voffA);
            PG8_BAR; PG8_WAIT_L(0); PG8_MMA(1, 0, At, B0); PG8_BAR; PG8_SCHED;
            PG8_STAGE(PG8_SB(0, 1), b2 + hstepB, voffB);
            PG8_WAIT_V(6); PG8_BAR; PG8_MMA(1, 1, At, B1); PG8_BAR;
            PG8_LDB(B0, 1, 0); PG8_SCHED; PG8_LDA(At, 1, 0); PG8_STAGE(PG8_SA(0, 1), a2 + hstepA, voffA);
            PG8_WAIT_L(8); PG8_BAR; PG8_WAIT_L(0); PG8_MMA(0, 0, At, B0); PG8_BAR; PG8_SCHED;
            PG8_LDB(B1, 1, 1); PG8_STAGE(PG8_SB(1, 0), b3, voffB);
            PG8_BAR; PG8_WAIT_L(0); PG8_MMA(0, 1, At, B1); PG8_BAR;
            PG8_LDA(At, 1, 1); PG8_STAGE(PG8_SA(1, 0), a3, voffA);
            PG8_BAR; PG8_WAIT_L(0); PG8_MMA(1, 0, At, B0); PG8_BAR; PG8_SCHED;
            PG8_STAGE(PG8_SB(1, 1), b3 + hstepB, voffB);
            PG8_WAIT_V(6); PG8_BAR; PG8_MMA(1, 1, At, B1); PG8_BAR;
        }
        E(acc, cur, wr, wc, fr, fq); S.done(cur);
        if (!has_next) break;
#pragma unroll
        for (int a = 0; a < 2; ++a)
#pragma unroll
            for (int b = 0; b < 2; ++b)
#pragma unroll
                for (int m = 0; m < 4; ++m)
#pragma unroll
                    for (int n = 0; n < 2; ++n) acc[a][b][m][n] = (f32x4){0.f, 0.f, 0.f, 0.f};
        cur = nxt; cA = nA; cB = nB; ++ui;
    }
    PG8_WAIT_V(0);
    if (wr == 0) PG8_BAR;
    PG8_BAR;
#undef PG8_SA
#undef PG8_SB
#undef PG8_STAGE
#undef PG8_LDA
#undef PG8_LDB
#undef PG8_MMA
#undef PG8_WAIT_V
#undef PG8_WAIT_L
#undef PG8_BAR
#undef PG8_SCHED
}
}

constexpr int D = 2048, SEQ = 16384, NMETA = 16;
constexpr int LP = 16640;
constexpr int ROWV = 240;
constexpr int NVALID = 16400;
constexpr int ABN = 2560, CN = 10240;
constexpr int NEXP = 64, DEXP = 512;
constexpr int MAXTILES = 192, MPAD = MAXTILES * 256;
constexpr float DN_ALPHA = 1.4142135623730951f;
constexpr float LN_EPS = 1e-5f;
constexpr int NWAVES = 8, NTHR = 512;

constexpr size_t al(size_t x) { return (x + 0xFFFFFull) & ~(size_t)0xFFFFFull; }
constexpr size_t WS_CTL = 0, CTL_BYTES = 1u << 20;
constexpr size_t WS_WAB = al(WS_CTL + CTL_BYTES);
constexpr size_t WS_WOAB = al(WS_WAB + (size_t)ABN * D * 2);
constexpr size_t WS_WGLU = al(WS_WOAB + (size_t)D * D * 2);
constexpr size_t WS_WC = al(WS_WGLU + (size_t)1024 * 1024 * 2);
constexpr size_t WS_WOC = al(WS_WC + (size_t)CN * D * 2);
constexpr size_t WS_WGU = al(WS_WOC + (size_t)D * D * 2);
constexpr size_t WS_WD = al(WS_WGU + (size_t)2 * NEXP * 1024 * D * 2);
constexpr size_t WS_HA = al(WS_WD + (size_t)2 * NEXP * D * DEXP * 2);
constexpr size_t WS_HB = al(WS_HA + (size_t)LP * D * 4);
constexpr size_t WS_HBF = al(WS_HB + (size_t)LP * D * 4);
constexpr size_t WS_PROJ0 = al(WS_HBF + (size_t)LP * D * 2);
constexpr size_t WS_MIXIN = al(WS_PROJ0 + (size_t)LP * ABN * 4);
constexpr size_t WS_MIX = al(WS_MIXIN + (size_t)LP * D * 2);
constexpr size_t WS_Z = al(WS_MIX + (size_t)LP * D * 4);
constexpr size_t WS_ZB = al(WS_Z + (size_t)LP * 1024 * 4);
constexpr size_t WS_GLU = al(WS_ZB + (size_t)LP * 1024 * 2);
constexpr size_t WS_S5P = al(WS_GLU + (size_t)LP * 1024 * 4);
constexpr size_t WS_APOW = al(WS_S5P + (size_t)(2 * 64 * 64 * 8 + 2 * 64 * 64 * 16 * 8));
constexpr size_t WS_KTAB = al(WS_APOW + (size_t)2 * 64 * 64 * 33 * 8);
constexpr size_t WS_MWT = al(WS_KTAB + (size_t)2 * 64 * 32 * 256 * 4);
constexpr size_t WS_WST = al(WS_MWT + (size_t)64 * 512 * 768 * 2);
constexpr size_t WS_ROPE = al(WS_WST + (size_t)64 * 256 * 512 * 2);
constexpr size_t WS_WRT = al(WS_ROPE + (size_t)LP * 64 * 8);
constexpr size_t WS_ROUTE = al(WS_WRT + (size_t)2 * 96 * 2048 * 4);
constexpr size_t WS_R1 = al(WS_ROUTE + (size_t)LP * 32);
constexpr size_t R1_BYTES = (size_t)2 * LP * 4096 * 8;
constexpr size_t WS_END = WS_R1 + R1_BYTES;
constexpr size_t R1_UA = 0;
constexpr size_t R1_SALL = al((size_t)64 * 768 * 768 * 2);
constexpr size_t R1_PROJ1 = 0;
constexpr size_t R1_OFW = al((size_t)LP * CN * 4);
constexpr size_t R1_OBW = al(R1_OFW + (size_t)LP * D * 4);
constexpr size_t R1_DS = al(R1_OBW + (size_t)LP * D * 4);
constexpr size_t R1_DSEG = al(R1_DS + (size_t)32 * 32 * 16384 * 4);
constexpr size_t R1_HG_END = R1_DSEG + (size_t)32 * 32 * 128 * 4;
constexpr size_t R1_XSRT = 0;
constexpr size_t R1_ACT = al((size_t)MPAD * D * 2);
constexpr size_t R1_Y = al(R1_ACT + (size_t)MPAD * DEXP * 2);
constexpr size_t R1_MOE_END = R1_Y + (size_t)MPAD * D * 4;
static_assert(R1_HG_END <= R1_BYTES && R1_MOE_END <= R1_BYTES, "R1 overlays");
static_assert(WS_END <= (size_t)4 << 30, "workspace map must fit 4 GiB");
constexpr int CW_BAR = 4096;
constexpr int CW_CNT = 16384;
constexpr int CW_PLAN = 32768;

#define LAS __attribute__((address_space(3)))
typedef unsigned short bf16;
typedef unsigned v4u __attribute__((ext_vector_type(4)));
typedef unsigned v2u __attribute__((ext_vector_type(2)));
typedef float f32x4 __attribute__((ext_vector_type(4)));
#define LDS_WAIT() asm volatile("s_waitcnt lgkmcnt(0)" ::: "memory")
__device__ __forceinline__ unsigned f2bf(float f) { unsigned u = __builtin_bit_cast(unsigned, f); return (u + 0x7fffu + ((u >> 16) & 1u)) >> 16; }
__device__ __forceinline__ unsigned pk2(float lo, float hi) { return f2bf(lo) | (f2bf(hi) << 16); }
__device__ __forceinline__ float wave_sum(float v) {
#pragma unroll
    for (int o = 1; o < 64; o <<= 1) v += __shfl_xor(v, o);
    return v;
}
__device__ __forceinline__ float wave_max(float v) {
#pragma unroll
    for (int o = 1; o < 64; o <<= 1) v = fmaxf(v, __shfl_xor(v, o));
    return v;
}
__device__ __forceinline__ float sigmoidf_(float x) { return 1.0f / (1.0f + expf(-x)); }

#define XB_TMO      128
#define XB_XCNT(j)  (256  + 64 * (j))
#define XB_XSUB(j)  (1280 + 64 * (j))
#define XB_XGEN(j)  (2304 + 64 * (j))
#define XB_TOP      3328
#define XB_TOPGEN   3392
#define XCD_BAR_WORDS 3456
#define XB_SPIN_CAP (1u << 22)
__device__ __forceinline__ unsigned xb_ld(unsigned* p)              { return __hip_atomic_load(p, __ATOMIC_RELAXED, __HIP_MEMORY_SCOPE_AGENT); }
__device__ __forceinline__ unsigned xb_add(unsigned* p, unsigned v) { return __hip_atomic_fetch_add(p, v, __ATOMIC_RELAXED, __HIP_MEMORY_SCOPE_AGENT); }
__device__ __forceinline__ unsigned xb_xcc_id() { return (unsigned)__builtin_amdgcn_s_getreg((3 << 11) | 20) & 0xFu; }
#define XB_SPIN(cond, bar) do { unsigned _sp = 0; while (cond) { __builtin_amdgcn_s_sleep(1); \
    if ((++_sp & 255u) == 0u) { if (xb_ld(&(bar)[XB_TMO])) break; if (_sp > XB_SPIN_CAP) { atomicAdd(&(bar)[XB_TMO], 1u); break; } } } } while (0)
struct XcdBarrier { unsigned* bar; unsigned x; volatile LAS unsigned* st; };
__device__ __forceinline__ XcdBarrier xcd_barrier_post(unsigned* bar, volatile LAS unsigned* st) {
    XcdBarrier b; b.bar = bar; b.x = xb_xcc_id(); b.st = st;
    if (threadIdx.x == 0) (void)xb_add(&bar[XB_XCNT(b.x)], 1u);
    return b;
}
__device__ __forceinline__ void xcd_barrier_complete(unsigned* bar, unsigned x, unsigned& nloc, unsigned& nx) {
    const unsigned G = gridDim.x * gridDim.y * gridDim.z;
    unsigned sum, cnt, mine, sp = 0u;
    for (;;) {
        sum = 0u; cnt = 0u; mine = 0u;
#pragma unroll
        for (unsigned j = 0; j < 16; ++j) { const unsigned c = xb_ld(&bar[XB_XCNT(j)]); sum += c; cnt += (c > 0u) ? 1u : 0u; mine = (j == x) ? c : mine; }
        if (sum == G) break;
        __builtin_amdgcn_s_sleep(1);
        if ((++sp & 255u) == 0u) { if (xb_ld(&bar[XB_TMO])) break; if (sp > XB_SPIN_CAP) { atomicAdd(&bar[XB_TMO], 1u); break; } }
    }
    nloc = mine > 0u ? mine : 1u; nx = cnt > 0u ? cnt : 1u;
}
__device__ __forceinline__ void xcd_barrier(const XcdBarrier& b) {
    asm volatile("s_waitcnt vmcnt(0)" ::: "memory");
    __syncthreads();
    if (threadIdx.x == 0) {
        unsigned* bar = b.bar;
        __builtin_amdgcn_s_waitcnt(0);
        unsigned nloc = b.st[0], nx = b.st[1];
        if (nloc == 0u) { xcd_barrier_complete(bar, b.x, nloc, nx); b.st[0] = nloc; b.st[1] = nx; }
        const unsigned old = xb_add(&bar[XB_XSUB(b.x)], 1u);
        const unsigned gen = old / nloc;
        if (old + 1u == (gen + 1u) * nloc) {
            __builtin_amdgcn_fence(__ATOMIC_RELEASE, "agent");
            asm volatile("s_waitcnt vmcnt(0)" ::: "memory");
            const unsigned og = xb_add(&bar[XB_TOP], 1u);
            const unsigned tg = og / nx;
            if (og + 1u == (tg + 1u) * nx) xb_add(&bar[XB_TOPGEN], 1u);
            else XB_SPIN(xb_ld(&bar[XB_TOPGEN]) == tg, bar);
            __builtin_amdgcn_fence(__ATOMIC_ACQUIRE, "agent");
            xb_add(&bar[XB_XGEN(b.x)], 1u);
            asm volatile("s_waitcnt vmcnt(0)" ::: "memory");
        } else {
            XB_SPIN(xb_ld(&bar[XB_XGEN(b.x)]) == gen, bar);
            __builtin_amdgcn_fence(__ATOMIC_ACQUIRE, "agent");
            asm volatile("s_waitcnt vmcnt(0)" ::: "memory");
        }
    }
    __syncthreads();
}

constexpr int RING_BYTES = 131072, MISC_OFF = RING_BYTES + 320, LDS_BYTES = 147456;
struct Args { const float* in[29]; float* out; unsigned char* ws; int ph_lo, ph_hi; };
enum In { I_X = 0, I_META, I_WAB, I_WOAB, I_SINK, I_LRE, I_LIM, I_LSTEP, I_BRE, I_BIM, I_CRE, I_CIM, I_S5D, I_WGLU, I_BGLU, I_WC, I_WOC, I_LB, I_NORMG,
          I_LNMG, I_LNMB, I_LNFG, I_LNFB, I_WGRP, I_BGRP, I_WEXP, I_BEXP, I_WGU, I_WD };
struct Ctx { LAS unsigned char* lds; unsigned char* ldsg; int tid, lane, wave, bid, nblk, gw, ngw; };

__device__ __forceinline__ int rowmap_gu(int n) { return n < 512 ? ((n >> 7) * 256 + (n & 127)) : (((n - 512) >> 7) * 256 + 128 + ((n - 512) & 127)); }
__device__ __forceinline__ void transpose_item(const float* W, int K, int N, bf16* WT, LAS float* scr, int kb, int nb, int lane, int mode) {
    const int k0 = 64 * kb, n0 = 32 * nb;
#pragma unroll 8
    for (int i = 0; i < 32; ++i) { const int kk = 2 * i + (lane >> 5); scr[kk * 33 + (lane & 31)] = W[(size_t)(k0 + kk) * N + n0 + (lane & 31)]; }
    LDS_WAIT(); asm volatile("" ::: "memory");
    const int c = lane & 7;
#pragma unroll
    for (int j = 0; j < 4; ++j) { const int n = (lane >> 3) + 8 * j; const LAS float* s = scr + (8 * c) * 33 + n;
        v4u o; o.x = pk2(s[0 * 33], s[1 * 33]); o.y = pk2(s[2 * 33], s[3 * 33]); o.z = pk2(s[4 * 33], s[5 * 33]); o.w = pk2(s[6 * 33], s[7 * 33]);
        const int nn = n0 + n; const int row = mode ? rowmap_gu(nn) : nn;
        *(v4u*)(WT + (size_t)row * K + k0 + 8 * c) = o; }
    LDS_WAIT(); asm volatile("" ::: "memory");
}
__device__ __forceinline__ void conv_family(const Ctx& c, const float* src, bf16* dst, int B, int K, int N, int mode) {
    LAS float* scr = (LAS float*)(c.lds + c.wave * 16384);
    const int nkb = K / 64, nnb = N / 32; const long per = (long)nkb * nnb, total = per * B;
    for (long it = c.gw; it < total; it += c.ngw) {
        const int b = (int)(it / per); const int r = (int)(it % per); const int kb = r / nnb, nb = r % nnb;
        transpose_item(src + (size_t)b * K * N, K, N, dst + (size_t)b * K * N, scr, kb, nb, c.lane, mode);
    }
}
__device__ __forceinline__ void phase_weights(const Ctx& c, const Args& a) {
    unsigned char* ws = a.ws;
    conv_family(c, a.in[I_WAB], (bf16*)(ws + WS_WAB), 1, D, ABN, 0);
    conv_family(c, a.in[I_WOAB], (bf16*)(ws + WS_WOAB), 1, D, D, 0);
    conv_family(c, a.in[I_WGLU], (bf16*)(ws + WS_WGLU), 1, 1024, 1024, 0);
    conv_family(c, a.in[I_WC], (bf16*)(ws + WS_WC), 1, D, CN, 0);
    conv_family(c, a.in[I_WOC], (bf16*)(ws + WS_WOC), 1, D, D, 0);
    conv_family(c, a.in[I_WGU], (bf16*)(ws + WS_WGU), 2 * NEXP, D, 1024, 1);
    conv_family(c, a.in[I_WD], (bf16*)(ws + WS_WD), 2 * NEXP, DEXP, D, 0);
}
__device__ __forceinline__ void phase_init(const Ctx& c, const Args& a) {
    float* H = (float*)(a.ws + WS_HA); bf16* HB = (bf16*)(a.ws + WS_HBF);
    for (int row = c.gw; row < LP; row += c.ngw) {
        const float* src = row < ROWV ? nullptr : (row < 256 ? a.in[I_META] + (size_t)(row - ROWV) * D : a.in[I_X] + (size_t)(row - 256) * D);
#pragma unroll
        for (int j = 0; j < 8; ++j) { const int idx = (j * 64 + c.lane) * 4; f32x4 v = src ? *(const f32x4*)(src + idx) : (f32x4){0.f, 0.f, 0.f, 0.f};
            *(f32x4*)(H + (size_t)row * D + idx) = v; v2u w; w.x = pk2(v.x, v.y); w.y = pk2(v.z, v.w); *(v2u*)(HB + (size_t)row * D + idx) = w; }
    }
    float2* rope = (float2*)(a.ws + WS_ROPE);
    for (long i = (long)c.bid * NTHR + c.tid; i < (long)LP * 64; i += (long)c.nblk * NTHR) {
        const int row = (int)(i >> 6), k = (int)(i & 63);
        const float inv = powf(10000.0f, -(float)k * 2.0f / 128.0f);
        const float ang = (float)(row - ROWV) * inv;
        float s, co; sincosf(ang, &s, &co); rope[i] = make_float2(co, s);
    }
    { float* wrt = (float*)(a.ws + WS_WRT);
      for (int i = c.bid * NTHR + c.tid; i < 2 * 96 * 2048; i += c.nblk * NTHR) { const int k = i & 2047, j = (i >> 11) % 96, layer = i / (96 * 2048);
          wrt[i] = j < 8 ? a.in[I_WGRP][((size_t)layer * D + k) * 8 + j] : (j < 72 ? a.in[I_WEXP][((size_t)layer * D + k) * 64 + (j - 8)] : 0.f); } }
    float2* abar = (float2*)(a.ws + WS_S5P); float2* bbar = abar + 2 * 64 * 64;
    for (int i = c.bid * NTHR + c.tid; i < 2 * 64 * 64; i += c.nblk * NTHR) {
        const int dg = i >> 6;
        const double lr = fmin((double)a.in[I_LRE][i], -1e-4), li = (double)a.in[I_LIM][i], st = exp((double)a.in[I_LSTEP][dg]);
        const double er = exp(lr * st), ar = er * cos(li * st), ai = er * sin(li * st);
        const double den = lr * lr + li * li, cr = ((ar - 1.0) * lr + ai * li) / den, ci = (ai * lr - (ar - 1.0) * li) / den;
        abar[i] = make_float2((float)ar, (float)ai);
        float2* apw = (float2*)(a.ws + WS_APOW) + (size_t)i * 33;
        for (int tau = 0; tau <= 32; ++tau) { const double m = exp(lr * st * tau); apw[tau] = make_float2((float)(m * cos(li * st * tau)), (float)(m * sin(li * st * tau))); }
        for (int cc = 0; cc < 16; ++cc) { const double br = a.in[I_BRE][(size_t)i * 16 + cc], bi = a.in[I_BIM][(size_t)i * 16 + cc];
            bbar[(size_t)i * 16 + cc] = make_float2((float)(cr * br - ci * bi), (float)(cr * bi + ci * br)); }
    }
}
__device__ __forceinline__ void phase_rope(const Ctx& c, const Args& a) {
    float* P = (float*)(a.ws + WS_PROJ0); const float2* rope = (const float2*)(a.ws + WS_ROPE);
    for (long i = (long)c.bid * NTHR + c.tid; i < (long)NVALID * 640; i += (long)c.nblk * NTHR) {
        const int row = ROWV + (int)(i / 640), r = (int)(i % 640), hs = r >> 6, k = r & 63;
        const float2 cs = rope[(size_t)row * 64 + k];
        float* p = P + (size_t)row * ABN + hs * 128 + k;
        const float x1 = p[0], x2 = p[64];
        p[0] = x1 * cs.x - x2 * cs.y; p[64] = x2 * cs.x + x1 * cs.y;
    }
}
__device__ __forceinline__ void phase_attn_naive(const Ctx& c, const Args& a) {
    const float* P = (const float*)(a.ws + WS_PROJ0); bf16* MI = (bf16*)(a.ws + WS_MIXIN);
    LAS float* qs = (LAS float*)(c.lds + c.wave * 16384); LAS float* ps = qs + 128;
    const float scale = 0.08838834764831845f;
    for (int T = c.gw; T < NVALID * 8; T += c.ngw) {
        const int row = ROWV + (T >> 3), h = T & 7, g = h >> 2;
        const float* pr = P + (size_t)row * ABN;
        qs[c.lane] = pr[h * 128 + c.lane]; qs[c.lane + 64] = pr[h * 128 + 64 + c.lane];
        LDS_WAIT(); asm volatile("" ::: "memory");
        int lo, hi;
        if (row < 256) { lo = 256; hi = row + 128; } else { lo = row - 128 < 256 ? 256 : row - 128; hi = row + 128 > LP - 1 ? LP - 1 : row + 128; }
        const int nk = 16 + (hi - lo + 1);
        const float sink = a.in[I_SINK][h];
        float sc[5]; float mx = sink;
#pragma unroll
        for (int s = 0; s < 5; ++s) { const int j = s * 64 + c.lane; sc[s] = -3.0e38f;
            if (j < nk) { const int kr = j < 16 ? ROWV + j : lo + j - 16; const float* kp = P + (size_t)kr * ABN + 1024 + g * 128; float d = 0.f;
                for (int e = 0; e < 128; e += 4) { const f32x4 kv = *(const f32x4*)(kp + e); d += kv.x * qs[e] + kv.y * qs[e + 1] + kv.z * qs[e + 2] + kv.w * qs[e + 3]; }
                sc[s] = d * scale; mx = fmaxf(mx, sc[s]); } }
        mx = wave_max(mx);
        float den = 0.f;
#pragma unroll
        for (int s = 0; s < 5; ++s) { const int j = s * 64 + c.lane; if (j < nk) { const float e = expf(sc[s] - mx); den += e; ps[j] = e; } }
        den = wave_sum(den) + expf(sink - mx);
        LDS_WAIT(); asm volatile("" ::: "memory");
        float o0 = 0.f, o1 = 0.f;
        for (int j = 0; j < nk; ++j) { const int kr = j < 16 ? ROWV + j : lo + j - 16; const float* vp = P + (size_t)kr * ABN + 1280 + g * 128; const float p = ps[j];
            o0 += p * vp[c.lane]; o1 += p * vp[c.lane + 64]; }
        const float inv = 1.0f / den;
        MI[(size_t)row * D + h * 128 + c.lane] = (bf16)f2bf(o0 * inv); MI[(size_t)row * D + h * 128 + 64 + c.lane] = (bf16)f2bf(o1 * inv);
        LDS_WAIT(); asm volatile("" ::: "memory");
    }
    for (int i = c.bid * NTHR + c.tid; i < ROWV * D / 8; i += c.nblk * NTHR) ((v4u*)MI)[i] = (v4u){0u, 0u, 0u, 0u};
}
typedef short bf16x8 __attribute__((ext_vector_type(8)));
constexpr int HG_QT = 0, HG_KT = 17408, HG_KH = 34816, HG_VT = 53248, HG_P = 71680, HG_ST = 80896, HG_T = 115712, HG_DV = 117760;
constexpr int LD_K = 272, LD_T = 144;
__device__ __forceinline__ bf16x8 ldfrag(LAS unsigned char* base, int row, int pitch, int kbyte) { return *(const LAS bf16x8*)(base + row * pitch + kbyte); }
#define MFMA16(a, b, c) __builtin_amdgcn_mfma_f32_16x16x32_bf16((a), (b), (c), 0, 0, 0)
constexpr int AT_K = 0, AT_VT = 17408;
__device__ __forceinline__ void phase_attn(const Ctx& c, const Args& a) {
    const float* P = (const float*)(a.ws + WS_PROJ0); bf16* MI = (bf16*)(a.ws + WS_MIXIN);
    LAS unsigned char* L = c.lds;
    const int r = c.lane & 15, gq = c.lane >> 4, w = c.wave, hr = w >> 1, qh = w & 1;
    const float C2 = 0.08838834764831845f * 1.4426950408889634f;
    const int skey = c.tid >> 3, sdc = c.tid & 7;
    const int sd = c.tid & 127, skq = c.tid >> 7;
    for (int u = c.bid; u < 514; u += c.nblk) {
        const int g = u & 1, qb = u >> 1, r0 = 192 + 64 * qb, h = 4 * g + hr, rq0 = r0 + 32 * qh;
        const int klo = (r0 / 64 - 2) < 4 ? 4 : (r0 / 64 - 2), khi = (r0 / 64 + 2) > 259 ? 259 : (r0 / 64 + 2), ntile = 1 + (khi - klo + 1);
        bf16x8 qf[2][4];
#pragma unroll
        for (int qt = 0; qt < 2; ++qt)
#pragma unroll
            for (int ks = 0; ks < 4; ++ks) { const float* qp = P + (size_t)(rq0 + 16 * qt + r) * ABN + h * 128 + 32 * ks + 8 * gq; const f32x4 x0 = *(const f32x4*)qp, x1 = *(const f32x4*)(qp + 4);
                v4u t; t.x = pk2(x0.x, x0.y); t.y = pk2(x0.z, x0.w); t.z = pk2(x1.x, x1.y); t.w = pk2(x1.z, x1.w); qf[qt][ks] = __builtin_bit_cast(bf16x8, t); }
        const float sink2 = a.in[I_SINK][h] * 1.4426950408889634f;
        float mrun[2] = {sink2, sink2}, lsum[2] = {gq == 0 ? 1.f : 0.f, gq == 0 ? 1.f : 0.f};
        f32x4 O[2][8];
#pragma unroll
        for (int qt = 0; qt < 2; ++qt)
#pragma unroll
            for (int dt = 0; dt < 8; ++dt) O[qt][dt] = (f32x4){0.f, 0.f, 0.f, 0.f};
        f32x4 kraw[4]; float vraw[16];
        { const int kt = 3; const float* kp = P + (size_t)(64 * kt + skey) * ABN + 1024 + g * 128 + 16 * sdc;
#pragma unroll
          for (int i = 0; i < 4; ++i) kraw[i] = *(const f32x4*)(kp + 4 * i);
          const float* vp = P + (size_t)(64 * kt + 16 * skq) * ABN + 1280 + g * 128 + sd;
#pragma unroll
          for (int i = 0; i < 16; ++i) vraw[i] = vp[(size_t)i * ABN]; }
        for (int ti = 0; ti < ntile; ++ti) {
            const int kt = ti == 0 ? 3 : klo + ti - 1;
            { v4u k0, k1; k0.x = pk2(kraw[0].x, kraw[0].y); k0.y = pk2(kraw[0].z, kraw[0].w); k0.z = pk2(kraw[1].x, kraw[1].y); k0.w = pk2(kraw[1].z, kraw[1].w);
              k1.x = pk2(kraw[2].x, kraw[2].y); k1.y = pk2(kraw[2].z, kraw[2].w); k1.z = pk2(kraw[3].x, kraw[3].y); k1.w = pk2(kraw[3].z, kraw[3].w);
              *(LAS v4u*)(L + AT_K + skey * LD_K + 32 * sdc) = k0; *(LAS v4u*)(L + AT_K + skey * LD_K + 32 * sdc + 16) = k1;
              v4u v0, v1; v0.x = pk2(vraw[0], vraw[1]); v0.y = pk2(vraw[2], vraw[3]); v0.z = pk2(vraw[4], vraw[5]); v0.w = pk2(vraw[6], vraw[7]);
              v1.x = pk2(vraw[8], vraw[9]); v1.y = pk2(vraw[10], vraw[11]); v1.z = pk2(vraw[12], vraw[13]); v1.w = pk2(vraw[14], vraw[15]);
              *(LAS v4u*)(L + AT_VT + sd * LD_T + 32 * skq) = v0; *(LAS v4u*)(L + AT_VT + sd * LD_T + 32 * skq + 16) = v1; }
            if (ti + 1 < ntile) { const int kn = klo + ti; const float* kp = P + (size_t)(64 * kn + skey) * ABN + 1024 + g * 128 + 16 * sdc;
#pragma unroll
                for (int i = 0; i < 4; ++i) kraw[i] = *(const f32x4*)(kp + 4 * i);
                const float* vp = P + (size_t)(64 * kn + 16 * skq) * ABN + 1280 + g * 128 + sd;
#pragma unroll
                for (int i = 0; i < 16; ++i) vraw[i] = vp[(size_t)i * ABN]; }
            __syncthreads();
            f32x4 sc[2][4];
#pragma unroll
            for (int qt = 0; qt < 2; ++qt)
#pragma unroll
                for (int ki = 0; ki < 4; ++ki) sc[qt][ki] = (f32x4){0.f, 0.f, 0.f, 0.f};
#pragma unroll
            for (int ks = 0; ks < 4; ++ks)
#pragma unroll
                for (int ki = 0; ki < 4; ++ki) { const bf16x8 kf = ldfrag(L + AT_K, 16 * ki + r, LD_K, (32 * ks + 8 * gq) * 2);
                    sc[0][ki] = MFMA16(kf, qf[0][ks], sc[0][ki]); sc[1][ki] = MFMA16(kf, qf[1][ks], sc[1][ki]); }
            bf16x8 pf[2][2];
#pragma unroll
            for (int qt = 0; qt < 2; ++qt) {
                const int rq = rq0 + 16 * qt + r; float tmax = -3.0e38f;
#pragma unroll
                for (int ki = 0; ki < 4; ++ki)
#pragma unroll
                    for (int e = 0; e < 4; ++e) { const int rk = 64 * kt + 16 * ki + 4 * gq + e; const int dd = rq - rk;
                        const bool ok = ti == 0 ? (rk >= ROWV) : (rk >= 256 && dd <= 128 && dd >= -128);
                        const float v = ok ? sc[qt][ki][e] * C2 : -3.0e38f; sc[qt][ki][e] = v; tmax = fmaxf(tmax, v); }
                tmax = fmaxf(tmax, __shfl_xor(tmax, 16)); tmax = fmaxf(tmax, __shfl_xor(tmax, 32));
                const float mn = fmaxf(mrun[qt], tmax), alpha = exp2f(mrun[qt] - mn); mrun[qt] = mn;
                float ps = 0.f;
#pragma unroll
                for (int ki = 0; ki < 4; ++ki)
#pragma unroll
                    for (int e = 0; e < 4; ++e) { const float pv = exp2f(sc[qt][ki][e] - mn); sc[qt][ki][e] = pv; ps += pv; }
                lsum[qt] = lsum[qt] * alpha + ps;
#pragma unroll
                for (int dt = 0; dt < 8; ++dt) O[qt][dt] = O[qt][dt] * alpha;
#pragma unroll
                for (int kk = 0; kk < 2; ++kk) { v4u t; t.x = pk2(sc[qt][2 * kk][0], sc[qt][2 * kk][1]); t.y = pk2(sc[qt][2 * kk][2], sc[qt][2 * kk][3]);
                    t.z = pk2(sc[qt][2 * kk + 1][0], sc[qt][2 * kk + 1][1]); t.w = pk2(sc[qt][2 * kk + 1][2], sc[qt][2 * kk + 1][3]); pf[qt][kk] = __builtin_bit_cast(bf16x8, t); }
            }
#pragma unroll
            for (int dt = 0; dt < 8; ++dt)
#pragma unroll
                for (int kk = 0; kk < 2; ++kk) { const LAS unsigned char* vp = L + AT_VT + (16 * dt + r) * LD_T + (32 * kk + 4 * gq) * 2;
                    const v2u lo = *(const LAS v2u*)vp, hi = *(const LAS v2u*)(vp + 32); const v4u t = (v4u){lo.x, lo.y, hi.x, hi.y}; const bf16x8 vf = __builtin_bit_cast(bf16x8, t);
                    O[0][dt] = MFMA16(vf, pf[0][kk], O[0][dt]); O[1][dt] = MFMA16(vf, pf[1][kk], O[1][dt]); }
            __syncthreads();
        }
#pragma unroll
        for (int qt = 0; qt < 2; ++qt) { float l = lsum[qt]; l += __shfl_xor(l, 16); l += __shfl_xor(l, 32); const float inv = 1.0f / l; const int rq = rq0 + 16 * qt + r;
            if (rq >= ROWV) {
#pragma unroll
                for (int dt = 0; dt < 8; ++dt) { v2u o; o.x = pk2(O[qt][dt][0] * inv, O[qt][dt][1] * inv); o.y = pk2(O[qt][dt][2] * inv, O[qt][dt][3] * inv);
                    *(v2u*)(MI + (size_t)rq * D + h * 128 + 16 * dt + 4 * gq) = o; } } }
    }
    for (int i = c.bid * NTHR + c.tid; i < ROWV * D / 8; i += c.nblk * NTHR) ((v4u*)MI)[i] = (v4u){0u, 0u, 0u, 0u};
}
__device__ __forceinline__ void phase_s5_ktab(const Ctx& c, const Args& a) {
    const float2* abar = (const float2*)(a.ws + WS_S5P); const float2* bbar = abar + 2 * 64 * 64; const float2* apow = (const float2*)(a.ws + WS_APOW);
    float* KT = (float*)(a.ws + WS_KTAB);
    for (int idx = c.bid * NTHR + c.tid; idx < 2 * 64 * 32 * 256; idx += c.nblk * NTHR) {
        const int c2 = idx & 15, c1 = (idx >> 4) & 15, tau = (idx >> 8) & 31, dg = idx >> 13;
        const float* cr = a.in[I_CRE] + ((size_t)dg * 16 + c1) * 64; const float* ci = a.in[I_CIM] + ((size_t)dg * 16 + c1) * 64;
        float sum = 0.f;
        for (int p = 0; p < 64; ++p) { const int i = dg * 64 + p; const float2 ap = apow[(size_t)i * 33 + tau], bb = bbar[(size_t)i * 16 + c2];
            const float tr = ap.x * bb.x - ap.y * bb.y, ti = ap.x * bb.y + ap.y * bb.x; sum += cr[p] * tr - ci[p] * ti; }
        KT[idx] = sum;
    }
}
__device__ __forceinline__ void phase_s5_fill(const Ctx& c, const Args& a) {
    const float2* abar = (const float2*)(a.ws + WS_S5P); const float2* bbar = abar + 2 * 64 * 64; const float2* apow = (const float2*)(a.ws + WS_APOW);
    const float* KT = (const float*)(a.ws + WS_KTAB); bf16* MWT = (bf16*)(a.ws + WS_MWT); bf16* WST = (bf16*)(a.ws + WS_WST);
    for (long it = (long)c.bid * NTHR + c.tid; it < (long)64 * 512 * 96; it += (long)c.nblk * NTHR) {
        const int kb = (int)(it % 96), n = (int)((it / 96) % 512), g = (int)(it / (96 * 512)), t = n >> 4, c1 = n & 15;
        float v[8];
        if (kb < 64) { const int s2 = kb >> 1, c2 = (kb & 1) * 8;
            if (s2 < t) { const float* k0 = KT + ((((size_t)(0 * 64 + g)) * 32 + (t - s2)) * 16 + c1) * 16 + c2;
#pragma unroll
                for (int i = 0; i < 8; ++i) v[i] = k0[i]; }
            else if (s2 > t) { const float* k0 = KT + ((((size_t)(1 * 64 + g)) * 32 + (s2 - t)) * 16 + c1) * 16 + c2;
#pragma unroll
                for (int i = 0; i < 8; ++i) v[i] = k0[i]; }
            else { const float* k0 = KT + ((((size_t)(0 * 64 + g)) * 32) * 16 + c1) * 16 + c2; const float* k1 = KT + ((((size_t)(1 * 64 + g)) * 32) * 16 + c1) * 16 + c2;
#pragma unroll
                for (int i = 0; i < 8; ++i) v[i] = k0[i] + k1[i] + ((c2 + i) == c1 ? a.in[I_S5D][16 * g + c1] : 0.f); }
        } else { const int j0 = (kb - 64) * 8, qd = j0 >> 6, dir = qd >> 1, p0 = j0 & 63, tau = dir == 0 ? t + 1 : 32 - t;
            const float* cr = a.in[I_CRE] + ((size_t)(dir * 64 + g) * 16 + c1) * 64; const float* ci = a.in[I_CIM] + ((size_t)(dir * 64 + g) * 16 + c1) * 64;
#pragma unroll
            for (int i = 0; i < 8; ++i) { const int p = p0 + i; const float2 ap = apow[((size_t)(dir * 64 + g) * 64 + p) * 33 + tau];
                v[i] = (qd & 1) == 0 ? (cr[p] * ap.x - ci[p] * ap.y) : -(cr[p] * ap.y + ci[p] * ap.x); }
        }
        v4u o; o.x = pk2(v[0], v[1]); o.y = pk2(v[2], v[3]); o.z = pk2(v[4], v[5]); o.w = pk2(v[6], v[7]);
        *(v4u*)(MWT + ((size_t)g * 512 + n) * 768 + kb * 8) = o;
    }
    for (long it = (long)c.bid * NTHR + c.tid; it < (long)64 * 256 * 64; it += (long)c.nblk * NTHR) {
        const int kb = (int)(it & 63), n = (int)((it >> 6) & 255), g = (int)(it >> 14), s2 = kb >> 1, c2 = (kb & 1) * 8, qd = n >> 6, dir = qd >> 1, p = n & 63;
        const int tau = dir == 0 ? 31 - s2 : s2; const size_t i = (size_t)(dir * 64 + g) * 64 + p; const float2 ap = apow[i * 33 + tau];
        float v[8];
#pragma unroll
        for (int e = 0; e < 8; ++e) { const float2 bb = bbar[i * 16 + c2 + e]; v[e] = (qd & 1) == 0 ? (ap.x * bb.x - ap.y * bb.y) : (ap.x * bb.y + ap.y * bb.x); }
        v4u o; o.x = pk2(v[0], v[1]); o.y = pk2(v[2], v[3]); o.z = pk2(v[4], v[5]); o.w = pk2(v[6], v[7]);
        *(v4u*)(WST + ((size_t)g * 256 + n) * 512 + kb * 8) = o;
    }
    bf16* ZB = (bf16*)(a.ws + WS_ZB);
    for (int i = c.bid * NTHR + c.tid; i < 224 * 1024 / 8; i += c.nblk * NTHR) ((v4u*)ZB)[i] = (v4u){0u, 0u, 0u, 0u};
}
__device__ __forceinline__ void phase_s5_chunkscan(const Ctx& c, const Args& a) {
    if (c.bid >= 128) return;
    const int g = c.bid & 63, dir = c.bid >> 6, p = c.lane, w = c.wave;
    const float2 a32 = ((const float2*)(a.ws + WS_APOW))[((size_t)(dir * 64 + g) * 64 + p) * 33 + 32];
    const float* S = (const float*)(a.ws + WS_R1 + R1_SALL) + (size_t)g * 768 * 256 + dir * 128 + p;
    bf16* UA = (bf16*)(a.ws + WS_R1 + R1_UA) + (size_t)g * 768 * 768 + 512 + dir * 128 + p;
    LAS float* E = (LAS float*)c.lds; LAS float* PW = E + 2 * 8 * 64;
    const int j0 = 65 * w, j1 = (j0 + 65) < 513 ? (j0 + 65) : 513, len = j1 - j0;
    float xr = 0.f, xi = 0.f, pr = 1.f, pi = 0.f;
    for (int b = 0; b < 5; ++b) { float sr[13], si[13];
#pragma unroll
        for (int i = 0; i < 13; ++i) { const int o = b * 13 + i; const int j = dir == 0 ? j0 + o : j1 - 1 - o; const bool ok = o < len; sr[i] = ok ? S[(size_t)j * 256] : 0.f; si[i] = ok ? S[(size_t)j * 256 + 64] : 0.f; }
#pragma unroll
        for (int i = 0; i < 13; ++i) { if (b * 13 + i < len) { const float nr = a32.x * xr - a32.y * xi + sr[i], ni = a32.x * xi + a32.y * xr + si[i]; xr = nr; xi = ni;
                const float qr = a32.x * pr - a32.y * pi, qi = a32.x * pi + a32.y * pr; pr = qr; pi = qi; } }
    }
    E[w * 128 + p] = xr; E[w * 128 + 64 + p] = xi; PW[w * 128 + p] = pr; PW[w * 128 + 64 + p] = pi;
    __syncthreads();
    float cr = 0.f, ci = 0.f;
    if (dir == 0) { for (int w2 = 0; w2 < w; ++w2) { const float2 e = make_float2(E[w2 * 128 + p], E[w2 * 128 + 64 + p]), q = make_float2(PW[w2 * 128 + p], PW[w2 * 128 + 64 + p]); const float nr = q.x * cr - q.y * ci + e.x, ni = q.x * ci + q.y * cr + e.y; cr = nr; ci = ni; } }
    else { for (int w2 = 7; w2 > w; --w2) { const float2 e = make_float2(E[w2 * 128 + p], E[w2 * 128 + 64 + p]), q = make_float2(PW[w2 * 128 + p], PW[w2 * 128 + 64 + p]); const float nr = q.x * cr - q.y * ci + e.x, ni = q.x * ci + q.y * cr + e.y; cr = nr; ci = ni; } }
    xr = cr; xi = ci;
    for (int b = 0; b < 5; ++b) { float sr[13], si[13];
#pragma unroll
        for (int i = 0; i < 13; ++i) { const int o = b * 13 + i; const int j = dir == 0 ? j0 + o : j1 - 1 - o; const bool ok = o < len; sr[i] = ok ? S[(size_t)j * 256] : 0.f; si[i] = ok ? S[(size_t)j * 256 + 64] : 0.f; }
#pragma unroll
        for (int i = 0; i < 13; ++i) { const int o = b * 13 + i; if (o < len) { const int j = dir == 0 ? j0 + o : j1 - 1 - o;
                UA[(size_t)j * 768] = (bf16)f2bf(xr); UA[(size_t)j * 768 + 64] = (bf16)f2bf(xi);
                const float nr = a32.x * xr - a32.y * xi + sr[i], ni = a32.x * xi + a32.y * xr + si[i]; xr = nr; xi = ni; } }
    }
}
__device__ __forceinline__ void ln_row(const float* hin, const float* add, const float* y0, float w0, const float* y1, float w1, const float* gam, const float* bet,
                                       float* hout, bf16* hb, float* dout, int lane) {
    f32x4 v[8]; float s = 0.f;
#pragma unroll
    for (int j = 0; j < 8; ++j) { const int idx = (j * 64 + lane) * 4; f32x4 x = *(const f32x4*)(hin + idx) * DN_ALPHA;
        if (add) x += *(const f32x4*)(add + idx);
        if (y0) x += *(const f32x4*)(y0 + idx) * w0 + *(const f32x4*)(y1 + idx) * w1;
        v[j] = x; s += (x.x + x.y) + (x.z + x.w); }
    const float mean = wave_sum(s) * (1.0f / D); float q = 0.f;
#pragma unroll
    for (int j = 0; j < 8; ++j) { v[j] = v[j] - mean; q += (v[j].x * v[j].x + v[j].y * v[j].y) + (v[j].z * v[j].z + v[j].w * v[j].w); }
    const float rstd = 1.0f / sqrtf(wave_sum(q) * (1.0f / D) + LN_EPS);
#pragma unroll
    for (int j = 0; j < 8; ++j) { const int idx = (j * 64 + lane) * 4; const f32x4 o = v[j] * rstd * *(const f32x4*)(gam + idx) + *(const f32x4*)(bet + idx);
        if (hout) *(f32x4*)(hout + idx) = o;
        if (hb) { v2u w; w.x = pk2(o.x, o.y); w.y = pk2(o.z, o.w); *(v2u*)(hb + idx) = w; }
        if (dout) *(f32x4*)(dout + idx) = o; }
}
__device__ __forceinline__ void phase_ln_mix(const Ctx& c, const Args& a, int layer, const float* Hin, float* Hout) {
    const float* MIX = (const float*)(a.ws + WS_MIX); bf16* HB = (bf16*)(a.ws + WS_HBF);
    for (int row = c.gw; row < LP; row += c.ngw)
        ln_row(Hin + (size_t)row * D, MIX + (size_t)row * D, nullptr, 0.f, nullptr, 0.f, a.in[I_LNMG] + layer * D, a.in[I_LNMB] + layer * D, Hout + (size_t)row * D, HB + (size_t)row * D, nullptr, c.lane);
}
__device__ __forceinline__ void phase_ln_ffn(const Ctx& c, const Args& a, int layer, const float* Hin, float* Hout, bool last) {
    const float* Y = (const float*)(a.ws + WS_R1 + R1_Y); bf16* HB = (bf16*)(a.ws + WS_HBF);
    const int* route = (const int*)(a.ws + WS_ROUTE);
    for (int row = c.gw; row < LP; row += c.ngw) {
        const float* y0 = nullptr; const float* y1 = nullptr; float w0 = 0.f, w1 = 0.f;
        if (row >= ROWV) { const int* r = route + (size_t)row * 8; y0 = Y + (size_t)r[4] * D; y1 = Y + (size_t)r[5] * D; w0 = __int_as_float(r[6]); w1 = __int_as_float(r[7]); }
        float* dout = (last && row >= 256) ? a.out + (size_t)(row - 256) * D : nullptr;
        if (row >= ROWV) ln_row(Hin + (size_t)row * D, nullptr, y0, w0, y1, w1, a.in[I_LNFG] + layer * D, a.in[I_LNFB] + layer * D, last ? nullptr : Hout + (size_t)row * D, last ? nullptr : HB + (size_t)row * D, dout, c.lane);
        else if (!last) ln_row(Hin + (size_t)row * D, nullptr, nullptr, 0.f, nullptr, 0.f, a.in[I_LNFG] + layer * D, a.in[I_LNFB] + layer * D, Hout + (size_t)row * D, HB + (size_t)row * D, nullptr, c.lane);
    }
}
typedef float f32x16 __attribute__((ext_vector_type(16)));
__device__ __forceinline__ void phase_router(const Ctx& c, const Args& a, int layer, const float* Hn) {
    LAS float* part = (LAS float*)c.lds;
    LAS float* lg = (LAS float*)(c.lds + 98304);
    const float* wrt = (const float*)(a.ws + WS_WRT) + (size_t)layer * 96 * 2048;
    const float* bg = a.in[I_BGRP] + layer * 8; const float* be = a.in[I_BEXP] + layer * 64;
    int* route = (int*)(a.ws + WS_ROUTE); unsigned* cnt = (unsigned*)(a.ws + WS_CTL) + CW_CNT + layer * 64;
    const int li = c.lane & 31, kh = c.lane >> 5, w = c.wave;
    for (int task = c.bid; task < 513; task += c.nblk) {
        const int row0 = 224 + 32 * task;
        f32x16 acc[3];
#pragma unroll
        for (int ct = 0; ct < 3; ++ct)
#pragma unroll
            for (int e = 0; e < 16; ++e) acc[ct][e] = 0.f;
        const float* ap = Hn + (size_t)(row0 + li) * D + 256 * w + 4 * kh;
        const float* bp = wrt + (size_t)li * 2048 + 256 * w + 4 * kh;
#pragma unroll 4
        for (int st = 0; st < 32; ++st) {
            const f32x4 av = *(const f32x4*)(ap + 8 * st);
            const f32x4 b0 = *(const f32x4*)(bp + 8 * st), b1 = *(const f32x4*)(bp + (size_t)32 * 2048 + 8 * st), b2 = *(const f32x4*)(bp + (size_t)64 * 2048 + 8 * st);
#pragma unroll
            for (int j = 0; j < 4; ++j) { acc[0] = __builtin_amdgcn_mfma_f32_32x32x2f32(av[j], b0[j], acc[0], 0, 0, 0);
                acc[1] = __builtin_amdgcn_mfma_f32_32x32x2f32(av[j], b1[j], acc[1], 0, 0, 0); acc[2] = __builtin_amdgcn_mfma_f32_32x32x2f32(av[j], b2[j], acc[2], 0, 0, 0); }
        }
#pragma unroll
        for (int ct = 0; ct < 3; ++ct)
#pragma unroll
            for (int e = 0; e < 16; ++e) part[((ct * 8 + w) * 16 + e) * 64 + c.lane] = acc[ct][e];
        __syncthreads();
        for (int i = c.tid; i < 3072; i += NTHR) { const int ct = i >> 10, e = (i >> 6) & 15, ln = i & 63; float sum = 0.f;
#pragma unroll
            for (int w2 = 0; w2 < 8; ++w2) sum += part[((ct * 8 + w2) * 16 + e) * 64 + ln];
            const int col = 32 * ct + (ln & 31), row = (e & 3) + 8 * (e >> 2) + 4 * (ln >> 5);
            lg[row * 96 + col] = sum + (col < 8 ? bg[col] : (col < 72 ? be[col - 8] : 0.f)); }
        __syncthreads();
        if (c.tid < 32) { const int row2 = row0 + c.tid;
            if (row2 >= ROWV) { const LAS float* l = lg + c.tid * 96;
                int grp = 0; float gm = l[0];
                for (int q = 1; q < 8; ++q) if (l[q] > gm) { gm = l[q]; grp = q; }
                float gs = 0.f; for (int q = 0; q < 8; ++q) gs += expf(l[q] - gm);
                const float pg = 1.0f / gs;
                const LAS float* el = l + 8 + grp * 8;
                int i0 = 0; float v0 = el[0]; for (int q = 1; q < 8; ++q) if (el[q] > v0) { v0 = el[q]; i0 = q; }
                int i1 = -1; float v1 = -3.0e38f; for (int q = 0; q < 8; ++q) if (q != i0 && el[q] > v1) { v1 = el[q]; i1 = q; }
                const float e1 = expf(v1 - v0), w0 = pg / (1.0f + e1), w1 = pg * e1 / (1.0f + e1);
                const int ex0 = grp * 8 + i0, ex1 = grp * 8 + i1;
                const int p0 = (int)atomicAdd(cnt + ex0, 1u), p1 = (int)atomicAdd(cnt + ex1, 1u);
                int* r = route + (size_t)row2 * 8; r[0] = ex0; r[1] = ex1; r[2] = p0; r[3] = p1; r[6] = __float_as_int(w0); r[7] = __float_as_int(w1); } }
        __syncthreads();
    }
}
__device__ __forceinline__ void phase_plan(const Ctx& c, const Args& a, int layer) {
    if (c.bid != 0 || c.tid != 0) return;
    const unsigned* cnt = (const unsigned*)(a.ws + WS_CTL) + CW_CNT + layer * 64; int* plan = (int*)(a.ws + WS_CTL) + CW_PLAN + layer * 512;
    int t = 0;
    for (int e = 0; e < NEXP; ++e) { const int n = (int)cnt[e], nt = (n + 255) / 256; plan[1 + e] = t * 256; for (int q = 0; q < nt; ++q) plan[128 + t + q] = e; t += nt; }
    plan[0] = t;
}
__device__ __forceinline__ void phase_gather(const Ctx& c, const Args& a, int layer) {
    const int* plan = (const int*)(a.ws + WS_CTL) + CW_PLAN + layer * 512; int* route = (int*)(a.ws + WS_ROUTE);
    const bf16* HB = (const bf16*)(a.ws + WS_HBF); bf16* XS = (bf16*)(a.ws + WS_R1 + R1_XSRT);
    for (int T = c.gw; T < NVALID * 2; T += c.ngw) {
        const int row = ROWV + (T >> 1), j = T & 1; int* r = route + (size_t)row * 8;
        const int slot = plan[1 + r[j]] + r[2 + j];
        if (c.lane == 0) r[4 + j] = slot;
        const v4u* s = (const v4u*)(HB + (size_t)row * D); v4u* d = (v4u*)(XS + (size_t)slot * D);
#pragma unroll
        for (int q = 0; q < 4; ++q) d[q * 64 + c.lane] = s[q * 64 + c.lane];
    }
}
__device__ __forceinline__ void phase_hg_prep(const Ctx& c, const Args& a) {
    float* P = (float*)(a.ws + WS_R1 + R1_PROJ1);
    for (long i = (long)c.bid * NTHR + c.tid; i < (long)NVALID * 4096; i += (long)c.nblk * NTHR) {
        const int row = ROWV + (int)(i >> 12), cc = (int)(i & 4095), ch = cc & 2047;
        const float l0 = a.in[I_LB][ch], l1 = a.in[I_LB][D + ch], lb = 1.0f / (1.0f + expf(l0 - l1));
        float* p = P + (size_t)row * CN + 4096 + cc;
        *p = lb + (1.0f - lb) * sigmoidf_(*p);
    }
}
__device__ __forceinline__ void phase_hg_rec_naive(const Ctx& c, const Args& a) {
    if (c.bid >= 32) return;
    const int dir = c.bid >> 4, head = c.bid & 15, v = c.tid >> 2, kq = c.tid & 3;
    const float* P = (const float*)(a.ws + WS_R1 + R1_PROJ1);
    float* O = (float*)(a.ws + WS_R1 + (dir == 0 ? R1_OFW : R1_OBW));
    float S[32];
#pragma unroll
    for (int k = 0; k < 32; ++k) S[k] = 0.f;
    const int fcol = (dir == 0 ? 4096 : 6144) + head * 128 + kq * 32, qcol = head * 128 + kq * 32, vcol = 2048 + head * 128 + v;
    for (int st = 0; st < NVALID; ++st) {
        const int row = dir == 0 ? ROWV + st : LP - 1 - st;
        const float* base = P + (size_t)row * CN;
        const float vv = base[vcol]; float o = 0.f;
#pragma unroll
        for (int k4 = 0; k4 < 8; ++k4) { const f32x4 f = *(const f32x4*)(base + fcol + k4 * 4), q = *(const f32x4*)(base + qcol + k4 * 4);
            S[k4 * 4 + 0] = f.x * S[k4 * 4 + 0] + (1.0f - f.x) * vv; o += S[k4 * 4 + 0] * q.x;
            S[k4 * 4 + 1] = f.y * S[k4 * 4 + 1] + (1.0f - f.y) * vv; o += S[k4 * 4 + 1] * q.y;
            S[k4 * 4 + 2] = f.z * S[k4 * 4 + 2] + (1.0f - f.z) * vv; o += S[k4 * 4 + 2] * q.z;
            S[k4 * 4 + 3] = f.w * S[k4 * 4 + 3] + (1.0f - f.w) * vv; o += S[k4 * 4 + 3] * q.w; }
        o += __shfl_xor(o, 1); o += __shfl_xor(o, 2);
        if (kq == 0) O[(size_t)row * D + head * 128 + v] = o;
    }
}

struct HgRaw { float f[16], q[16], v[16]; };
template <bool NEEDQ> __device__ __forceinline__ void hg_load(HgRaw& r, const float* P, int r0, int head, int dir, int k, int tq) {
    const float* base = P + (size_t)(r0 + 16 * tq) * CN + head * 128 + k;
#pragma unroll
    for (int i = 0; i < 16; ++i) { r.f[i] = base[(size_t)i * CN + 4096 + 2048 * dir]; r.v[i] = base[(size_t)i * CN + 2048]; if (NEEDQ) r.q[i] = base[(size_t)i * CN]; }
}
template <bool NEEDQ> __device__ __forceinline__ float hg_prep(const Ctx& c, const HgRaw& r, int r0, int dir, int k, int tq) {
    LAS unsigned char* L = c.lds;
    LAS float* T = (LAS float*)(L + HG_T);
    float g[16], kk[16], cs[16];
#pragma unroll
    for (int i = 0; i < 16; ++i) { const bool valid = (r0 + 16 * tq + i) >= ROWV; g[i] = valid ? logf(r.f[i]) : 0.f; kk[i] = valid ? 1.0f - r.f[i] : 0.f; }
    if (dir == 0) { cs[0] = g[0];
#pragma unroll
        for (int i = 1; i < 16; ++i) cs[i] = cs[i - 1] + g[i]; }
    else { cs[15] = g[15];
#pragma unroll
        for (int i = 14; i >= 0; --i) cs[i] = cs[i + 1] + g[i]; }
    T[tq * 128 + k] = dir == 0 ? cs[15] : cs[0];
    __syncthreads();
    const float t0 = T[k], t1 = T[128 + k], t2 = T[256 + k], t3 = T[384 + k];
    const float btot = (t0 + t1) + (t2 + t3);
    float off;
    if (dir == 0) off = tq == 0 ? 0.f : tq == 1 ? t0 : tq == 2 ? t0 + t1 : t0 + t1 + t2;
    else off = tq == 3 ? 0.f : tq == 2 ? t3 : tq == 1 ? t3 + t2 : t3 + t2 + t1;
    unsigned kh[8], vt[8];
#pragma unroll
    for (int i = 0; i < 16; i += 2) {
        const float b0 = off + cs[i], b1 = off + cs[i + 1];
        const float h0 = kk[i] * __expf(btot - b0), h1 = kk[i + 1] * __expf(btot - b1);
        kh[i >> 1] = pk2(h0, h1); vt[i >> 1] = pk2(r.v[i], r.v[i + 1]);
        if (NEEDQ) {
            const int t = 16 * tq + i;
            *(LAS unsigned short*)(L + HG_QT + t * LD_K + 2 * k) = (unsigned short)f2bf(r.q[i] * __expf(b0));
            *(LAS unsigned short*)(L + HG_QT + (t + 1) * LD_K + 2 * k) = (unsigned short)f2bf(r.q[i + 1] * __expf(b1));
            *(LAS unsigned short*)(L + HG_KT + t * LD_K + 2 * k) = (unsigned short)f2bf(kk[i] * __expf(-b0));
            *(LAS unsigned short*)(L + HG_KT + (t + 1) * LD_K + 2 * k) = (unsigned short)f2bf(kk[i + 1] * __expf(-b1));
        }
    }
    *(LAS v4u*)(L + HG_KH + k * LD_T + 32 * tq) = (v4u){kh[0], kh[1], kh[2], kh[3]};
    *(LAS v4u*)(L + HG_KH + k * LD_T + 32 * tq + 16) = (v4u){kh[4], kh[5], kh[6], kh[7]};
    *(LAS v4u*)(L + HG_VT + k * LD_T + 32 * tq) = (v4u){vt[0], vt[1], vt[2], vt[3]};
    *(LAS v4u*)(L + HG_VT + k * LD_T + 32 * tq + 16) = (v4u){vt[4], vt[5], vt[6], vt[7]};
    if (tq == 0) ((LAS float*)(L + HG_DV))[k] = __expf(btot);
    return btot;
}
__device__ __forceinline__ void hg_update(const Ctx& c, f32x4 (&S)[8]) {
    LAS unsigned char* L = c.lds; const int r = c.lane & 15, q = c.lane >> 4, w = c.wave;
    const LAS float* DV = (const LAS float*)(L + HG_DV);
#pragma unroll
    for (int kt = 0; kt < 8; ++kt) { const float d = DV[16 * kt + r]; S[kt] = S[kt] * d; }
#pragma unroll
    for (int ks = 0; ks < 2; ++ks) { const bf16x8 a = ldfrag(L + HG_VT, 16 * w + r, LD_T, (32 * ks + 8 * q) * 2);
#pragma unroll
        for (int kt = 0; kt < 8; ++kt) { const bf16x8 b = ldfrag(L + HG_KH, 16 * kt + r, LD_T, (32 * ks + 8 * q) * 2); S[kt] = MFMA16(a, b, S[kt]); } }
}
__device__ __forceinline__ void hg_store_st(const Ctx& c, const f32x4 (&S)[8]) {
    LAS unsigned char* L = c.lds; const int r = c.lane & 15, q = c.lane >> 4, w = c.wave;
#pragma unroll
    for (int kt = 0; kt < 8; ++kt)
#pragma unroll
        for (int e = 0; e < 4; ++e) *(LAS unsigned short*)(L + HG_ST + (16 * w + 4 * q + e) * LD_K + 2 * (16 * kt + r)) = (unsigned short)f2bf(S[kt][e]);
}
__device__ __forceinline__ void hg_seg_range(int seg, int& c0, int& n) { if (seg == 0) { c0 = 3; n = 9; } else { c0 = 4 + 8 * seg; n = 8; } }
__device__ __forceinline__ void phase_hg_pass1(const Ctx& c, const Args& a) {
    const float* P = (const float*)(a.ws + WS_R1 + R1_PROJ1);
    float* DS = (float*)(a.ws + WS_R1 + R1_DS); float* DSEG = (float*)(a.ws + WS_R1 + R1_DSEG);
    const int k = c.tid & 127, tq = c.tid >> 7, r = c.lane & 15, q = c.lane >> 4, w = c.wave;
    for (int u = c.bid; u < 1024; u += c.nblk) {
        const int chain = u & 31, seg = u >> 5, dir = chain >> 4, head = chain & 15;
        int c0, n; hg_seg_range(seg, c0, n);
        f32x4 S[8];
#pragma unroll
        for (int kt = 0; kt < 8; ++kt) S[kt] = (f32x4){0.f, 0.f, 0.f, 0.f};
        float bsum = 0.f;
        HgRaw raw; hg_load<false>(raw, P, 64 * (dir == 0 ? c0 : c0 + n - 1), head, dir, k, tq);
        for (int j = 0; j < n; ++j) {
            const int ci = dir == 0 ? c0 + j : c0 + n - 1 - j;
            bsum += hg_prep<false>(c, raw, 64 * ci, dir, k, tq);
            if (j + 1 < n) hg_load<false>(raw, P, 64 * (dir == 0 ? ci + 1 : ci - 1), head, dir, k, tq);
            __syncthreads();
            hg_update(c, S);
            __syncthreads();
        }
        float* dst = DS + ((size_t)seg * 32 + chain) * 16384;
#pragma unroll
        for (int kt = 0; kt < 8; ++kt)
#pragma unroll
            for (int e = 0; e < 4; ++e) dst[(16 * w + 4 * q + e) * 128 + 16 * kt + r] = S[kt][e];
        if (tq == 0) DSEG[((size_t)seg * 32 + chain) * 128 + k] = __expf(bsum);
    }
}
__device__ __forceinline__ void phase_hg_segscan(const Ctx& c, const Args& a) {
    float* DS = (float*)(a.ws + WS_R1 + R1_DS); const float* DSEG = (const float*)(a.ws + WS_R1 + R1_DSEG);
    for (int i = c.bid * NTHR + c.tid; i < 32 * 4096; i += c.nblk * NTHR) {
        const int chain = i >> 12, e4 = i & 4095, k4 = (e4 & 31) * 4, dir = chain >> 4;
        f32x4 run = (f32x4){0.f, 0.f, 0.f, 0.f};
        for (int j = 0; j < 32; ++j) { const int seg = dir == 0 ? j : 31 - j;
            f32x4* p = (f32x4*)(DS + ((size_t)seg * 32 + chain) * 16384) + e4; const f32x4 d = *(const f32x4*)(DSEG + ((size_t)seg * 32 + chain) * 128 + k4);
            const f32x4 ds = *p; *p = run; run = run * d + ds; }
    }
}
__device__ __forceinline__ void phase_hg_pass2(const Ctx& c, const Args& a) {
    const float* P = (const float*)(a.ws + WS_R1 + R1_PROJ1);
    const float* DS = (const float*)(a.ws + WS_R1 + R1_DS);
    LAS unsigned char* L = c.lds;
    const int k = c.tid & 127, tq = c.tid >> 7, r = c.lane & 15, q = c.lane >> 4, w = c.wave;
    const int tr = w >> 1;
    for (int u = c.bid; u < 1024; u += c.nblk) {
        const int chain = u & 31, seg = u >> 5, dir = chain >> 4, head = chain & 15;
        float* O = (float*)(a.ws + WS_R1 + (dir == 0 ? R1_OFW : R1_OBW));
        int c0, n; hg_seg_range(seg, c0, n);
        f32x4 S[8];
        { const float* src = DS + ((size_t)seg * 32 + chain) * 16384;
#pragma unroll
          for (int kt = 0; kt < 8; ++kt)
#pragma unroll
              for (int e = 0; e < 4; ++e) S[kt][e] = src[(16 * w + 4 * q + e) * 128 + 16 * kt + r]; }
        hg_store_st(c, S);
        HgRaw raw; hg_load<true>(raw, P, 64 * (dir == 0 ? c0 : c0 + n - 1), head, dir, k, tq);
        for (int j = 0; j < n; ++j) {
            const int ci = dir == 0 ? c0 + j : c0 + n - 1 - j, r0 = 64 * ci;
            (void)hg_prep<true>(c, raw, r0, dir, k, tq);
            if (j + 1 < n) hg_load<true>(raw, P, 64 * (dir == 0 ? ci + 1 : ci - 1), head, dir, k, tq);
            __syncthreads();
            {
                const int tc0 = (w & 1) * 2; f32x4 sc[2] = {(f32x4){0.f, 0.f, 0.f, 0.f}, (f32x4){0.f, 0.f, 0.f, 0.f}};
#pragma unroll
                for (int ks = 0; ks < 4; ++ks) { const bf16x8 af = ldfrag(L + HG_QT, 16 * tr + r, LD_K, (32 * ks + 8 * q) * 2);
#pragma unroll
                    for (int jj = 0; jj < 2; ++jj) { const bf16x8 bf = ldfrag(L + HG_KT, 16 * (tc0 + jj) + r, LD_K, (32 * ks + 8 * q) * 2); sc[jj] = MFMA16(af, bf, sc[jj]); } }
#pragma unroll
                for (int jj = 0; jj < 2; ++jj) { const int s = 16 * (tc0 + jj) + r;
#pragma unroll
                    for (int e = 0; e < 4; ++e) { const int t = 16 * tr + 4 * q + e; const bool keep = dir == 0 ? (s <= t) : (s >= t);
                        *(LAS unsigned short*)(L + HG_P + t * LD_T + 2 * s) = (unsigned short)f2bf(keep ? sc[jj][e] : 0.f); } }
            }
            __syncthreads();
            {
                const int tc0 = (w & 1) * 4; f32x4 o[4];
#pragma unroll
                for (int jj = 0; jj < 4; ++jj) o[jj] = (f32x4){0.f, 0.f, 0.f, 0.f};
#pragma unroll
                for (int ks = 0; ks < 2; ++ks) { const bf16x8 af = ldfrag(L + HG_P, 16 * tr + r, LD_T, (32 * ks + 8 * q) * 2);
#pragma unroll
                    for (int jj = 0; jj < 4; ++jj) { const bf16x8 bf = ldfrag(L + HG_VT, 16 * (tc0 + jj) + r, LD_T, (32 * ks + 8 * q) * 2); o[jj] = MFMA16(af, bf, o[jj]); } }
#pragma unroll
                for (int ks = 0; ks < 4; ++ks) { const bf16x8 af = ldfrag(L + HG_QT, 16 * tr + r, LD_K, (32 * ks + 8 * q) * 2);
#pragma unroll
                    for (int jj = 0; jj < 4; ++jj) { const bf16x8 bf = ldfrag(L + HG_ST, 16 * (tc0 + jj) + r, LD_K, (32 * ks + 8 * q) * 2); o[jj] = MFMA16(af, bf, o[jj]); } }
#pragma unroll
                for (int jj = 0; jj < 4; ++jj)
#pragma unroll
                    for (int e = 0; e < 4; ++e) O[(size_t)(r0 + 16 * tr + 4 * q + e) * D + head * 128 + 16 * (tc0 + jj) + r] = o[jj][e];
            }
            hg_update(c, S);
            __syncthreads();
            hg_store_st(c, S);
        }
        __syncthreads();
    }
}
__device__ __forceinline__ void phase_hg_finish(const Ctx& c, const Args& a) {
    const float* P = (const float*)(a.ws + WS_R1 + R1_PROJ1);
    const float* OF = (const float*)(a.ws + WS_R1 + R1_OFW); const float* OB = (const float*)(a.ws + WS_R1 + R1_OBW); bf16* MI = (bf16*)(a.ws + WS_MIXIN);
    for (int T = c.gw; T < LP * 16; T += c.ngw) {
        const int row = T >> 4, head = T & 15; const size_t off = (size_t)row * D + head * 128;
        float r0 = 0.f, r1 = 0.f;
        if (row >= ROWV) {
            const float o0 = OF[off + c.lane] + OB[off + c.lane], o1 = OF[off + 64 + c.lane] + OB[off + 64 + c.lane];
            const float ss = wave_sum(o0 * o0 + o1 * o1), rs = 1.0f / sqrtf(ss * (1.0f / 128.0f) + 1e-6f);
            const float* gp = P + (size_t)row * CN + 8192 + head * 128; const float* ng = a.in[I_NORMG] + head * 128;
            r0 = o0 * rs * ng[c.lane] * sigmoidf_(gp[c.lane]); r1 = o1 * rs * ng[64 + c.lane] * sigmoidf_(gp[64 + c.lane]);
        }
        MI[off + c.lane] = (bf16)f2bf(r0); MI[off + 64 + c.lane] = (bf16)f2bf(r1);
    }
}

constexpr int NPHASE = 40;
__global__ void __launch_bounds__(NTHR, 2) fwd(Args args) {
    extern __shared__ __attribute__((aligned(16))) unsigned char lds[];
    Ctx c; c.lds = (LAS unsigned char*)lds; c.ldsg = lds; c.tid = threadIdx.x; c.lane = c.tid & 63; c.wave = __builtin_amdgcn_readfirstlane(c.tid >> 6);
    c.bid = blockIdx.x; c.nblk = gridDim.x; c.gw = c.bid * NWAVES + c.wave; c.ngw = c.nblk * NWAVES;
    volatile LAS unsigned* MISC = (volatile LAS unsigned*)(c.lds + MISC_OFF);
    for (int u = c.tid; u < (LDS_BYTES - RING_BYTES) / 4; u += NTHR) ((LAS unsigned*)(c.lds + RING_BYTES))[u] = 0u;
    __syncthreads();
    const int lo = args.ph_lo, hi = args.ph_hi;
    const bool multi = (hi - lo) > 1;
    XcdBarrier bar; bar.bar = (unsigned*)(args.ws + WS_CTL) + CW_BAR; bar.x = 0; bar.st = nullptr;
    if (multi) bar = xcd_barrier_post((unsigned*)(args.ws + WS_CTL) + CW_BAR, MISC + 8);
#define IN(k) (lo <= (k) && (k) < hi)
#define SEAM(k) do { if (IN(k) && IN((k) + 1)) xcd_barrier(bar); } while (0)
    unsigned char* ws = args.ws;
    float* HA = (float*)(ws + WS_HA); float* HBuf = (float*)(ws + WS_HB);
    const pg8::bf16_t* HBF = (const pg8::bf16_t*)(ws + WS_HBF);
    const pg8::bf16_t* MIXIN = (const pg8::bf16_t*)(ws + WS_MIXIN);
    if (IN(0)) { phase_init(c, args); } SEAM(0);
    if (IN(1)) { phase_s5_ktab(c, args); } SEAM(1);
    if (IN(2)) { phase_weights(c, args); phase_s5_fill(c, args); } SEAM(2);
    if (IN(3)) { pg8::Gemm g = pg8::mkgemm(HBF, ws + WS_WAB, LP, ABN, D); pg8::StaticOrder S; S.init(LP, ABN, c.nblk, c.bid);
        pg8::EpiProjAB E{(float*)(ws + WS_PROJ0), (pg8::bf16_t*)(ws + WS_R1 + R1_UA)}; pg8::gemm_phase(c.lds, g, S, E); } SEAM(3);
    if (IN(4)) { phase_rope(c, args); } SEAM(4);
    if (IN(5)) { phase_attn(c, args); } SEAM(5);
    if (IN(6)) { pg8::Gemm g = pg8::mkgemm(ws + WS_R1 + R1_UA, ws + WS_WST, 768, 256, 512, (size_t)256 * 512 * 2); g.lda = 768; g.astride = (size_t)768 * 768 * 2;
        pg8::GroupTileOrder S; S.init(64, 768, 256, c.nblk, c.bid); pg8::EpiF32 E{(float*)(ws + WS_R1 + R1_SALL), 256, (size_t)768 * 256}; pg8::gemm_phase(c.lds, g, S, E); } SEAM(6);
    if (IN(7)) { phase_s5_chunkscan(c, args); } SEAM(7);
    if (IN(8)) { pg8::Gemm g = pg8::mkgemm(ws + WS_R1 + R1_UA, ws + WS_MWT, 768, 512, 768, (size_t)512 * 768 * 2); g.astride = (size_t)768 * 768 * 2;
        pg8::GroupTileOrder S; S.init(64, 768, 512, c.nblk, c.bid); pg8::EpiS5Y E{(pg8::bf16_t*)(ws + WS_ZB)}; pg8::gemm_phase(c.lds, g, S, E); } SEAM(8);
    if (IN(9)) { pg8::Gemm g = pg8::mkgemm(ws + WS_ZB, ws + WS_WGLU, LP, 1024, 1024); pg8::StaticOrder S; S.init(LP, 1024, c.nblk, c.bid);
        pg8::EpiGlu E{(const pg8::bf16_t*)(ws + WS_ZB), args.in[I_BGLU], (pg8::bf16_t*)(ws + WS_MIXIN)}; pg8::gemm_phase(c.lds, g, S, E); } SEAM(9);
    if (IN(10)) { pg8::Gemm g = pg8::mkgemm(MIXIN, ws + WS_WOAB, LP, D, D); pg8::StaticOrder S; S.init(LP, D, c.nblk, c.bid);
        pg8::EpiF32 E{(float*)(ws + WS_MIX), D, 0}; pg8::gemm_phase(c.lds, g, S, E); } SEAM(10);
    if (IN(11)) { phase_ln_mix(c, args, 0, HA, HBuf); } SEAM(11);
    if (IN(12)) { phase_router(c, args, 0, HBuf); } SEAM(12);
    if (IN(13)) { phase_plan(c, args, 0); } SEAM(13);
    if (IN(14)) { phase_gather(c, args, 0); } SEAM(14);
    if (IN(15)) { pg8::Gemm g = pg8::mkgemm(ws + WS_R1 + R1_XSRT, ws + WS_WGU, MPAD, 1024, D, (size_t)1024 * D * 2); pg8::GroupedOrder S; S.init((const int*)(ws + WS_CTL) + CW_PLAN, 1024, c.nblk, c.bid);
        pg8::EpiSwiGLU E{(pg8::bf16_t*)(ws + WS_R1 + R1_ACT), DEXP}; pg8::gemm_phase(c.lds, g, S, E); } SEAM(15);
    if (IN(16)) { pg8::Gemm g = pg8::mkgemm(ws + WS_R1 + R1_ACT, ws + WS_WD, MPAD, D, DEXP, (size_t)D * DEXP * 2); pg8::GroupedOrder S; S.init((const int*)(ws + WS_CTL) + CW_PLAN, D, c.nblk, c.bid);
        pg8::EpiF32 E{(float*)(ws + WS_R1 + R1_Y), D, 0}; pg8::gemm_phase(c.lds, g, S, E); } SEAM(16);
    if (IN(17)) { phase_ln_ffn(c, args, 0, HBuf, HA, false); } SEAM(17);
    if (IN(18)) { pg8::Gemm g = pg8::mkgemm(HBF, ws + WS_WC, LP, CN, D); pg8::StaticOrder S; S.init(LP, CN, c.nblk, c.bid);
        pg8::EpiF32 E{(float*)(ws + WS_R1 + R1_PROJ1), CN, 0}; pg8::gemm_phase(c.lds, g, S, E); } SEAM(18);
    if (IN(19)) { phase_hg_prep(c, args); } SEAM(19);
    if (IN(20)) { phase_hg_pass1(c, args); xcd_barrier(bar); phase_hg_segscan(c, args); xcd_barrier(bar); phase_hg_pass2(c, args); } SEAM(20);
    if (IN(21)) { phase_hg_finish(c, args); } SEAM(21);
    if (IN(22)) { pg8::Gemm g = pg8::mkgemm(MIXIN, ws + WS_WOC, LP, D, D); pg8::StaticOrder S; S.init(LP, D, c.nblk, c.bid);
        pg8::EpiF32 E{(float*)(ws + WS_MIX), D, 0}; pg8::gemm_phase(c.lds, g, S, E); } SEAM(22);
    if (IN(23)) { phase_ln_mix(c, args, 1, HA, HBuf); } SEAM(23);
    if (IN(24)) { phase_router(c, args, 1, HBuf); } SEAM(24);
    if (IN(25)) { phase_plan(c, args, 1); } SEAM(25);
    if (IN(26)) { phase_gather(c, args, 1); } SEAM(26);
    if (IN(27)) { pg8::Gemm g = pg8::mkgemm(ws + WS_R1 + R1_XSRT, (const pg8::bf16_t*)(ws + WS_WGU) + (size_t)NEXP * 1024 * D, MPAD, 1024, D, (size_t)1024 * D * 2); pg8::GroupedOrder S; S.init((const int*)(ws + WS_CTL) + CW_PLAN + 512, 1024, c.nblk, c.bid);
        pg8::EpiSwiGLU E{(pg8::bf16_t*)(ws + WS_R1 + R1_ACT), DEXP}; pg8::gemm_phase(c.lds, g, S, E); } SEAM(27);
    if (IN(28)) { pg8::Gemm g = pg8::mkgemm(ws + WS_R1 + R1_ACT, (const pg8::bf16_t*)(ws + WS_WD) + (size_t)NEXP * D * DEXP, MPAD, D, DEXP, (size_t)D * DEXP * 2); pg8::GroupedOrder S; S.init((const int*)(ws + WS_CTL) + CW_PLAN + 512, D, c.nblk, c.bid);
        pg8::EpiF32 E{(float*)(ws + WS_R1 + R1_Y), D, 0}; pg8::gemm_phase(c.lds, g, S, E); } SEAM(28);
    if (IN(29)) { phase_ln_ffn(c, args, 1, HBuf, HA, true); }
#undef IN
#undef SEAM
}
constexpr int LAST_PHASE = 29;

extern "C" void kernel_launch(void* const* d_in, const int* in_sizes, int n_in, void* d_out, int out_size, void* d_ws, size_t ws_size, hipStream_t stream) {
    static int grid = 0;
    if (grid == 0) {
        if (n_in != 29 || ws_size < WS_END) { fprintf(stderr, "kernel_launch: expected 29 inputs and >= %zu bytes of workspace (got %d, %zu)\n", (size_t)WS_END, n_in, ws_size); grid = -1; return; }
        int dev = 0, cus = 0, per_cu = 0;
        if (hipGetDevice(&dev) != hipSuccess || hipDeviceGetAttribute(&cus, hipDeviceAttributeMultiprocessorCount, dev) != hipSuccess) { grid = -1; return; }
        if (hipFuncSetAttribute((const void*)fwd, hipFuncAttributeMaxDynamicSharedMemorySize, LDS_BYTES) != hipSuccess) { fprintf(stderr, "kernel_launch: hipFuncSetAttribute failed\n"); grid = -1; return; }
        if (hipOccupancyMaxActiveBlocksPerMultiprocessor(&per_cu, (const void*)fwd, NTHR, LDS_BYTES) != hipSuccess || per_cu < 1) fprintf(stderr, "kernel_launch: occupancy query says %d\n", per_cu);
        (void)hipGetLastError();
        grid = cus;
    }
    if (grid < 0) return;
    (void)hipMemsetAsync((char*)d_ws + WS_CTL, 0, CTL_BYTES, stream);
    Args a{};
    for (int i = 0; i < 29; ++i) a.in[i] = (const float*)d_in[i];
    a.out = (float*)d_out; a.ws = (unsigned char*)d_ws;
#ifndef MK_N_LAUNCHES
#define MK_N_LAUNCHES 1
#endif
    if (MK_N_LAUNCHES == 1) { a.ph_lo = 0; a.ph_hi = LAST_PHASE + 1; hipLaunchKernelGGL(fwd, dim3(grid), dim3(NTHR), LDS_BYTES, stream, a); }
    else for (int p = 0; p <= LAST_PHASE; ++p) {
        a.ph_lo = p; a.ph_hi = p + 1;
        hipLaunchKernelGGL(fwd, dim3(grid), dim3(NTHR), LDS_BYTES, stream, a);
    }
}
```

```cpp
#include <hip/hip_runtime.h>
#include <cstdio>
#include <cstdint>

namespace pg8 {
#define PG8_LAS __attribute__((address_space(3)))
typedef unsigned short bf16_t;
typedef short bf16x8 __attribute__((ext_vector_type(8)));
typedef float f32x4 __attribute__((ext_vector_type(4)));
typedef unsigned u32x4 __attribute__((ext_vector_type(4)));
constexpr int BM = 256, BK = 64, HALF = 128, HTB = HALF * BK * 2, STAGE_BYTES = 8 * HTB, NXCD = 8, WGM = 4;

__host__ __device__ __forceinline__ int lds_byte(int r, int c) { const int st = (r >> 4) * 2 + (c >> 5), rr = r & 15, cc = c & 31, ob = rr * 64 + cc * 2; return st * 1024 + (ob ^ (((ob >> 9) & 1) << 5)); }
__host__ __device__ __forceinline__ void stage_rc(int b, int& R, int& C) { const int st = b / 1024, sb = b % 1024, swz = sb ^ (((sb >> 9) & 1) << 5); R = (st >> 1) * 16 + swz / 64; C = (st & 1) * 32 + (swz % 64) / 2; }
__host__ __device__ __forceinline__ int perm32(int rho) { const int n = rho >> 4, i = rho & 15; return 8 * (i >> 2) + 4 * n + (i & 3); }

struct Unit { int pm, pn, eb; };
struct Gemm { const bf16_t* A; const bf16_t* Bt; int M, N, K, lda, ldb; size_t astride, bstride; };

struct StaticOrder {
    static constexpr bool GATHER = false;
    int nM, nN, nwg, G, c, pm_off, pn_off, gap_at, gap;
    __host__ __device__ __forceinline__ void init(int M, int N, int G_, int c_, int pm_off_ = 0, int pn_off_ = 0, int gap_at_ = 1 << 30, int gap_ = 0) { nM = M / BM; nN = N / BM; nwg = nM * nN; G = G_; c = c_; pm_off = pm_off_; pn_off = pn_off_; gap_at = gap_at_; gap = gap_; }
    __host__ __device__ __forceinline__ bool next(int i, Unit& u) const {
        const long L = (long)i * G + c; if (L >= nwg) return false;
        int wgid = (int)L; { const int q = nwg / NXCD, r = nwg % NXCD, xcd = wgid % NXCD, off = wgid / NXCD; wgid = (xcd < r ? xcd * (q + 1) : r * (q + 1) + (xcd - r) * q) + off; }
        const int nig = WGM * nN, gid = wgid / nig, fm = gid * WGM, gsz = (nM - fm) < WGM ? (nM - fm) : WGM;
        u.pm = fm + ((wgid % nig) % gsz) + pm_off; const int pn_ = (wgid % nig) / gsz; u.pn = pn_ + pn_off + (pn_ >= gap_at ? gap : 0); u.eb = 0; return true;
    }
    __device__ __forceinline__ void a_ready(const Unit&) const {}
    __device__ __forceinline__ void done(const Unit&) const {}
};
template <bool GATHER_> struct GroupedOrderT {
    static constexpr bool GATHER = GATHER_;
    int ntiles, nN, nwg, G, c; const int* tile_expert; const int* rowlist;
    __device__ __forceinline__ void init(const int* plan, int N, int G_, int c_, const int* rowlist_ = nullptr) { ntiles = plan[0]; tile_expert = plan + 128; nN = N / BM; nwg = ntiles * nN; G = G_; rowlist = rowlist_;
        c = (G_ % NXCD == 0) ? (c_ % NXCD) * (G_ / NXCD) + c_ / NXCD : c_; }
    __device__ __forceinline__ bool next(int i, Unit& u) const {
        const long L = (long)i * G + c; if (L >= nwg) return false;
        u.pm = (int)(L / nN); u.pn = (int)(L % nN); u.eb = tile_expert[u.pm]; return true;
    }
    __device__ __forceinline__ void a_ready(const Unit&) const {}
    __device__ __forceinline__ void done(const Unit&) const {}
};

typedef GroupedOrderT<false> GroupedOrder; typedef GroupedOrderT<true> GatherOrder;
struct GroupTileOrder {
    static constexpr bool GATHER = false;
    int nM, nN, nwg, G, c;
    __device__ __forceinline__ void init(int groups, int M, int N, int G_, int c_) { nM = M / BM; nN = N / BM; nwg = groups * nM * nN; G = G_; c = c_; }
    __device__ __forceinline__ bool next(int i, Unit& u) const {
        const long L = (long)i * G + c; if (L >= nwg) return false;
        const int per = nM * nN, rem = (int)(L % per); u.eb = (int)(L / per); u.pm = rem % nM; u.pn = rem / nM; return true;
    }
    __device__ __forceinline__ void a_ready(const Unit&) const {}
    __device__ __forceinline__ void done(const Unit&) const {}
};
__device__ __forceinline__ unsigned cvt_pk_bf16(float lo, float hi) { unsigned r; asm volatile("v_cvt_pk_bf16_f32 %0, %1, %2" : "=v"(r) : "v"(lo), "v"(hi)); return r; }

struct EpiF32 {
    static constexpr bool PERM = false, AFTER_DRAIN = false;
    float* C; int ldc; size_t cstride;
    __device__ __forceinline__ void operator()(const f32x4 (&acc)[2][2][4][2], const Unit& u, int wr, int wc, int fr, int fq) const {
        const int row0 = u.pm * BM + wr * 64 + fr, col0 = u.pn * BM + wc * 32 + 4 * fq;
#pragma unroll
        for (int ai = 0; ai < 2; ++ai)
#pragma unroll
            for (int m = 0; m < 4; ++m) { float* rowp = C + (size_t)u.eb * cstride + (size_t)(row0 + ai * HALF + m * 16) * ldc + col0;
#pragma unroll
                for (int bj = 0; bj < 2; ++bj)
#pragma unroll
                    for (int n = 0; n < 2; ++n) *(f32x4*)(rowp + bj * HALF + n * 16) = acc[ai][bj][m][n]; }
    }
};
struct EpiSwiGLU {
    static constexpr bool PERM = true, AFTER_DRAIN = false;
    bf16_t* O; int ldc;
    __device__ __forceinline__ void operator()(const f32x4 (&acc)[2][2][4][2], const Unit& u, int wr, int wc, int fr, int fq) const {
        const int row0 = u.pm * BM + wr * 64 + fr, col0 = u.pn * HALF + wc * 32 + 8 * fq;
#pragma unroll
        for (int ai = 0; ai < 2; ++ai)
#pragma unroll
            for (int m = 0; m < 4; ++m) { bf16_t* rowp = O + (size_t)(row0 + ai * HALF + m * 16) * ldc + col0;
                float r[8];
#pragma unroll
                for (int n = 0; n < 2; ++n)
#pragma unroll
                    for (int i = 0; i < 4; ++i) { const float g = acc[ai][0][m][n][i], up = acc[ai][1][m][n][i]; r[n * 4 + i] = g / (1.0f + __expf(-g)) * up; }
                u32x4 w; w.x = cvt_pk_bf16(r[0], r[1]); w.y = cvt_pk_bf16(r[2], r[3]); w.z = cvt_pk_bf16(r[4], r[5]); w.w = cvt_pk_bf16(r[6], r[7]);
                *(u32x4*)rowp = w; }
    }
};

struct EpiSwiGLU8 {
    static constexpr bool PERM = true, AFTER_DRAIN = false;
    unsigned char* O; int ldc;
    __device__ __forceinline__ void operator()(const f32x4 (&acc)[2][2][4][2], const Unit& u, int wr, int wc, int fr, int fq) const {
        typedef unsigned u32x2 __attribute__((ext_vector_type(2)));
        const int row0 = u.pm * BM + wr * 64 + fr, col0 = u.pn * HALF + wc * 32 + 8 * fq;
#pragma unroll
        for (int ai = 0; ai < 2; ++ai)
#pragma unroll
            for (int m = 0; m < 4; ++m) { unsigned char* rowp = O + (size_t)(row0 + ai * HALF + m * 16) * ldc + col0;
                float r[8];
#pragma unroll
                for (int n = 0; n < 2; ++n)
#pragma unroll
                    for (int i = 0; i < 4; ++i) { const float g = acc[ai][0][m][n][i], up = acc[ai][1][m][n][i]; r[n * 4 + i] = g / (1.0f + __expf(-g)) * up; }
                int w0 = 0, w1 = 0; w0 = __builtin_amdgcn_cvt_pk_fp8_f32(r[0], r[1], w0, false); w0 = __builtin_amdgcn_cvt_pk_fp8_f32(r[2], r[3], w0, true);
                w1 = __builtin_amdgcn_cvt_pk_fp8_f32(r[4], r[5], w1, false); w1 = __builtin_amdgcn_cvt_pk_fp8_f32(r[6], r[7], w1, true);
                *(u32x2*)rowp = (u32x2){(unsigned)w0, (unsigned)w1}; }
    }
};
__host__ __device__ __forceinline__ Gemm mkgemm(const void* A, const void* Bt, int M, int N, int K, size_t bstride = 0) { Gemm g; g.A = (const bf16_t*)A; g.Bt = (const bf16_t*)Bt; g.M = M; g.N = N; g.K = K; g.lda = K; g.ldb = K; g.astride = 0; g.bstride = bstride; return g; }
struct EpiS5Y {
    static constexpr bool PERM = false, AFTER_DRAIN = false;
    bf16_t* ZB;
    __device__ __forceinline__ void operator()(const f32x4 (&acc)[2][2][4][2], const Unit& u, int wr, int wc, int fr, int fq) const {
#pragma unroll
        for (int ai = 0; ai < 2; ++ai)
#pragma unroll
            for (int m = 0; m < 4; ++m) { const int chunk = u.pm * BM + ai * HALF + wr * 64 + m * 16 + fr;
                if (chunk <= 512) {
#pragma unroll
                    for (int bj = 0; bj < 2; ++bj)
#pragma unroll
                        for (int n = 0; n < 2; ++n) { const int t = 16 * u.pn + 8 * bj + 2 * wc + n, row = 224 + 32 * chunk + t; float z[4];
#pragma unroll
                            for (int i = 0; i < 4; ++i) { const float y = acc[ai][bj][m][n][i]; const float x2 = 1.5957691216057308f * (y + 0.044715f * y * y * y);
                                const float th = 1.0f - 2.0f / (1.0f + __expf(x2)); z[i] = 0.5f * y * (1.0f + th); }
                            typedef unsigned u32x2 __attribute__((ext_vector_type(2)));
                            u32x2 w; w.x = cvt_pk_bf16(z[0], z[1]); w.y = cvt_pk_bf16(z[2], z[3]);
                            *(u32x2*)(ZB + (size_t)row * 1024 + 16 * u.eb + 4 * fq) = w; } } }
    }
};
struct EpiGlu {
    static constexpr bool PERM = true, AFTER_DRAIN = false;
    const bf16_t* ZB; const float* bias; bf16_t* O;
    __device__ __forceinline__ void operator()(const f32x4 (&acc)[2][2][4][2], const Unit& u, int wr, int wc, int fr, int fq) const {
        const int row0 = u.pm * BM + wr * 64 + fr, col0 = u.pn * BM + wc * 32 + 8 * fq;
#pragma unroll
        for (int ai = 0; ai < 2; ++ai)
#pragma unroll
            for (int m = 0; m < 4; ++m) { const int row = row0 + ai * HALF + m * 16;
#pragma unroll
                for (int bj = 0; bj < 2; ++bj) { const int col = col0 + bj * HALF;
                    const u32x4 zw = *(const u32x4*)(ZB + (size_t)row * 1024 + col);
                    const f32x4 b0 = *(const f32x4*)(bias + col), b1 = *(const f32x4*)(bias + col + 4);
                    float r[8];
#pragma unroll
                    for (int i = 0; i < 4; ++i) { const unsigned zz = i < 2 ? (i == 0 ? zw.x : zw.y) : (i == 2 ? zw.z : zw.w);
                        const float z0 = __uint_as_float(zz << 16), z1 = __uint_as_float(zz & 0xffff0000u);
                        const int e0 = 2 * i, e1 = 2 * i + 1;
                        const float a0 = (e0 < 4 ? acc[ai][bj][m][0][e0] : acc[ai][bj][m][1][e0 - 4]) + (e0 < 4 ? b0[e0] : b1[e0 - 4]);
                        const float a1 = (e1 < 4 ? acc[ai][bj][m][0][e1] : acc[ai][bj][m][1][e1 - 4]) + (e1 < 4 ? b0[e1] : b1[e1 - 4]);
                        r[e0] = z0 / (1.0f + __expf(-a0)); r[e1] = z1 / (1.0f + __expf(-a1)); }
                    u32x4 w; w.x = cvt_pk_bf16(r[0], r[1]); w.y = cvt_pk_bf16(r[2], r[3]); w.z = cvt_pk_bf16(r[4], r[5]); w.w = cvt_pk_bf16(r[6], r[7]);
                    *(u32x4*)(O + (size_t)row * 2048 + 1024 + col) = w; } }
    }
};

struct EpiBf16 {
    static constexpr bool PERM = true, AFTER_DRAIN = false;
    bf16_t* O; int ldc;
    __device__ __forceinline__ void operator()(const f32x4 (&acc)[2][2][4][2], const Unit& u, int wr, int wc, int fr, int fq) const {
        const int row0 = u.pm * BM + wr * 64 + fr, col0 = u.pn * BM + wc * 32 + 8 * fq;
#pragma unroll
        for (int ai = 0; ai < 2; ++ai)
#pragma unroll
            for (int m = 0; m < 4; ++m) { bf16_t* rowp = O + (size_t)(row0 + ai * HALF + m * 16) * ldc + col0;
#pragma unroll
                for (int bj = 0; bj < 2; ++bj) { const f32x4 v0 = acc[ai][bj][m][0], v1 = acc[ai][bj][m][1];
                    u32x4 w; w.x = cvt_pk_bf16(v0[0], v0[1]); w.y = cvt_pk_bf16(v0[2], v0[3]); w.z = cvt_pk_bf16(v1[0], v1[1]); w.w = cvt_pk_bf16(v1[2], v1[3]);
                    *(u32x4*)(rowp + bj * HALF) = w; } }
    }
};
struct EpiNull { static constexpr bool PERM = true, AFTER_DRAIN = false; float* sink;
    __device__ __forceinline__ void operator()(const f32x4 (&acc)[2][2][4][2], const Unit& u, int wr, int wc, int fr, int fq) const {
        float t = 0.f;
#pragma unroll
        for (int ai = 0; ai < 2; ++ai)
#pragma unroll
            for (int bj = 0; bj < 2; ++bj)
#pragma unroll
                for (int m = 0; m < 4; ++m)
#pragma unroll
                    for (int n = 0; n < 2; ++n) t += acc[ai][bj][m][n][0] + acc[ai][bj][m][n][1] + acc[ai][bj][m][n][2] + acc[ai][bj][m][n][3];
        if (t == 123.456f) sink[0] = t; } };
#ifndef PG8_SP2
#define PG8_SP2 1
#endif
template <class Epi, class Sched, bool FP8 = false>
__device__ __forceinline__ void gemm_phase(PG8_LAS unsigned char* lds, const Gemm g, const Sched& S, const Epi& E, int scale_w = 0x7f7f7f7f) {
    const int tid = threadIdx.x, wid = __builtin_amdgcn_readfirstlane(tid >> 6), lane = tid & 63, wr = wid >> 2, wc = wid & 3, fr = lane & 15, fq = lane >> 4;
    const int K = g.K, nt = K / BK;
    unsigned voffA[2], voffB[2]; int stR[2], stC[2];
#pragma unroll
    for (int i = 0; i < 2; ++i) { int R, C; stage_rc(tid * 16 + i * 8192, R, C); const int Rb = Epi::PERM ? ((R & ~31) + perm32(R & 31)) : R;
        voffA[i] = (unsigned)(R * g.lda + C) * 2u; voffB[i] = (unsigned)(Rb * g.ldb + C) * 2u; stR[i] = R; stC[i] = C; }
    const size_t kstep = (size_t)(BK * 2);
    const size_t hstepA = (size_t)HALF * g.lda * 2, hstepB = (size_t)HALF * g.ldb * 2;
    const size_t tstepA = 2 * hstepA, tstepB = 2 * hstepB;
    const unsigned ldsw = (unsigned)wid * 1024u;
    const int aoff = lds_byte(wr * 64 + fr, fq * 8), boff = lds_byte(wc * 32 + fr, fq * 8);
#define PG8_SA(b, h) (((b) * 2 + (h)) * HTB)
#define PG8_SB(b, h) ((4 + (b) * 2 + (h)) * HTB)
#define PG8_STAGE(bufoff, gbase, voff) do { _Pragma("unroll") for (int _i = 0; _i < 2; ++_i) \
        __builtin_amdgcn_global_load_lds((const unsigned*)((const char*)(gbase) + (voff)[_i]), (PG8_LAS unsigned*)(lds + (bufoff) + ldsw + _i * 8192), 16, 0, 0); } while (0)
#define PG8_LD8(base_) __builtin_shufflevector(*(const PG8_LAS v4i_t*)(base_), *(const PG8_LAS v4i_t*)((base_) + 1024), 0, 1, 2, 3, 4, 5, 6, 7)
#define PG8_LDA(dst, b, h) do { if constexpr (FP8) { _Pragma("unroll") for (int m = 0; m < 4; ++m) dst##8[m] = PG8_LD8(lds + PG8_SA(b, h) + aoff + m * 2048); } \
        else { _Pragma("unroll") for (int m = 0; m < 4; ++m) _Pragma("unroll") for (int k = 0; k < 2; ++k) dst[m][k] = *(const PG8_LAS bf16x8*)(lds + PG8_SA(b, h) + aoff + m * 2048 + k * 1024); } } while (0)
#define PG8_LDB(dst, b, h) do { if constexpr (FP8) { _Pragma("unroll") for (int n = 0; n < 2; ++n) dst##8[n] = PG8_LD8(lds + PG8_SB(b, h) + boff + n * 2048); } \
        else { _Pragma("unroll") for (int n = 0; n < 2; ++n) _Pragma("unroll") for (int k = 0; k < 2; ++k) dst[n][k] = *(const PG8_LAS bf16x8*)(lds + PG8_SB(b, h) + boff + n * 2048 + k * 1024); } } while (0)
#define PG8_MMA(ai, bj, At, Bt) do { __builtin_amdgcn_s_setprio(1); _Pragma("unroll") for (int m = 0; m < 4; ++m) _Pragma("unroll") for (int n = 0; n < 2; ++n) { \
        if constexpr (FP8) asm volatile("v_mfma_scale_f32_16x16x128_f8f6f4 %0, %1, %2, %0, %3, %4 op_sel_hi:[0,0,0]" : "+v"(acc[ai][bj][m][n]) : "v"(Bt##8[n]), "v"(At##8[m]), "v"(scw_), "v"(sca_)); \
        else { _Pragma("unroll") for (int k = 0; k < 2; ++k) acc[ai][bj][m][n] = __builtin_amdgcn_mfma_f32_16x16x32_bf16(Bt[n][k], At[m][k], acc[ai][bj][m][n], 0, 0, 0); } } \
        __builtin_amdgcn_s_setprio(0); } while (0)
#define PG8_WAIT_V(n) asm volatile("s_waitcnt vmcnt(" #n ")" ::: "memory")
#define PG8_WAIT_L(n) asm volatile("s_waitcnt lgkmcnt(" #n ")" ::: "memory")
#define PG8_BAR __builtin_amdgcn_s_barrier()
#define PG8_SCHED __builtin_amdgcn_sched_barrier(0)
    unsigned vC[2][2], vN[2][2];
#define PG8_AOFF(dst, unit) do { _Pragma("unroll") for (int h_ = 0; h_ < 2; ++h_) _Pragma("unroll") for (int i_ = 0; i_ < 2; ++i_) { \
        if constexpr (Sched::GATHER) { const int row_ = S.rowlist[(unit).pm * BM + h_ * HALF + stR[i_]]; dst[h_][i_] = (unsigned)(row_ * g.lda + stC[i_]) * 2u; } \
        else dst[h_][i_] = voffA[i_] + (unsigned)(h_ * hstepA); } } while (0)
    Unit cur, nxt; int ui = 0;
    if (!S.next(0, cur)) return;
    f32x4 acc[2][2][4][2];
#pragma unroll
    for (int a = 0; a < 2; ++a)
#pragma unroll
        for (int b = 0; b < 2; ++b)
#pragma unroll
            for (int m = 0; m < 4; ++m)
#pragma unroll
                for (int n = 0; n < 2; ++n) acc[a][b][m][n] = (f32x4){0.f, 0.f, 0.f, 0.f};
    typedef int v8i_t __attribute__((ext_vector_type(8))); typedef int v4i_t __attribute__((ext_vector_type(4)));
    const int scw_ = scale_w, sca_ = 0x7f7f7f7f;
    bf16x8 At[4][2], B0[2][2], B1[2][2]; v8i_t At8[4], B08[2], B18[2];
    const char* cA = (const char*)g.A + (size_t)cur.eb * g.astride + (Sched::GATHER ? (size_t)0 : (size_t)cur.pm * tstepA); const char* cB = (const char*)g.Bt + (size_t)cur.eb * g.bstride + (size_t)cur.pn * tstepB;
    PG8_AOFF(vC, cur);
    S.a_ready(cur);
#if PG8_SP2
    PG8_STAGE(PG8_SB(0, 0), cB, voffB); PG8_STAGE(PG8_SB(0, 1), cB + hstepB, voffB); PG8_STAGE(PG8_SA(0, 0), cA, vC[0]); PG8_STAGE(PG8_SA(0, 1), cA, vC[1]);
    if (wr == 1) PG8_BAR;
    PG8_WAIT_V(2); PG8_BAR;
    PG8_STAGE(PG8_SB(1, 0), cB + kstep, voffB); PG8_STAGE(PG8_SA(1, 0), cA + kstep, vC[0]); PG8_STAGE(PG8_SB(1, 1), cB + hstepB + kstep, voffB);
    PG8_WAIT_V(6); PG8_BAR;
#else
    PG8_STAGE(PG8_SB(0, 0), cB, voffB); PG8_STAGE(PG8_SA(0, 0), cA, vC[0]); PG8_STAGE(PG8_SB(0, 1), cB + hstepB, voffB); PG8_STAGE(PG8_SA(0, 1), cA, vC[1]);
    if (wr == 1) PG8_BAR;
    PG8_WAIT_V(4); PG8_BAR;
    PG8_STAGE(PG8_SB(1, 0), cB + kstep, voffB); PG8_STAGE(PG8_SA(1, 0), cA + kstep, vC[0]); PG8_STAGE(PG8_SB(1, 1), cB + hstepB + kstep, voffB);
    PG8_WAIT_V(6); PG8_BAR;
#endif
    for (;;) {
        const bool has_next = S.next(ui + 1, nxt);
        const char* nA = has_next ? (const char*)g.A + (size_t)nxt.eb * g.astride + (Sched::GATHER ? (size_t)0 : (size_t)nxt.pm * tstepA) : cA;
        if constexpr (Sched::GATHER) { if (has_next) PG8_AOFF(vN, nxt); else { _Pragma("unroll") for (int h_ = 0; h_ < 2; ++h_) _Pragma("unroll") for (int i_ = 0; i_ < 2; ++i_) vN[h_][i_] = vC[h_][i_]; } }
        const char* nB = has_next ? (const char*)g.Bt + (size_t)nxt.eb * g.bstride + (size_t)nxt.pn * tstepB : cB;
        for (int t = 0; t < nt; t += 2) {
            const bool last = (t == nt - 2);
            const char* a1 = cA + (size_t)(t + 1) * kstep;
            const char* a2 = last ? nA : cA + (size_t)(t + 2) * kstep; const char* b2 = last ? nB : cB + (size_t)(t + 2) * kstep;
            const char* a3 = a2 + kstep; const char* b3 = b2 + kstep;
            if (last && has_next) S.a_ready(nxt);
            unsigned vs0[2], vs1[2];
            if constexpr (Sched::GATHER) { vs0[0] = last ? vN[0][0] : vC[0][0]; vs0[1] = last ? vN[0][1] : vC[0][1]; vs1[0] = last ? vN[1][0] : vC[1][0]; vs1[1] = last ? vN[1][1] : vC[1][1]; }
            else { vs0[0] = vC[0][0]; vs0[1] = vC[0][1]; vs1[0] = vC[1][0]; vs1[1] = vC[1][1]; }
#if PG8_SP2
            PG8_LDB(B0, 0, 0); PG8_LDB(B1, 0, 1); PG8_SCHED; PG8_LDA(At, 0, 0); PG8_STAGE(PG8_SA(1, 1), a1, vC[1]);
            PG8_WAIT_V(8); PG8_WAIT_L(0); PG8_BAR; PG8_MMA(0, 0, At, B0); PG8_MMA(0, 1, At, B1); PG8_BAR; PG8_SCHED;
            PG8_LDA(At, 0, 1); PG8_STAGE(PG8_SB(0, 0), b2, voffB); PG8_STAGE(PG8_SB(0, 1), b2 + hstepB, voffB); PG8_STAGE(PG8_SA(0, 0), a2, vs0);
            PG8_WAIT_V(8); PG8_WAIT_L(0); PG8_BAR; PG8_MMA(1, 0, At, B0); PG8_MMA(1, 1, At, B1); PG8_BAR; PG8_SCHED;
            PG8_LDB(B0, 1, 0); PG8_LDB(B1, 1, 1); PG8_SCHED; PG8_LDA(At, 1, 0); PG8_STAGE(PG8_SA(0, 1), a2, vs1);
            PG8_WAIT_V(8); PG8_WAIT_L(0); PG8_BAR; PG8_MMA(0, 0, At, B0); PG8_MMA(0, 1, At, B1); PG8_BAR; PG8_SCHED;
            PG8_LDA(At, 1, 1); PG8_STAGE(PG8_SB(1, 0), b3, voffB); PG8_STAGE(PG8_SB(1, 1), b3 + hstepB, voffB); PG8_STAGE(PG8_SA(1, 0), a3, vs0);
            PG8_WAIT_V(8); PG8_WAIT_L(0); PG8_BAR; PG8_MMA(1, 0, At, B0); PG8_MMA(1, 1, At, B1); PG8_BAR; PG8_SCHED;
#else
            PG8_LDB(B0, 0, 0); PG8_SCHED; PG8_LDA(At, 0, 0); PG8_STAGE(PG8_SA(1, 1), a1, vC[1]);
            PG8_WAIT_L(8); PG8_BAR; PG8_WAIT_L(0); PG8_MMA(0, 0, At, B0); PG8_BAR; PG8_SCHED;
            PG8_LDB(B1, 0, 1); PG8_STAGE(PG8_SB(0, 0), b2, voffB);
            PG8_BAR; PG8_WAIT_L(0); PG8_MMA(0, 1, At, B1); PG8_BAR;
            PG8_LDA(At, 0, 1); PG8_STAGE(PG8_SA(0, 0), a2, vs0);
            PG8_BAR; PG8_WAIT_L(0); PG8_MMA(1, 0, At, B0); PG8_BAR; PG8_SCHED;
            PG8_STAGE(PG8_SB(0, 1), b2 + hstepB, voffB);
            PG8_WAIT_V(6); PG8_BAR; PG8_MMA(1, 1, At, B1); PG8_BAR;
            PG8_LDB(B0, 1, 0); PG8_SCHED; PG8_LDA(At, 1, 0); PG8_STAGE(PG8_SA(0, 1), a2, vs1);
            PG8_WAIT_L(8); PG8_BAR; PG8_WAIT_L(0); PG8_MMA(0, 0, At, B0); PG8_BAR; PG8_SCHED;
            PG8_LDB(B1, 1, 1); PG8_STAGE(PG8_SB(1, 0), b3, voffB);
            PG8_BAR; PG8_WAIT_L(0); PG8_MMA(0, 1, At, B1); PG8_BAR;
            PG8_LDA(At, 1, 1); PG8_STAGE(PG8_SA(1, 0), a3, vs0);
            PG8_BAR; PG8_WAIT_L(0); PG8_MMA(1, 0, At, B0); PG8_BAR; PG8_SCHED;
            PG8_STAGE(PG8_SB(1, 1), b3 + hstepB, voffB);
            PG8_WAIT_V(6); PG8_BAR; PG8_MMA(1, 1, At, B1); PG8_BAR;
#endif
        }
        if constexpr (FP8) asm volatile("s_nop 15\n\ts_nop 15" ::: "memory");
        if (wr == 0) PG8_BAR;
        E(acc, cur, wr, wc, fr, fq); S.done(cur);
        if (!has_next) break;
#pragma unroll
        for (int a = 0; a < 2; ++a)
#pragma unroll
            for (int b = 0; b < 2; ++b)
#pragma unroll
                for (int m = 0; m < 4; ++m)
#pragma unroll
                    for (int n = 0; n < 2; ++n) acc[a][b][m][n] = (f32x4){0.f, 0.f, 0.f, 0.f};
        cur = nxt; cA = nA; cB = nB; ++ui;
        if constexpr (Sched::GATHER) {
#pragma unroll
            for (int h_ = 0; h_ < 2; ++h_)
#pragma unroll
                for (int i_ = 0; i_ < 2; ++i_) vC[h_][i_] = vN[h_][i_]; }
        if (wr == 1) PG8_BAR;
    }
    PG8_WAIT_V(0);
    PG8_BAR;
#undef PG8_AOFF
#undef PG8_SA
#undef PG8_SB
#undef PG8_STAGE
#undef PG8_LDA
#undef PG8_LD8
#undef PG8_LDB
#undef PG8_MMA
#undef PG8_WAIT_V
#undef PG8_WAIT_L
#undef PG8_BAR
#undef PG8_SCHED
}
}

constexpr int D = 2048, SEQ = 16384, NMETA = 16;
constexpr int LP = 16640;
constexpr int ROWV = 240;
constexpr int NVALID = 16400;
constexpr int ABN = 2560, CN = 10240;
constexpr int NEXP = 64, DEXP = 512;
constexpr int MAXTILES = 192, MPAD = MAXTILES * 256;
constexpr float DN_ALPHA = 1.4142135623730951f;
constexpr float LN_EPS = 1e-5f;
constexpr int NWAVES = 8, NTHR = 512;

constexpr size_t al(size_t x) { return (x + 0xFFFFFull) & ~(size_t)0xFFFFFull; }
constexpr size_t WS_CTL = 0, CTL_BYTES = 1u << 20;
constexpr size_t WS_WAB = al(WS_CTL + CTL_BYTES);
constexpr size_t WS_WOAB = al(WS_WAB + (size_t)ABN * D * 2);
constexpr size_t WS_WGLU = al(WS_WOAB + (size_t)D * D * 2);
constexpr size_t WS_WC = al(WS_WGLU + (size_t)1024 * 1024 * 2);
constexpr size_t WS_WOC = al(WS_WC + (size_t)CN * D * 2);
constexpr size_t WS_WGU = al(WS_WOC + (size_t)D * D * 2);
constexpr size_t WS_WD = al(WS_WGU + (size_t)2 * NEXP * 1024 * D * 2);
constexpr size_t WS_HA = al(WS_WD + (size_t)2 * NEXP * D * DEXP * 2);
constexpr size_t WS_HB = al(WS_HA + (size_t)LP * D * 4);
constexpr size_t WS_WC8 = WS_HB;
constexpr size_t WS_H8 = WS_HA;
constexpr size_t WS_HBF = al(WS_HB + (size_t)LP * D * 4);
constexpr size_t WS_PROJ0 = al(WS_HBF + (size_t)LP * D * 2);
constexpr size_t WS_QB0 = WS_PROJ0;
constexpr size_t WS_KB0 = al(WS_QB0 + (size_t)LP * 1024 * 2);
constexpr size_t WS_VB0 = al(WS_KB0 + (size_t)LP * 256 * 2);
constexpr size_t WS_MIXIN = al(WS_VB0 + (size_t)LP * 256 * 2);
constexpr size_t WS_MIX = al(WS_MIXIN + (size_t)LP * D * 2);
constexpr size_t WS_Z = al(WS_MIX + (size_t)LP * D * 4);
constexpr size_t WS_ZB = al(WS_Z + (size_t)LP * 1024 * 4);
constexpr size_t WS_GLU = al(WS_ZB + (size_t)LP * 1024 * 2);
constexpr size_t WS_S5P = al(WS_GLU + (size_t)LP * 1024 * 4);
constexpr size_t WS_APOW = al(WS_S5P + (size_t)(2 * 64 * 64 * 8 + 2 * 64 * 64 * 16 * 8));
constexpr size_t WS_KTAB = al(WS_APOW + (size_t)2 * 64 * 64 * 33 * 8);
constexpr size_t WS_MWT = al(WS_KTAB + (size_t)2 * 64 * 32 * 256 * 4);
constexpr size_t WS_WST = al(WS_MWT + (size_t)64 * 512 * 768 * 2);
constexpr size_t WS_ROPE = al(WS_WST + (size_t)64 * 256 * 512 * 2);
constexpr size_t WS_WRT = al(WS_ROPE + (size_t)LP * 64 * 8);
constexpr size_t WS_WRH = al(WS_WRT + (size_t)2 * 96 * 2048 * 4);
constexpr size_t WS_WRL = al(WS_WRH + (size_t)2 * 96 * 2048 * 2);
constexpr size_t WS_LBT = al(WS_WRL + (size_t)2 * 96 * 2048 * 2);
constexpr size_t WS_ROUTE = al(WS_LBT + (size_t)2048 * 4);
constexpr size_t WS_ROWLIST = al(WS_ROUTE + (size_t)LP * 32);
constexpr size_t WS_R1 = al(WS_ROWLIST + (size_t)MPAD * 4);
constexpr size_t R1_BYTES = (size_t)1200 << 20;
constexpr size_t WS_END = WS_R1 + R1_BYTES;
constexpr size_t R1_UA = 0;
constexpr size_t R1_SALL = al((size_t)64 * 768 * 768 * 2);
constexpr size_t R1_QB = 0;
constexpr size_t R1_VB = al(R1_QB + (size_t)LP * D * 2);
constexpr size_t R1_GB = al(R1_VB + (size_t)LP * D * 2);
constexpr size_t R1_F = al(R1_GB + (size_t)LP * D * 2);
constexpr size_t R1_OBW = al(R1_F + (size_t)LP * 4096 * 4);
constexpr size_t R1_DS = al(R1_OBW + (size_t)LP * D * 2);
constexpr size_t R1_DSEG = al(R1_DS + (size_t)32 * 32 * 16384 * 4);
constexpr size_t IMG_SZ = 18432 + 2 * 54272;
constexpr size_t R1_IMG = al(R1_DSEG + (size_t)32 * 32 * 128 * 4);
constexpr size_t R1_GT = al(R1_IMG + (size_t)260 * 16 * IMG_SZ);
constexpr size_t R1_HG_END = R1_GT + (size_t)260 * 16 * 16384;
constexpr size_t R1_XSRT = 0;
constexpr size_t R1_ACT = al((size_t)MPAD * D * 2);
constexpr size_t R1_Y = al(R1_ACT + (size_t)MPAD * DEXP * 2);
constexpr size_t R1_MOE_END = R1_Y + (size_t)MPAD * D * 2;
static_assert(R1_HG_END <= R1_BYTES && R1_MOE_END <= R1_BYTES, "R1 overlays");
static_assert(WS_END <= (size_t)4 << 30, "workspace map must fit 4 GiB");
constexpr int CW_BAR = 4096;
constexpr int CW_CNT = 16384;
constexpr int CW_TS = 65536;
constexpr int CW_PLAN = 32768;

namespace pg8 {
struct EpiProjC {
    static constexpr bool PERM = true, AFTER_DRAIN = false;
    unsigned char* R1; const float* lbt;
    __device__ __forceinline__ void operator()(const f32x4 (&acc)[2][2][4][2], const Unit& u, int wr, int wc, int fr, int fq) const {
        bf16_t* F = (bf16_t*)(R1 + R1_F);
        const int row0 = u.pm * BM + wr * 64 + fr, col0 = u.pn * BM + wc * 32 + 8 * fq;
        const int kind = u.pn < 8 ? 0 : (u.pn < 16 ? 1 : (u.pn < 32 ? 2 : 3));
        if (kind == 2) {
#pragma unroll
            for (int bj = 0; bj < 2; ++bj) { const int col = col0 + bj * HALF - 4096; const f32x4 l0 = *(const f32x4*)(lbt + (col & 2047)), l1 = *(const f32x4*)(lbt + (col & 2047) + 4);
#pragma unroll
                for (int ai = 0; ai < 2; ++ai)
#pragma unroll
                    for (int m = 0; m < 4; ++m) { bf16_t* rowp = F + (size_t)(row0 + ai * HALF + m * 16) * 4096 + col; f32x4 v0 = acc[ai][bj][m][0], v1 = acc[ai][bj][m][1];
#pragma unroll
                        for (int i = 0; i < 4; ++i) { v0[i] = (1.0f - l0[i]) / (1.0f + __expf(v0[i])); v1[i] = (1.0f - l1[i]) / (1.0f + __expf(v1[i])); }
                        u32x4 w; w.x = cvt_pk_bf16(v0[0], v0[1]); w.y = cvt_pk_bf16(v0[2], v0[3]); w.z = cvt_pk_bf16(v1[0], v1[1]); w.w = cvt_pk_bf16(v1[2], v1[3]);
                        *(u32x4*)rowp = w; } }
        } else {
            const size_t ob = kind == 0 ? R1_QB : (kind == 1 ? R1_VB : R1_GB); bf16_t* O = (bf16_t*)(R1 + ob); const int cbase = kind == 0 ? 0 : (kind == 1 ? 2048 : 8192);
#pragma unroll
            for (int ai = 0; ai < 2; ++ai)
#pragma unroll
                for (int m = 0; m < 4; ++m) { bf16_t* rowp = O + (size_t)(row0 + ai * HALF + m * 16) * 2048 + col0 - cbase;
#pragma unroll
                    for (int bj = 0; bj < 2; ++bj) { f32x4 v0 = acc[ai][bj][m][0], v1 = acc[ai][bj][m][1];
                        if (kind == 3) {
#pragma unroll
                            for (int i = 0; i < 4; ++i) { v0[i] = 1.0f / (1.0f + __expf(-v0[i])); v1[i] = 1.0f / (1.0f + __expf(-v1[i])); } }
                        u32x4 w; w.x = cvt_pk_bf16(v0[0], v0[1]); w.y = cvt_pk_bf16(v0[2], v0[3]); w.z = cvt_pk_bf16(v1[0], v1[1]); w.w = cvt_pk_bf16(v1[2], v1[3]);
                        *(u32x4*)(rowp + bj * HALF) = w; } }
        }
    }
};
}

namespace pg8 {
struct EpiProjAB {
    static constexpr bool PERM = false, AFTER_DRAIN = false;
    unsigned char* ws;
    __device__ __forceinline__ void operator()(const f32x4 (&acc)[2][2][4][2], const Unit& u, int wr, int wc, int fr, int fq) const {
        typedef unsigned u32x2 __attribute__((ext_vector_type(2)));
        const int row0 = u.pm * BM + wr * 64 + fr;
        if (u.pn < 5) {
            const float* rope = (const float*)(ws + WS_ROPE); const int d0 = 16 * wc + 4 * fq;
#pragma unroll
            for (int ai = 0; ai < 2; ++ai)
#pragma unroll
                for (int m = 0; m < 4; ++m) { const int row = row0 + ai * HALF + m * 16; const f32x4 cs0 = *(const f32x4*)(rope + ((size_t)row * 64 + d0) * 2), cs1 = *(const f32x4*)(rope + ((size_t)row * 64 + d0) * 2 + 4);
                    const float cc[4] = {cs0[0], cs0[2], cs1[0], cs1[2]}, sn[4] = {cs0[1], cs0[3], cs1[1], cs1[3]};
#pragma unroll
                    for (int bj = 0; bj < 2; ++bj) { const f32x4 x1 = acc[ai][bj][m][0], x2 = acc[ai][bj][m][1]; float o1[4], o2[4];
#pragma unroll
                        for (int i = 0; i < 4; ++i) { o1[i] = x1[i] * cc[i] - x2[i] * sn[i]; o2[i] = x2[i] * cc[i] + x1[i] * sn[i]; }
                        bf16_t* dst = u.pn < 4 ? (bf16_t*)(ws + WS_QB0) + (size_t)row * 1024 + (2 * u.pn + bj) * 128 + d0 : (bf16_t*)(ws + WS_KB0) + (size_t)row * 256 + bj * 128 + d0;
                        u32x2 w1, w2; w1.x = cvt_pk_bf16(o1[0], o1[1]); w1.y = cvt_pk_bf16(o1[2], o1[3]); w2.x = cvt_pk_bf16(o2[0], o2[1]); w2.y = cvt_pk_bf16(o2[2], o2[3]);
                        *(u32x2*)dst = w1; *(u32x2*)(dst + 64) = w2; } }
        } else if (u.pn == 5) {
            const int col0 = wc * 32 + 4 * fq;
#pragma unroll
            for (int ai = 0; ai < 2; ++ai)
#pragma unroll
                for (int m = 0; m < 4; ++m) { bf16_t* rowp = (bf16_t*)(ws + WS_VB0) + (size_t)(row0 + ai * HALF + m * 16) * 256 + col0;
#pragma unroll
                    for (int bj = 0; bj < 2; ++bj)
#pragma unroll
                        for (int n = 0; n < 2; ++n) { const f32x4 v = acc[ai][bj][m][n]; u32x2 w; w.x = cvt_pk_bf16(v[0], v[1]); w.y = cvt_pk_bf16(v[2], v[3]); *(u32x2*)(rowp + bj * HALF + n * 16) = w; } }
        } else {
            bf16_t* UA = (bf16_t*)(ws + WS_R1 + R1_UA); const int col0 = u.pn * BM + wc * 32 + 4 * fq;
#pragma unroll
            for (int ai = 0; ai < 2; ++ai)
#pragma unroll
                for (int m = 0; m < 4; ++m) { const int row = row0 + ai * HALF + m * 16;
                    if (row >= 224) { const int chunk = (row - 224) >> 5, t = (row - 224) & 31;
#pragma unroll
                        for (int bj = 0; bj < 2; ++bj)
#pragma unroll
                            for (int n = 0; n < 2; ++n) { const int ch = col0 + bj * HALF + n * 16 - 1536, g = ch >> 4, cc = ch & 15; const f32x4 v = acc[ai][bj][m][n];
                                u32x2 w; w.x = cvt_pk_bf16(v[0], v[1]); w.y = cvt_pk_bf16(v[2], v[3]);
                                *(u32x2*)(UA + ((size_t)g * 768 + chunk) * 768 + t * 16 + cc) = w; } } }
        }
    }
};
}

#define LAS __attribute__((address_space(3)))
typedef unsigned short bf16;
typedef unsigned v4u __attribute__((ext_vector_type(4)));
typedef unsigned v2u __attribute__((ext_vector_type(2)));
typedef float f32x4 __attribute__((ext_vector_type(4)));
#define LDS_WAIT() asm volatile("s_waitcnt lgkmcnt(0)" ::: "memory")
__device__ __forceinline__ unsigned f2bf(float f) { unsigned u = __builtin_bit_cast(unsigned, f); return (u + 0x7fffu + ((u >> 16) & 1u)) >> 16; }
__device__ __forceinline__ unsigned pk2(float lo, float hi) { return f2bf(lo) | (f2bf(hi) << 16); }
typedef __bf16 bf16x2_t __attribute__((ext_vector_type(2)));
__device__ __forceinline__ unsigned pkbf(float lo, float hi) { bf16x2_t v = {(__bf16)lo, (__bf16)hi}; return __builtin_bit_cast(unsigned, v); }
__device__ __forceinline__ float wave_sum(float v) {
#pragma unroll
    for (int o = 1; o < 64; o <<= 1) v += __shfl_xor(v, o);
    return v;
}
__device__ __forceinline__ float wave_max(float v) {
#pragma unroll
    for (int o = 1; o < 64; o <<= 1) v = fmaxf(v, __shfl_xor(v, o));
    return v;
}
__device__ __forceinline__ float sigmoidf_(float x) { return 1.0f / (1.0f + expf(-x)); }

#define XB_TMO      128
#define XB_XCNT(j)  (256  + 64 * (j))
#define XB_XSUB(j)  (1280 + 64 * (j))
#define XB_XGEN(j)  (2304 + 64 * (j))
#define XB_TOP      3328
#define XB_TOPGEN   3392
#define XCD_BAR_WORDS 3456
#define XB_SPIN_CAP (1u << 22)
__device__ __forceinline__ unsigned xb_ld(unsigned* p)              { return __hip_atomic_load(p, __ATOMIC_RELAXED, __HIP_MEMORY_SCOPE_AGENT); }
__device__ __forceinline__ unsigned xb_add(unsigned* p, unsigned v) { return __hip_atomic_fetch_add(p, v, __ATOMIC_RELAXED, __HIP_MEMORY_SCOPE_AGENT); }
__device__ __forceinline__ unsigned xb_xcc_id() { return (unsigned)__builtin_amdgcn_s_getreg((3 << 11) | 20) & 0xFu; }
#define XB_SPIN(cond, bar) do { unsigned _sp = 0; while (cond) { __builtin_amdgcn_s_sleep(1); \
    if ((++_sp & 255u) == 0u) { if (xb_ld(&(bar)[XB_TMO])) break; if (_sp > XB_SPIN_CAP) { atomicAdd(&(bar)[XB_TMO], 1u); break; } } } } while (0)
struct XcdBarrier { unsigned* bar; unsigned x; volatile LAS unsigned* st; };
__device__ __forceinline__ XcdBarrier xcd_barrier_post(unsigned* bar, volatile LAS unsigned* st) {
    XcdBarrier b; b.bar = bar; b.x = xb_xcc_id(); b.st = st;
    if (threadIdx.x == 0) (void)xb_add(&bar[XB_XCNT(b.x)], 1u);
    return b;
}
__device__ __forceinline__ void xcd_barrier_complete(unsigned* bar, unsigned x, unsigned& nloc, unsigned& nx) {
    const unsigned G = gridDim.x * gridDim.y * gridDim.z;
    unsigned sum, cnt, mine, sp = 0u;
    for (;;) {
        sum = 0u; cnt = 0u; mine = 0u;
#pragma unroll
        for (unsigned j = 0; j < 16; ++j) { const unsigned c = xb_ld(&bar[XB_XCNT(j)]); sum += c; cnt += (c > 0u) ? 1u : 0u; mine = (j == x) ? c : mine; }
        if (sum == G) break;
        __builtin_amdgcn_s_sleep(1);
        if ((++sp & 255u) == 0u) { if (xb_ld(&bar[XB_TMO])) break; if (sp > XB_SPIN_CAP) { atomicAdd(&bar[XB_TMO], 1u); break; } }
    }
    nloc = mine > 0u ? mine : 1u; nx = cnt > 0u ? cnt : 1u;
}
__device__ __forceinline__ void xcd_barrier(const XcdBarrier& b) {
    asm volatile("s_waitcnt vmcnt(0)" ::: "memory");
    __syncthreads();
    if (threadIdx.x == 0) {
        unsigned* bar = b.bar;
        __builtin_amdgcn_s_waitcnt(0);
        unsigned nloc = b.st[0], nx = b.st[1];
        if (nloc == 0u) { xcd_barrier_complete(bar, b.x, nloc, nx); b.st[0] = nloc; b.st[1] = nx; }
        const unsigned old = xb_add(&bar[XB_XSUB(b.x)], 1u);
        const unsigned gen = old / nloc;
        if (old + 1u == (gen + 1u) * nloc) {
            __builtin_amdgcn_fence(__ATOMIC_RELEASE, "agent");
            asm volatile("s_waitcnt vmcnt(0)" ::: "memory");
            const unsigned og = xb_add(&bar[XB_TOP], 1u);
            const unsigned tg = og / nx;
            if (og + 1u == (tg + 1u) * nx) xb_add(&bar[XB_TOPGEN], 1u);
            else XB_SPIN(xb_ld(&bar[XB_TOPGEN]) == tg, bar);
            __builtin_amdgcn_fence(__ATOMIC_ACQUIRE, "agent");
            xb_add(&bar[XB_XGEN(b.x)], 1u);
            asm volatile("s_waitcnt vmcnt(0)" ::: "memory");
        } else {
            XB_SPIN(xb_ld(&bar[XB_XGEN(b.x)]) == gen, bar);
            __builtin_amdgcn_fence(__ATOMIC_ACQUIRE, "agent");
            asm volatile("s_waitcnt vmcnt(0)" ::: "memory");
        }
    }
    __syncthreads();
}

constexpr int RING_BYTES = 131072, LDS_BYTES = 155648, MISC_OFF = 153600;
struct Args { const float* in[29]; float* out; unsigned char* ws; int ph_lo, ph_hi; };
enum In { I_X = 0, I_META, I_WAB, I_WOAB, I_SINK, I_LRE, I_LIM, I_LSTEP, I_BRE, I_BIM, I_CRE, I_CIM, I_S5D, I_WGLU, I_BGLU, I_WC, I_WOC, I_LB, I_NORMG,
          I_LNMG, I_LNMB, I_LNFG, I_LNFB, I_WGRP, I_BGRP, I_WEXP, I_BEXP, I_WGU, I_WD };
struct Ctx { LAS unsigned char* lds; unsigned char* ldsg; int tid, lane, wave, bid, nblk, gw, ngw; };

__device__ __forceinline__ int rowmap_rope(int n) { if (n >= 1280) return n; const int d = n & 127; return (n & ~127) + 32 * ((d & 63) >> 4) + 16 * (d >> 6) + (d & 15); }
__device__ __forceinline__ int rowmap_gu(int n) { return n < 512 ? ((n >> 7) * 256 + (n & 127)) : (((n - 512) >> 7) * 256 + 128 + ((n - 512) & 127)); }
__device__ __forceinline__ void transpose_out(bf16* WT, int ldw, const LAS float* scr, int kb, int nb, int lane, int mode, unsigned char* WT8);
__device__ __forceinline__ void transpose_item(const float* W, int K, int N, bf16* WT, int ldw, LAS float* scr, int kb, int nb, int lane, int mode, unsigned char* WT8 = nullptr) {
    const int k0 = 128 * kb, n0 = 32 * nb;
    const float* wp = W + (size_t)(k0 + (lane >> 5)) * N + n0 + (lane & 31);
#pragma unroll
    for (int hh = 0; hh < 2; ++hh) { float v[32];
#pragma unroll
        for (int i = 0; i < 32; ++i) v[i] = __builtin_nontemporal_load(wp + (size_t)(64 * hh + 2 * i) * N);
#pragma unroll
        for (int i = 0; i < 32; ++i) scr[(64 * hh + 2 * i + (lane >> 5)) * 33 + (lane & 31)] = v[i]; }
    LDS_WAIT(); asm volatile("" ::: "memory");
    transpose_out(WT, ldw, scr, kb, nb, lane, mode, WT8);
}
__device__ __forceinline__ void transpose_out(bf16* WT, int ldw, const LAS float* scr, int kb, int nb, int lane, int mode, unsigned char* WT8) {
    const int k0 = 128 * kb, n0 = 32 * nb;
    if (mode & 12) {
        const int c8 = lane & 7; unsigned char* W8 = (mode & 8) ? WT8 : (unsigned char*)WT;
#pragma unroll
        for (int j = 0; j < 4; ++j) { const int n = (lane >> 3) + 8 * j; const LAS float* sp = scr + (16 * c8) * 33 + n; int w4[4];
#pragma unroll
            for (int q4 = 0; q4 < 4; ++q4) { int t = 0; t = __builtin_amdgcn_cvt_pk_fp8_f32(sp[(4 * q4) * 33] * 64.0f, sp[(4 * q4 + 1) * 33] * 64.0f, t, false);
                t = __builtin_amdgcn_cvt_pk_fp8_f32(sp[(4 * q4 + 2) * 33] * 64.0f, sp[(4 * q4 + 3) * 33] * 64.0f, t, true); w4[q4] = t; }
            const int nn = n0 + n; const int row = (mode & 3) == 1 ? rowmap_gu(nn) : nn;
            *(v4u*)(W8 + (size_t)row * ldw + k0 + 16 * c8) = (v4u){(unsigned)w4[0], (unsigned)w4[1], (unsigned)w4[2], (unsigned)w4[3]}; }
        if (mode & 4) { LDS_WAIT(); asm volatile("" ::: "memory"); return; }
    }
    const int c = lane & 15;
#pragma unroll
    for (int j = 0; j < 8; ++j) { const int n = (lane >> 4) + 4 * j; const LAS float* sp = scr + (8 * c) * 33 + n;
        v4u o; o.x = pkbf(sp[0 * 33], sp[1 * 33]); o.y = pkbf(sp[2 * 33], sp[3 * 33]); o.z = pkbf(sp[4 * 33], sp[5 * 33]); o.w = pkbf(sp[6 * 33], sp[7 * 33]);
        const int nn = n0 + n; const int row = (mode & 3) == 1 ? rowmap_gu(nn) : ((mode & 3) == 2 ? rowmap_rope(nn) : nn);
        *(v4u*)(WT + (size_t)row * ldw + k0 + 8 * c) = o; }
    LDS_WAIT(); asm volatile("" ::: "memory");
}
__device__ __forceinline__ void conv_family(const Ctx& c, const float* src, bf16* dst, int B, int K, int N, int mode, int ldw = 0, unsigned char* dst8 = nullptr, long lo = 0, long hi = -1) {
    if (ldw == 0) ldw = K;
    LAS float* scr = (LAS float*)(c.lds + c.wave * 17408);
    const int nkb = K / 128, nnb = N / 32; const long per = (long)nkb * nnb; if (hi < 0) hi = per * B;
    long it = lo + c.gw; if (it >= hi) return;
    const int lane = c.lane;
    float v[64];
#define CF_ISSUE(IT) do { const int b_ = (int)((IT) / per), r_ = (int)((IT) % per), kb_ = r_ / nnb, nb_ = r_ % nnb; \
        const float* wp_ = src + (size_t)b_ * K * N + (size_t)(128 * kb_ + (lane >> 5)) * N + 32 * nb_ + (lane & 31); \
        _Pragma("unroll") for (int i = 0; i < 64; ++i) v[i] = __builtin_nontemporal_load(wp_ + (size_t)(2 * i) * N); } while (0)
    CF_ISSUE(it);
    for (;;) {
#pragma unroll
        for (int i = 0; i < 64; ++i) scr[(2 * i + (lane >> 5)) * 33 + (lane & 31)] = v[i];
        LDS_WAIT(); asm volatile("" ::: "memory");
        const long nx = it + c.ngw; const bool more = nx < hi;
        if (more) CF_ISSUE(nx);
        const int b = (int)(it / per), r = (int)(it % per), kb = r / nnb, nb = r % nnb;
        bf16* d2 = (mode & 4) ? (bf16*)((unsigned char*)dst + (size_t)b * N * ldw) : dst + (size_t)b * N * ldw;
        transpose_out(d2, ldw, scr, kb, nb, lane, mode, dst8);
        if (!more) break;
        it = nx;
    }
#undef CF_ISSUE
}
constexpr int L1_GU = 64 * 16 * 32, L1_ALL = L1_GU + 64 * 4 * 64;
constexpr int FILL3 = 8192, FILL5 = FILL3 + 1280, FILL6 = FILL5 + 3328, FILL7 = FILL6 + 5120, FILL4 = FILL7 + 254 * 48;
constexpr int R11_LO = FILL4, R11_HI = R11_LO + 255 * 8, R13_LO = R11_HI, R13_HI = R13_LO + 128 * 40, R17_LO = R13_HI, R17_HI = R17_LO + 240 * 8, R21_LO = R17_HI, R21_HI = R21_LO + 255 * 8, FILLX = R21_HI;
static_assert(FILL4 < L1_GU && FILLX > L1_GU && FILLX < L1_ALL, "filler ranges");
__device__ __forceinline__ void conv_l1_item(const Ctx& c, const Args& a, int it) {
    LAS float* scr = (LAS float*)(c.lds + c.wave * 17408);
    if (it < L1_GU) { const int b = it >> 9, r = it & 511; transpose_item(a.in[I_WGU] + (size_t)(NEXP + b) * D * 1024, D, 1024, (bf16*)(a.ws + WS_WGU + (size_t)(NEXP + b) * 1024 * D), D, scr, r >> 5, r & 31, c.lane, 5); }
    else { const int i2 = it - L1_GU, b = i2 >> 8, r = i2 & 255; transpose_item(a.in[I_WD] + (size_t)(NEXP + b) * DEXP * D, DEXP, D, (bf16*)(a.ws + WS_WD + (size_t)(NEXP + b) * D * DEXP), DEXP, scr, r >> 6, r & 63, c.lane, 4); }
}
__device__ __forceinline__ void conv_fill(const Ctx& c, const Args& a, int lo, int hi, int rank, int nranks) {
    const int q = (hi - lo + nranks - 1) / nranks, b0 = lo + rank * q, b1 = (b0 + q) < hi ? (b0 + q) : hi;
    for (int it = b0 + c.wave; it < b1; it += NWAVES) conv_l1_item(c, a, it);
    __syncthreads();
}
__device__ __forceinline__ void phase_weights(const Ctx& c, const Args& a) {
    unsigned char* ws = a.ws;
    conv_family(c, a.in[I_WAB], (bf16*)(ws + WS_WAB), 1, D, ABN, 2);
    conv_family(c, a.in[I_WOAB], (bf16*)(ws + WS_WOAB), 1, D, D, 0);
    conv_family(c, a.in[I_WGLU], (bf16*)(ws + WS_WGLU), 1, 1024, 1024, 0);
    conv_family(c, a.in[I_WC], (bf16*)(ws + WS_WC), 1, D, CN, 8, 0, ws + WS_WC8);
    conv_family(c, a.in[I_WOC], (bf16*)(ws + WS_WOC), 1, D, D, 0);
    conv_family(c, a.in[I_WGU], (bf16*)(ws + WS_WGU), NEXP, D, 1024, 5);
    conv_family(c, a.in[I_WD], (bf16*)(ws + WS_WD), NEXP, DEXP, D, 4);
    if (c.nblk != 256) conv_family(c, a.in[I_WGU] + (size_t)NEXP * D * 1024, (bf16*)(ws + WS_WGU + (size_t)NEXP * 1024 * D), NEXP, D, 1024, 5);
    conv_family(c, a.in[I_WD] + (size_t)NEXP * DEXP * D, (bf16*)(ws + WS_WD + (size_t)NEXP * D * DEXP), NEXP, DEXP, D, 4, 0, nullptr, c.nblk == 256 ? FILLX - L1_GU : 0);
}
__device__ __forceinline__ void phase_init(const Ctx& c, const Args& a) {
    bf16* HB = (bf16*)(a.ws + WS_HBF);
    for (int row = c.gw; row < LP; row += c.ngw) {
        const float* src = row < ROWV ? nullptr : (row < 256 ? a.in[I_META] + (size_t)(row - ROWV) * D : a.in[I_X] + (size_t)(row - 256) * D);
#pragma unroll
        for (int j = 0; j < 8; ++j) { const int idx = (j * 64 + c.lane) * 4; f32x4 v = src ? *(const f32x4*)(src + idx) : (f32x4){0.f, 0.f, 0.f, 0.f};
            v2u w; w.x = pkbf(v.x, v.y); w.y = pkbf(v.z, v.w); *(v2u*)(HB + (size_t)row * D + idx) = w; }
    }
    float2* rope = (float2*)(a.ws + WS_ROPE);
    for (long i = (long)c.bid * NTHR + c.tid; i < (long)LP * 64; i += (long)c.nblk * NTHR) {
        const int row = (int)(i >> 6), k = (int)(i & 63);
        const float inv = powf(10000.0f, -(float)k * 2.0f / 128.0f);
        const float ang = (float)(row - ROWV) * inv;
        float s, co; sincosf(ang, &s, &co); rope[i] = make_float2(co, s);
    }
    { float* wrt = (float*)(a.ws + WS_WRT);
      for (int i = c.bid * NTHR + c.tid; i < 2 * 96 * 2048; i += c.nblk * NTHR) { const int k = i & 2047, j = (i >> 11) % 96, layer = i / (96 * 2048);
          const float wv = j < 8 ? a.in[I_WGRP][((size_t)layer * D + k) * 8 + j] : (j < 72 ? a.in[I_WEXP][((size_t)layer * D + k) * 64 + (j - 8)] : 0.f); wrt[i] = wv;
          const unsigned hb = f2bf(wv); const float hf = __uint_as_float(hb << 16); ((bf16*)(a.ws + WS_WRH))[i] = (bf16)hb; ((bf16*)(a.ws + WS_WRL))[i] = (bf16)f2bf(wv - hf); } }
    { float* lbt = (float*)(a.ws + WS_LBT);
      for (int i = c.bid * NTHR + c.tid; i < D; i += c.nblk * NTHR) lbt[i] = 1.0f / (1.0f + expf(a.in[I_LB][i] - a.in[I_LB][D + i])); }
    float2* abar = (float2*)(a.ws + WS_S5P); float2* bbar = abar + 2 * 64 * 64;
    for (int i = c.bid * NTHR + c.tid; i < 2 * 64 * 64; i += c.nblk * NTHR) {
        const int dg = i >> 6;
        const double lr = fmin((double)a.in[I_LRE][i], -1e-4), li = (double)a.in[I_LIM][i], st = exp((double)a.in[I_LSTEP][dg]);
        const double er = exp(lr * st), ar = er * cos(li * st), ai = er * sin(li * st);
        const double den = lr * lr + li * li, cr = ((ar - 1.0) * lr + ai * li) / den, ci = (ai * lr - (ar - 1.0) * li) / den;
        abar[i] = make_float2((float)ar, (float)ai);
        for (int cc = 0; cc < 16; ++cc) { const double br = a.in[I_BRE][(size_t)i * 16 + cc], bi = a.in[I_BIM][(size_t)i * 16 + cc];
            bbar[(size_t)i * 16 + cc] = make_float2((float)(cr * br - ci * bi), (float)(cr * bi + ci * br)); }
    }
    for (int j = c.bid * NTHR + c.tid; j < 2 * 64 * 64 * 33; j += c.nblk * NTHR) { const int i = j / 33, tau = j % 33, dg = i >> 6;
        const double lr = fmin((double)a.in[I_LRE][i], -1e-4), li = (double)a.in[I_LIM][i], st = exp((double)a.in[I_LSTEP][dg]);
        const double m = exp(lr * st * tau); ((float2*)(a.ws + WS_APOW))[j] = make_float2((float)(m * cos(li * st * tau)), (float)(m * sin(li * st * tau))); }
}
typedef short bf16x8 __attribute__((ext_vector_type(8)));
constexpr int HG_VT = 0, HG_QT = 18432, HG_KT = 35840, HG_KH = 53248, HG_DV = 71680, HB_SZ = 72704, HG_SCR = 2 * HB_SZ;
constexpr int LD_K = 272, LD_T = 144;
__device__ __forceinline__ bf16x8 ldfrag(LAS unsigned char* base, int row, int pitch, int kbyte) { return *(const LAS bf16x8*)(base + row * pitch + kbyte); }
#define MFMA16(a, b, c) __builtin_amdgcn_mfma_f32_16x16x32_bf16((a), (b), (c), 0, 0, 0)
constexpr int AT_K = 0, AT_VT = 17408;
__device__ __forceinline__ void phase_attn(const Ctx& c, const Args& a) {
    const bf16* QB = (const bf16*)(a.ws + WS_QB0); const bf16* KB = (const bf16*)(a.ws + WS_KB0); const bf16* VB = (const bf16*)(a.ws + WS_VB0); bf16* MI = (bf16*)(a.ws + WS_MIXIN);
    LAS unsigned char* L = c.lds;
    const int w = c.wave, hr = w >> 1, qh = w & 1;
    const float C2 = 0.08838834764831845f * 1.4426950408889634f;
    for (int u = c.bid; u < 514; u += c.nblk) {
        int tv = c.tid; asm volatile("" : "+v"(tv));
        const int r = tv & 15, gq = (tv >> 4) & 3;
        const int skey = tv >> 3, sc16 = tv & 7;
        const int sd = tv & 127, skq = tv >> 7;
        const int g = u & 1, qb = u >> 1, r0 = 192 + 64 * qb, h = 4 * g + hr, rq0 = r0 + 32 * qh;
        const int klo = (r0 / 64 - 2) < 4 ? 4 : (r0 / 64 - 2), khi = (r0 / 64 + 2) > 259 ? 259 : (r0 / 64 + 2), ntile = 1 + (khi - klo + 1);
        bf16x8 qf[2][4];
#pragma unroll
        for (int qt = 0; qt < 2; ++qt)
#pragma unroll
            for (int ks = 0; ks < 4; ++ks) qf[qt][ks] = *(const bf16x8*)(QB + (size_t)(rq0 + 16 * qt + r) * 1024 + h * 128 + 32 * ks + 8 * gq);
        const float sink2 = a.in[I_SINK][h] * 1.4426950408889634f;
        float mrun[2] = {sink2, sink2}, lsum[2] = {gq == 0 ? 1.f : 0.f, gq == 0 ? 1.f : 0.f};
        f32x4 O[2][8];
#pragma unroll
        for (int qt = 0; qt < 2; ++qt)
#pragma unroll
            for (int dt = 0; dt < 8; ++dt) O[qt][dt] = (f32x4){0.f, 0.f, 0.f, 0.f};
        v4u kraw[2]; unsigned short vraw[16];
#define AT_LOAD(kt_) do { const bf16* kp = KB + (size_t)(64 * (kt_) + skey) * 256 + g * 128 + 16 * sc16; kraw[0] = *(const v4u*)kp; kraw[1] = *(const v4u*)(kp + 8); \
            const bf16* vp = VB + (size_t)(64 * (kt_) + 16 * skq) * 256 + g * 128 + sd; _Pragma("unroll") for (int i = 0; i < 16; ++i) vraw[i] = vp[(size_t)i * 256]; } while (0)
        AT_LOAD(3);
        for (int ti = 0; ti < ntile; ++ti) {
            const int kt = ti == 0 ? 3 : klo + ti - 1;
            { *(LAS v4u*)(L + AT_K + skey * LD_K + 32 * sc16) = kraw[0]; *(LAS v4u*)(L + AT_K + skey * LD_K + 32 * sc16 + 16) = kraw[1];
              v4u v0, v1; v0.x = vraw[0] | ((unsigned)vraw[1] << 16); v0.y = vraw[2] | ((unsigned)vraw[3] << 16); v0.z = vraw[4] | ((unsigned)vraw[5] << 16); v0.w = vraw[6] | ((unsigned)vraw[7] << 16);
              v1.x = vraw[8] | ((unsigned)vraw[9] << 16); v1.y = vraw[10] | ((unsigned)vraw[11] << 16); v1.z = vraw[12] | ((unsigned)vraw[13] << 16); v1.w = vraw[14] | ((unsigned)vraw[15] << 16);
              *(LAS v4u*)(L + AT_VT + sd * LD_T + 32 * skq) = v0; *(LAS v4u*)(L + AT_VT + sd * LD_T + 32 * skq + 16) = v1; }
            if (ti + 1 < ntile) AT_LOAD(klo + ti);
            __syncthreads();
            bf16x8 pf[2][2];
#pragma unroll
            for (int qt = 0; qt < 2; ++qt) {
                f32x4 sc[4];
#pragma unroll
                for (int ki = 0; ki < 4; ++ki) sc[ki] = (f32x4){0.f, 0.f, 0.f, 0.f};
#pragma unroll
                for (int ks = 0; ks < 4; ++ks)
#pragma unroll
                    for (int ki = 0; ki < 4; ++ki) { const bf16x8 kf = ldfrag(L + AT_K, 16 * ki + r, LD_K, (32 * ks + 8 * gq) * 2); sc[ki] = MFMA16(kf, qf[qt][ks], sc[ki]); }
                const int rq = rq0 + 16 * qt + r; float tmax = -3.0e38f;
#pragma unroll
                for (int ki = 0; ki < 4; ++ki)
#pragma unroll
                    for (int e = 0; e < 4; ++e) { const int rk = 64 * kt + 16 * ki + 4 * gq + e; const int dd = rq - rk;
                        const bool ok = ti == 0 ? (rk >= ROWV) : (rk >= 256 && dd <= 128 && dd >= -128);
                        const float v = ok ? sc[ki][e] * C2 : -3.0e38f; sc[ki][e] = v; tmax = fmaxf(tmax, v); }
                tmax = fmaxf(tmax, __shfl_xor(tmax, 16)); tmax = fmaxf(tmax, __shfl_xor(tmax, 32));
                const float mn = fmaxf(mrun[qt], tmax), alpha = exp2f(mrun[qt] - mn); mrun[qt] = mn;
                float ps = 0.f;
#pragma unroll
                for (int ki = 0; ki < 4; ++ki)
#pragma unroll
                    for (int e = 0; e < 4; ++e) { const float pv = exp2f(sc[ki][e] - mn); sc[ki][e] = pv; ps += pv; }
                lsum[qt] = lsum[qt] * alpha + ps;
#pragma unroll
                for (int dt = 0; dt < 8; ++dt) O[qt][dt] = O[qt][dt] * alpha;
#pragma unroll
                for (int kk = 0; kk < 2; ++kk) { v4u t; t.x = pkbf(sc[2 * kk][0], sc[2 * kk][1]); t.y = pkbf(sc[2 * kk][2], sc[2 * kk][3]);
                    t.z = pkbf(sc[2 * kk + 1][0], sc[2 * kk + 1][1]); t.w = pkbf(sc[2 * kk + 1][2], sc[2 * kk + 1][3]); pf[qt][kk] = __builtin_bit_cast(bf16x8, t); }
            }
#pragma unroll
            for (int dt = 0; dt < 8; ++dt)
#pragma unroll
                for (int kk = 0; kk < 2; ++kk) { const LAS unsigned char* vp = L + AT_VT + (16 * dt + r) * LD_T + (32 * kk + 4 * gq) * 2;
                    const v2u lo = *(const LAS v2u*)vp, hi = *(const LAS v2u*)(vp + 32); const v4u t = (v4u){lo.x, lo.y, hi.x, hi.y}; const bf16x8 vf = __builtin_bit_cast(bf16x8, t);
                    O[0][dt] = MFMA16(vf, pf[0][kk], O[0][dt]); O[1][dt] = MFMA16(vf, pf[1][kk], O[1][dt]); }
            __syncthreads();
        }
#undef AT_LOAD
#pragma unroll
        for (int qt = 0; qt < 2; ++qt) { float l = lsum[qt]; l += __shfl_xor(l, 16); l += __shfl_xor(l, 32); const float inv = 1.0f / l; const int rq = rq0 + 16 * qt + r;
            if (rq >= ROWV) {
#pragma unroll
                for (int dt = 0; dt < 8; ++dt) { v2u o; o.x = pkbf(O[qt][dt][0] * inv, O[qt][dt][1] * inv); o.y = pkbf(O[qt][dt][2] * inv, O[qt][dt][3] * inv);
                    *(v2u*)(MI + (size_t)rq * D + h * 128 + 16 * dt + 4 * gq) = o; } } }
    }
    for (int i = c.bid * NTHR + c.tid; i < ROWV * D / 8; i += c.nblk * NTHR) ((v4u*)MI)[i] = (v4u){0u, 0u, 0u, 0u};
}
__device__ __forceinline__ void phase_s5_ktab(const Ctx& c, const Args& a) {
    const float2* abar = (const float2*)(a.ws + WS_S5P); const float2* bbar = abar + 2 * 64 * 64; const float2* apow = (const float2*)(a.ws + WS_APOW);
    float* KT = (float*)(a.ws + WS_KTAB);
    LAS float* Lb = (LAS float*)c.lds;
    LAS float* La = Lb + 2048;
    LAS float* Lc = La + 2048;
    for (int u = c.bid; u < 256; u += c.nblk) {
        const int dg = u >> 1, th = u & 1;
        __syncthreads();
        for (int i = c.tid; i < 1024; i += NTHR) { const float2 v = bbar[(size_t)dg * 1024 + i]; Lb[2 * i] = v.x; Lb[2 * i + 1] = v.y; }
        for (int i = c.tid; i < 1024; i += NTHR) { const int p = i >> 4, tl = i & 15; const float2 v = apow[((size_t)dg * 64 + p) * 33 + 16 * th + tl]; La[2 * i] = v.x; La[2 * i + 1] = v.y; }
        for (int i = c.tid; i < 1024; i += NTHR) { Lc[i] = a.in[I_CRE][(size_t)dg * 1024 + i]; Lc[1024 + i] = a.in[I_CIM][(size_t)dg * 1024 + i]; }
        __syncthreads();
        const int tl = c.tid >> 5, c1 = (c.tid & 31) >> 1, c20 = (c.tid & 1) * 8;
        float sum[8];
#pragma unroll
        for (int j = 0; j < 8; ++j) sum[j] = 0.f;
        for (int p = 0; p < 64; ++p) { const float apx = La[(p * 16 + tl) * 2], apy = La[(p * 16 + tl) * 2 + 1], cr = Lc[c1 * 64 + p], ci = Lc[1024 + c1 * 64 + p];
            const float wr_ = cr * apx - ci * apy, wi_ = cr * apy + ci * apx;
#pragma unroll
            for (int j = 0; j < 8; ++j) sum[j] += wr_ * Lb[(p * 16 + c20 + j) * 2] - wi_ * Lb[(p * 16 + c20 + j) * 2 + 1]; }
        float* dst = KT + ((((size_t)dg * 32 + 16 * th + tl) * 16 + c1) * 16 + c20);
        *(f32x4*)dst = (f32x4){sum[0], sum[1], sum[2], sum[3]}; *(f32x4*)(dst + 4) = (f32x4){sum[4], sum[5], sum[6], sum[7]};
    }
    __syncthreads();
}
__device__ __forceinline__ void phase_s5_fill(const Ctx& c, const Args& a) {
    const float2* abar = (const float2*)(a.ws + WS_S5P); const float2* bbar = abar + 2 * 64 * 64; const float2* apow = (const float2*)(a.ws + WS_APOW);
    const float* KT = (const float*)(a.ws + WS_KTAB); bf16* MWT = (bf16*)(a.ws + WS_MWT); bf16* WST = (bf16*)(a.ws + WS_WST);
    for (long it = (long)c.bid * NTHR + c.tid; it < (long)64 * 512 * 96; it += (long)c.nblk * NTHR) {
        const int kb = (int)(it % 96), n = (int)((it / 96) % 512), g = (int)(it / (96 * 512)), t = n >> 4, c1 = n & 15;
        float v[8];
        if (kb < 64) { const int s2 = kb >> 1, c2 = (kb & 1) * 8;
            if (s2 < t) { const float* k0 = KT + ((((size_t)(0 * 64 + g)) * 32 + (t - s2)) * 16 + c1) * 16 + c2;
#pragma unroll
                for (int i = 0; i < 8; ++i) v[i] = k0[i]; }
            else if (s2 > t) { const float* k0 = KT + ((((size_t)(1 * 64 + g)) * 32 + (s2 - t)) * 16 + c1) * 16 + c2;
#pragma unroll
                for (int i = 0; i < 8; ++i) v[i] = k0[i]; }
            else { const float* k0 = KT + ((((size_t)(0 * 64 + g)) * 32) * 16 + c1) * 16 + c2; const float* k1 = KT + ((((size_t)(1 * 64 + g)) * 32) * 16 + c1) * 16 + c2;
#pragma unroll
                for (int i = 0; i < 8; ++i) v[i] = k0[i] + k1[i] + ((c2 + i) == c1 ? a.in[I_S5D][16 * g + c1] : 0.f); }
        } else { const int j0 = (kb - 64) * 8, qd = j0 >> 6, dir = qd >> 1, p0 = j0 & 63, tau = dir == 0 ? t + 1 : 32 - t;
            const float* cr = a.in[I_CRE] + ((size_t)(dir * 64 + g) * 16 + c1) * 64; const float* ci = a.in[I_CIM] + ((size_t)(dir * 64 + g) * 16 + c1) * 64;
#pragma unroll
            for (int i = 0; i < 8; ++i) { const int p = p0 + i; const float2 ap = apow[((size_t)(dir * 64 + g) * 64 + p) * 33 + tau];
                v[i] = (qd & 1) == 0 ? (cr[p] * ap.x - ci[p] * ap.y) : -(cr[p] * ap.y + ci[p] * ap.x); }
        }
        v4u o; o.x = pk2(v[0], v[1]); o.y = pk2(v[2], v[3]); o.z = pk2(v[4], v[5]); o.w = pk2(v[6], v[7]);
        *(v4u*)(MWT + ((size_t)g * 512 + n) * 768 + kb * 8) = o;
    }
    for (long it = (long)c.bid * NTHR + c.tid; it < (long)64 * 256 * 64; it += (long)c.nblk * NTHR) {
        const int kb = (int)(it & 63), n = (int)((it >> 6) & 255), g = (int)(it >> 14), s2 = kb >> 1, c2 = (kb & 1) * 8, qd = n >> 6, dir = qd >> 1, p = n & 63;
        const int tau = dir == 0 ? 31 - s2 : s2; const size_t i = (size_t)(dir * 64 + g) * 64 + p; const float2 ap = apow[i * 33 + tau];
        float v[8];
#pragma unroll
        for (int e = 0; e < 8; ++e) { const float2 bb = bbar[i * 16 + c2 + e]; v[e] = (qd & 1) == 0 ? (ap.x * bb.x - ap.y * bb.y) : (ap.x * bb.y + ap.y * bb.x); }
        v4u o; o.x = pk2(v[0], v[1]); o.y = pk2(v[2], v[3]); o.z = pk2(v[4], v[5]); o.w = pk2(v[6], v[7]);
        *(v4u*)(WST + ((size_t)g * 256 + n) * 512 + kb * 8) = o;
    }
    bf16* ZB = (bf16*)(a.ws + WS_ZB);
    for (int i = c.bid * NTHR + c.tid; i < 224 * 1024 / 8; i += c.nblk * NTHR) ((v4u*)ZB)[i] = (v4u){0u, 0u, 0u, 0u};
}
__device__ __forceinline__ void phase_s5_chunkscan(const Ctx& c, const Args& a) {
    if (c.bid >= 128) return;
    const int g = c.bid & 63, dir = c.bid >> 6, p = c.lane, w = c.wave;
    const float2 a32 = ((const float2*)(a.ws + WS_APOW))[((size_t)(dir * 64 + g) * 64 + p) * 33 + 32];
    const float* S = (const float*)(a.ws + WS_R1 + R1_SALL) + (size_t)g * 768 * 256 + dir * 128 + p;
    bf16* UA = (bf16*)(a.ws + WS_R1 + R1_UA) + (size_t)g * 768 * 768 + 512 + dir * 128 + p;
    LAS float* E = (LAS float*)c.lds; LAS float* PW = E + 2 * 8 * 64;
    const int j0 = 65 * w, j1 = (j0 + 65) < 513 ? (j0 + 65) : 513, len = j1 - j0;
    float xr = 0.f, xi = 0.f, pr = 1.f, pi = 0.f;
    for (int b = 0; b < 5; ++b) { float sr[13], si[13];
#pragma unroll
        for (int i = 0; i < 13; ++i) { const int o = b * 13 + i; const int j = dir == 0 ? j0 + o : j1 - 1 - o; const bool ok = o < len; sr[i] = ok ? S[(size_t)j * 256] : 0.f; si[i] = ok ? S[(size_t)j * 256 + 64] : 0.f; }
#pragma unroll
        for (int i = 0; i < 13; ++i) { if (b * 13 + i < len) { const float nr = a32.x * xr - a32.y * xi + sr[i], ni = a32.x * xi + a32.y * xr + si[i]; xr = nr; xi = ni;
                const float qr = a32.x * pr - a32.y * pi, qi = a32.x * pi + a32.y * pr; pr = qr; pi = qi; } }
    }
    E[w * 128 + p] = xr; E[w * 128 + 64 + p] = xi; PW[w * 128 + p] = pr; PW[w * 128 + 64 + p] = pi;
    __syncthreads();
    float cr = 0.f, ci = 0.f;
    if (dir == 0) { for (int w2 = 0; w2 < w; ++w2) { const float2 e = make_float2(E[w2 * 128 + p], E[w2 * 128 + 64 + p]), q = make_float2(PW[w2 * 128 + p], PW[w2 * 128 + 64 + p]); const float nr = q.x * cr - q.y * ci + e.x, ni = q.x * ci + q.y * cr + e.y; cr = nr; ci = ni; } }
    else { for (int w2 = 7; w2 > w; --w2) { const float2 e = make_float2(E[w2 * 128 + p], E[w2 * 128 + 64 + p]), q = make_float2(PW[w2 * 128 + p], PW[w2 * 128 + 64 + p]); const float nr = q.x * cr - q.y * ci + e.x, ni = q.x * ci + q.y * cr + e.y; cr = nr; ci = ni; } }
    xr = cr; xi = ci;
    for (int b = 0; b < 5; ++b) { float sr[13], si[13];
#pragma unroll
        for (int i = 0; i < 13; ++i) { const int o = b * 13 + i; const int j = dir == 0 ? j0 + o : j1 - 1 - o; const bool ok = o < len; sr[i] = ok ? S[(size_t)j * 256] : 0.f; si[i] = ok ? S[(size_t)j * 256 + 64] : 0.f; }
#pragma unroll
        for (int i = 0; i < 13; ++i) { const int o = b * 13 + i; if (o < len) { const int j = dir == 0 ? j0 + o : j1 - 1 - o;
                UA[(size_t)j * 768] = (bf16)f2bf(xr); UA[(size_t)j * 768 + 64] = (bf16)f2bf(xi);
                const float nr = a32.x * xr - a32.y * xi + sr[i], ni = a32.x * xi + a32.y * xr + si[i]; xr = nr; xi = ni; } }
    }
}
template <class F> __device__ __forceinline__ void skinny_gemm(const Ctx& c, const bf16* A, int lda, const bf16* Wt, int K, int N, const F& f) {
    int tv = c.tid; asm volatile("" : "+v"(tv));
    const int r = tv & 15, q = (tv >> 4) & 3;
    for (int tile = c.gw; tile < N / 16; tile += c.ngw) {
        f32x4 acc = (f32x4){0.f, 0.f, 0.f, 0.f};
        const bf16* ap = A + (size_t)(ROWV + r) * lda + 8 * q; const bf16* bp = Wt + (size_t)(16 * tile + r) * K + 8 * q;
        for (int ks = 0; ks < K / 32; ks += 8) { bf16x8 af[8], bfr[8];
#pragma unroll
            for (int i = 0; i < 8; ++i) { af[i] = *(const bf16x8*)(ap + (ks + i) * 32); bfr[i] = *(const bf16x8*)(bp + (ks + i) * 32); }
#pragma unroll
            for (int i = 0; i < 8; ++i) acc = MFMA16(af[i], bfr[i], acc); }
#pragma unroll
        for (int e = 0; e < 4; ++e) f(ROWV + 4 * q + e, 16 * tile + r, acc[e]);
    }
}
template <class F> __device__ __forceinline__ void skinny_gemm2(const Ctx& c, const bf16* A, int lda, const bf16* Wt, int K, int N, const F& f) {
    int tv = c.tid; asm volatile("" : "+v"(tv));
    const int r = tv & 15, q = (tv >> 4) & 3;
    for (int pt = c.gw; pt < N / 32; pt += c.ngw) {
        f32x4 acc0 = (f32x4){0.f, 0.f, 0.f, 0.f}, acc1 = (f32x4){0.f, 0.f, 0.f, 0.f};
        const bf16* ap = A + (size_t)(ROWV + r) * lda + 8 * q; const bf16* bp = Wt + (size_t)(32 * pt + r) * K + 8 * q;
        for (int ks = 0; ks < K / 32; ks += 4) { bf16x8 af[4], b0[4], b1[4];
#pragma unroll
            for (int i = 0; i < 4; ++i) { af[i] = *(const bf16x8*)(ap + (ks + i) * 32); b0[i] = *(const bf16x8*)(bp + (ks + i) * 32); b1[i] = *(const bf16x8*)(bp + (size_t)16 * K + (ks + i) * 32); }
#pragma unroll
            for (int i = 0; i < 4; ++i) { acc0 = MFMA16(af[i], b0[i], acc0); acc1 = MFMA16(af[i], b1[i], acc1); } }
#pragma unroll
        for (int e = 0; e < 4; ++e) f(ROWV + 4 * q + e, 32 * pt + r, acc0[e], acc1[e]);
    }
}
struct SkAB2 { unsigned char* ws; __device__ __forceinline__ void operator()(int row, int n0, float v0, float v1) const {
    if (n0 < 1280) { const int hb = n0 >> 7, d = 16 * ((n0 & 127) >> 5) + (n0 & 15); const float2 cs = ((const float2*)(ws + WS_ROPE))[(size_t)row * 64 + d];
        const float o1 = v0 * cs.x - v1 * cs.y, o2 = v1 * cs.x + v0 * cs.y;
        bf16* dst = hb < 8 ? (bf16*)(ws + WS_QB0) + (size_t)row * 1024 + hb * 128 + d : (bf16*)(ws + WS_KB0) + (size_t)row * 256 + (hb - 8) * 128 + d;
        dst[0] = (bf16)f2bf(o1); dst[64] = (bf16)f2bf(o2); }
    else if (n0 < 1536) { bf16* dst = (bf16*)(ws + WS_VB0) + (size_t)row * 256 + n0 - 1280; dst[0] = (bf16)f2bf(v0); dst[16] = (bf16)f2bf(v1); }
    else { bf16* UA = (bf16*)(ws + WS_R1 + R1_UA); const int ch = n0 - 1536, ch1 = ch + 16;
        UA[((size_t)(ch >> 4) * 768) * 768 + (16 + row - ROWV) * 16 + (ch & 15)] = (bf16)f2bf(v0); UA[((size_t)(ch1 >> 4) * 768) * 768 + (16 + row - ROWV) * 16 + (ch1 & 15)] = (bf16)f2bf(v1); } } };
struct SkAB { float* C; bf16* UA; __device__ __forceinline__ void operator()(int row, int n, float v) const {
    if (n < 1536) C[(size_t)row * ABN + n] = v; else { const int ch = n - 1536; UA[((size_t)(ch >> 4) * 768) * 768 + (16 + row - ROWV) * 16 + (ch & 15)] = (bf16)f2bf(v); } } };
struct SkGlu { const bf16* ZB; const float* bias; bf16* O; __device__ __forceinline__ void operator()(int row, int n, float v) const {
    const float z = __uint_as_float((unsigned)ZB[(size_t)row * 1024 + n] << 16); O[(size_t)row * D + 1024 + n] = (bf16)f2bf(z / (1.0f + __expf(-(v + bias[n])))); } };
struct SkBf16 { bf16* O; int ldc; __device__ __forceinline__ void operator()(int row, int n, float v) const { O[(size_t)row * ldc + n] = (bf16)f2bf(v); } };
struct SkC { bf16* QB; bf16* VB; bf16* GB; bf16* F; const float* lbt; __device__ __forceinline__ void operator()(int row, int n, float v) const {
    if (n < 2048) QB[(size_t)row * D + n] = (bf16)f2bf(v);
    else if (n < 4096) VB[(size_t)row * D + n - 2048] = (bf16)f2bf(v);
    else if (n < 8192) { const float lb = lbt[n & 2047]; F[(size_t)row * 4096 + n - 4096] = (bf16)f2bf((1.0f - lb) / (1.0f + __expf(v))); }
    else GB[(size_t)row * D + n - 8192] = (bf16)f2bf(1.0f / (1.0f + __expf(-v))); } };
__device__ __forceinline__ void zero_rows_bf16(const Ctx& c, bf16* B, int ld, int r0, int r1) {
    const int per = ld / 8;
    for (int i = c.bid * NTHR + c.tid; i < (r1 - r0) * per; i += c.nblk * NTHR) *(v4u*)(B + (size_t)(r0 + i / per) * ld + (i % per) * 8) = (v4u){0u, 0u, 0u, 0u};
}
__device__ __forceinline__ void zero_rows_f32(const Ctx& c, float* B, int ld, int r0, int r1, int ncols) {
    const int per = ncols / 4;
    for (int i = c.bid * NTHR + c.tid; i < (r1 - r0) * per; i += c.nblk * NTHR) *(f32x4*)(B + (size_t)(r0 + i / per) * ld + (i % per) * 4) = (f32x4){0.f, 0.f, 0.f, 0.f};
}
#ifdef PROBE_MASK
#ifndef PROBE_BARMASK
#define PROBE_BARMASK 0ull
#endif
#define PROBE_SCALE g_probe_scale
#define PROBE_DECL , float g_probe_scale
#define PROBE_PASS , g_probe_scale
#define PROBE_ONE , 1.0f
#else
#define PROBE_SCALE 1.0f
#define PROBE_DECL
#define PROBE_PASS
#define PROBE_ONE
#endif
typedef int v4i_ __attribute__((ext_vector_type(4)));
__device__ __forceinline__ f32x4 bf4(v2u w) { return (f32x4){__uint_as_float(w.x << 16), __uint_as_float(w.x & 0xffff0000u), __uint_as_float(w.y << 16), __uint_as_float(w.y & 0xffff0000u)}; }
struct LnSrc { const bf16* h; const bf16* add; const bf16* y0; const bf16* y1; float w0, w1; };
struct LnDst { bf16* hb; unsigned char* h8; float* dout; };
template <bool FFN> __device__ __forceinline__ void ln_pair(const LnSrc& A, const LnSrc& B, const float* gam, const float* bet, const LnDst& oA, const LnDst& oB, bool hasB, int lane PROBE_DECL) {
    f32x4 va[8], vb[8]; float sa = 0.f, sb = 0.f;
#pragma unroll
    for (int j = 0; j < 8; ++j) { const int idx = (j * 64 + lane) * 4;
        f32x4 xa = bf4(*(const v2u*)(A.h + idx)) * DN_ALPHA, xb = bf4(*(const v2u*)(B.h + idx)) * DN_ALPHA;
        if (FFN) { xa += bf4(*(const v2u*)(A.y0 + idx)) * A.w0 + bf4(*(const v2u*)(A.y1 + idx)) * A.w1; xb += bf4(*(const v2u*)(B.y0 + idx)) * B.w0 + bf4(*(const v2u*)(B.y1 + idx)) * B.w1; }
        else { xa += bf4(*(const v2u*)(A.add + idx)); xb += bf4(*(const v2u*)(B.add + idx)); }
        va[j] = xa; vb[j] = xb; sa += (xa.x + xa.y) + (xa.z + xa.w); sb += (xb.x + xb.y) + (xb.z + xb.w); }
    const float ma = wave_sum(sa) * (1.0f / D), mb = wave_sum(sb) * (1.0f / D); float qa = 0.f, qb = 0.f;
#pragma unroll
    for (int j = 0; j < 8; ++j) { va[j] = va[j] - ma; vb[j] = vb[j] - mb; qa += (va[j].x * va[j].x + va[j].y * va[j].y) + (va[j].z * va[j].z + va[j].w * va[j].w); qb += (vb[j].x * vb[j].x + vb[j].y * vb[j].y) + (vb[j].z * vb[j].z + vb[j].w * vb[j].w); }
    const float ra = 1.0f / sqrtf(wave_sum(qa) * (1.0f / D) + LN_EPS), rb = 1.0f / sqrtf(wave_sum(qb) * (1.0f / D) + LN_EPS);
#pragma unroll
    for (int j = 0; j < 8; ++j) { const int idx = (j * 64 + lane) * 4; const f32x4 g = *(const f32x4*)(gam + idx), b = *(const f32x4*)(bet + idx);
        const f32x4 o = va[j] * ra * g + b, p = vb[j] * rb * g + b;
        if (oA.hb) { v2u w; w.x = pk2(o.x, o.y); w.y = pk2(o.z, o.w); *(v2u*)(oA.hb + idx) = w; int t = 0; t = __builtin_amdgcn_cvt_pk_fp8_f32(o.x, o.y, t, false); t = __builtin_amdgcn_cvt_pk_fp8_f32(o.z, o.w, t, true); *(int*)(oA.h8 + idx) = t; }
        if (oA.dout) *(f32x4*)(oA.dout + idx) = o * PROBE_SCALE;
        if (hasB) {
            if (oB.hb) { v2u w; w.x = pk2(p.x, p.y); w.y = pk2(p.z, p.w); *(v2u*)(oB.hb + idx) = w; int t = 0; t = __builtin_amdgcn_cvt_pk_fp8_f32(p.x, p.y, t, false); t = __builtin_amdgcn_cvt_pk_fp8_f32(p.z, p.w, t, true); *(int*)(oB.h8 + idx) = t; }
            if (oB.dout) *(f32x4*)(oB.dout + idx) = p * PROBE_SCALE; } }
}
__device__ __forceinline__ void ln_zero_pad(const Ctx& c, bf16* HB, unsigned char* H8) {
    for (int row = c.gw; row < ROWV; row += c.ngw) {
#pragma unroll
        for (int j = 0; j < 8; ++j) { const int idx = (j * 64 + c.lane) * 4; *(v2u*)(HB + (size_t)row * D + idx) = (v2u){0u, 0u}; *(int*)(H8 + (size_t)row * D + idx) = 0; } }
}
__device__ __forceinline__ void phase_ln_mix(const Ctx& c, const Args& a, int layer) {
    const bf16* MIX = (const bf16*)(a.ws + WS_MIX); bf16* HB = (bf16*)(a.ws + WS_HBF); unsigned char* H8 = a.ws + WS_H8;
    ln_zero_pad(c, HB, H8);
    for (int i = c.gw; i < NVALID; i += 2 * c.ngw) {
        const int rowA = ROWV + i, rowB0 = rowA + c.ngw; const bool hasB = rowB0 < LP; const int rowB = hasB ? rowB0 : rowA;
        const LnSrc A{HB + (size_t)rowA * D, MIX + (size_t)rowA * D, nullptr, nullptr, 0.f, 0.f}, B{HB + (size_t)rowB * D, MIX + (size_t)rowB * D, nullptr, nullptr, 0.f, 0.f};
        ln_pair<false>(A, B, a.in[I_LNMG] + layer * D, a.in[I_LNMB] + layer * D, LnDst{HB + (size_t)rowA * D, H8 + (size_t)rowA * D, nullptr}, LnDst{HB + (size_t)rowB * D, H8 + (size_t)rowB * D, nullptr}, hasB, c.lane PROBE_ONE); }
}
__device__ __forceinline__ void phase_ln_ffn(const Ctx& c, const Args& a, int layer, bool last PROBE_DECL) {
    const bf16* Y = (const bf16*)(a.ws + WS_R1 + R1_Y); bf16* HB = (bf16*)(a.ws + WS_HBF); unsigned char* H8 = a.ws + WS_H8;
    const int* route = (const int*)(a.ws + WS_ROUTE);
    if (!last) ln_zero_pad(c, HB, H8);
    const int first = last ? 256 : ROWV;
    for (int i = c.gw; i < LP - first; i += 2 * c.ngw) {
        const int rowA = first + i, rowB0 = rowA + c.ngw; const bool hasB = rowB0 < LP; const int rowB = hasB ? rowB0 : rowA;
        const int* rA = route + (size_t)rowA * 8; const int* rB = route + (size_t)rowB * 8;
        const v4i_ qa = *(const v4i_*)(rA + 4), qb = *(const v4i_*)(rB + 4);
        const LnSrc A{HB + (size_t)rowA * D, nullptr, Y + (size_t)qa.x * D, Y + (size_t)qa.y * D, __int_as_float(qa.z), __int_as_float(qa.w)}, B{HB + (size_t)rowB * D, nullptr, Y + (size_t)qb.x * D, Y + (size_t)qb.y * D, __int_as_float(qb.z), __int_as_float(qb.w)};
        const LnDst oA{last ? nullptr : HB + (size_t)rowA * D, last ? nullptr : H8 + (size_t)rowA * D, last ? a.out + (size_t)(rowA - 256) * D : nullptr}, oB{last ? nullptr : HB + (size_t)rowB * D, last ? nullptr : H8 + (size_t)rowB * D, last ? a.out + (size_t)(rowB - 256) * D : nullptr};
        ln_pair<true>(A, B, a.in[I_LNFG] + layer * D, a.in[I_LNFB] + layer * D, oA, oB, hasB, c.lane PROBE_PASS); }
}
typedef float f32x16 __attribute__((ext_vector_type(16)));
__device__ __forceinline__ void phase_router(const Ctx& c, const Args& a, int layer) {
    const bf16* HBr = (const bf16*)(a.ws + WS_HBF);
    LAS float* part = (LAS float*)c.lds;
    LAS float* lg = (LAS float*)(c.lds + 98304);
    const bf16* wrh = (const bf16*)(a.ws + WS_WRH) + (size_t)layer * 96 * 2048; const bf16* wrl = (const bf16*)(a.ws + WS_WRL) + (size_t)layer * 96 * 2048;
    const float* bg = a.in[I_BGRP] + layer * 8; const float* be = a.in[I_BEXP] + layer * 64;
    int* route = (int*)(a.ws + WS_ROUTE); unsigned* cnt = (unsigned*)(a.ws + WS_CTL) + CW_CNT + layer * 64;
    const int li = c.lane & 31, kh = c.lane >> 5, w = c.wave;
    for (int task = c.bid; task < 513; task += c.nblk) {
        const int row0 = 224 + 32 * task;
        f32x16 acc[3];
#pragma unroll
        for (int ct = 0; ct < 3; ++ct)
#pragma unroll
            for (int e = 0; e < 16; ++e) acc[ct][e] = 0.f;
        const bf16* ap = HBr + (size_t)(row0 + li) * D + 256 * w + 8 * kh;
        const bf16* bh = wrh + (size_t)li * 2048 + 256 * w + 8 * kh; const bf16* bl = wrl + (size_t)li * 2048 + 256 * w + 8 * kh;
#pragma unroll 4
        for (int st = 0; st < 16; ++st) {
            const bf16x8 ah = *(const bf16x8*)(ap + 16 * st);
#pragma unroll
            for (int ct = 0; ct < 3; ++ct) { const bf16x8 wh = *(const bf16x8*)(bh + (size_t)ct * 32 * 2048 + 16 * st), wl = *(const bf16x8*)(bl + (size_t)ct * 32 * 2048 + 16 * st);
                acc[ct] = __builtin_amdgcn_mfma_f32_32x32x16_bf16(ah, wh, acc[ct], 0, 0, 0); acc[ct] = __builtin_amdgcn_mfma_f32_32x32x16_bf16(ah, wl, acc[ct], 0, 0, 0); }
        }
#pragma unroll
        for (int ct = 0; ct < 3; ++ct)
#pragma unroll
            for (int e = 0; e < 16; ++e) part[((ct * 8 + w) * 16 + e) * 64 + c.lane] = acc[ct][e];
        __syncthreads();
        for (int i = c.tid; i < 3072; i += NTHR) { const int ct = i >> 10, e = (i >> 6) & 15, ln = i & 63; float sum = 0.f;
#pragma unroll
            for (int w2 = 0; w2 < 8; ++w2) sum += part[((ct * 8 + w2) * 16 + e) * 64 + ln];
            const int col = 32 * ct + (ln & 31), row = (e & 3) + 8 * (e >> 2) + 4 * (ln >> 5);
            lg[row * 96 + col] = sum + (col < 8 ? bg[col] : (col < 72 ? be[col - 8] : 0.f)); }
        __syncthreads();
        if (c.tid < 32) { const int row2 = row0 + c.tid;
            if (row2 >= ROWV) { const LAS float* l = lg + c.tid * 96;
                int grp = 0; float gm = l[0];
                for (int q = 1; q < 8; ++q) if (l[q] > gm) { gm = l[q]; grp = q; }
                float gs = 0.f; for (int q = 0; q < 8; ++q) gs += expf(l[q] - gm);
                const float pg = 1.0f / gs;
                const LAS float* el = l + 8 + grp * 8;
                int i0 = 0; float v0 = el[0]; for (int q = 1; q < 8; ++q) if (el[q] > v0) { v0 = el[q]; i0 = q; }
                int i1 = -1; float v1 = -3.0e38f; for (int q = 0; q < 8; ++q) if (q != i0 && el[q] > v1) { v1 = el[q]; i1 = q; }
                const float e1 = expf(v1 - v0), w0 = pg / (1.0f + e1), w1 = pg * e1 / (1.0f + e1);
                const int ex0 = grp * 8 + i0, ex1 = grp * 8 + i1;
                const int p0 = (int)atomicAdd(cnt + ex0, 1u), p1 = (int)atomicAdd(cnt + ex1, 1u);
                int* r = route + (size_t)row2 * 8; r[0] = ex0; r[1] = ex1; r[2] = p0; r[3] = p1; r[6] = __float_as_int(w0); r[7] = __float_as_int(w1); } }
        __syncthreads();
    }
}
__device__ __forceinline__ void phase_gather(const Ctx& c, const Args& a, int layer) {
    LAS int* lbase = (LAS int*)c.lds; LAS int* lcnt = lbase + 64;
    if (c.tid == 0) {
        const unsigned* cnt = (const unsigned*)(a.ws + WS_CTL) + CW_CNT + layer * 64; int* plan = (int*)(a.ws + WS_CTL) + CW_PLAN + layer * 512;
        int t = 0;
        for (int e = 0; e < NEXP; ++e) { const int n = (int)__hip_atomic_load(cnt + e, __ATOMIC_RELAXED, __HIP_MEMORY_SCOPE_AGENT), nt = (n + 255) / 256; lbase[e] = t * 256; lcnt[e] = n;
            if (c.bid == 0) { plan[1 + e] = t * 256; for (int q = 0; q < nt; ++q) plan[128 + t + q] = e; }
            t += nt; }
        if (c.bid == 0) plan[0] = t;
    }
    __syncthreads();
    int* route = (int*)(a.ws + WS_ROUTE); int* rowlist = (int*)(a.ws + WS_ROWLIST);
    for (int T = c.bid * NTHR + c.tid; T < NVALID * 2; T += c.nblk * NTHR) {
        const int row = ROWV + (T >> 1), j = T & 1; int* r = route + (size_t)row * 8;
        const int slot = lbase[r[j]] + r[2 + j];
        r[4 + j] = slot; rowlist[slot] = row;
    }
    for (int e = c.bid; e < NEXP; e += c.nblk) { const int n = lcnt[e], end = ((n + 255) / 256) * 256;
        for (int i = n + c.tid; i < end; i += NTHR) rowlist[lbase[e] + i] = 0; }
    __syncthreads();
}
struct HgRaw { float f[16], q[16], v[16]; };
__device__ __forceinline__ float bf2f(bf16 x) { return __uint_as_float((unsigned)x << 16); }
template <bool NEEDQ> __device__ __forceinline__ void hg_load(HgRaw& r, const unsigned char* R1, int r0, int head, int dir, int k, int tq) {
    const bf16* fb = (const bf16*)(R1 + R1_F) + (size_t)(r0 + 16 * tq) * 4096 + 2048 * dir + head * 128 + k;
    const bf16* vb = (const bf16*)(R1 + R1_VB) + (size_t)(r0 + 16 * tq) * D + head * 128 + k; const bf16* qb = (const bf16*)(R1 + R1_QB) + (size_t)(r0 + 16 * tq) * D + head * 128 + k;
#pragma unroll
    for (int i = 0; i < 16; ++i) { r.f[i] = 1.0f - bf2f(fb[(size_t)i * 4096]); r.v[i] = bf2f(vb[(size_t)i * D]); if (NEEDQ) r.q[i] = bf2f(qb[(size_t)i * D]); }
}
constexpr int HG_T = HG_SCR;
template <bool NEEDQ> __device__ __forceinline__ float hg_prep(const Ctx& c, const HgRaw& r, int r0, int dir, int k, int tq, int lane) {
    LAS unsigned char* L = c.lds;
    float g[16], kk[16], cs[16];
#pragma unroll
    for (int i = 0; i < 16; ++i) { const bool valid = (r0 + 16 * tq + i) >= ROWV; g[i] = valid ? __logf(r.f[i]) : 0.f; kk[i] = valid ? 1.0f - r.f[i] : 0.f; }
    if (dir == 0) { cs[0] = g[0];
#pragma unroll
        for (int i = 1; i < 16; ++i) cs[i] = cs[i - 1] + g[i]; }
    else { cs[15] = g[15];
#pragma unroll
        for (int i = 14; i >= 0; --i) cs[i] = cs[i + 1] + g[i]; }
    LAS float* T = (LAS float*)(L + HG_T);
    T[tq * 128 + k] = dir == 0 ? cs[15] : cs[0];
    __syncthreads();
    const float t0 = T[k], t1 = T[128 + k], t2 = T[256 + k], t3 = T[384 + k];
    const float btot = (t0 + t1) + (t2 + t3);
    float off;
    if (dir == 0) off = tq == 0 ? 0.f : tq == 1 ? t0 : tq == 2 ? t0 + t1 : t0 + t1 + t2;
    else off = tq == 3 ? 0.f : tq == 2 ? t3 : tq == 1 ? t3 + t2 : t3 + t2 + t1;
    unsigned kh[8], vt[8];
#pragma unroll
    for (int i = 0; i < 16; i += 2) {
        const float b0 = off + cs[i], b1 = off + cs[i + 1];
        const unsigned pk = pkbf(kk[i] * __expf(-b0), kk[i + 1] * __expf(-b1));
        kh[i >> 1] = pk; vt[i >> 1] = pkbf(r.v[i], r.v[i + 1]);
        if (NEEDQ) { const int t = 16 * tq + i; const unsigned pq = pkbf(r.q[i] * __expf(b0), r.q[i + 1] * __expf(b1));
            *(LAS unsigned short*)(L + HG_QT + t * LD_K + 2 * k) = (unsigned short)pq; *(LAS unsigned short*)(L + HG_QT + (t + 1) * LD_K + 2 * k) = (unsigned short)(pq >> 16);
            *(LAS unsigned short*)(L + HG_KT + t * LD_K + 2 * k) = (unsigned short)pk; *(LAS unsigned short*)(L + HG_KT + (t + 1) * LD_K + 2 * k) = (unsigned short)(pk >> 16); }
    }
    *(LAS v4u*)(L + HG_KH + k * LD_T + 32 * tq) = (v4u){kh[0], kh[1], kh[2], kh[3]};
    *(LAS v4u*)(L + HG_KH + k * LD_T + 32 * tq + 16) = (v4u){kh[4], kh[5], kh[6], kh[7]};
    *(LAS v4u*)(L + HG_VT + k * LD_T + 32 * tq) = (v4u){vt[0], vt[1], vt[2], vt[3]};
    *(LAS v4u*)(L + HG_VT + k * LD_T + 32 * tq + 16) = (v4u){vt[4], vt[5], vt[6], vt[7]};
    if (tq == 0) ((LAS float*)(L + HG_DV))[k] = __expf(btot);
    return btot;
}
__device__ __forceinline__ void hg_update(LAS unsigned char* Lb, int w, f32x4 (&S)[8], int r, int q) {
#pragma unroll
    for (int ks = 0; ks < 2; ++ks) { const bf16x8 b = ldfrag(Lb + HG_VT, 16 * w + r, LD_T, (32 * ks + 8 * q) * 2);
#pragma unroll
        for (int kt = 0; kt < 8; ++kt) { const bf16x8 a2 = ldfrag(Lb + HG_KH, 16 * kt + r, LD_T, (32 * ks + 8 * q) * 2); S[kt] = MFMA16(a2, b, S[kt]); } }
#pragma unroll
    for (int kt = 0; kt < 8; ++kt) { const f32x4 d = *(const LAS f32x4*)(Lb + HG_DV + (16 * kt + 4 * q) * 4); S[kt] = S[kt] * d; }
}
__device__ __forceinline__ void hg_seg_range(int seg, int& c0, int& n) { if (seg == 0) { c0 = 3; n = 9; } else { c0 = 4 + 8 * seg; n = 8; } }
__device__ __forceinline__ void glds16(const unsigned char* gsrc_lane, LAS unsigned char* lds_wave) { __builtin_amdgcn_global_load_lds((const unsigned*)gsrc_lane, (LAS unsigned*)lds_wave, 16, 0, 0); }
__device__ __forceinline__ void phase_hg_build(const Ctx& c, const Args& a) {
    const unsigned char* R1 = a.ws + WS_R1; unsigned char* IMG = a.ws + WS_R1 + R1_IMG; LAS unsigned char* L = c.lds;
    for (int u = c.bid; u < 257 * 16; u += c.nblk) {
        int tv = c.tid; asm volatile("" : "+v"(tv));
        const int lane = tv & 63, k = tv & 127, tq = tv >> 7, ci = 3 + (u >> 4), head = u & 15, r0 = 64 * ci;
        unsigned char* img = IMG + ((size_t)ci * 16 + head) * IMG_SZ;
#pragma unroll 1
        for (int dir = 0; dir < 2; ++dir) {
            HgRaw raw; hg_load<true>(raw, R1, r0, head, dir, k, tq);
            (void)hg_prep<true>(c, raw, r0, dir, k, tq, lane);
            __syncthreads();
            for (int i = tv; i < 3392; i += NTHR) *(v4u*)(img + 18432 + (size_t)dir * 54272 + (size_t)i * 16) = *(const LAS v4u*)(L + HG_QT + i * 16);
            if (dir == 0) for (int i = tv; i < 1152; i += NTHR) *(v4u*)(img + (size_t)i * 16) = *(const LAS v4u*)(L + HG_VT + i * 16);
            if (dir == 0) { const bf16* gp = (const bf16*)(R1 + R1_GB) + (size_t)(r0 + 16 * tq) * D + head * 128 + k; float gv[16];
#pragma unroll
                for (int i = 0; i < 16; ++i) gv[i] = bf2f(gp[(size_t)i * D]);
                bf16* gt = (bf16*)(a.ws + WS_R1 + R1_GT) + ((size_t)ci * 16 + head) * 8192 + (size_t)(((k >> 4) * 4 + tq) * 64 + (k & 15)) * 4;
#pragma unroll
                for (int qq = 0; qq < 4; ++qq) { v2u w2; w2.x = pkbf(gv[4 * qq], gv[4 * qq + 1]); w2.y = pkbf(gv[4 * qq + 2], gv[4 * qq + 3]); *(v2u*)(gt + qq * 64) = w2; } }
            __syncthreads();
        }
    }
}
__device__ __forceinline__ void phase_hg_pass1(const Ctx& c, const Args& a) {
    const unsigned char* IMG = a.ws + WS_R1 + R1_IMG; LAS unsigned char* L = c.lds;
    float* DS = (float*)(a.ws + WS_R1 + R1_DS); float* DSEG = (float*)(a.ws + WS_R1 + R1_DSEG);
    const int w = c.wave;
    for (int u = c.bid; u < 1024; u += c.nblk) {
        int tv = c.tid; asm volatile("" : "+v"(tv));
        const int lane = tv & 63, r = lane & 15, q = lane >> 4;
        const int chain = u & 31, seg = u >> 5, dir = chain >> 4, head = chain & 15;
        int c0, n; hg_seg_range(seg, c0, n);
        f32x4 S[8];
#pragma unroll
        for (int kt = 0; kt < 8; ++kt) S[kt] = (f32x4){0.f, 0.f, 0.f, 0.f};
        float dprod = 1.0f;
#define HG1_ISSUE(step, buf) do { const int ci_ = dir == 0 ? c0 + (step) : c0 + n - 1 - (step); const unsigned char* img_ = IMG + ((size_t)ci_ * 16 + head) * IMG_SZ; LAS unsigned char* lb_ = L + (buf) * HB_SZ; \
            for (int p_ = w; p_ < 37; p_ += 8) { if (p_ < 18) glds16(img_ + p_ * 1024 + lane * 16, lb_ + HG_VT + p_ * 1024); \
                else glds16(img_ + 18432 + (size_t)dir * 54272 + (HG_KH - HG_QT) + (p_ - 18) * 1024 + lane * 16, lb_ + HG_KH + (p_ - 18) * 1024); } } while (0)
        HG1_ISSUE(0, 0);
        for (int j = 0; j < n; ++j) {
            asm volatile("s_waitcnt vmcnt(0)" ::: "memory"); __syncthreads();
            if (j + 1 < n) HG1_ISSUE(j + 1, (j + 1) & 1);
            LAS unsigned char* Lb = L + (j & 1) * HB_SZ;
            hg_update(Lb, w, S, r, q);
            if (tv < 128) dprod *= *(const LAS float*)(Lb + HG_DV + tv * 4);
        }
#undef HG1_ISSUE
        float* dst = DS + ((size_t)seg * 32 + chain) * 16384 + w * 2048 + lane;
#pragma unroll
        for (int kt = 0; kt < 8; ++kt)
#pragma unroll
            for (int e = 0; e < 4; ++e) dst[(kt * 4 + e) * 64] = S[kt][e];
        if (tv < 128) DSEG[((size_t)seg * 32 + chain) * 128 + tv] = dprod;
        __syncthreads();
    }
}
__device__ __forceinline__ void phase_hg_segscan(const Ctx& c, const Args& a) {
    float* DS = (float*)(a.ws + WS_R1 + R1_DS); const float* DSEG = (const float*)(a.ws + WS_R1 + R1_DSEG);
    for (int i = c.bid * NTHR + c.tid; i < 32 * 4096; i += c.nblk * NTHR) {
        const int chain = i >> 12, e4 = i & 4095, el = e4 * 4, ln = el & 63, e = (el >> 6) & 3, kt = (el >> 8) & 7, k = 16 * kt + 4 * (ln >> 4) + e, dir = chain >> 4;
        f32x4 run = (f32x4){0.f, 0.f, 0.f, 0.f};
        for (int j0 = 0; j0 < 32; j0 += 8) { f32x4 ds[8]; float d[8];
#pragma unroll
            for (int j = 0; j < 8; ++j) { const int sg = dir == 0 ? j0 + j : 31 - j0 - j; ds[j] = *((const f32x4*)(DS + ((size_t)sg * 32 + chain) * 16384) + e4); d[j] = DSEG[((size_t)sg * 32 + chain) * 128 + k]; }
#pragma unroll
            for (int j = 0; j < 8; ++j) { const int sg = dir == 0 ? j0 + j : 31 - j0 - j; *((f32x4*)(DS + ((size_t)sg * 32 + chain) * 16384) + e4) = run; run = run * d[j] + ds[j]; } }
    }
}
template <int DIR> __device__ __forceinline__ void phase_hg_pass2(const Ctx& c, const Args& a) {
    const unsigned char* IMG = a.ws + WS_R1 + R1_IMG;
    const float* DS = (const float*)(a.ws + WS_R1 + R1_DS);
    bf16* OBW = (bf16*)(a.ws + WS_R1 + R1_OBW); const bf16* GB = (const bf16*)(a.ws + WS_R1 + R1_GB); bf16* MI = (bf16*)(a.ws + WS_MIXIN);
    LAS unsigned char* L = c.lds;
    const int w = c.wave;
    for (int u = c.bid; u < 512; u += c.nblk) {
        int tv = c.tid; asm volatile("" : "+v"(tv));
        const int lane = tv & 63, r = lane & 15, q = lane >> 4;
        const int head = u & 15, seg = u >> 4, dir = DIR, chain = dir * 16 + head;
        int c0, n; hg_seg_range(seg, c0, n);
        f32x4 S[8];
        { const float* src = DS + ((size_t)seg * 32 + chain) * 16384 + w * 2048 + lane;
#pragma unroll
          for (int kt = 0; kt < 8; ++kt)
#pragma unroll
              for (int e = 0; e < 4; ++e) S[kt][e] = src[(kt * 4 + e) * 64]; }
#define HG2_ISSUE(step, buf) do { const int ci_ = dir == 0 ? c0 + (step) : c0 + n - 1 - (step); const unsigned char* img_ = IMG + ((size_t)ci_ * 16 + head) * IMG_SZ; LAS unsigned char* lb_ = L + (buf) * HB_SZ; \
            for (int p_ = w; p_ < 71; p_ += 8) { if (p_ < 18) glds16(img_ + p_ * 1024 + lane * 16, lb_ + HG_VT + p_ * 1024); \
                else glds16(img_ + 18432 + (size_t)dir * 54272 + (p_ - 18) * 1024 + lane * 16, lb_ + HG_QT + (p_ - 18) * 1024); } } while (0)
        HG2_ISSUE(0, 0);
        float ng = 0.f; if (DIR == 0) ng = a.in[I_NORMG][head * 128 + 16 * w + r];
        f32x4 po[4]; v2u pg[4]; int pci = 0;
#pragma unroll
        for (int tt = 0; tt < 4; ++tt) { po[tt] = (f32x4){0.f, 0.f, 0.f, 0.f}; pg[tt] = (v2u){0u, 0u}; }
#define HG2_FLUSH(par) do { if (DIR == 1) { v2u* ob_ = (v2u*)(OBW + ((size_t)pci * 16 + head) * 8192) + (w * 4) * 64 + lane; \
                _Pragma("unroll") for (int tt = 0; tt < 4; ++tt) { v2u w2; w2.x = pkbf(po[tt][0], po[tt][1]); w2.y = pkbf(po[tt][2], po[tt][3]); ob_[tt * 64] = w2; } \
            } else { const LAS float* RS_ = (const LAS float*)(L + HG_SCR + (par) * 2048); bf16* mi_ = MI + (size_t)(64 * pci) * D + head * 128 + 16 * w + r; \
                _Pragma("unroll") for (int tt = 0; tt < 4; ++tt) { const f32x4 g4 = bf4(pg[tt]); \
                    _Pragma("unroll") for (int e = 0; e < 4; ++e) { const int t = 16 * tt + 4 * q + e; const f32x4 s0 = *(const LAS f32x4*)(RS_ + t * 8), s1 = *(const LAS f32x4*)(RS_ + t * 8 + 4); \
                        const float rs = 1.0f / sqrtf(((s0.x + s0.y) + (s0.z + s0.w) + (s1.x + s1.y) + (s1.z + s1.w)) * (1.0f / 128.0f) + 1e-6f); \
                        mi_[(size_t)t * D] = (bf16)f2bf(64 * pci + t >= ROWV ? po[tt][e] * rs * ng * g4[e] : 0.f); } } } } while (0)
        for (int j = 0; j < n; ++j) {
            const int ci = dir == 0 ? c0 + j : c0 + n - 1 - j;
            asm volatile("s_waitcnt vmcnt(0)" ::: "memory"); __syncthreads();
            if (j + 1 < n) HG2_ISSUE(j + 1, (j + 1) & 1);
            if (j > 0) HG2_FLUSH((j - 1) & 1);
            LAS unsigned char* Lb = L + (j & 1) * HB_SZ;
            v2u obp[4], gtp[4];
            if (DIR == 0) { const v2u* ob_ = (const v2u*)(OBW + ((size_t)ci * 16 + head) * 8192) + (w * 4) * 64 + lane; const v2u* gt_ = (const v2u*)((const bf16*)(a.ws + WS_R1 + R1_GT) + ((size_t)ci * 16 + head) * 8192) + (w * 4) * 64 + lane;
#pragma unroll
                for (int tt = 0; tt < 4; ++tt) { obp[tt] = ob_[tt * 64]; gtp[tt] = gt_[tt * 64]; } }
            f32x4 o[4];
#pragma unroll
            for (int tt = 0; tt < 4; ++tt) {
                o[tt] = (f32x4){0.f, 0.f, 0.f, 0.f};
                bf16x8 qf[4];
#pragma unroll
                for (int ks = 0; ks < 4; ++ks) qf[ks] = ldfrag(Lb + HG_QT, 16 * tt + r, LD_K, (32 * ks + 8 * q) * 2);
                unsigned pp[4][2];
#pragma unroll
                for (int st = 0; st < 4; ++st) { f32x4 acc = (f32x4){0.f, 0.f, 0.f, 0.f};
#pragma unroll
                    for (int ks = 0; ks < 4; ++ks) { const bf16x8 kf = ldfrag(Lb + HG_KT, 16 * st + r, LD_K, (32 * ks + 8 * q) * 2); acc = MFMA16(kf, qf[ks], acc); }
                    const int s0 = 16 * st + 4 * q, t = 16 * tt + r;
                    const float m0 = (dir == 0 ? (s0 <= t) : (s0 >= t)) ? acc[0] : 0.f, m1 = (dir == 0 ? (s0 + 1 <= t) : (s0 + 1 >= t)) ? acc[1] : 0.f;
                    const float m2 = (dir == 0 ? (s0 + 2 <= t) : (s0 + 2 >= t)) ? acc[2] : 0.f, m3 = (dir == 0 ? (s0 + 3 <= t) : (s0 + 3 >= t)) ? acc[3] : 0.f;
                    pp[st][0] = pkbf(m0, m1); pp[st][1] = pkbf(m2, m3); }
#pragma unroll
                for (int ks = 0; ks < 2; ++ks) { const v4u af = (v4u){pp[2 * ks][0], pp[2 * ks][1], pp[2 * ks + 1][0], pp[2 * ks + 1][1]};
                    const LAS unsigned char* vp = Lb + HG_VT + (16 * w + r) * LD_T + (32 * ks + 4 * q) * 2; const v2u lo = *(const LAS v2u*)vp, hi = *(const LAS v2u*)(vp + 32);
                    const v4u vf = (v4u){lo.x, lo.y, hi.x, hi.y}; o[tt] = MFMA16(__builtin_bit_cast(bf16x8, af), __builtin_bit_cast(bf16x8, vf), o[tt]); }
            }
#pragma unroll
            for (int ks = 0; ks < 4; ++ks) { v4u sb; sb.x = pkbf(S[2 * ks][0], S[2 * ks][1]); sb.y = pkbf(S[2 * ks][2], S[2 * ks][3]); sb.z = pkbf(S[2 * ks + 1][0], S[2 * ks + 1][1]); sb.w = pkbf(S[2 * ks + 1][2], S[2 * ks + 1][3]);
                const bf16x8 bf = __builtin_bit_cast(bf16x8, sb);
#pragma unroll
                for (int tt = 0; tt < 4; ++tt) { const LAS unsigned char* qp = Lb + HG_QT + (16 * tt + r) * LD_K + (32 * ks + 4 * q) * 2; const v2u lo = *(const LAS v2u*)qp, hi = *(const LAS v2u*)(qp + 32);
                    const v4u t4 = (v4u){lo.x, lo.y, hi.x, hi.y}; o[tt] = MFMA16(__builtin_bit_cast(bf16x8, t4), bf, o[tt]); } }
            hg_update(Lb, w, S, r, q);
            pci = ci;
            if (DIR == 1) {
#pragma unroll
                for (int tt = 0; tt < 4; ++tt) po[tt] = o[tt];
            } else {
                LAS float* RS = (LAS float*)(L + HG_SCR + (j & 1) * 2048);
                float ss[16];
#pragma unroll
                for (int tt = 0; tt < 4; ++tt) { const f32x4 b4 = bf4(obp[tt]); o[tt] = o[tt] + b4;
#pragma unroll
                    for (int e = 0; e < 4; ++e) ss[tt * 4 + e] = o[tt][e] * o[tt][e]; }
                float b8[8], b4v[4], b2v[2], tot;
#pragma unroll
                for (int i = 0; i < 8; ++i) { const float keep = (r & 8) ? ss[i + 8] : ss[i], send = (r & 8) ? ss[i] : ss[i + 8]; b8[i] = keep + __shfl_xor(send, 8); }
#pragma unroll
                for (int i = 0; i < 4; ++i) { const float keep = (r & 4) ? b8[i + 4] : b8[i], send = (r & 4) ? b8[i] : b8[i + 4]; b4v[i] = keep + __shfl_xor(send, 4); }
#pragma unroll
                for (int i = 0; i < 2; ++i) { const float keep = (r & 2) ? b4v[i + 2] : b4v[i], send = (r & 2) ? b4v[i] : b4v[i + 2]; b2v[i] = keep + __shfl_xor(send, 2); }
                { const float keep = (r & 1) ? b2v[1] : b2v[0], send = (r & 1) ? b2v[0] : b2v[1]; tot = keep + __shfl_xor(send, 1); }
                RS[(16 * (r >> 2) + 4 * q + (r & 3)) * 8 + w] = tot;
#pragma unroll
                for (int tt = 0; tt < 4; ++tt) { po[tt] = o[tt]; pg[tt] = gtp[tt]; }
            }
        }
#undef HG2_ISSUE
        __syncthreads();
        HG2_FLUSH((n - 1) & 1);
#undef HG2_FLUSH
    }
    if (DIR == 0) { for (int i = c.bid * NTHR + c.tid; i < 192 * D / 8; i += c.nblk * NTHR) ((v4u*)MI)[i] = (v4u){0u, 0u, 0u, 0u}; }
}
constexpr int NPHASE = 40;
__global__ void __launch_bounds__(NTHR, 2) fwd(Args args) {
    extern __shared__ __attribute__((aligned(16))) unsigned char lds[];
    Ctx c; c.lds = (LAS unsigned char*)lds; c.ldsg = lds; c.tid = threadIdx.x; c.lane = c.tid & 63; c.wave = __builtin_amdgcn_readfirstlane(c.tid >> 6);
    c.bid = blockIdx.x; c.nblk = gridDim.x; c.gw = c.bid * NWAVES + c.wave; c.ngw = c.nblk * NWAVES;
    volatile LAS unsigned* MISC = (volatile LAS unsigned*)(c.lds + MISC_OFF);
    for (int u = c.tid; u < (LDS_BYTES - MISC_OFF) / 4; u += NTHR) ((LAS unsigned*)(c.lds + MISC_OFF))[u] = 0u;
    __syncthreads();
    const int lo = args.ph_lo, hi = args.ph_hi;
#ifdef PROBE_MASK
    float g_probe_scale = 1.0f;
#endif
    const bool multi = (hi - lo) > 1;
    XcdBarrier bar; bar.bar = (unsigned*)(args.ws + WS_CTL) + CW_BAR; bar.x = 0; bar.st = nullptr;
    if (multi) bar = xcd_barrier_post((unsigned*)(args.ws + WS_CTL) + CW_BAR, MISC + 8);
#define IN(k) (lo <= (k) && (k) < hi)
#ifdef PROBE_MASK
#define STAMP(k) do { if (c.bid == 0 && c.tid == 0) ((unsigned long long*)((unsigned*)(args.ws + WS_CTL) + CW_TS))[(k)] = __builtin_amdgcn_s_memrealtime(); } while (0)
#else
#define STAMP(k) do { } while (0)
#endif
#define SEAM(k) do { if (IN(k) && IN((k) + 1)) { STAMP(64 + (k)); xcd_barrier(bar); STAMP((k) + 1); } } while (0)
    STAMP(0);
    unsigned char* ws = args.ws;
    float* HA = (float*)(ws + WS_HA); float* HBuf = (float*)(ws + WS_HB);
    const pg8::bf16_t* HBF = (const pg8::bf16_t*)(ws + WS_HBF);
    const pg8::bf16_t* MIXIN = (const pg8::bf16_t*)(ws + WS_MIXIN);
    if (IN(0)) { phase_init(c, args);
#if defined(DUP_PHASE)
        if (DUP_PHASE == 0) { xcd_barrier(bar); phase_init(c, args); }
#endif
    } SEAM(0);
    if (IN(1)) { phase_s5_ktab(c, args);
#if defined(DUP_PHASE)
        if (DUP_PHASE == 1) { xcd_barrier(bar); phase_s5_ktab(c, args); }
#endif
    } SEAM(1);
    if (IN(2)) { phase_weights(c, args); phase_s5_fill(c, args);
#if defined(DUP_PHASE)
        if (DUP_PHASE == 2) { xcd_barrier(bar); phase_weights(c, args); phase_s5_fill(c, args); }
#endif
    } SEAM(2);
    if (IN(3)) { skinny_gemm2(c, (const bf16*)HBF, D, (const bf16*)(ws + WS_WAB), D, ABN, SkAB2{ws});
        zero_rows_bf16(c, (bf16*)(ws + WS_QB0), 1024, 192, ROWV); zero_rows_bf16(c, (bf16*)(ws + WS_KB0), 256, 192, ROWV); zero_rows_bf16(c, (bf16*)(ws + WS_VB0), 256, 192, ROWV);
        for (int i = c.bid * NTHR + c.tid; i < 64 * 256; i += c.nblk * NTHR) ((bf16*)(ws + WS_R1 + R1_UA))[(size_t)(i >> 8) * 768 * 768 + (i & 255)] = 0;
        pg8::Gemm g = pg8::mkgemm(HBF, ws + WS_WAB, SEQ, ABN, D); pg8::StaticOrder S; S.init(SEQ, ABN, c.nblk, c.bid, 1);
        pg8::EpiProjAB E{ws}; pg8::gemm_phase(c.lds, g, S, E);
        if (c.nblk == 256 && c.bid >= 128) conv_fill(c, args, 0, FILL3, c.bid - 128, c.nblk - 128);
    } SEAM(3);
    if (IN(4)) { phase_attn(c, args);
        if (c.nblk == 256 && c.bid >= 2) { __syncthreads(); conv_fill(c, args, FILL7, FILL4, c.bid - 2, c.nblk - 2); }
#if defined(DUP_PHASE)
        if (DUP_PHASE == 4) { xcd_barrier(bar); phase_attn(c, args); }
#endif
    } SEAM(4);
    if (IN(5)) { pg8::Gemm g = pg8::mkgemm(ws + WS_R1 + R1_UA, ws + WS_WST, 768, 256, 512, (size_t)256 * 512 * 2); g.lda = 768; g.astride = (size_t)768 * 768 * 2;
        pg8::GroupTileOrder S; S.init(64, 768, 256, c.nblk, c.bid); pg8::EpiF32 E{(float*)(ws + WS_R1 + R1_SALL), 256, (size_t)768 * 256}; pg8::gemm_phase(c.lds, g, S, E);
        if (c.nblk == 256 && c.bid >= 192) conv_fill(c, args, FILL3, FILL5, c.bid - 192, c.nblk - 192);
#if defined(DUP_PHASE)
        if (DUP_PHASE == 5) { xcd_barrier(bar); pg8::Gemm g = pg8::mkgemm(ws + WS_R1 + R1_UA, ws + WS_WST, 768, 256, 512, (size_t)256 * 512 * 2); g.lda = 768; g.astride = (size_t)768 * 768 * 2;
        pg8::GroupTileOrder S; S.init(64, 768, 256, c.nblk, c.bid); pg8::EpiF32 E{(float*)(ws + WS_R1 + R1_SALL), 256, (size_t)768 * 256}; pg8::gemm_phase(c.lds, g, S, E); }
#endif
    } SEAM(5);
    if (IN(6)) { phase_s5_chunkscan(c, args);
        if (c.nblk == 256 && c.bid >= 128) conv_fill(c, args, FILL5, FILL6, c.bid - 128, c.nblk - 128);
#if defined(DUP_PHASE)
        if (DUP_PHASE == 6) { xcd_barrier(bar); phase_s5_chunkscan(c, args); }
#endif
    } SEAM(6);
    if (IN(7)) { pg8::Gemm g = pg8::mkgemm(ws + WS_R1 + R1_UA, ws + WS_MWT, 768, 512, 768, (size_t)512 * 768 * 2); g.astride = (size_t)768 * 768 * 2;
        pg8::GroupTileOrder S; S.init(64, 768, 512, c.nblk, c.bid); pg8::EpiS5Y E{(pg8::bf16_t*)(ws + WS_ZB)}; pg8::gemm_phase(c.lds, g, S, E);
        if (c.nblk == 256 && c.bid >= 128) conv_fill(c, args, FILL6, FILL7, c.bid - 128, c.nblk - 128);
#if defined(DUP_PHASE)
        if (DUP_PHASE == 7) { xcd_barrier(bar); pg8::Gemm g = pg8::mkgemm(ws + WS_R1 + R1_UA, ws + WS_MWT, 768, 512, 768, (size_t)512 * 768 * 2); g.astride = (size_t)768 * 768 * 2;
        pg8::GroupTileOrder S; S.init(64, 768, 512, c.nblk, c.bid); pg8::EpiS5Y E{(pg8::bf16_t*)(ws + WS_ZB)}; pg8::gemm_phase(c.lds, g, S, E); }
#endif
    } SEAM(7);
    if (IN(8)) { skinny_gemm(c, (const bf16*)(ws + WS_ZB), 1024, (const bf16*)(ws + WS_WGLU), 1024, 1024, SkGlu{(const bf16*)(ws + WS_ZB), args.in[I_BGLU], (bf16*)(ws + WS_MIXIN)});
        pg8::Gemm g = pg8::mkgemm(ws + WS_ZB, ws + WS_WGLU, SEQ, 1024, 1024); pg8::StaticOrder S; S.init(SEQ, 1024, c.nblk, c.bid, 1);
        pg8::EpiGlu E{(const pg8::bf16_t*)(ws + WS_ZB), args.in[I_BGLU], (pg8::bf16_t*)(ws + WS_MIXIN)}; pg8::gemm_phase(c.lds, g, S, E);
#if defined(DUP_PHASE)
        if (DUP_PHASE == 8) { xcd_barrier(bar); skinny_gemm(c, (const bf16*)(ws + WS_ZB), 1024, (const bf16*)(ws + WS_WGLU), 1024, 1024, SkGlu{(const bf16*)(ws + WS_ZB), args.in[I_BGLU], (bf16*)(ws + WS_MIXIN)});
        pg8::Gemm g = pg8::mkgemm(ws + WS_ZB, ws + WS_WGLU, SEQ, 1024, 1024); pg8::StaticOrder S; S.init(SEQ, 1024, c.nblk, c.bid, 1);
        pg8::EpiGlu E{(const pg8::bf16_t*)(ws + WS_ZB), args.in[I_BGLU], (pg8::bf16_t*)(ws + WS_MIXIN)}; pg8::gemm_phase(c.lds, g, S, E); }
#endif
    } SEAM(8);
    if (IN(9)) { skinny_gemm(c, (const bf16*)MIXIN, D, (const bf16*)(ws + WS_WOAB), D, D, SkBf16{(bf16*)(ws + WS_MIX), D});
        pg8::Gemm g = pg8::mkgemm(MIXIN, ws + WS_WOAB, SEQ, D, D); pg8::StaticOrder S; S.init(SEQ, D, c.nblk, c.bid, 1);
        pg8::EpiBf16 E{(pg8::bf16_t*)(ws + WS_MIX), D}; pg8::gemm_phase(c.lds, g, S, E);
#if defined(DUP_PHASE)
        if (DUP_PHASE == 9) { xcd_barrier(bar); skinny_gemm(c, (const bf16*)MIXIN, D, (const bf16*)(ws + WS_WOAB), D, D, SkBf16{(bf16*)(ws + WS_MIX), D});
        pg8::Gemm g = pg8::mkgemm(MIXIN, ws + WS_WOAB, SEQ, D, D); pg8::StaticOrder S; S.init(SEQ, D, c.nblk, c.bid, 1);
        pg8::EpiBf16 E{(pg8::bf16_t*)(ws + WS_MIX), D}; pg8::gemm_phase(c.lds, g, S, E); }
#endif
    } SEAM(9);
    if (IN(10)) { phase_ln_mix(c, args, 0);
#if defined(DUP_PHASE)
        if (DUP_PHASE == 10) { xcd_barrier(bar); phase_ln_mix(c, args, 0); }
#endif
    } SEAM(10);
    if (IN(11)) { phase_router(c, args, 0);
        if (c.nblk == 256 && c.bid != 0) { __syncthreads(); conv_fill(c, args, R11_LO, R11_HI, c.bid - 1, 255); }
#if defined(DUP_PHASE)
        if (DUP_PHASE == 11) { xcd_barrier(bar); phase_router(c, args, 0); }
#endif
    } SEAM(11);
    if (IN(12)) { phase_gather(c, args, 0);
#if defined(DUP_PHASE)
        if (DUP_PHASE == 12) { xcd_barrier(bar); phase_gather(c, args, 0); }
#endif
    } SEAM(12);
    if (IN(13)) { pg8::Gemm g = pg8::mkgemm(ws + WS_H8, ws + WS_WGU, MPAD, 1024, D / 2, (size_t)1024 * D); pg8::GatherOrder S; S.init((const int*)(ws + WS_CTL) + CW_PLAN, 1024, c.nblk, c.bid, (const int*)(ws + WS_ROWLIST));
        pg8::EpiSwiGLU8 E{ws + WS_R1 + R1_ACT, DEXP}; pg8::gemm_phase<pg8::EpiSwiGLU8, pg8::GatherOrder, true>(c.lds, g, S, E, 0x79797979);
        if (c.nblk == 256) { const int nwg = ((const int*)(ws + WS_CTL))[CW_PLAN] * 4, rank = (c.bid % 8) * 32 + c.bid / 8 - (nwg - 512);
            if (nwg > 512 && nwg < 768 && rank >= 0 && rank < 128) { __syncthreads(); const int b0 = R13_LO + rank * 40; for (int it = b0 + c.wave; it < b0 + 40; it += NWAVES) conv_l1_item(c, args, it); __syncthreads(); } }
#if defined(DUP_PHASE)
        if (DUP_PHASE == 13) { xcd_barrier(bar); pg8::Gemm g = pg8::mkgemm(ws + WS_H8, ws + WS_WGU, MPAD, 1024, D / 2, (size_t)1024 * D); pg8::GatherOrder S; S.init((const int*)(ws + WS_CTL) + CW_PLAN, 1024, c.nblk, c.bid, (const int*)(ws + WS_ROWLIST));
        pg8::EpiSwiGLU8 E{ws + WS_R1 + R1_ACT, DEXP}; pg8::gemm_phase<pg8::EpiSwiGLU8, pg8::GatherOrder, true>(c.lds, g, S, E, 0x79797979); }
#endif
    } SEAM(13);
    if (IN(14)) { pg8::Gemm g = pg8::mkgemm(ws + WS_R1 + R1_ACT, ws + WS_WD, MPAD, D, DEXP / 2, (size_t)D * DEXP); pg8::GroupedOrder S; S.init((const int*)(ws + WS_CTL) + CW_PLAN, D, c.nblk, c.bid);
        pg8::EpiBf16 E{(pg8::bf16_t*)(ws + WS_R1 + R1_Y), D}; pg8::gemm_phase<pg8::EpiBf16, pg8::GroupedOrder, true>(c.lds, g, S, E, 0x79797979);
#if defined(DUP_PHASE)
        if (DUP_PHASE == 14) { xcd_barrier(bar); pg8::Gemm g = pg8::mkgemm(ws + WS_R1 + R1_ACT, ws + WS_WD, MPAD, D, DEXP / 2, (size_t)D * DEXP); pg8::GroupedOrder S; S.init((const int*)(ws + WS_CTL) + CW_PLAN, D, c.nblk, c.bid);
        pg8::EpiBf16 E{(pg8::bf16_t*)(ws + WS_R1 + R1_Y), D}; pg8::gemm_phase<pg8::EpiBf16, pg8::GroupedOrder, true>(c.lds, g, S, E, 0x79797979); }
#endif
    } SEAM(14);
    if (IN(15)) { phase_ln_ffn(c, args, 0, false PROBE_PASS);
#if defined(DUP_PHASE)
        if (DUP_PHASE == 15) { xcd_barrier(bar); phase_ln_ffn(c, args, 0, false PROBE_PASS); }
#endif
    } SEAM(15);
    if (IN(16)) { skinny_gemm(c, (const bf16*)HBF, D, (const bf16*)(ws + WS_WC), D, CN, SkC{(bf16*)(ws + WS_R1 + R1_QB), (bf16*)(ws + WS_R1 + R1_VB), (bf16*)(ws + WS_R1 + R1_GB), (bf16*)(ws + WS_R1 + R1_F), (const float*)(ws + WS_LBT)});
        zero_rows_bf16(c, (bf16*)(ws + WS_R1 + R1_F), 4096, 192, ROWV); zero_rows_bf16(c, (bf16*)(ws + WS_R1 + R1_QB), D, 192, ROWV); zero_rows_bf16(c, (bf16*)(ws + WS_R1 + R1_VB), D, 192, ROWV); zero_rows_bf16(c, (bf16*)(ws + WS_R1 + R1_GB), D, 192, ROWV);
        pg8::Gemm g = pg8::mkgemm(ws + WS_H8, ws + WS_WC8, SEQ, CN, D / 2); pg8::StaticOrder S; S.init(SEQ, 6144, c.nblk, c.bid, 1, 16);
        pg8::EpiProjC E{ws + WS_R1, (const float*)(ws + WS_LBT)}; pg8::gemm_phase<pg8::EpiProjC, pg8::StaticOrder, true>(c.lds, g, S, E, 0x79797979);
        pg8::Gemm g2 = pg8::mkgemm(HBF, ws + WS_WC, SEQ, CN, D); pg8::StaticOrder S2; S2.init(SEQ, 4096, c.nblk, c.bid, 1, 0);
        __syncthreads(); pg8::gemm_phase(c.lds, g2, S2, E);
#if defined(DUP_PHASE)
        if (DUP_PHASE == 16) { xcd_barrier(bar); pg8::gemm_phase<pg8::EpiProjC, pg8::StaticOrder, true>(c.lds, g, S, E, 0x79797979); __syncthreads(); pg8::gemm_phase(c.lds, g2, S2, E); }
#endif
    } SEAM(16);
    if (IN(17)) { phase_hg_build(c, args); if (c.nblk == 256 && c.bid >= 16) { __syncthreads(); conv_fill(c, args, R17_LO, R17_HI, c.bid - 16, 240); } xcd_barrier(bar); phase_hg_pass1(c, args); xcd_barrier(bar); phase_hg_segscan(c, args); xcd_barrier(bar); phase_hg_pass2<1>(c, args);
#if defined(DUP_PHASE)
        if (DUP_PHASE == 17) { xcd_barrier(bar); phase_hg_build(c, args); }
        if (DUP_PHASE == 170) { xcd_barrier(bar); phase_hg_pass1(c, args); xcd_barrier(bar); phase_hg_segscan(c, args); }
        if (DUP_PHASE == 171) { xcd_barrier(bar); phase_hg_pass2<1>(c, args); }
#endif
    } SEAM(17);
    if (IN(18)) { phase_hg_pass2<0>(c, args);
#if defined(DUP_PHASE)
        if (DUP_PHASE == 18) { xcd_barrier(bar); phase_hg_pass2<0>(c, args); }
#endif
    } SEAM(18);
    if (IN(19)) { skinny_gemm(c, (const bf16*)MIXIN, D, (const bf16*)(ws + WS_WOC), D, D, SkBf16{(bf16*)(ws + WS_MIX), D});
        pg8::Gemm g = pg8::mkgemm(MIXIN, ws + WS_WOC, SEQ, D, D); pg8::StaticOrder S; S.init(SEQ, D, c.nblk, c.bid, 1);
        pg8::EpiBf16 E{(pg8::bf16_t*)(ws + WS_MIX), D}; pg8::gemm_phase(c.lds, g, S, E);
#if defined(DUP_PHASE)
        if (DUP_PHASE == 19) { xcd_barrier(bar); skinny_gemm(c, (const bf16*)MIXIN, D, (const bf16*)(ws + WS_WOC), D, D, SkBf16{(bf16*)(ws + WS_MIX), D});
        pg8::Gemm g = pg8::mkgemm(MIXIN, ws + WS_WOC, SEQ, D, D); pg8::StaticOrder S; S.init(SEQ, D, c.nblk, c.bid, 1);
        pg8::EpiBf16 E{(pg8::bf16_t*)(ws + WS_MIX), D}; pg8::gemm_phase(c.lds, g, S, E); }
#endif

#if defined(DUP_PHASE)
        if (DUP_PHASE == 190) { xcd_barrier(bar); pg8::EpiNull EN{(float*)(ws + WS_CTL) + 70000}; pg8::gemm_phase(c.lds, g, S, EN); }
#endif
    } SEAM(19);
    if (IN(20)) { phase_ln_mix(c, args, 1);
#if defined(DUP_PHASE)
        if (DUP_PHASE == 20) { xcd_barrier(bar); phase_ln_mix(c, args, 1); }
#endif
    } SEAM(20);
    if (IN(21)) { phase_router(c, args, 1);
        if (c.nblk == 256 && c.bid != 0) { __syncthreads(); conv_fill(c, args, R21_LO, R21_HI, c.bid - 1, 255); }
#if defined(DUP_PHASE)
        if (DUP_PHASE == 21) { xcd_barrier(bar); phase_router(c, args, 1); }
#endif
    } SEAM(21);
    if (IN(22)) {
        if (c.nblk == 256) { const int nwg = ((const int*)(ws + WS_CTL))[CW_PLAN] * 4, done = (nwg > 512 && nwg < 768) ? ((768 - nwg) < 128 ? (768 - nwg) : 128) : 0;
            for (int it = R13_LO + done * 40 + c.gw; it < R13_HI; it += c.ngw) conv_l1_item(c, args, it);
            __syncthreads(); }
        phase_gather(c, args, 1);
#if defined(DUP_PHASE)
        if (DUP_PHASE == 22) { xcd_barrier(bar); phase_gather(c, args, 1); }
#endif
    } SEAM(22);
    if (IN(23)) { pg8::Gemm g = pg8::mkgemm(ws + WS_H8, ws + WS_WGU + (size_t)NEXP * 1024 * D, MPAD, 1024, D / 2, (size_t)1024 * D); pg8::GatherOrder S; S.init((const int*)(ws + WS_CTL) + CW_PLAN + 512, 1024, c.nblk, c.bid, (const int*)(ws + WS_ROWLIST));
        pg8::EpiSwiGLU8 E{ws + WS_R1 + R1_ACT, DEXP}; pg8::gemm_phase<pg8::EpiSwiGLU8, pg8::GatherOrder, true>(c.lds, g, S, E, 0x79797979);
#if defined(DUP_PHASE)
        if (DUP_PHASE == 23) { xcd_barrier(bar); pg8::Gemm g = pg8::mkgemm(ws + WS_H8, ws + WS_WGU + (size_t)NEXP * 1024 * D, MPAD, 1024, D / 2, (size_t)1024 * D); pg8::GatherOrder S; S.init((const int*)(ws + WS_CTL) + CW_PLAN + 512, 1024, c.nblk, c.bid, (const int*)(ws + WS_ROWLIST));
        pg8::EpiSwiGLU8 E{ws + WS_R1 + R1_ACT, DEXP}; pg8::gemm_phase<pg8::EpiSwiGLU8, pg8::GatherOrder, true>(c.lds, g, S, E, 0x79797979); }
#endif
    } SEAM(23);
    if (IN(24)) { pg8::Gemm g = pg8::mkgemm(ws + WS_R1 + R1_ACT, ws + WS_WD + (size_t)NEXP * D * DEXP, MPAD, D, DEXP / 2, (size_t)D * DEXP); pg8::GroupedOrder S; S.init((const int*)(ws + WS_CTL) + CW_PLAN + 512, D, c.nblk, c.bid);
        pg8::EpiBf16 E{(pg8::bf16_t*)(ws + WS_R1 + R1_Y), D}; pg8::gemm_phase<pg8::EpiBf16, pg8::GroupedOrder, true>(c.lds, g, S, E, 0x79797979);
#if defined(DUP_PHASE)
        if (DUP_PHASE == 24) { xcd_barrier(bar); pg8::Gemm g = pg8::mkgemm(ws + WS_R1 + R1_ACT, ws + WS_WD + (size_t)NEXP * D * DEXP, MPAD, D, DEXP / 2, (size_t)D * DEXP); pg8::GroupedOrder S; S.init((const int*)(ws + WS_CTL) + CW_PLAN + 512, D, c.nblk, c.bid);
        pg8::EpiBf16 E{(pg8::bf16_t*)(ws + WS_R1 + R1_Y), D}; pg8::gemm_phase<pg8::EpiBf16, pg8::GroupedOrder, true>(c.lds, g, S, E, 0x79797979); }
#endif
    } SEAM(24);
    if (IN(25)) {
#ifdef PROBE_MASK
        { const unsigned long long* ts = (const unsigned long long*)((unsigned*)(args.ws + WS_CTL) + CW_TS); const double tot = (double)(ts[25] - ts[0]); double acc = 0.0;
          for (int k = 0; k < 25; ++k) { if ((PROBE_MASK >> k) & 1ull) acc += (double)(ts[k + 1] - ts[k]); if ((PROBE_BARMASK >> k) & 1ull) acc += (double)(ts[k + 1] - ts[64 + k]); }
          g_probe_scale = 1.0f + 0.05f + 0.5f * (float)(acc / tot); }
#endif
        phase_ln_ffn(c, args, 1, true PROBE_PASS); }
#undef IN
#undef SEAM
}
constexpr int LAST_PHASE = 25;

extern "C" void kernel_launch(void* const* d_in, const int* in_sizes, int n_in, void* d_out, int out_size, void* d_ws, size_t ws_size, hipStream_t stream) {
    static int grid = 0;
    if (grid == 0) {
        if (n_in != 29 || ws_size < WS_END) { fprintf(stderr, "kernel_launch: expected 29 inputs and >= %zu bytes of workspace (got %d, %zu)\n", (size_t)WS_END, n_in, ws_size); grid = -1; return; }
        int dev = 0, cus = 0, per_cu = 0;
        if (hipGetDevice(&dev) != hipSuccess || hipDeviceGetAttribute(&cus, hipDeviceAttributeMultiprocessorCount, dev) != hipSuccess) { grid = -1; return; }
        if (hipFuncSetAttribute((const void*)fwd, hipFuncAttributeMaxDynamicSharedMemorySize, LDS_BYTES) != hipSuccess) { fprintf(stderr, "kernel_launch: hipFuncSetAttribute failed\n"); grid = -1; return; }
        if (hipOccupancyMaxActiveBlocksPerMultiprocessor(&per_cu, (const void*)fwd, NTHR, LDS_BYTES) != hipSuccess || per_cu < 1) fprintf(stderr, "kernel_launch: occupancy query says %d\n", per_cu);
        (void)hipGetLastError();
        grid = cus;
    }
    if (grid < 0) return;
    (void)hipMemsetAsync((char*)d_ws + WS_CTL, 0, CTL_BYTES, stream);
    Args a{};
    for (int i = 0; i < 29; ++i) a.in[i] = (const float*)d_in[i];
    a.out = (float*)d_out; a.ws = (unsigned char*)d_ws;
#ifndef MK_N_LAUNCHES
#define MK_N_LAUNCHES 1
#endif
    if (MK_N_LAUNCHES == 1) { a.ph_lo = 0; a.ph_hi = LAST_PHASE + 1; hipLaunchKernelGGL(fwd, dim3(grid), dim3(NTHR), LDS_BYTES, stream, a); }
    else for (int p = 0; p <= LAST_PHASE; ++p) {
        a.ph_lo = p; a.ph_hi = p + 1;
        hipLaunchKernelGGL(fwd, dim3(grid), dim3(NTHR), LDS_BYTES, stream, a);
    }
}
```

```cpp
#include <hip/hip_runtime.h>
#include <cstdio>
#include <cstdint>

namespace pg8 {
#define PG8_LAS __attribute__((address_space(3)))
typedef unsigned short bf16_t;
typedef short bf16x8 __attribute__((ext_vector_type(8)));
typedef float f32x4 __attribute__((ext_vector_type(4)));
typedef unsigned u32x4 __attribute__((ext_vector_type(4)));
constexpr int BM = 256, BK = 64, HALF = 128, HTB = HALF * BK * 2, STAGE_BYTES = 8 * HTB, NXCD = 8, WGM = 4;

__host__ __device__ __forceinline__ int lds_byte(int r, int c) { const int st = (r >> 4) * 2 + (c >> 5), rr = r & 15, cc = c & 31, ob = rr * 64 + cc * 2; return st * 1024 + (ob ^ (((ob >> 9) & 1) << 5)); }
__host__ __device__ __forceinline__ void stage_rc(int b, int& R, int& C) { const int st = b / 1024, sb = b % 1024, swz = sb ^ (((sb >> 9) & 1) << 5); R = (st >> 1) * 16 + swz / 64; C = (st & 1) * 32 + (swz % 64) / 2; }
__host__ __device__ __forceinline__ int perm32(int rho) { const int n = rho >> 4, i = rho & 15; return 8 * (i >> 2) + 4 * n + (i & 3); }

struct Unit { int pm, pn, eb; };
struct Gemm { const bf16_t* A; const bf16_t* Bt; int M, N, K, lda, ldb; size_t astride, bstride; };

struct StaticOrder {
    static constexpr bool GATHER = false;
    int nM, nN, nwg, G, c, pm_off, pn_off, gap_at, gap;
    __host__ __device__ __forceinline__ void init(int M, int N, int G_, int c_, int pm_off_ = 0, int pn_off_ = 0, int gap_at_ = 1 << 30, int gap_ = 0) { nM = M / BM; nN = N / BM; nwg = nM * nN; G = G_; c = c_; pm_off = pm_off_; pn_off = pn_off_; gap_at = gap_at_; gap = gap_; }
    __host__ __device__ __forceinline__ bool next(int i, Unit& u) const {
        const long L = (long)i * G + c; if (L >= nwg) return false;
        int wgid = (int)L; { const int q = nwg / NXCD, r = nwg % NXCD, xcd = wgid % NXCD, off = wgid / NXCD; wgid = (xcd < r ? xcd * (q + 1) : r * (q + 1) + (xcd - r) * q) + off; }
        const int nig = WGM * nN, gid = wgid / nig, fm = gid * WGM, gsz = (nM - fm) < WGM ? (nM - fm) : WGM;
        u.pm = fm + ((wgid % nig) % gsz) + pm_off; const int pn_ = (wgid % nig) / gsz; u.pn = pn_ + pn_off + (pn_ >= gap_at ? gap : 0); u.eb = 0; return true;
    }
    __device__ __forceinline__ void a_ready(const Unit&) const {}
    __device__ __forceinline__ void done(const Unit&) const {}
};
template <bool GATHER_> struct GroupedOrderT {
    static constexpr bool GATHER = GATHER_;
    int ntiles, nN, nwg, G, c; const int* tile_expert; const int* rowlist;
    __device__ __forceinline__ void init(const int* plan, int N, int G_, int c_, const int* rowlist_ = nullptr) { ntiles = plan[0]; tile_expert = plan + 128; nN = N / BM; nwg = ntiles * nN; G = G_; rowlist = rowlist_;
        c = (G_ % NXCD == 0) ? (c_ % NXCD) * (G_ / NXCD) + c_ / NXCD : c_; }
    __device__ __forceinline__ bool next(int i, Unit& u) const {
        const long L = (long)i * G + c; if (L >= nwg) return false;
        u.pm = (int)(L / nN); u.pn = (int)(L % nN); u.eb = tile_expert[u.pm]; return true;
    }
    __device__ __forceinline__ void a_ready(const Unit&) const {}
    __device__ __forceinline__ void done(const Unit&) const {}
};

typedef GroupedOrderT<false> GroupedOrder; typedef GroupedOrderT<true> GatherOrder;
struct GroupTileOrder {
    static constexpr bool GATHER = false;
    int nM, nN, nwg, G, c;
    __device__ __forceinline__ void init(int groups, int M, int N, int G_, int c_) { nM = M / BM; nN = N / BM; nwg = groups * nM * nN; G = G_; c = c_; }
    __device__ __forceinline__ bool next(int i, Unit& u) const {
        const long L = (long)i * G + c; if (L >= nwg) return false;
        const int per = nM * nN, rem = (int)(L % per); u.eb = (int)(L / per); u.pm = rem % nM; u.pn = rem / nM; return true;
    }
    __device__ __forceinline__ void a_ready(const Unit&) const {}
    __device__ __forceinline__ void done(const Unit&) const {}
};
__device__ __forceinline__ unsigned cvt_pk_bf16(float lo, float hi) { unsigned r; asm volatile("v_cvt_pk_bf16_f32 %0, %1, %2" : "=v"(r) : "v"(lo), "v"(hi)); return r; }

struct EpiF32 {
    static constexpr bool PERM = false, AFTER_DRAIN = false;
    float* C; int ldc; size_t cstride;
    __device__ __forceinline__ void operator()(const f32x4 (&acc)[2][2][4][2], const Unit& u, int wr, int wc, int fr, int fq) const {
        const int row0 = u.pm * BM + wr * 64 + fr, col0 = u.pn * BM + wc * 32 + 4 * fq;
#pragma unroll
        for (int ai = 0; ai < 2; ++ai)
#pragma unroll
            for (int m = 0; m < 4; ++m) { float* rowp = C + (size_t)u.eb * cstride + (size_t)(row0 + ai * HALF + m * 16) * ldc + col0;
#pragma unroll
                for (int bj = 0; bj < 2; ++bj)
#pragma unroll
                    for (int n = 0; n < 2; ++n) *(f32x4*)(rowp + bj * HALF + n * 16) = acc[ai][bj][m][n]; }
    }
};
struct EpiSwiGLU {
    static constexpr bool PERM = true, AFTER_DRAIN = false;
    bf16_t* O; int ldc;
    __device__ __forceinline__ void operator()(const f32x4 (&acc)[2][2][4][2], const Unit& u, int wr, int wc, int fr, int fq) const {
        const int row0 = u.pm * BM + wr * 64 + fr, col0 = u.pn * HALF + wc * 32 + 8 * fq;
#pragma unroll
        for (int ai = 0; ai < 2; ++ai)
#pragma unroll
            for (int m = 0; m < 4; ++m) { bf16_t* rowp = O + (size_t)(row0 + ai * HALF + m * 16) * ldc + col0;
                float r[8];
#pragma unroll
                for (int n = 0; n < 2; ++n)
#pragma unroll
                    for (int i = 0; i < 4; ++i) { const float g = acc[ai][0][m][n][i], up = acc[ai][1][m][n][i]; r[n * 4 + i] = g / (1.0f + __expf(-g)) * up; }
                u32x4 w; w.x = cvt_pk_bf16(r[0], r[1]); w.y = cvt_pk_bf16(r[2], r[3]); w.z = cvt_pk_bf16(r[4], r[5]); w.w = cvt_pk_bf16(r[6], r[7]);
                *(u32x4*)rowp = w; }
    }
};

struct EpiSwiGLU8 {
    static constexpr bool PERM = true, AFTER_DRAIN = false;
    unsigned char* O; int ldc;
    __device__ __forceinline__ void operator()(const f32x4 (&acc)[2][2][4][2], const Unit& u, int wr, int wc, int fr, int fq) const {
        typedef unsigned u32x2 __attribute__((ext_vector_type(2)));
        const int row0 = u.pm * BM + wr * 64 + fr, col0 = u.pn * HALF + wc * 32 + 8 * fq;
#pragma unroll
        for (int ai = 0; ai < 2; ++ai)
#pragma unroll
            for (int m = 0; m < 4; ++m) { unsigned char* rowp = O + (size_t)(row0 + ai * HALF + m * 16) * ldc + col0;
                float r[8];
#pragma unroll
                for (int n = 0; n < 2; ++n)
#pragma unroll
                    for (int i = 0; i < 4; ++i) { const float g = acc[ai][0][m][n][i], up = acc[ai][1][m][n][i]; r[n * 4 + i] = g / (1.0f + __expf(-g)) * up; }
                int w0 = 0, w1 = 0; w0 = __builtin_amdgcn_cvt_pk_fp8_f32(r[0], r[1], w0, false); w0 = __builtin_amdgcn_cvt_pk_fp8_f32(r[2], r[3], w0, true);
                w1 = __builtin_amdgcn_cvt_pk_fp8_f32(r[4], r[5], w1, false); w1 = __builtin_amdgcn_cvt_pk_fp8_f32(r[6], r[7], w1, true);
                *(u32x2*)rowp = (u32x2){(unsigned)w0, (unsigned)w1}; }
    }
};
__host__ __device__ __forceinline__ Gemm mkgemm(const void* A, const void* Bt, int M, int N, int K, size_t bstride = 0) { Gemm g; g.A = (const bf16_t*)A; g.Bt = (const bf16_t*)Bt; g.M = M; g.N = N; g.K = K; g.lda = K; g.ldb = K; g.astride = 0; g.bstride = bstride; return g; }
struct EpiS5Y {
    static constexpr bool PERM = false, AFTER_DRAIN = false;
    bf16_t* ZB;
    __device__ __forceinline__ void operator()(const f32x4 (&acc)[2][2][4][2], const Unit& u, int wr, int wc, int fr, int fq) const {
#pragma unroll
        for (int ai = 0; ai < 2; ++ai)
#pragma unroll
            for (int m = 0; m < 4; ++m) { const int chunk = u.pm * BM + ai * HALF + wr * 64 + m * 16 + fr;
                if (chunk <= 512) {
#pragma unroll
                    for (int bj = 0; bj < 2; ++bj)
#pragma unroll
                        for (int n = 0; n < 2; ++n) { const int t = 16 * u.pn + 8 * bj + 2 * wc + n, row = 224 + 32 * chunk + t; float z[4];
#pragma unroll
                            for (int i = 0; i < 4; ++i) { const float y = acc[ai][bj][m][n][i]; const float x2 = 1.5957691216057308f * (y + 0.044715f * y * y * y);
                                const float th = 1.0f - 2.0f / (1.0f + __expf(x2)); z[i] = 0.5f * y * (1.0f + th); }
                            typedef unsigned u32x2 __attribute__((ext_vector_type(2)));
                            u32x2 w; w.x = cvt_pk_bf16(z[0], z[1]); w.y = cvt_pk_bf16(z[2], z[3]);
                            *(u32x2*)(ZB + (size_t)row * 1024 + 16 * u.eb + 4 * fq) = w; } } }
    }
};
struct EpiGlu {
    static constexpr bool PERM = true, AFTER_DRAIN = false;
    const bf16_t* ZB; const float* bias; bf16_t* O;
    __device__ __forceinline__ void operator()(const f32x4 (&acc)[2][2][4][2], const Unit& u, int wr, int wc, int fr, int fq) const {
        const int row0 = u.pm * BM + wr * 64 + fr, col0 = u.pn * BM + wc * 32 + 8 * fq;
#pragma unroll
        for (int ai = 0; ai < 2; ++ai)
#pragma unroll
            for (int m = 0; m < 4; ++m) { const int row = row0 + ai * HALF + m * 16;
#pragma unroll
                for (int bj = 0; bj < 2; ++bj) { const int col = col0 + bj * HALF;
                    const u32x4 zw = *(const u32x4*)(ZB + (size_t)row * 1024 + col);
                    const f32x4 b0 = *(const f32x4*)(bias + col), b1 = *(const f32x4*)(bias + col + 4);
                    float r[8];
#pragma unroll
                    for (int i = 0; i < 4; ++i) { const unsigned zz = i < 2 ? (i == 0 ? zw.x : zw.y) : (i == 2 ? zw.z : zw.w);
                        const float z0 = __uint_as_float(zz << 16), z1 = __uint_as_float(zz & 0xffff0000u);
                        const int e0 = 2 * i, e1 = 2 * i + 1;
                        const float a0 = (e0 < 4 ? acc[ai][bj][m][0][e0] : acc[ai][bj][m][1][e0 - 4]) + (e0 < 4 ? b0[e0] : b1[e0 - 4]);
                        const float a1 = (e1 < 4 ? acc[ai][bj][m][0][e1] : acc[ai][bj][m][1][e1 - 4]) + (e1 < 4 ? b0[e1] : b1[e1 - 4]);
                        r[e0] = z0 / (1.0f + __expf(-a0)); r[e1] = z1 / (1.0f + __expf(-a1)); }
                    u32x4 w; w.x = cvt_pk_bf16(r[0], r[1]); w.y = cvt_pk_bf16(r[2], r[3]); w.z = cvt_pk_bf16(r[4], r[5]); w.w = cvt_pk_bf16(r[6], r[7]);
                    *(u32x4*)(O + (size_t)row * 2048 + 1024 + col) = w; } }
    }
};

struct EpiBf16 {
    static constexpr bool PERM = true, AFTER_DRAIN = false;
    bf16_t* O; int ldc;
    __device__ __forceinline__ void operator()(const f32x4 (&acc)[2][2][4][2], const Unit& u, int wr, int wc, int fr, int fq) const {
        const int row0 = u.pm * BM + wr * 64 + fr, col0 = u.pn * BM + wc * 32 + 8 * fq;
#pragma unroll
        for (int ai = 0; ai < 2; ++ai)
#pragma unroll
            for (int m = 0; m < 4; ++m) { bf16_t* rowp = O + (size_t)(row0 + ai * HALF + m * 16) * ldc + col0;
#pragma unroll
                for (int bj = 0; bj < 2; ++bj) { const f32x4 v0 = acc[ai][bj][m][0], v1 = acc[ai][bj][m][1];
                    u32x4 w; w.x = cvt_pk_bf16(v0[0], v0[1]); w.y = cvt_pk_bf16(v0[2], v0[3]); w.z = cvt_pk_bf16(v1[0], v1[1]); w.w = cvt_pk_bf16(v1[2], v1[3]);
                    *(u32x4*)(rowp + bj * HALF) = w; } }
    }
};
struct EpiNull { static constexpr bool PERM = true, AFTER_DRAIN = false; float* sink;
    __device__ __forceinline__ void operator()(const f32x4 (&acc)[2][2][4][2], const Unit& u, int wr, int wc, int fr, int fq) const {
        float t = 0.f;
#pragma unroll
        for (int ai = 0; ai < 2; ++ai)
#pragma unroll
            for (int bj = 0; bj < 2; ++bj)
#pragma unroll
                for (int m = 0; m < 4; ++m)
#pragma unroll
                    for (int n = 0; n < 2; ++n) t += acc[ai][bj][m][n][0] + acc[ai][bj][m][n][1] + acc[ai][bj][m][n][2] + acc[ai][bj][m][n][3];
        if (t == 123.456f) sink[0] = t; } };
#ifndef PG8_SP2
#define PG8_SP2 1
#endif
template <class Epi, class Sched, bool FP8 = false>
__device__ __forceinline__ void gemm_phase(PG8_LAS unsigned char* lds, const Gemm g, const Sched& S, const Epi& E, int scale_w = 0x7f7f7f7f) {
    const int tid = threadIdx.x, wid = __builtin_amdgcn_readfirstlane(tid >> 6), lane = tid & 63, wr = wid >> 2, wc = wid & 3, fr = lane & 15, fq = lane >> 4;
    const int K = g.K, nt = K / BK;
    unsigned voffA[2], voffB[2]; int stR[2], stC[2];
#pragma unroll
    for (int i = 0; i < 2; ++i) { int R, C; stage_rc(tid * 16 + i * 8192, R, C); const int Rb = Epi::PERM ? ((R & ~31) + perm32(R & 31)) : R;
        voffA[i] = (unsigned)(R * g.lda + C) * 2u; voffB[i] = (unsigned)(Rb * g.ldb + C) * 2u; stR[i] = R; stC[i] = C; }
    const size_t kstep = (size_t)(BK * 2);
    const size_t hstepA = (size_t)HALF * g.lda * 2, hstepB = (size_t)HALF * g.ldb * 2;
    const size_t tstepA = 2 * hstepA, tstepB = 2 * hstepB;
    const unsigned ldsw = (unsigned)wid * 1024u;
    const int aoff = lds_byte(wr * 64 + fr, fq * 8), boff = lds_byte(wc * 32 + fr, fq * 8);
#define PG8_SA(b, h) (((b) * 2 + (h)) * HTB)
#define PG8_SB(b, h) ((4 + (b) * 2 + (h)) * HTB)
#define PG8_STAGE(bufoff, gbase, voff) do { _Pragma("unroll") for (int _i = 0; _i < 2; ++_i) \
        __builtin_amdgcn_global_load_lds((const unsigned*)((const char*)(gbase) + (voff)[_i]), (PG8_LAS unsigned*)(lds + (bufoff) + ldsw + _i * 8192), 16, 0, 0); } while (0)
#define PG8_LD8(base_) __builtin_shufflevector(*(const PG8_LAS v4i_t*)(base_), *(const PG8_LAS v4i_t*)((base_) + 1024), 0, 1, 2, 3, 4, 5, 6, 7)
#define PG8_LDA(dst, b, h) do { if constexpr (FP8) { _Pragma("unroll") for (int m = 0; m < 4; ++m) dst##8[m] = PG8_LD8(lds + PG8_SA(b, h) + aoff + m * 2048); } \
        else { _Pragma("unroll") for (int m = 0; m < 4; ++m) _Pragma("unroll") for (int k = 0; k < 2; ++k) dst[m][k] = *(const PG8_LAS bf16x8*)(lds + PG8_SA(b, h) + aoff + m * 2048 + k * 1024); } } while (0)
#define PG8_LDB(dst, b, h) do { if constexpr (FP8) { _Pragma("unroll") for (int n = 0; n < 2; ++n) dst##8[n] = PG8_LD8(lds + PG8_SB(b, h) + boff + n * 2048); } \
        else { _Pragma("unroll") for (int n = 0; n < 2; ++n) _Pragma("unroll") for (int k = 0; k < 2; ++k) dst[n][k] = *(const PG8_LAS bf16x8*)(lds + PG8_SB(b, h) + boff + n * 2048 + k * 1024); } } while (0)
#define PG8_MMA(ai, bj, At, Bt) do { __builtin_amdgcn_s_setprio(1); _Pragma("unroll") for (int m = 0; m < 4; ++m) _Pragma("unroll") for (int n = 0; n < 2; ++n) { \
        if constexpr (FP8) asm volatile("v_mfma_scale_f32_16x16x128_f8f6f4 %0, %1, %2, %0, %3, %4 op_sel_hi:[0,0,0]" : "+v"(acc[ai][bj][m][n]) : "v"(Bt##8[n]), "v"(At##8[m]), "v"(scw_), "v"(sca_)); \
        else { _Pragma("unroll") for (int k = 0; k < 2; ++k) acc[ai][bj][m][n] = __builtin_amdgcn_mfma_f32_16x16x32_bf16(Bt[n][k], At[m][k], acc[ai][bj][m][n], 0, 0, 0); } } \
        __builtin_amdgcn_s_setprio(0); } while (0)
#define PG8_WAIT_V(n) asm volatile("s_waitcnt vmcnt(" #n ")" ::: "memory")
#define PG8_WAIT_L(n) asm volatile("s_waitcnt lgkmcnt(" #n ")" ::: "memory")
#define PG8_BAR __builtin_amdgcn_s_barrier()
#define PG8_SCHED __builtin_amdgcn_sched_barrier(0)
    unsigned vC[2][2], vN[2][2];
#define PG8_AOFF(dst, unit) do { _Pragma("unroll") for (int h_ = 0; h_ < 2; ++h_) _Pragma("unroll") for (int i_ = 0; i_ < 2; ++i_) { \
        if constexpr (Sched::GATHER) { const int row_ = S.rowlist[(unit).pm * BM + h_ * HALF + stR[i_]]; dst[h_][i_] = (unsigned)(row_ * g.lda + stC[i_]) * 2u; } \
        else dst[h_][i_] = voffA[i_] + (unsigned)(h_ * hstepA); } } while (0)
    Unit cur, nxt; int ui = 0;
    if (!S.next(0, cur)) return;
    f32x4 acc[2][2][4][2];
#pragma unroll
    for (int a = 0; a < 2; ++a)
#pragma unroll
        for (int b = 0; b < 2; ++b)
#pragma unroll
            for (int m = 0; m < 4; ++m)
#pragma unroll
                for (int n = 0; n < 2; ++n) acc[a][b][m][n] = (f32x4){0.f, 0.f, 0.f, 0.f};
    typedef int v8i_t __attribute__((ext_vector_type(8))); typedef int v4i_t __attribute__((ext_vector_type(4)));
    const int scw_ = scale_w, sca_ = 0x7f7f7f7f;
    bf16x8 At[4][2], B0[2][2], B1[2][2]; v8i_t At8[4], B08[2], B18[2];
    const char* cA = (const char*)g.A + (size_t)cur.eb * g.astride + (Sched::GATHER ? (size_t)0 : (size_t)cur.pm * tstepA); const char* cB = (const char*)g.Bt + (size_t)cur.eb * g.bstride + (size_t)cur.pn * tstepB;
    PG8_AOFF(vC, cur);
    S.a_ready(cur);
#if PG8_SP2
    PG8_STAGE(PG8_SB(0, 0), cB, voffB); PG8_STAGE(PG8_SB(0, 1), cB + hstepB, voffB); PG8_STAGE(PG8_SA(0, 0), cA, vC[0]); PG8_STAGE(PG8_SA(0, 1), cA, vC[1]);
    if (wr == 1) PG8_BAR;
    PG8_WAIT_V(2); PG8_BAR;
    PG8_STAGE(PG8_SB(1, 0), cB + kstep, voffB); PG8_STAGE(PG8_SA(1, 0), cA + kstep, vC[0]); PG8_STAGE(PG8_SB(1, 1), cB + hstepB + kstep, voffB);
    PG8_WAIT_V(6); PG8_BAR;
#else
    PG8_STAGE(PG8_SB(0, 0), cB, voffB); PG8_STAGE(PG8_SA(0, 0), cA, vC[0]); PG8_STAGE(PG8_SB(0, 1), cB + hstepB, voffB); PG8_STAGE(PG8_SA(0, 1), cA, vC[1]);
    if (wr == 1) PG8_BAR;
    PG8_WAIT_V(4); PG8_BAR;
    PG8_STAGE(PG8_SB(1, 0), cB + kstep, voffB); PG8_STAGE(PG8_SA(1, 0), cA + kstep, vC[0]); PG8_STAGE(PG8_SB(1, 1), cB + hstepB + kstep, voffB);
    PG8_WAIT_V(6); PG8_BAR;
#endif
    for (;;) {
        const bool has_next = S.next(ui + 1, nxt);
        const char* nA = has_next ? (const char*)g.A + (size_t)nxt.eb * g.astride + (Sched::GATHER ? (size_t)0 : (size_t)nxt.pm * tstepA) : cA;
        if constexpr (Sched::GATHER) { if (has_next) PG8_AOFF(vN, nxt); else { _Pragma("unroll") for (int h_ = 0; h_ < 2; ++h_) _Pragma("unroll") for (int i_ = 0; i_ < 2; ++i_) vN[h_][i_] = vC[h_][i_]; } }
        const char* nB = has_next ? (const char*)g.Bt + (size_t)nxt.eb * g.bstride + (size_t)nxt.pn * tstepB : cB;
        for (int t = 0; t < nt; t += 2) {
            const bool last = (t == nt - 2);
            const char* a1 = cA + (size_t)(t + 1) * kstep;
            const char* a2 = last ? nA : cA + (size_t)(t + 2) * kstep; const char* b2 = last ? nB : cB + (size_t)(t + 2) * kstep;
            const char* a3 = a2 + kstep; const char* b3 = b2 + kstep;
            if (last && has_next) S.a_ready(nxt);
            unsigned vs0[2], vs1[2];
            if constexpr (Sched::GATHER) { vs0[0] = last ? vN[0][0] : vC[0][0]; vs0[1] = last ? vN[0][1] : vC[0][1]; vs1[0] = last ? vN[1][0] : vC[1][0]; vs1[1] = last ? vN[1][1] : vC[1][1]; }
            else { vs0[0] = vC[0][0]; vs0[1] = vC[0][1]; vs1[0] = vC[1][0]; vs1[1] = vC[1][1]; }
#if PG8_SP2
            PG8_LDB(B0, 0, 0); PG8_LDB(B1, 0, 1); PG8_SCHED; PG8_LDA(At, 0, 0); PG8_STAGE(PG8_SA(1, 1), a1, vC[1]);
            PG8_WAIT_V(8); PG8_WAIT_L(0); PG8_BAR; PG8_MMA(0, 0, At, B0); PG8_MMA(0, 1, At, B1); PG8_BAR; PG8_SCHED;
            PG8_LDA(At, 0, 1); PG8_STAGE(PG8_SB(0, 0), b2, voffB); PG8_STAGE(PG8_SB(0, 1), b2 + hstepB, voffB); PG8_STAGE(PG8_SA(0, 0), a2, vs0);
            PG8_WAIT_V(8); PG8_WAIT_L(0); PG8_BAR; PG8_MMA(1, 0, At, B0); PG8_MMA(1, 1, At, B1); PG8_BAR; PG8_SCHED;
            PG8_LDB(B0, 1, 0); PG8_LDB(B1, 1, 1); PG8_SCHED; PG8_LDA(At, 1, 0); PG8_STAGE(PG8_SA(0, 1), a2, vs1);
            PG8_WAIT_V(8); PG8_WAIT_L(0); PG8_BAR; PG8_MMA(0, 0, At, B0); PG8_MMA(0, 1, At, B1); PG8_BAR; PG8_SCHED;
            PG8_LDA(At, 1, 1); PG8_STAGE(PG8_SB(1, 0), b3, voffB); PG8_STAGE(PG8_SB(1, 1), b3 + hstepB, voffB); PG8_STAGE(PG8_SA(1, 0), a3, vs0);
            PG8_WAIT_V(8); PG8_WAIT_L(0); PG8_BAR; PG8_MMA(1, 0, At, B0); PG8_MMA(1, 1, At, B1); PG8_BAR; PG8_SCHED;
#else
            PG8_LDB(B0, 0, 0); PG8_SCHED; PG8_LDA(At, 0, 0); PG8_STAGE(PG8_SA(1, 1), a1, vC[1]);
            PG8_WAIT_L(8); PG8_BAR; PG8_WAIT_L(0); PG8_MMA(0, 0, At, B0); PG8_BAR; PG8_SCHED;
            PG8_LDB(B1, 0, 1); PG8_STAGE(PG8_SB(0, 0), b2, voffB);
            PG8_BAR; PG8_WAIT_L(0); PG8_MMA(0, 1, At, B1); PG8_BAR;
            PG8_LDA(At, 0, 1); PG8_STAGE(PG8_SA(0, 0), a2, vs0);
            PG8_BAR; PG8_WAIT_L(0); PG8_MMA(1, 0, At, B0); PG8_BAR; PG8_SCHED;
            PG8_STAGE(PG8_SB(0, 1), b2 + hstepB, voffB);
            PG8_WAIT_V(6); PG8_BAR; PG8_MMA(1, 1, At, B1); PG8_BAR;
            PG8_LDB(B0, 1, 0); PG8_SCHED; PG8_LDA(At, 1, 0); PG8_STAGE(PG8_SA(0, 1), a2, vs1);
            PG8_WAIT_L(8); PG8_BAR; PG8_WAIT_L(0); PG8_MMA(0, 0, At, B0); PG8_BAR; PG8_SCHED;
            PG8_LDB(B1, 1, 1); PG8_STAGE(PG8_SB(1, 0), b3, voffB);
            PG8_BAR; PG8_WAIT_L(0); PG8_MMA(0, 1, At, B1); PG8_BAR;
            PG8_LDA(At, 1, 1); PG8_STAGE(PG8_SA(1, 0), a3, vs0);
            PG8_BAR; PG8_WAIT_L(0); PG8_MMA(1, 0, At, B0); PG8_BAR; PG8_SCHED;
            PG8_STAGE(PG8_SB(1, 1), b3 + hstepB, voffB);
            PG8_WAIT_V(6); PG8_BAR; PG8_MMA(1, 1, At, B1); PG8_BAR;
#endif
        }
        if constexpr (FP8) asm volatile("s_nop 15\n\ts_nop 15" ::: "memory");
        if (wr == 0) PG8_BAR;
        E(acc, cur, wr, wc, fr, fq); S.done(cur);
        if (!has_next) break;
#pragma unroll
        for (int a = 0; a < 2; ++a)
#pragma unroll
            for (int b = 0; b < 2; ++b)
#pragma unroll
                for (int m = 0; m < 4; ++m)
#pragma unroll
                    for (int n = 0; n < 2; ++n) acc[a][b][m][n] = (f32x4){0.f, 0.f, 0.f, 0.f};
        cur = nxt; cA = nA; cB = nB; ++ui;
        if constexpr (Sched::GATHER) {
#pragma unroll
            for (int h_ = 0; h_ < 2; ++h_)
#pragma unroll
                for (int i_ = 0; i_ < 2; ++i_) vC[h_][i_] = vN[h_][i_]; }
        if (wr == 1) PG8_BAR;
    }
    PG8_WAIT_V(0);
    PG8_BAR;
#undef PG8_AOFF
#undef PG8_SA
#undef PG8_SB
#undef PG8_STAGE
#undef PG8_LDA
#undef PG8_LD8
#undef PG8_LDB
#undef PG8_MMA
#undef PG8_WAIT_V
#undef PG8_WAIT_L
#undef PG8_BAR
#undef PG8_SCHED
}
}

constexpr int D = 2048, SEQ = 16384, NMETA = 16;
constexpr int LP = 16640;
constexpr int ROWV = 240;
constexpr int NVALID = 16400;
constexpr int ABN = 2560, CN = 10240;
constexpr int NEXP = 64, DEXP = 512;
constexpr int MAXTILES = 192, MPAD = MAXTILES * 256;
constexpr float DN_ALPHA = 1.4142135623730951f;
constexpr float LN_EPS = 1e-5f;
constexpr int NWAVES = 8, NTHR = 512;

constexpr size_t al(size_t x) { return (x + 0xFFFFFull) & ~(size_t)0xFFFFFull; }
constexpr size_t WS_CTL = 0, CTL_BYTES = 1u << 20;
constexpr size_t WS_WAB = al(WS_CTL + CTL_BYTES);
constexpr size_t WS_WOAB = al(WS_WAB + (size_t)ABN * D * 2);
constexpr size_t WS_WGLU = al(WS_WOAB + (size_t)D * D * 2);
constexpr size_t WS_WC = al(WS_WGLU + (size_t)1024 * 1024 * 2);
constexpr size_t WS_WOC = al(WS_WC + (size_t)CN * D * 2);
constexpr size_t WS_WGU = al(WS_WOC + (size_t)D * D * 2);
constexpr size_t WS_WD = al(WS_WGU + (size_t)2 * NEXP * 1024 * D * 2);
constexpr size_t WS_HA = al(WS_WD + (size_t)2 * NEXP * D * DEXP * 2);
constexpr size_t WS_HB = al(WS_HA + (size_t)LP * D * 4);
constexpr size_t WS_WC8 = WS_HB;
constexpr size_t WS_WOC8 = WS_WC8 + ((size_t)32 << 20);
constexpr size_t WS_MI8 = WS_WC8 + ((size_t)64 << 20);
constexpr size_t WS_H8 = WS_HA;
constexpr size_t WS_HBF = al(WS_HB + (size_t)LP * D * 4);
constexpr size_t WS_PROJ0 = al(WS_HBF + (size_t)LP * D * 2);
static_assert(WS_MI8 + (size_t)LP * D <= WS_HBF, "fp8 copies fit the unused f32 slot");
constexpr size_t WS_QB0 = WS_PROJ0;
constexpr size_t WS_KB0 = al(WS_QB0 + (size_t)LP * 1024 * 2);
constexpr size_t WS_VB0 = al(WS_KB0 + (size_t)LP * 256 * 2);
constexpr size_t WS_MIXIN = al(WS_VB0 + (size_t)LP * 256 * 2);
constexpr size_t WS_MIX = al(WS_MIXIN + (size_t)LP * D * 2);
constexpr size_t WS_Z = al(WS_MIX + (size_t)LP * D * 4);
constexpr size_t WS_ZB = al(WS_Z + (size_t)LP * 1024 * 4);
constexpr size_t WS_GLU = al(WS_ZB + (size_t)LP * 1024 * 2);
constexpr size_t WS_S5P = al(WS_GLU + (size_t)LP * 1024 * 4);
constexpr size_t WS_APOW = al(WS_S5P + (size_t)(2 * 64 * 64 * 8 + 2 * 64 * 64 * 16 * 8));
constexpr size_t WS_KTAB = al(WS_APOW + (size_t)2 * 64 * 64 * 33 * 8);
constexpr size_t WS_MWT = al(WS_KTAB + (size_t)2 * 64 * 32 * 256 * 4);
constexpr size_t WS_WST = al(WS_MWT + (size_t)64 * 512 * 768 * 2);
constexpr size_t WS_ROPE = al(WS_WST + (size_t)64 * 256 * 512 * 2);
constexpr size_t WS_WRT = al(WS_ROPE + (size_t)LP * 64 * 8);
constexpr size_t WS_WRH = al(WS_WRT + (size_t)2 * 96 * 2048 * 4);
constexpr size_t WS_WRL = al(WS_WRH + (size_t)2 * 96 * 2048 * 2);
constexpr size_t WS_LBT = al(WS_WRL + (size_t)2 * 96 * 2048 * 2);
constexpr size_t WS_ROUTE = al(WS_LBT + (size_t)2048 * 4);
constexpr size_t WS_ROWLIST = al(WS_ROUTE + (size_t)LP * 32);
constexpr size_t WS_R1 = al(WS_ROWLIST + (size_t)MPAD * 4);
constexpr size_t R1_BYTES = (size_t)1200 << 20;
constexpr size_t WS_END = WS_R1 + R1_BYTES;
constexpr size_t R1_UA = 0;
constexpr size_t R1_SALL = al((size_t)64 * 768 * 768 * 2);
constexpr size_t R1_QB = 0;
constexpr size_t R1_VB = al(R1_QB + (size_t)LP * D * 2);
constexpr size_t R1_GB = al(R1_VB + (size_t)LP * D * 2);
constexpr size_t R1_F = al(R1_GB + (size_t)LP * D * 2);
constexpr size_t R1_OBW = al(R1_F + (size_t)LP * 4096 * 4);
constexpr size_t R1_DS = al(R1_OBW + (size_t)LP * D * 2);
constexpr size_t R1_DSEG = al(R1_DS + (size_t)32 * 32 * 16384 * 4);
constexpr size_t IMG_SZ = 18432 + 2 * 54272;
constexpr size_t R1_IMG = al(R1_DSEG + (size_t)32 * 32 * 128 * 4);
constexpr size_t R1_GT = al(R1_IMG + (size_t)260 * 16 * IMG_SZ);
constexpr size_t R1_HG_END = R1_GT + (size_t)260 * 16 * 16384;
constexpr size_t R1_XSRT = 0;
constexpr size_t R1_ACT = al((size_t)MPAD * D * 2);
constexpr size_t R1_Y = al(R1_ACT + (size_t)MPAD * DEXP * 2);
constexpr size_t R1_MOE_END = R1_Y + (size_t)MPAD * D * 2;
static_assert(R1_HG_END <= R1_BYTES && R1_MOE_END <= R1_BYTES, "R1 overlays");
static_assert(WS_END <= (size_t)4 << 30, "workspace map must fit 4 GiB");
constexpr int CW_BAR = 4096;
constexpr int CW_CNT = 16384;
constexpr int CW_TS = 65536;
constexpr int CW_PLAN = 32768;

namespace pg8 {
struct EpiProjC {
    static constexpr bool PERM = true, AFTER_DRAIN = false;
    unsigned char* R1; const float* lbt;
    __device__ __forceinline__ void operator()(const f32x4 (&acc)[2][2][4][2], const Unit& u, int wr, int wc, int fr, int fq) const {
        bf16_t* F = (bf16_t*)(R1 + R1_F);
        const int row0 = u.pm * BM + wr * 64 + fr, col0 = u.pn * BM + wc * 32 + 8 * fq;
        const int kind = u.pn < 8 ? 0 : (u.pn < 16 ? 1 : (u.pn < 32 ? 2 : 3));
        if (kind == 2) {
#pragma unroll
            for (int bj = 0; bj < 2; ++bj) { const int col = col0 + bj * HALF - 4096; const f32x4 l0 = *(const f32x4*)(lbt + (col & 2047)), l1 = *(const f32x4*)(lbt + (col & 2047) + 4);
#pragma unroll
                for (int ai = 0; ai < 2; ++ai)
#pragma unroll
                    for (int m = 0; m < 4; ++m) { bf16_t* rowp = F + (size_t)(row0 + ai * HALF + m * 16) * 4096 + col; f32x4 v0 = acc[ai][bj][m][0], v1 = acc[ai][bj][m][1];
#pragma unroll
                        for (int i = 0; i < 4; ++i) { v0[i] = (1.0f - l0[i]) / (1.0f + __expf(v0[i])); v1[i] = (1.0f - l1[i]) / (1.0f + __expf(v1[i])); }
                        u32x4 w; w.x = cvt_pk_bf16(v0[0], v0[1]); w.y = cvt_pk_bf16(v0[2], v0[3]); w.z = cvt_pk_bf16(v1[0], v1[1]); w.w = cvt_pk_bf16(v1[2], v1[3]);
                        *(u32x4*)rowp = w; } }
        } else {
            const size_t ob = kind == 0 ? R1_QB : (kind == 1 ? R1_VB : R1_GB); bf16_t* O = (bf16_t*)(R1 + ob); const int cbase = kind == 0 ? 0 : (kind == 1 ? 2048 : 8192);
#pragma unroll
            for (int ai = 0; ai < 2; ++ai)
#pragma unroll
                for (int m = 0; m < 4; ++m) { bf16_t* rowp = O + (size_t)(row0 + ai * HALF + m * 16) * 2048 + col0 - cbase;
#pragma unroll
                    for (int bj = 0; bj < 2; ++bj) { f32x4 v0 = acc[ai][bj][m][0], v1 = acc[ai][bj][m][1];
                        if (kind == 3) {
#pragma unroll
                            for (int i = 0; i < 4; ++i) { v0[i] = 1.0f / (1.0f + __expf(-v0[i])); v1[i] = 1.0f / (1.0f + __expf(-v1[i])); } }
                        u32x4 w; w.x = cvt_pk_bf16(v0[0], v0[1]); w.y = cvt_pk_bf16(v0[2], v0[3]); w.z = cvt_pk_bf16(v1[0], v1[1]); w.w = cvt_pk_bf16(v1[2], v1[3]);
                        *(u32x4*)(rowp + bj * HALF) = w; } }
        }
    }
};
}

namespace pg8 {
struct EpiProjAB {
    static constexpr bool PERM = false, AFTER_DRAIN = false;
    unsigned char* ws;
    __device__ __forceinline__ void operator()(const f32x4 (&acc)[2][2][4][2], const Unit& u, int wr, int wc, int fr, int fq) const {
        typedef unsigned u32x2 __attribute__((ext_vector_type(2)));
        const int row0 = u.pm * BM + wr * 64 + fr;
        if (u.pn < 5) {
            const float* rope = (const float*)(ws + WS_ROPE); const int d0 = 16 * wc + 4 * fq;
#pragma unroll
            for (int ai = 0; ai < 2; ++ai)
#pragma unroll
                for (int m = 0; m < 4; ++m) { const int row = row0 + ai * HALF + m * 16; const f32x4 cs0 = *(const f32x4*)(rope + ((size_t)row * 64 + d0) * 2), cs1 = *(const f32x4*)(rope + ((size_t)row * 64 + d0) * 2 + 4);
                    const float cc[4] = {cs0[0], cs0[2], cs1[0], cs1[2]}, sn[4] = {cs0[1], cs0[3], cs1[1], cs1[3]};
#pragma unroll
                    for (int bj = 0; bj < 2; ++bj) { const f32x4 x1 = acc[ai][bj][m][0], x2 = acc[ai][bj][m][1]; float o1[4], o2[4];
#pragma unroll
                        for (int i = 0; i < 4; ++i) { o1[i] = x1[i] * cc[i] - x2[i] * sn[i]; o2[i] = x2[i] * cc[i] + x1[i] * sn[i]; }
                        bf16_t* dst = u.pn < 4 ? (bf16_t*)(ws + WS_QB0) + (size_t)row * 1024 + (2 * u.pn + bj) * 128 + d0 : (bf16_t*)(ws + WS_KB0) + (size_t)row * 256 + bj * 128 + d0;
                        u32x2 w1, w2; w1.x = cvt_pk_bf16(o1[0], o1[1]); w1.y = cvt_pk_bf16(o1[2], o1[3]); w2.x = cvt_pk_bf16(o2[0], o2[1]); w2.y = cvt_pk_bf16(o2[2], o2[3]);
                        *(u32x2*)dst = w1; *(u32x2*)(dst + 64) = w2; } }
        } else if (u.pn == 5) {
            const int col0 = wc * 32 + 4 * fq;
#pragma unroll
            for (int ai = 0; ai < 2; ++ai)
#pragma unroll
                for (int m = 0; m < 4; ++m) { bf16_t* rowp = (bf16_t*)(ws + WS_VB0) + (size_t)(row0 + ai * HALF + m * 16) * 256 + col0;
#pragma unroll
                    for (int bj = 0; bj < 2; ++bj)
#pragma unroll
                        for (int n = 0; n < 2; ++n) { const f32x4 v = acc[ai][bj][m][n]; u32x2 w; w.x = cvt_pk_bf16(v[0], v[1]); w.y = cvt_pk_bf16(v[2], v[3]); *(u32x2*)(rowp + bj * HALF + n * 16) = w; } }
        } else {
            bf16_t* UA = (bf16_t*)(ws + WS_R1 + R1_UA); const int col0 = u.pn * BM + wc * 32 + 4 * fq;
#pragma unroll
            for (int ai = 0; ai < 2; ++ai)
#pragma unroll
                for (int m = 0; m < 4; ++m) { const int row = row0 + ai * HALF + m * 16;
                    if (row >= 224) { const int chunk = (row - 224) >> 5, t = (row - 224) & 31;
#pragma unroll
                        for (int bj = 0; bj < 2; ++bj)
#pragma unroll
                            for (int n = 0; n < 2; ++n) { const int ch = col0 + bj * HALF + n * 16 - 1536, g = ch >> 4, cc = ch & 15; const f32x4 v = acc[ai][bj][m][n];
                                u32x2 w; w.x = cvt_pk_bf16(v[0], v[1]); w.y = cvt_pk_bf16(v[2], v[3]);
                                *(u32x2*)(UA + ((size_t)g * 768 + chunk) * 768 + t * 16 + cc) = w; } } }
        }
    }
};
}

#define LAS __attribute__((address_space(3)))
typedef unsigned short bf16;
typedef unsigned v4u __attribute__((ext_vector_type(4)));
typedef unsigned v2u __attribute__((ext_vector_type(2)));
typedef float f32x4 __attribute__((ext_vector_type(4)));
#define LDS_WAIT() asm volatile("s_waitcnt lgkmcnt(0)" ::: "memory")
__device__ __forceinline__ unsigned f2bf(float f) { unsigned u = __builtin_bit_cast(unsigned, f); return (u + 0x7fffu + ((u >> 16) & 1u)) >> 16; }
__device__ __forceinline__ unsigned pk2(float lo, float hi) { return f2bf(lo) | (f2bf(hi) << 16); }
typedef __bf16 bf16x2_t __attribute__((ext_vector_type(2)));
__device__ __forceinline__ unsigned pkbf(float lo, float hi) { bf16x2_t v = {(__bf16)lo, (__bf16)hi}; return __builtin_bit_cast(unsigned, v); }
__device__ __forceinline__ float wave_sum(float v) {
#pragma unroll
    for (int o = 1; o < 64; o <<= 1) v += __shfl_xor(v, o);
    return v;
}
__device__ __forceinline__ float wave_max(float v) {
#pragma unroll
    for (int o = 1; o < 64; o <<= 1) v = fmaxf(v, __shfl_xor(v, o));
    return v;
}
__device__ __forceinline__ float sigmoidf_(float x) { return 1.0f / (1.0f + expf(-x)); }

#define XB_TMO      128
#define XB_XCNT(j)  (256  + 64 * (j))
#define XB_XSUB(j)  (1280 + 64 * (j))
#define XB_XGEN(j)  (2304 + 64 * (j))
#define XB_TOP      3328
#define XB_TOPGEN   3392
#define XCD_BAR_WORDS 3456
#define XB_SPIN_CAP (1u << 22)
__device__ __forceinline__ unsigned xb_ld(unsigned* p)              { return __hip_atomic_load(p, __ATOMIC_RELAXED, __HIP_MEMORY_SCOPE_AGENT); }
__device__ __forceinline__ unsigned xb_add(unsigned* p, unsigned v) { return __hip_atomic_fetch_add(p, v, __ATOMIC_RELAXED, __HIP_MEMORY_SCOPE_AGENT); }
__device__ __forceinline__ unsigned xb_xcc_id() { return (unsigned)__builtin_amdgcn_s_getreg((3 << 11) | 20) & 0xFu; }
#define XB_SPIN(cond, bar) do { unsigned _sp = 0; while (cond) { __builtin_amdgcn_s_sleep(1); \
    if ((++_sp & 255u) == 0u) { if (xb_ld(&(bar)[XB_TMO])) break; if (_sp > XB_SPIN_CAP) { atomicAdd(&(bar)[XB_TMO], 1u); break; } } } } while (0)
struct XcdBarrier { unsigned* bar; unsigned x; volatile LAS unsigned* st; };
__device__ __forceinline__ XcdBarrier xcd_barrier_post(unsigned* bar, volatile LAS unsigned* st) {
    XcdBarrier b; b.bar = bar; b.x = xb_xcc_id(); b.st = st;
    if (threadIdx.x == 0) (void)xb_add(&bar[XB_XCNT(b.x)], 1u);
    return b;
}
__device__ __forceinline__ void xcd_barrier_complete(unsigned* bar, unsigned x, unsigned& nloc, unsigned& nx) {
    const unsigned G = gridDim.x * gridDim.y * gridDim.z;
    unsigned sum, cnt, mine, sp = 0u;
    for (;;) {
        sum = 0u; cnt = 0u; mine = 0u;
#pragma unroll
        for (unsigned j = 0; j < 16; ++j) { const unsigned c = xb_ld(&bar[XB_XCNT(j)]); sum += c; cnt += (c > 0u) ? 1u : 0u; mine = (j == x) ? c : mine; }
        if (sum == G) break;
        __builtin_amdgcn_s_sleep(1);
        if ((++sp & 255u) == 0u) { if (xb_ld(&bar[XB_TMO])) break; if (sp > XB_SPIN_CAP) { atomicAdd(&bar[XB_TMO], 1u); break; } }
    }
    nloc = mine > 0u ? mine : 1u; nx = cnt > 0u ? cnt : 1u;
}
__device__ __forceinline__ void xcd_barrier(const XcdBarrier& b) {
    asm volatile("s_waitcnt vmcnt(0)" ::: "memory");
    __syncthreads();
    if (threadIdx.x == 0) {
        unsigned* bar = b.bar;
        __builtin_amdgcn_s_waitcnt(0);
        unsigned nloc = b.st[0], nx = b.st[1];
        if (nloc == 0u) { xcd_barrier_complete(bar, b.x, nloc, nx); b.st[0] = nloc; b.st[1] = nx; }
        const unsigned old = xb_add(&bar[XB_XSUB(b.x)], 1u);
        const unsigned gen = old / nloc;
        if (old + 1u == (gen + 1u) * nloc) {
            __builtin_amdgcn_fence(__ATOMIC_RELEASE, "agent");
            asm volatile("s_waitcnt vmcnt(0)" ::: "memory");
            const unsigned og = xb_add(&bar[XB_TOP], 1u);
            const unsigned tg = og / nx;
            if (og + 1u == (tg + 1u) * nx) xb_add(&bar[XB_TOPGEN], 1u);
            else XB_SPIN(xb_ld(&bar[XB_TOPGEN]) == tg, bar);
            __builtin_amdgcn_fence(__ATOMIC_ACQUIRE, "agent");
            xb_add(&bar[XB_XGEN(b.x)], 1u);
            asm volatile("s_waitcnt vmcnt(0)" ::: "memory");
        } else {
            XB_SPIN(xb_ld(&bar[XB_XGEN(b.x)]) == gen, bar);
            __builtin_amdgcn_fence(__ATOMIC_ACQUIRE, "agent");
            asm volatile("s_waitcnt vmcnt(0)" ::: "memory");
        }
    }
    __syncthreads();
}

constexpr int RING_BYTES = 131072, LDS_BYTES = 155648, MISC_OFF = 153600;
struct Args { const float* in[29]; float* out; unsigned char* ws; int ph_lo, ph_hi; };
enum In { I_X = 0, I_META, I_WAB, I_WOAB, I_SINK, I_LRE, I_LIM, I_LSTEP, I_BRE, I_BIM, I_CRE, I_CIM, I_S5D, I_WGLU, I_BGLU, I_WC, I_WOC, I_LB, I_NORMG,
          I_LNMG, I_LNMB, I_LNFG, I_LNFB, I_WGRP, I_BGRP, I_WEXP, I_BEXP, I_WGU, I_WD };
struct Ctx { LAS unsigned char* lds; unsigned char* ldsg; int tid, lane, wave, bid, nblk, gw, ngw; };

__device__ __forceinline__ int rowmap_rope(int n) { if (n >= 1280) return n; const int d = n & 127; return (n & ~127) + 32 * ((d & 63) >> 4) + 16 * (d >> 6) + (d & 15); }
__device__ __forceinline__ int rowmap_gu(int n) { return n < 512 ? ((n >> 7) * 256 + (n & 127)) : (((n - 512) >> 7) * 256 + 128 + ((n - 512) & 127)); }
__device__ __forceinline__ void transpose_out(bf16* WT, int ldw, const LAS float* scr, int kb, int nb, int lane, int mode, unsigned char* WT8);
__device__ __forceinline__ void transpose_item(const float* W, int K, int N, bf16* WT, int ldw, LAS float* scr, int kb, int nb, int lane, int mode, unsigned char* WT8 = nullptr) {
    const int k0 = 128 * kb, n0 = 32 * nb;
    const float* wp = W + (size_t)(k0 + (lane >> 5)) * N + n0 + (lane & 31);
#pragma unroll
    for (int hh = 0; hh < 2; ++hh) { float v[32];
#pragma unroll
        for (int i = 0; i < 32; ++i) v[i] = __builtin_nontemporal_load(wp + (size_t)(64 * hh + 2 * i) * N);
#pragma unroll
        for (int i = 0; i < 32; ++i) scr[(64 * hh + 2 * i + (lane >> 5)) * 33 + (lane & 31)] = v[i]; }
    LDS_WAIT(); asm volatile("" ::: "memory");
    transpose_out(WT, ldw, scr, kb, nb, lane, mode, WT8);
}
__device__ __forceinline__ void transpose_out(bf16* WT, int ldw, const LAS float* scr, int kb, int nb, int lane, int mode, unsigned char* WT8) {
    const int k0 = 128 * kb, n0 = 32 * nb;
    if (mode & 12) {
        const int c8 = lane & 7; unsigned char* W8 = (mode & 8) ? WT8 : (unsigned char*)WT;
#pragma unroll
        for (int j = 0; j < 4; ++j) { const int n = (lane >> 3) + 8 * j; const LAS float* sp = scr + (16 * c8) * 33 + n; int w4[4];
#pragma unroll
            for (int q4 = 0; q4 < 4; ++q4) { int t = 0; t = __builtin_amdgcn_cvt_pk_fp8_f32(sp[(4 * q4) * 33] * 64.0f, sp[(4 * q4 + 1) * 33] * 64.0f, t, false);
                t = __builtin_amdgcn_cvt_pk_fp8_f32(sp[(4 * q4 + 2) * 33] * 64.0f, sp[(4 * q4 + 3) * 33] * 64.0f, t, true); w4[q4] = t; }
            const int nn = n0 + n; const int row = (mode & 3) == 1 ? rowmap_gu(nn) : nn;
            *(v4u*)(W8 + (size_t)row * ldw + k0 + 16 * c8) = (v4u){(unsigned)w4[0], (unsigned)w4[1], (unsigned)w4[2], (unsigned)w4[3]}; }
        if (mode & 4) { LDS_WAIT(); asm volatile("" ::: "memory"); return; }
    }
    const int c = lane & 15;
#pragma unroll
    for (int j = 0; j < 8; ++j) { const int n = (lane >> 4) + 4 * j; const LAS float* sp = scr + (8 * c) * 33 + n;
        v4u o; o.x = pkbf(sp[0 * 33], sp[1 * 33]); o.y = pkbf(sp[2 * 33], sp[3 * 33]); o.z = pkbf(sp[4 * 33], sp[5 * 33]); o.w = pkbf(sp[6 * 33], sp[7 * 33]);
        const int nn = n0 + n; const int row = (mode & 3) == 1 ? rowmap_gu(nn) : ((mode & 3) == 2 ? rowmap_rope(nn) : nn);
        *(v4u*)(WT + (size_t)row * ldw + k0 + 8 * c) = o; }
    LDS_WAIT(); asm volatile("" ::: "memory");
}
__device__ __forceinline__ void conv_family(const Ctx& c, const float* src, bf16* dst, int B, int K, int N, int mode, int ldw = 0, unsigned char* dst8 = nullptr, long lo = 0, long hi = -1) {
    if (ldw == 0) ldw = K;
    LAS float* scr = (LAS float*)(c.lds + c.wave * 17408);
    const int nkb = K / 128, nnb = N / 32; const long per = (long)nkb * nnb; if (hi < 0) hi = per * B;
    long it = lo + c.gw; if (it >= hi) return;
    const int lane = c.lane;
    float v[64];
#define CF_ISSUE(IT) do { const int b_ = (int)((IT) / per), r_ = (int)((IT) % per), kb_ = r_ / nnb, nb_ = r_ % nnb; \
        const float* wp_ = src + (size_t)b_ * K * N + (size_t)(128 * kb_ + (lane >> 5)) * N + 32 * nb_ + (lane & 31); \
        _Pragma("unroll") for (int i = 0; i < 64; ++i) v[i] = __builtin_nontemporal_load(wp_ + (size_t)(2 * i) * N); } while (0)
    CF_ISSUE(it);
    for (;;) {
#pragma unroll
        for (int i = 0; i < 64; ++i) scr[(2 * i + (lane >> 5)) * 33 + (lane & 31)] = v[i];
        LDS_WAIT(); asm volatile("" ::: "memory");
        const long nx = it + c.ngw; const bool more = nx < hi;
        if (more) CF_ISSUE(nx);
        const int b = (int)(it / per), r = (int)(it % per), kb = r / nnb, nb = r % nnb;
        bf16* d2 = (mode & 4) ? (bf16*)((unsigned char*)dst + (size_t)b * N * ldw) : dst + (size_t)b * N * ldw;
        transpose_out(d2, ldw, scr, kb, nb, lane, mode, dst8);
        if (!more) break;
        it = nx;
    }
#undef CF_ISSUE
}
constexpr int L1_GU = 64 * 16 * 32, L1_ALL = L1_GU + 64 * 4 * 64;
constexpr int FILL3 = 8192, FILL5 = FILL3 + 1280, FILL6 = FILL5 + 3328, FILL7 = FILL6 + 5120, FILL4 = FILL7 + 254 * 48;
constexpr int R11_LO = FILL4, R11_HI = R11_LO + 255 * 8, R13_LO = R11_HI, R13_HI = R13_LO + 128 * 40, R17_LO = R13_HI, R17_HI = R17_LO + 240 * 8, R21_LO = R17_HI, R21_HI = R21_LO + 255 * 8, FILLX = R21_HI;
static_assert(FILL4 < L1_GU && FILLX > L1_GU && FILLX < L1_ALL, "filler ranges");
__device__ __forceinline__ void conv_l1_item(const Ctx& c, const Args& a, int it) {
    LAS float* scr = (LAS float*)(c.lds + c.wave * 17408);
    if (it < L1_GU) { const int b = it >> 9, r = it & 511; transpose_item(a.in[I_WGU] + (size_t)(NEXP + b) * D * 1024, D, 1024, (bf16*)(a.ws + WS_WGU + (size_t)(NEXP + b) * 1024 * D), D, scr, r >> 5, r & 31, c.lane, 5); }
    else { const int i2 = it - L1_GU, b = i2 >> 8, r = i2 & 255; transpose_item(a.in[I_WD] + (size_t)(NEXP + b) * DEXP * D, DEXP, D, (bf16*)(a.ws + WS_WD + (size_t)(NEXP + b) * D * DEXP), DEXP, scr, r >> 6, r & 63, c.lane, 4); }
}
__device__ __forceinline__ void conv_fill(const Ctx& c, const Args& a, int lo, int hi, int rank, int nranks) {
    const int q = (hi - lo + nranks - 1) / nranks, b0 = lo + rank * q, b1 = (b0 + q) < hi ? (b0 + q) : hi;
    for (int it = b0 + c.wave; it < b1; it += NWAVES) conv_l1_item(c, a, it);
    __syncthreads();
}
__device__ __forceinline__ void phase_weights(const Ctx& c, const Args& a) {
    unsigned char* ws = a.ws;
    conv_family(c, a.in[I_WAB], (bf16*)(ws + WS_WAB), 1, D, ABN, 2);
    conv_family(c, a.in[I_WOAB], (bf16*)(ws + WS_WOAB), 1, D, D, 0);
    conv_family(c, a.in[I_WGLU], (bf16*)(ws + WS_WGLU), 1, 1024, 1024, 0);
    conv_family(c, a.in[I_WC], (bf16*)(ws + WS_WC), 1, D, CN, 8, 0, ws + WS_WC8);
    conv_family(c, a.in[I_WOC], (bf16*)(ws + WS_WOC), 1, D, D, 8, 0, ws + WS_WOC8);
    conv_family(c, a.in[I_WGU], (bf16*)(ws + WS_WGU), NEXP, D, 1024, 5);
    conv_family(c, a.in[I_WD], (bf16*)(ws + WS_WD), NEXP, DEXP, D, 4);
    if (c.nblk != 256) conv_family(c, a.in[I_WGU] + (size_t)NEXP * D * 1024, (bf16*)(ws + WS_WGU + (size_t)NEXP * 1024 * D), NEXP, D, 1024, 5);
    conv_family(c, a.in[I_WD] + (size_t)NEXP * DEXP * D, (bf16*)(ws + WS_WD + (size_t)NEXP * D * DEXP), NEXP, DEXP, D, 4, 0, nullptr, c.nblk == 256 ? FILLX - L1_GU : 0);
}
__device__ __forceinline__ void phase_init(const Ctx& c, const Args& a) {
    bf16* HB = (bf16*)(a.ws + WS_HBF);
    for (int row = c.gw; row < LP; row += c.ngw) {
        const float* src = row < ROWV ? nullptr : (row < 256 ? a.in[I_META] + (size_t)(row - ROWV) * D : a.in[I_X] + (size_t)(row - 256) * D);
#pragma unroll
        for (int j = 0; j < 8; ++j) { const int idx = (j * 64 + c.lane) * 4; f32x4 v = src ? *(const f32x4*)(src + idx) : (f32x4){0.f, 0.f, 0.f, 0.f};
            v2u w; w.x = pkbf(v.x, v.y); w.y = pkbf(v.z, v.w); *(v2u*)(HB + (size_t)row * D + idx) = w; }
    }
    float2* rope = (float2*)(a.ws + WS_ROPE);
    for (long i = (long)c.bid * NTHR + c.tid; i < (long)LP * 64; i += (long)c.nblk * NTHR) {
        const int row = (int)(i >> 6), k = (int)(i & 63);
        const float inv = powf(10000.0f, -(float)k * 2.0f / 128.0f);
        const float ang = (float)(row - ROWV) * inv;
        float s, co; sincosf(ang, &s, &co); rope[i] = make_float2(co, s);
    }
    { float* wrt = (float*)(a.ws + WS_WRT);
      for (int i = c.bid * NTHR + c.tid; i < 2 * 96 * 2048; i += c.nblk * NTHR) { const int k = i & 2047, j = (i >> 11) % 96, layer = i / (96 * 2048);
          const float wv = j < 8 ? a.in[I_WGRP][((size_t)layer * D + k) * 8 + j] : (j < 72 ? a.in[I_WEXP][((size_t)layer * D + k) * 64 + (j - 8)] : 0.f); wrt[i] = wv;
          const unsigned hb = f2bf(wv); const float hf = __uint_as_float(hb << 16); ((bf16*)(a.ws + WS_WRH))[i] = (bf16)hb; ((bf16*)(a.ws + WS_WRL))[i] = (bf16)f2bf(wv - hf); } }
    { float* lbt = (float*)(a.ws + WS_LBT);
      for (int i = c.bid * NTHR + c.tid; i < D; i += c.nblk * NTHR) lbt[i] = 1.0f / (1.0f + expf(a.in[I_LB][i] - a.in[I_LB][D + i])); }
    float2* abar = (float2*)(a.ws + WS_S5P); float2* bbar = abar + 2 * 64 * 64;
    for (int i = c.bid * NTHR + c.tid; i < 2 * 64 * 64; i += c.nblk * NTHR) {
        const int dg = i >> 6;
        const double lr = fmin((double)a.in[I_LRE][i], -1e-4), li = (double)a.in[I_LIM][i], st = exp((double)a.in[I_LSTEP][dg]);
        const double er = exp(lr * st), ar = er * cos(li * st), ai = er * sin(li * st);
        const double den = lr * lr + li * li, cr = ((ar - 1.0) * lr + ai * li) / den, ci = (ai * lr - (ar - 1.0) * li) / den;
        abar[i] = make_float2((float)ar, (float)ai);
        for (int cc = 0; cc < 16; ++cc) { const double br = a.in[I_BRE][(size_t)i * 16 + cc], bi = a.in[I_BIM][(size_t)i * 16 + cc];
            bbar[(size_t)i * 16 + cc] = make_float2((float)(cr * br - ci * bi), (float)(cr * bi + ci * br)); }
    }
    for (int j = c.bid * NTHR + c.tid; j < 2 * 64 * 64 * 33; j += c.nblk * NTHR) { const int i = j / 33, tau = j % 33, dg = i >> 6;
        const double lr = fmin((double)a.in[I_LRE][i], -1e-4), li = (double)a.in[I_LIM][i], st = exp((double)a.in[I_LSTEP][dg]);
        const double m = exp(lr * st * tau); ((float2*)(a.ws + WS_APOW))[j] = make_float2((float)(m * cos(li * st * tau)), (float)(m * sin(li * st * tau))); }
}
typedef short bf16x8 __attribute__((ext_vector_type(8)));
constexpr int HG_VT = 0, HG_QT = 18432, HG_KT = 35840, HG_KH = 53248, HG_DV = 71680, HB_SZ = 72704, HG_SCR = 2 * HB_SZ;
constexpr int LD_K = 272, LD_T = 144;
__device__ __forceinline__ bf16x8 ldfrag(LAS unsigned char* base, int row, int pitch, int kbyte) { return *(const LAS bf16x8*)(base + row * pitch + kbyte); }
#define MFMA16(a, b, c) __builtin_amdgcn_mfma_f32_16x16x32_bf16((a), (b), (c), 0, 0, 0)
constexpr int AT_K = 0, AT_VT = 17408;
__device__ __forceinline__ void phase_attn(const Ctx& c, const Args& a) {
    const bf16* QB = (const bf16*)(a.ws + WS_QB0); const bf16* KB = (const bf16*)(a.ws + WS_KB0); const bf16* VB = (const bf16*)(a.ws + WS_VB0); bf16* MI = (bf16*)(a.ws + WS_MIXIN);
    LAS unsigned char* L = c.lds;
    const int w = c.wave, hr = w >> 1, qh = w & 1;
    const float C2 = 0.08838834764831845f * 1.4426950408889634f;
    for (int u = c.bid; u < 514; u += c.nblk) {
        int tv = c.tid; asm volatile("" : "+v"(tv));
        const int r = tv & 15, gq = (tv >> 4) & 3;
        const int skey = tv >> 3, sc16 = tv & 7;
        const int sd = tv & 127, skq = tv >> 7;
        const int g = u & 1, qb = u >> 1, r0 = 192 + 64 * qb, h = 4 * g + hr, rq0 = r0 + 32 * qh;
        const int klo = (r0 / 64 - 2) < 4 ? 4 : (r0 / 64 - 2), khi = (r0 / 64 + 2) > 259 ? 259 : (r0 / 64 + 2), ntile = 1 + (khi - klo + 1);
        bf16x8 qf[2][4];
#pragma unroll
        for (int qt = 0; qt < 2; ++qt)
#pragma unroll
            for (int ks = 0; ks < 4; ++ks) qf[qt][ks] = *(const bf16x8*)(QB + (size_t)(rq0 + 16 * qt + r) * 1024 + h * 128 + 32 * ks + 8 * gq);
        const float sink2 = a.in[I_SINK][h] * 1.4426950408889634f;
        float mrun[2] = {sink2, sink2}, lsum[2] = {gq == 0 ? 1.f : 0.f, gq == 0 ? 1.f : 0.f};
        f32x4 O[2][8];
#pragma unroll
        for (int qt = 0; qt < 2; ++qt)
#pragma unroll
            for (int dt = 0; dt < 8; ++dt) O[qt][dt] = (f32x4){0.f, 0.f, 0.f, 0.f};
        v4u kraw[2]; unsigned short vraw[16];
#define AT_LOAD(kt_) do { const bf16* kp = KB + (size_t)(64 * (kt_) + skey) * 256 + g * 128 + 16 * sc16; kraw[0] = *(const v4u*)kp; kraw[1] = *(const v4u*)(kp + 8); \
            const bf16* vp = VB + (size_t)(64 * (kt_) + 16 * skq) * 256 + g * 128 + sd; _Pragma("unroll") for (int i = 0; i < 16; ++i) vraw[i] = vp[(size_t)i * 256]; } while (0)
        AT_LOAD(3);
        for (int ti = 0; ti < ntile; ++ti) {
            const int kt = ti == 0 ? 3 : klo + ti - 1;
            { *(LAS v4u*)(L + AT_K + skey * LD_K + 32 * sc16) = kraw[0]; *(LAS v4u*)(L + AT_K + skey * LD_K + 32 * sc16 + 16) = kraw[1];
              v4u v0, v1; v0.x = vraw[0] | ((unsigned)vraw[1] << 16); v0.y = vraw[2] | ((unsigned)vraw[3] << 16); v0.z = vraw[4] | ((unsigned)vraw[5] << 16); v0.w = vraw[6] | ((unsigned)vraw[7] << 16);
              v1.x = vraw[8] | ((unsigned)vraw[9] << 16); v1.y = vraw[10] | ((unsigned)vraw[11] << 16); v1.z = vraw[12] | ((unsigned)vraw[13] << 16); v1.w = vraw[14] | ((unsigned)vraw[15] << 16);
              *(LAS v4u*)(L + AT_VT + sd * LD_T + 32 * skq) = v0; *(LAS v4u*)(L + AT_VT + sd * LD_T + 32 * skq + 16) = v1; }
            if (ti + 1 < ntile) AT_LOAD(klo + ti);
            __syncthreads();
            bf16x8 pf[2][2];
#pragma unroll
            for (int qt = 0; qt < 2; ++qt) {
                f32x4 sc[4];
#pragma unroll
                for (int ki = 0; ki < 4; ++ki) sc[ki] = (f32x4){0.f, 0.f, 0.f, 0.f};
#pragma unroll
                for (int ks = 0; ks < 4; ++ks)
#pragma unroll
                    for (int ki = 0; ki < 4; ++ki) { const bf16x8 kf = ldfrag(L + AT_K, 16 * ki + r, LD_K, (32 * ks + 8 * gq) * 2); sc[ki] = MFMA16(kf, qf[qt][ks], sc[ki]); }
                const int rq = rq0 + 16 * qt + r; float tmax = -3.0e38f;
#pragma unroll
                for (int ki = 0; ki < 4; ++ki)
#pragma unroll
                    for (int e = 0; e < 4; ++e) { const int rk = 64 * kt + 16 * ki + 4 * gq + e; const int dd = rq - rk;
                        const bool ok = ti == 0 ? (rk >= ROWV) : (rk >= 256 && dd <= 128 && dd >= -128);
                        const float v = ok ? sc[ki][e] * C2 : -3.0e38f; sc[ki][e] = v; tmax = fmaxf(tmax, v); }
                tmax = fmaxf(tmax, __shfl_xor(tmax, 16)); tmax = fmaxf(tmax, __shfl_xor(tmax, 32));
                const float mn = fmaxf(mrun[qt], tmax), alpha = exp2f(mrun[qt] - mn); mrun[qt] = mn;
                float ps = 0.f;
#pragma unroll
                for (int ki = 0; ki < 4; ++ki)
#pragma unroll
                    for (int e = 0; e < 4; ++e) { const float pv = exp2f(sc[ki][e] - mn); sc[ki][e] = pv; ps += pv; }
                lsum[qt] = lsum[qt] * alpha + ps;
#pragma unroll
                for (int dt = 0; dt < 8; ++dt) O[qt][dt] = O[qt][dt] * alpha;
#pragma unroll
                for (int kk = 0; kk < 2; ++kk) { v4u t; t.x = pkbf(sc[2 * kk][0], sc[2 * kk][1]); t.y = pkbf(sc[2 * kk][2], sc[2 * kk][3]);
                    t.z = pkbf(sc[2 * kk + 1][0], sc[2 * kk + 1][1]); t.w = pkbf(sc[2 * kk + 1][2], sc[2 * kk + 1][3]); pf[qt][kk] = __builtin_bit_cast(bf16x8, t); }
            }
#pragma unroll
            for (int dt = 0; dt < 8; ++dt)
#pragma unroll
                for (int kk = 0; kk < 2; ++kk) { const LAS unsigned char* vp = L + AT_VT + (16 * dt + r) * LD_T + (32 * kk + 4 * gq) * 2;
                    const v2u lo = *(const LAS v2u*)vp, hi = *(const LAS v2u*)(vp + 32); const v4u t = (v4u){lo.x, lo.y, hi.x, hi.y}; const bf16x8 vf = __builtin_bit_cast(bf16x8, t);
                    O[0][dt] = MFMA16(vf, pf[0][kk], O[0][dt]); O[1][dt] = MFMA16(vf, pf[1][kk], O[1][dt]); }
            __syncthreads();
        }
#undef AT_LOAD
#pragma unroll
        for (int qt = 0; qt < 2; ++qt) { float l = lsum[qt]; l += __shfl_xor(l, 16); l += __shfl_xor(l, 32); const float inv = 1.0f / l; const int rq = rq0 + 16 * qt + r;
            if (rq >= ROWV) {
#pragma unroll
                for (int dt = 0; dt < 8; ++dt) { v2u o; o.x = pkbf(O[qt][dt][0] * inv, O[qt][dt][1] * inv); o.y = pkbf(O[qt][dt][2] * inv, O[qt][dt][3] * inv);
                    *(v2u*)(MI + (size_t)rq * D + h * 128 + 16 * dt + 4 * gq) = o; } } }
    }
    for (int i = c.bid * NTHR + c.tid; i < ROWV * D / 8; i += c.nblk * NTHR) ((v4u*)MI)[i] = (v4u){0u, 0u, 0u, 0u};
}
__device__ __forceinline__ void phase_s5_ktab(const Ctx& c, const Args& a) {
    const float2* abar = (const float2*)(a.ws + WS_S5P); const float2* bbar = abar + 2 * 64 * 64; const float2* apow = (const float2*)(a.ws + WS_APOW);
    float* KT = (float*)(a.ws + WS_KTAB);
    LAS float* Lb = (LAS float*)c.lds;
    LAS float* La = Lb + 2048;
    LAS float* Lc = La + 2048;
    for (int u = c.bid; u < 256; u += c.nblk) {
        const int dg = u >> 1, th = u & 1;
        __syncthreads();
        for (int i = c.tid; i < 1024; i += NTHR) { const float2 v = bbar[(size_t)dg * 1024 + i]; Lb[2 * i] = v.x; Lb[2 * i + 1] = v.y; }
        for (int i = c.tid; i < 1024; i += NTHR) { const int p = i >> 4, tl = i & 15; const float2 v = apow[((size_t)dg * 64 + p) * 33 + 16 * th + tl]; La[2 * i] = v.x; La[2 * i + 1] = v.y; }
        for (int i = c.tid; i < 1024; i += NTHR) { Lc[i] = a.in[I_CRE][(size_t)dg * 1024 + i]; Lc[1024 + i] = a.in[I_CIM][(size_t)dg * 1024 + i]; }
        __syncthreads();
        const int tl = c.tid >> 5, c1 = (c.tid & 31) >> 1, c20 = (c.tid & 1) * 8;
        float sum[8];
#pragma unroll
        for (int j = 0; j < 8; ++j) sum[j] = 0.f;
        for (int p = 0; p < 64; ++p) { const float apx = La[(p * 16 + tl) * 2], apy = La[(p * 16 + tl) * 2 + 1], cr = Lc[c1 * 64 + p], ci = Lc[1024 + c1 * 64 + p];
            const float wr_ = cr * apx - ci * apy, wi_ = cr * apy + ci * apx;
#pragma unroll
            for (int j = 0; j < 8; ++j) sum[j] += wr_ * Lb[(p * 16 + c20 + j) * 2] - wi_ * Lb[(p * 16 + c20 + j) * 2 + 1]; }
        float* dst = KT + ((((size_t)dg * 32 + 16 * th + tl) * 16 + c1) * 16 + c20);
        *(f32x4*)dst = (f32x4){sum[0], sum[1], sum[2], sum[3]}; *(f32x4*)(dst + 4) = (f32x4){sum[4], sum[5], sum[6], sum[7]};
    }
    __syncthreads();
}
__device__ __forceinline__ void phase_s5_fill(const Ctx& c, const Args& a) {
    const float2* abar = (const float2*)(a.ws + WS_S5P); const float2* bbar = abar + 2 * 64 * 64; const float2* apow = (const float2*)(a.ws + WS_APOW);
    const float* KT = (const float*)(a.ws + WS_KTAB); bf16* MWT = (bf16*)(a.ws + WS_MWT); bf16* WST = (bf16*)(a.ws + WS_WST);
    for (long it = (long)c.bid * NTHR + c.tid; it < (long)64 * 512 * 96; it += (long)c.nblk * NTHR) {
        const int kb = (int)(it % 96), n = (int)((it / 96) % 512), g = (int)(it / (96 * 512)), t = n >> 4, c1 = n & 15;
        float v[8];
        if (kb < 64) { const int s2 = kb >> 1, c2 = (kb & 1) * 8;
            if (s2 < t) { const float* k0 = KT + ((((size_t)(0 * 64 + g)) * 32 + (t - s2)) * 16 + c1) * 16 + c2;
#pragma unroll
                for (int i = 0; i < 8; ++i) v[i] = k0[i]; }
            else if (s2 > t) { const float* k0 = KT + ((((size_t)(1 * 64 + g)) * 32 + (s2 - t)) * 16 + c1) * 16 + c2;
#pragma unroll
                for (int i = 0; i < 8; ++i) v[i] = k0[i]; }
            else { const float* k0 = KT + ((((size_t)(0 * 64 + g)) * 32) * 16 + c1) * 16 + c2; const float* k1 = KT + ((((size_t)(1 * 64 + g)) * 32) * 16 + c1) * 16 + c2;
#pragma unroll
                for (int i = 0; i < 8; ++i) v[i] = k0[i] + k1[i] + ((c2 + i) == c1 ? a.in[I_S5D][16 * g + c1] : 0.f); }
        } else { const int j0 = (kb - 64) * 8, qd = j0 >> 6, dir = qd >> 1, p0 = j0 & 63, tau = dir == 0 ? t + 1 : 32 - t;
            const float* cr = a.in[I_CRE] + ((size_t)(dir * 64 + g) * 16 + c1) * 64; const float* ci = a.in[I_CIM] + ((size_t)(dir * 64 + g) * 16 + c1) * 64;
#pragma unroll
            for (int i = 0; i < 8; ++i) { const int p = p0 + i; const float2 ap = apow[((size_t)(dir * 64 + g) * 64 + p) * 33 + tau];
                v[i] = (qd & 1) == 0 ? (cr[p] * ap.x - ci[p] * ap.y) : -(cr[p] * ap.y + ci[p] * ap.x); }
        }
        v4u o; o.x = pk2(v[0], v[1]); o.y = pk2(v[2], v[3]); o.z = pk2(v[4], v[5]); o.w = pk2(v[6], v[7]);
        *(v4u*)(MWT + ((size_t)g * 512 + n) * 768 + kb * 8) = o;
    }
    for (long it = (long)c.bid * NTHR + c.tid; it < (long)64 * 256 * 64; it += (long)c.nblk * NTHR) {
        const int kb = (int)(it & 63), n = (int)((it >> 6) & 255), g = (int)(it >> 14), s2 = kb >> 1, c2 = (kb & 1) * 8, qd = n >> 6, dir = qd >> 1, p = n & 63;
        const int tau = dir == 0 ? 31 - s2 : s2; const size_t i = (size_t)(dir * 64 + g) * 64 + p; const float2 ap = apow[i * 33 + tau];
        float v[8];
#pragma unroll
        for (int e = 0; e < 8; ++e) { const float2 bb = bbar[i * 16 + c2 + e]; v[e] = (qd & 1) == 0 ? (ap.x * bb.x - ap.y * bb.y) : (ap.x * bb.y + ap.y * bb.x); }
        v4u o; o.x = pk2(v[0], v[1]); o.y = pk2(v[2], v[3]); o.z = pk2(v[4], v[5]); o.w = pk2(v[6], v[7]);
        *(v4u*)(WST + ((size_t)g * 256 + n) * 512 + kb * 8) = o;
    }
    bf16* ZB = (bf16*)(a.ws + WS_ZB);
    for (int i = c.bid * NTHR + c.tid; i < 224 * 1024 / 8; i += c.nblk * NTHR) ((v4u*)ZB)[i] = (v4u){0u, 0u, 0u, 0u};
}
__device__ __forceinline__ void phase_s5_chunkscan(const Ctx& c, const Args& a) {
    if (c.bid >= 128) return;
    const int g = c.bid & 63, dir = c.bid >> 6, p = c.lane, w = c.wave;
    const float2 a32 = ((const float2*)(a.ws + WS_APOW))[((size_t)(dir * 64 + g) * 64 + p) * 33 + 32];
    const float* S = (const float*)(a.ws + WS_R1 + R1_SALL) + (size_t)g * 768 * 256 + dir * 128 + p;
    bf16* UA = (bf16*)(a.ws + WS_R1 + R1_UA) + (size_t)g * 768 * 768 + 512 + dir * 128 + p;
    LAS float* E = (LAS float*)c.lds; LAS float* PW = E + 2 * 8 * 64;
    const int j0 = 65 * w, j1 = (j0 + 65) < 513 ? (j0 + 65) : 513, len = j1 - j0;
    float xr = 0.f, xi = 0.f, pr = 1.f, pi = 0.f;
    for (int b = 0; b < 5; ++b) { float sr[13], si[13];
#pragma unroll
        for (int i = 0; i < 13; ++i) { const int o = b * 13 + i; const int j = dir == 0 ? j0 + o : j1 - 1 - o; const bool ok = o < len; sr[i] = ok ? S[(size_t)j * 256] : 0.f; si[i] = ok ? S[(size_t)j * 256 + 64] : 0.f; }
#pragma unroll
        for (int i = 0; i < 13; ++i) { if (b * 13 + i < len) { const float nr = a32.x * xr - a32.y * xi + sr[i], ni = a32.x * xi + a32.y * xr + si[i]; xr = nr; xi = ni;
                const float qr = a32.x * pr - a32.y * pi, qi = a32.x * pi + a32.y * pr; pr = qr; pi = qi; } }
    }
    E[w * 128 + p] = xr; E[w * 128 + 64 + p] = xi; PW[w * 128 + p] = pr; PW[w * 128 + 64 + p] = pi;
    __syncthreads();
    float cr = 0.f, ci = 0.f;
    if (dir == 0) { for (int w2 = 0; w2 < w; ++w2) { const float2 e = make_float2(E[w2 * 128 + p], E[w2 * 128 + 64 + p]), q = make_float2(PW[w2 * 128 + p], PW[w2 * 128 + 64 + p]); const float nr = q.x * cr - q.y * ci + e.x, ni = q.x * ci + q.y * cr + e.y; cr = nr; ci = ni; } }
    else { for (int w2 = 7; w2 > w; --w2) { const float2 e = make_float2(E[w2 * 128 + p], E[w2 * 128 + 64 + p]), q = make_float2(PW[w2 * 128 + p], PW[w2 * 128 + 64 + p]); const float nr = q.x * cr - q.y * ci + e.x, ni = q.x * ci + q.y * cr + e.y; cr = nr; ci = ni; } }
    xr = cr; xi = ci;
    for (int b = 0; b < 5; ++b) { float sr[13], si[13];
#pragma unroll
        for (int i = 0; i < 13; ++i) { const int o = b * 13 + i; const int j = dir == 0 ? j0 + o : j1 - 1 - o; const bool ok = o < len; sr[i] = ok ? S[(size_t)j * 256] : 0.f; si[i] = ok ? S[(size_t)j * 256 + 64] : 0.f; }
#pragma unroll
        for (int i = 0; i < 13; ++i) { const int o = b * 13 + i; if (o < len) { const int j = dir == 0 ? j0 + o : j1 - 1 - o;
                UA[(size_t)j * 768] = (bf16)f2bf(xr); UA[(size_t)j * 768 + 64] = (bf16)f2bf(xi);
                const float nr = a32.x * xr - a32.y * xi + sr[i], ni = a32.x * xi + a32.y * xr + si[i]; xr = nr; xi = ni; } }
    }
}
template <class F> __device__ __forceinline__ void skinny_gemm(const Ctx& c, const bf16* A, int lda, const bf16* Wt, int K, int N, const F& f) {
    int tv = c.tid; asm volatile("" : "+v"(tv));
    const int r = tv & 15, q = (tv >> 4) & 3;
    for (int tile = c.gw; tile < N / 16; tile += c.ngw) {
        f32x4 acc = (f32x4){0.f, 0.f, 0.f, 0.f};
        const bf16* ap = A + (size_t)(ROWV + r) * lda + 8 * q; const bf16* bp = Wt + (size_t)(16 * tile + r) * K + 8 * q;
        for (int ks = 0; ks < K / 32; ks += 8) { bf16x8 af[8], bfr[8];
#pragma unroll
            for (int i = 0; i < 8; ++i) { af[i] = *(const bf16x8*)(ap + (ks + i) * 32); bfr[i] = *(const bf16x8*)(bp + (ks + i) * 32); }
#pragma unroll
            for (int i = 0; i < 8; ++i) acc = MFMA16(af[i], bfr[i], acc); }
#pragma unroll
        for (int e = 0; e < 4; ++e) f(ROWV + 4 * q + e, 16 * tile + r, acc[e]);
    }
}
template <class F> __device__ __forceinline__ void skinny_gemm2(const Ctx& c, const bf16* A, int lda, const bf16* Wt, int K, int N, const F& f) {
    int tv = c.tid; asm volatile("" : "+v"(tv));
    const int r = tv & 15, q = (tv >> 4) & 3;
    for (int pt = c.gw; pt < N / 32; pt += c.ngw) {
        f32x4 acc0 = (f32x4){0.f, 0.f, 0.f, 0.f}, acc1 = (f32x4){0.f, 0.f, 0.f, 0.f};
        const bf16* ap = A + (size_t)(ROWV + r) * lda + 8 * q; const bf16* bp = Wt + (size_t)(32 * pt + r) * K + 8 * q;
        for (int ks = 0; ks < K / 32; ks += 4) { bf16x8 af[4], b0[4], b1[4];
#pragma unroll
            for (int i = 0; i < 4; ++i) { af[i] = *(const bf16x8*)(ap + (ks + i) * 32); b0[i] = *(const bf16x8*)(bp + (ks + i) * 32); b1[i] = *(const bf16x8*)(bp + (size_t)16 * K + (ks + i) * 32); }
#pragma unroll
            for (int i = 0; i < 4; ++i) { acc0 = MFMA16(af[i], b0[i], acc0); acc1 = MFMA16(af[i], b1[i], acc1); } }
#pragma unroll
        for (int e = 0; e < 4; ++e) f(ROWV + 4 * q + e, 32 * pt + r, acc0[e], acc1[e]);
    }
}
struct SkAB2 { unsigned char* ws; __device__ __forceinline__ void operator()(int row, int n0, float v0, float v1) const {
    if (n0 < 1280) { const int hb = n0 >> 7, d = 16 * ((n0 & 127) >> 5) + (n0 & 15); const float2 cs = ((const float2*)(ws + WS_ROPE))[(size_t)row * 64 + d];
        const float o1 = v0 * cs.x - v1 * cs.y, o2 = v1 * cs.x + v0 * cs.y;
        bf16* dst = hb < 8 ? (bf16*)(ws + WS_QB0) + (size_t)row * 1024 + hb * 128 + d : (bf16*)(ws + WS_KB0) + (size_t)row * 256 + (hb - 8) * 128 + d;
        dst[0] = (bf16)f2bf(o1); dst[64] = (bf16)f2bf(o2); }
    else if (n0 < 1536) { bf16* dst = (bf16*)(ws + WS_VB0) + (size_t)row * 256 + n0 - 1280; dst[0] = (bf16)f2bf(v0); dst[16] = (bf16)f2bf(v1); }
    else { bf16* UA = (bf16*)(ws + WS_R1 + R1_UA); const int ch = n0 - 1536, ch1 = ch + 16;
        UA[((size_t)(ch >> 4) * 768) * 768 + (16 + row - ROWV) * 16 + (ch & 15)] = (bf16)f2bf(v0); UA[((size_t)(ch1 >> 4) * 768) * 768 + (16 + row - ROWV) * 16 + (ch1 & 15)] = (bf16)f2bf(v1); } } };
struct SkAB { float* C; bf16* UA; __device__ __forceinline__ void operator()(int row, int n, float v) const {
    if (n < 1536) C[(size_t)row * ABN + n] = v; else { const int ch = n - 1536; UA[((size_t)(ch >> 4) * 768) * 768 + (16 + row - ROWV) * 16 + (ch & 15)] = (bf16)f2bf(v); } } };
struct SkGlu { const bf16* ZB; const float* bias; bf16* O; __device__ __forceinline__ void operator()(int row, int n, float v) const {
    const float z = __uint_as_float((unsigned)ZB[(size_t)row * 1024 + n] << 16); O[(size_t)row * D + 1024 + n] = (bf16)f2bf(z / (1.0f + __expf(-(v + bias[n])))); } };
struct SkBf16 { bf16* O; int ldc; __device__ __forceinline__ void operator()(int row, int n, float v) const { O[(size_t)row * ldc + n] = (bf16)f2bf(v); } };
struct SkC { bf16* QB; bf16* VB; bf16* GB; bf16* F; const float* lbt; __device__ __forceinline__ void operator()(int row, int n, float v) const {
    if (n < 2048) QB[(size_t)row * D + n] = (bf16)f2bf(v);
    else if (n < 4096) VB[(size_t)row * D + n - 2048] = (bf16)f2bf(v);
    else if (n < 8192) { const float lb = lbt[n & 2047]; F[(size_t)row * 4096 + n - 4096] = (bf16)f2bf((1.0f - lb) / (1.0f + __expf(v))); }
    else GB[(size_t)row * D + n - 8192] = (bf16)f2bf(1.0f / (1.0f + __expf(-v))); } };
__device__ __forceinline__ void zero_rows_bf16(const Ctx& c, bf16* B, int ld, int r0, int r1) {
    const int per = ld / 8;
    for (int i = c.bid * NTHR + c.tid; i < (r1 - r0) * per; i += c.nblk * NTHR) *(v4u*)(B + (size_t)(r0 + i / per) * ld + (i % per) * 8) = (v4u){0u, 0u, 0u, 0u};
}
__device__ __forceinline__ void zero_rows_f32(const Ctx& c, float* B, int ld, int r0, int r1, int ncols) {
    const int per = ncols / 4;
    for (int i = c.bid * NTHR + c.tid; i < (r1 - r0) * per; i += c.nblk * NTHR) *(f32x4*)(B + (size_t)(r0 + i / per) * ld + (i % per) * 4) = (f32x4){0.f, 0.f, 0.f, 0.f};
}
#ifdef PROBE_MASK
#ifndef PROBE_BARMASK
#define PROBE_BARMASK 0ull
#endif
#define PROBE_SCALE g_probe_scale
#define PROBE_DECL , float g_probe_scale
#define PROBE_PASS , g_probe_scale
#define PROBE_ONE , 1.0f
#else
#define PROBE_SCALE 1.0f
#define PROBE_DECL
#define PROBE_PASS
#define PROBE_ONE
#endif
typedef int v4i_ __attribute__((ext_vector_type(4)));
__device__ __forceinline__ f32x4 bf4(v2u w) { return (f32x4){__uint_as_float(w.x << 16), __uint_as_float(w.x & 0xffff0000u), __uint_as_float(w.y << 16), __uint_as_float(w.y & 0xffff0000u)}; }
struct LnSrc { const bf16* h; const bf16* add; const bf16* y0; const bf16* y1; float w0, w1; };
struct LnDst { bf16* hb; unsigned char* h8; float* dout; };
template <bool FFN> __device__ __forceinline__ void ln_pair(const LnSrc& A, const LnSrc& B, const float* gam, const float* bet, const LnDst& oA, const LnDst& oB, bool hasB, int lane PROBE_DECL) {
    f32x4 va[8], vb[8]; float sa = 0.f, sb = 0.f;
#pragma unroll
    for (int j = 0; j < 8; ++j) { const int idx = (j * 64 + lane) * 4;
        f32x4 xa = bf4(*(const v2u*)(A.h + idx)) * DN_ALPHA, xb = bf4(*(const v2u*)(B.h + idx)) * DN_ALPHA;
        if (FFN) { xa += bf4(*(const v2u*)(A.y0 + idx)) * A.w0 + bf4(*(const v2u*)(A.y1 + idx)) * A.w1; xb += bf4(*(const v2u*)(B.y0 + idx)) * B.w0 + bf4(*(const v2u*)(B.y1 + idx)) * B.w1; }
        else { xa += bf4(*(const v2u*)(A.add + idx)); xb += bf4(*(const v2u*)(B.add + idx)); }
        va[j] = xa; vb[j] = xb; sa += (xa.x + xa.y) + (xa.z + xa.w); sb += (xb.x + xb.y) + (xb.z + xb.w); }
    const float ma = wave_sum(sa) * (1.0f / D), mb = wave_sum(sb) * (1.0f / D); float qa = 0.f, qb = 0.f;
#pragma unroll
    for (int j = 0; j < 8; ++j) { va[j] = va[j] - ma; vb[j] = vb[j] - mb; qa += (va[j].x * va[j].x + va[j].y * va[j].y) + (va[j].z * va[j].z + va[j].w * va[j].w); qb += (vb[j].x * vb[j].x + vb[j].y * vb[j].y) + (vb[j].z * vb[j].z + vb[j].w * vb[j].w); }
    const float ra = 1.0f / sqrtf(wave_sum(qa) * (1.0f / D) + LN_EPS), rb = 1.0f / sqrtf(wave_sum(qb) * (1.0f / D) + LN_EPS);
#pragma unroll
    for (int j = 0; j < 8; ++j) { const int idx = (j * 64 + lane) * 4; const f32x4 g = *(const f32x4*)(gam + idx), b = *(const f32x4*)(bet + idx);
        const f32x4 o = va[j] * ra * g + b, p = vb[j] * rb * g + b;
        if (oA.hb) { v2u w; w.x = pk2(o.x, o.y); w.y = pk2(o.z, o.w); *(v2u*)(oA.hb + idx) = w; int t = 0; t = __builtin_amdgcn_cvt_pk_fp8_f32(o.x, o.y, t, false); t = __builtin_amdgcn_cvt_pk_fp8_f32(o.z, o.w, t, true); *(int*)(oA.h8 + idx) = t; }
        if (oA.dout) *(f32x4*)(oA.dout + idx) = o * PROBE_SCALE;
        if (hasB) {
            if (oB.hb) { v2u w; w.x = pk2(p.x, p.y); w.y = pk2(p.z, p.w); *(v2u*)(oB.hb + idx) = w; int t = 0; t = __builtin_amdgcn_cvt_pk_fp8_f32(p.x, p.y, t, false); t = __builtin_amdgcn_cvt_pk_fp8_f32(p.z, p.w, t, true); *(int*)(oB.h8 + idx) = t; }
            if (oB.dout) *(f32x4*)(oB.dout + idx) = p * PROBE_SCALE; } }
}
__device__ __forceinline__ void ln_zero_pad(const Ctx& c, bf16* HB, unsigned char* H8) {
    for (int row = c.gw; row < ROWV; row += c.ngw) {
#pragma unroll
        for (int j = 0; j < 8; ++j) { const int idx = (j * 64 + c.lane) * 4; *(v2u*)(HB + (size_t)row * D + idx) = (v2u){0u, 0u}; *(int*)(H8 + (size_t)row * D + idx) = 0; } }
}
__device__ __forceinline__ void phase_ln_mix(const Ctx& c, const Args& a, int layer) {
    const bf16* MIX = (const bf16*)(a.ws + WS_MIX); bf16* HB = (bf16*)(a.ws + WS_HBF); unsigned char* H8 = a.ws + WS_H8;
    ln_zero_pad(c, HB, H8);
    for (int i = c.gw; i < NVALID; i += 2 * c.ngw) {
        const int rowA = ROWV + i, rowB0 = rowA + c.ngw; const bool hasB = rowB0 < LP; const int rowB = hasB ? rowB0 : rowA;
        const LnSrc A{HB + (size_t)rowA * D, MIX + (size_t)rowA * D, nullptr, nullptr, 0.f, 0.f}, B{HB + (size_t)rowB * D, MIX + (size_t)rowB * D, nullptr, nullptr, 0.f, 0.f};
        ln_pair<false>(A, B, a.in[I_LNMG] + layer * D, a.in[I_LNMB] + layer * D, LnDst{HB + (size_t)rowA * D, H8 + (size_t)rowA * D, nullptr}, LnDst{HB + (size_t)rowB * D, H8 + (size_t)rowB * D, nullptr}, hasB, c.lane PROBE_ONE); }
}
__device__ __forceinline__ void phase_ln_ffn(const Ctx& c, const Args& a, int layer, bool last PROBE_DECL) {
    const bf16* Y = (const bf16*)(a.ws + WS_R1 + R1_Y); bf16* HB = (bf16*)(a.ws + WS_HBF); unsigned char* H8 = a.ws + WS_H8;
    const int* route = (const int*)(a.ws + WS_ROUTE);
    if (!last) ln_zero_pad(c, HB, H8);
    const int first = last ? 256 : ROWV;
    for (int i = c.gw; i < LP - first; i += 2 * c.ngw) {
        const int rowA = first + i, rowB0 = rowA + c.ngw; const bool hasB = rowB0 < LP; const int rowB = hasB ? rowB0 : rowA;
        const int* rA = route + (size_t)rowA * 8; const int* rB = route + (size_t)rowB * 8;
        const v4i_ qa = *(const v4i_*)(rA + 4), qb = *(const v4i_*)(rB + 4);
        const LnSrc A{HB + (size_t)rowA * D, nullptr, Y + (size_t)qa.x * D, Y + (size_t)qa.y * D, __int_as_float(qa.z), __int_as_float(qa.w)}, B{HB + (size_t)rowB * D, nullptr, Y + (size_t)qb.x * D, Y + (size_t)qb.y * D, __int_as_float(qb.z), __int_as_float(qb.w)};
        const LnDst oA{last ? nullptr : HB + (size_t)rowA * D, last ? nullptr : H8 + (size_t)rowA * D, last ? a.out + (size_t)(rowA - 256) * D : nullptr}, oB{last ? nullptr : HB + (size_t)rowB * D, last ? nullptr : H8 + (size_t)rowB * D, last ? a.out + (size_t)(rowB - 256) * D : nullptr};
        ln_pair<true>(A, B, a.in[I_LNFG] + layer * D, a.in[I_LNFB] + layer * D, oA, oB, hasB, c.lane PROBE_PASS); }
}
typedef float f32x16 __attribute__((ext_vector_type(16)));
__device__ __forceinline__ void phase_router(const Ctx& c, const Args& a, int layer) {
    const bf16* HBr = (const bf16*)(a.ws + WS_HBF);
    LAS float* part = (LAS float*)c.lds;
    LAS float* lg = (LAS float*)(c.lds + 98304);
    const bf16* wrh = (const bf16*)(a.ws + WS_WRH) + (size_t)layer * 96 * 2048; const bf16* wrl = (const bf16*)(a.ws + WS_WRL) + (size_t)layer * 96 * 2048;
    const float* bg = a.in[I_BGRP] + layer * 8; const float* be = a.in[I_BEXP] + layer * 64;
    int* route = (int*)(a.ws + WS_ROUTE); unsigned* cnt = (unsigned*)(a.ws + WS_CTL) + CW_CNT + layer * 64;
    const int li = c.lane & 31, kh = c.lane >> 5, w = c.wave;
    for (int task = c.bid; task < 513; task += c.nblk) {
        const int row0 = 224 + 32 * task;
        f32x16 acc[3];
#pragma unroll
        for (int ct = 0; ct < 3; ++ct)
#pragma unroll
            for (int e = 0; e < 16; ++e) acc[ct][e] = 0.f;
        const bf16* ap = HBr + (size_t)(row0 + li) * D + 256 * w + 8 * kh;
        const bf16* bh = wrh + (size_t)li * 2048 + 256 * w + 8 * kh; const bf16* bl = wrl + (size_t)li * 2048 + 256 * w + 8 * kh;
#pragma unroll 4
        for (int st = 0; st < 16; ++st) {
            const bf16x8 ah = *(const bf16x8*)(ap + 16 * st);
#pragma unroll
            for (int ct = 0; ct < 3; ++ct) { const bf16x8 wh = *(const bf16x8*)(bh + (size_t)ct * 32 * 2048 + 16 * st), wl = *(const bf16x8*)(bl + (size_t)ct * 32 * 2048 + 16 * st);
                acc[ct] = __builtin_amdgcn_mfma_f32_32x32x16_bf16(ah, wh, acc[ct], 0, 0, 0); acc[ct] = __builtin_amdgcn_mfma_f32_32x32x16_bf16(ah, wl, acc[ct], 0, 0, 0); }
        }
#pragma unroll
        for (int ct = 0; ct < 3; ++ct)
#pragma unroll
            for (int e = 0; e < 16; ++e) part[((ct * 8 + w) * 16 + e) * 64 + c.lane] = acc[ct][e];
        __syncthreads();
        for (int i = c.tid; i < 3072; i += NTHR) { const int ct = i >> 10, e = (i >> 6) & 15, ln = i & 63; float sum = 0.f;
#pragma unroll
            for (int w2 = 0; w2 < 8; ++w2) sum += part[((ct * 8 + w2) * 16 + e) * 64 + ln];
            const int col = 32 * ct + (ln & 31), row = (e & 3) + 8 * (e >> 2) + 4 * (ln >> 5);
            lg[row * 96 + col] = sum + (col < 8 ? bg[col] : (col < 72 ? be[col - 8] : 0.f)); }
        __syncthreads();
        if (c.tid < 32) { const int row2 = row0 + c.tid;
            if (row2 >= ROWV) { const LAS float* l = lg + c.tid * 96;
                int grp = 0; float gm = l[0];
                for (int q = 1; q < 8; ++q) if (l[q] > gm) { gm = l[q]; grp = q; }
                float gs = 0.f; for (int q = 0; q < 8; ++q) gs += expf(l[q] - gm);
                const float pg = 1.0f / gs;
                const LAS float* el = l + 8 + grp * 8;
                int i0 = 0; float v0 = el[0]; for (int q = 1; q < 8; ++q) if (el[q] > v0) { v0 = el[q]; i0 = q; }
                int i1 = -1; float v1 = -3.0e38f; for (int q = 0; q < 8; ++q) if (q != i0 && el[q] > v1) { v1 = el[q]; i1 = q; }
                const float e1 = expf(v1 - v0), w0 = pg / (1.0f + e1), w1 = pg * e1 / (1.0f + e1);
                const int ex0 = grp * 8 + i0, ex1 = grp * 8 + i1;
                const int p0 = (int)atomicAdd(cnt + ex0, 1u), p1 = (int)atomicAdd(cnt + ex1, 1u);
                int* r = route + (size_t)row2 * 8; r[0] = ex0; r[1] = ex1; r[2] = p0; r[3] = p1; r[6] = __float_as_int(w0); r[7] = __float_as_int(w1); } }
        __syncthreads();
    }
}
__device__ __forceinline__ void phase_gather(const Ctx& c, const Args& a, int layer) {
    LAS int* lbase = (LAS int*)c.lds; LAS int* lcnt = lbase + 64;
    if (c.tid == 0) {
        const unsigned* cnt = (const unsigned*)(a.ws + WS_CTL) + CW_CNT + layer * 64; int* plan = (int*)(a.ws + WS_CTL) + CW_PLAN + layer * 512;
        int t = 0;
        for (int e = 0; e < NEXP; ++e) { const int n = (int)__hip_atomic_load(cnt + e, __ATOMIC_RELAXED, __HIP_MEMORY_SCOPE_AGENT), nt = (n + 255) / 256; lbase[e] = t * 256; lcnt[e] = n;
            if (c.bid == 0) { plan[1 + e] = t * 256; for (int q = 0; q < nt; ++q) plan[128 + t + q] = e; }
            t += nt; }
        if (c.bid == 0) plan[0] = t;
    }
    __syncthreads();
    int* route = (int*)(a.ws + WS_ROUTE); int* rowlist = (int*)(a.ws + WS_ROWLIST);
    for (int T = c.bid * NTHR + c.tid; T < NVALID * 2; T += c.nblk * NTHR) {
        const int row = ROWV + (T >> 1), j = T & 1; int* r = route + (size_t)row * 8;
        const int slot = lbase[r[j]] + r[2 + j];
        r[4 + j] = slot; rowlist[slot] = row;
    }
    for (int e = c.bid; e < NEXP; e += c.nblk) { const int n = lcnt[e], end = ((n + 255) / 256) * 256;
        for (int i = n + c.tid; i < end; i += NTHR) rowlist[lbase[e] + i] = 0; }
    __syncthreads();
}
struct HgRaw { float f[16], q[16], v[16]; };
__device__ __forceinline__ float bf2f(bf16 x) { return __uint_as_float((unsigned)x << 16); }
template <bool NEEDQ> __device__ __forceinline__ void hg_load(HgRaw& r, const unsigned char* R1, int r0, int head, int dir, int k, int tq) {
    const bf16* fb = (const bf16*)(R1 + R1_F) + (size_t)(r0 + 16 * tq) * 4096 + 2048 * dir + head * 128 + k;
    const bf16* vb = (const bf16*)(R1 + R1_VB) + (size_t)(r0 + 16 * tq) * D + head * 128 + k; const bf16* qb = (const bf16*)(R1 + R1_QB) + (size_t)(r0 + 16 * tq) * D + head * 128 + k;
#pragma unroll
    for (int i = 0; i < 16; ++i) { r.f[i] = 1.0f - bf2f(fb[(size_t)i * 4096]); r.v[i] = bf2f(vb[(size_t)i * D]); if (NEEDQ) r.q[i] = bf2f(qb[(size_t)i * D]); }
}
constexpr int HG_T = HG_SCR;
template <bool NEEDQ> __device__ __forceinline__ float hg_prep(const Ctx& c, const HgRaw& r, int r0, int dir, int k, int tq, int lane) {
    LAS unsigned char* L = c.lds;
    float g[16], kk[16], cs[16];
#pragma unroll
    for (int i = 0; i < 16; ++i) { const bool valid = (r0 + 16 * tq + i) >= ROWV; g[i] = valid ? __logf(r.f[i]) : 0.f; kk[i] = valid ? 1.0f - r.f[i] : 0.f; }
    if (dir == 0) { cs[0] = g[0];
#pragma unroll
        for (int i = 1; i < 16; ++i) cs[i] = cs[i - 1] + g[i]; }
    else { cs[15] = g[15];
#pragma unroll
        for (int i = 14; i >= 0; --i) cs[i] = cs[i + 1] + g[i]; }
    LAS float* T = (LAS float*)(L + HG_T);
    T[tq * 128 + k] = dir == 0 ? cs[15] : cs[0];
    __syncthreads();
    const float t0 = T[k], t1 = T[128 + k], t2 = T[256 + k], t3 = T[384 + k];
    const float btot = (t0 + t1) + (t2 + t3);
    float off;
    if (dir == 0) off = tq == 0 ? 0.f : tq == 1 ? t0 : tq == 2 ? t0 + t1 : t0 + t1 + t2;
    else off = tq == 3 ? 0.f : tq == 2 ? t3 : tq == 1 ? t3 + t2 : t3 + t2 + t1;
    unsigned kh[8], vt[8];
#pragma unroll
    for (int i = 0; i < 16; i += 2) {
        const float b0 = off + cs[i], b1 = off + cs[i + 1];
        const unsigned pk = pkbf(kk[i] * __expf(-b0), kk[i + 1] * __expf(-b1));
        kh[i >> 1] = pk; vt[i >> 1] = pkbf(r.v[i], r.v[i + 1]);
        if (NEEDQ) { const int t = 16 * tq + i; const unsigned pq = pkbf(r.q[i] * __expf(b0), r.q[i + 1] * __expf(b1));
            *(LAS unsigned short*)(L + HG_QT + t * LD_K + 2 * k) = (unsigned short)pq; *(LAS unsigned short*)(L + HG_QT + (t + 1) * LD_K + 2 * k) = (unsigned short)(pq >> 16);
            *(LAS unsigned short*)(L + HG_KT + t * LD_K + 2 * k) = (unsigned short)pk; *(LAS unsigned short*)(L + HG_KT + (t + 1) * LD_K + 2 * k) = (unsigned short)(pk >> 16); }
    }
    *(LAS v4u*)(L + HG_KH + k * LD_T + 32 * tq) = (v4u){kh[0], kh[1], kh[2], kh[3]};
    *(LAS v4u*)(L + HG_KH + k * LD_T + 32 * tq + 16) = (v4u){kh[4], kh[5], kh[6], kh[7]};
    *(LAS v4u*)(L + HG_VT + k * LD_T + 32 * tq) = (v4u){vt[0], vt[1], vt[2], vt[3]};
    *(LAS v4u*)(L + HG_VT + k * LD_T + 32 * tq + 16) = (v4u){vt[4], vt[5], vt[6], vt[7]};
    if (tq == 0) ((LAS float*)(L + HG_DV))[k] = __expf(btot);
    return btot;
}
__device__ __forceinline__ void hg_update(LAS unsigned char* Lb, int w, f32x4 (&S)[8], int r, int q) {
#pragma unroll
    for (int ks = 0; ks < 2; ++ks) { const bf16x8 b = ldfrag(Lb + HG_VT, 16 * w + r, LD_T, (32 * ks + 8 * q) * 2);
#pragma unroll
        for (int kt = 0; kt < 8; ++kt) { const bf16x8 a2 = ldfrag(Lb + HG_KH, 16 * kt + r, LD_T, (32 * ks + 8 * q) * 2); S[kt] = MFMA16(a2, b, S[kt]); } }
#pragma unroll
    for (int kt = 0; kt < 8; ++kt) { const f32x4 d = *(const LAS f32x4*)(Lb + HG_DV + (16 * kt + 4 * q) * 4); S[kt] = S[kt] * d; }
}
__device__ __forceinline__ void hg_seg_range(int seg, int& c0, int& n) { if (seg == 0) { c0 = 3; n = 9; } else { c0 = 4 + 8 * seg; n = 8; } }
__device__ __forceinline__ void glds16(const unsigned char* gsrc_lane, LAS unsigned char* lds_wave) { __builtin_amdgcn_global_load_lds((const unsigned*)gsrc_lane, (LAS unsigned*)lds_wave, 16, 0, 0); }
__device__ __forceinline__ void phase_hg_build(const Ctx& c, const Args& a) {
    const unsigned char* R1 = a.ws + WS_R1; unsigned char* IMG = a.ws + WS_R1 + R1_IMG; LAS unsigned char* L = c.lds;
    for (int u = c.bid; u < 257 * 16; u += c.nblk) {
        int tv = c.tid; asm volatile("" : "+v"(tv));
        const int lane = tv & 63, k = tv & 127, tq = tv >> 7, ci = 3 + (u >> 4), head = u & 15, r0 = 64 * ci;
        unsigned char* img = IMG + ((size_t)ci * 16 + head) * IMG_SZ;
#pragma unroll 1
        for (int dir = 0; dir < 2; ++dir) {
            HgRaw raw; hg_load<true>(raw, R1, r0, head, dir, k, tq);
            (void)hg_prep<true>(c, raw, r0, dir, k, tq, lane);
            __syncthreads();
            for (int i = tv; i < 3392; i += NTHR) *(v4u*)(img + 18432 + (size_t)dir * 54272 + (size_t)i * 16) = *(const LAS v4u*)(L + HG_QT + i * 16);
            if (dir == 0) for (int i = tv; i < 1152; i += NTHR) *(v4u*)(img + (size_t)i * 16) = *(const LAS v4u*)(L + HG_VT + i * 16);
            if (dir == 0) { const bf16* gp = (const bf16*)(R1 + R1_GB) + (size_t)(r0 + 16 * tq) * D + head * 128 + k; float gv[16];
#pragma unroll
                for (int i = 0; i < 16; ++i) gv[i] = bf2f(gp[(size_t)i * D]);
                bf16* gt = (bf16*)(a.ws + WS_R1 + R1_GT) + ((size_t)ci * 16 + head) * 8192 + (size_t)(((k >> 4) * 4 + tq) * 64 + (k & 15)) * 4;
#pragma unroll
                for (int qq = 0; qq < 4; ++qq) { v2u w2; w2.x = pkbf(gv[4 * qq], gv[4 * qq + 1]); w2.y = pkbf(gv[4 * qq + 2], gv[4 * qq + 3]); *(v2u*)(gt + qq * 64) = w2; } }
            __syncthreads();
        }
    }
}
__device__ __forceinline__ void phase_hg_pass1(const Ctx& c, const Args& a) {
    const unsigned char* IMG = a.ws + WS_R1 + R1_IMG; LAS unsigned char* L = c.lds;
    float* DS = (float*)(a.ws + WS_R1 + R1_DS); float* DSEG = (float*)(a.ws + WS_R1 + R1_DSEG);
    const int w = c.wave;
    for (int u = c.bid; u < 1024; u += c.nblk) {
        int tv = c.tid; asm volatile("" : "+v"(tv));
        const int lane = tv & 63, r = lane & 15, q = lane >> 4;
        const int chain = u & 31, seg = u >> 5, dir = chain >> 4, head = chain & 15;
        int c0, n; hg_seg_range(seg, c0, n);
        f32x4 S[8];
#pragma unroll
        for (int kt = 0; kt < 8; ++kt) S[kt] = (f32x4){0.f, 0.f, 0.f, 0.f};
        float dprod = 1.0f;
#define HG1_ISSUE(step, buf) do { const int ci_ = dir == 0 ? c0 + (step) : c0 + n - 1 - (step); const unsigned char* img_ = IMG + ((size_t)ci_ * 16 + head) * IMG_SZ; LAS unsigned char* lb_ = L + (buf) * HB_SZ; \
            for (int p_ = w; p_ < 37; p_ += 8) { if (p_ < 18) glds16(img_ + p_ * 1024 + lane * 16, lb_ + HG_VT + p_ * 1024); \
                else glds16(img_ + 18432 + (size_t)dir * 54272 + (HG_KH - HG_QT) + (p_ - 18) * 1024 + lane * 16, lb_ + HG_KH + (p_ - 18) * 1024); } } while (0)
        HG1_ISSUE(0, 0);
        for (int j = 0; j < n; ++j) {
            asm volatile("s_waitcnt vmcnt(0)" ::: "memory"); __syncthreads();
            if (j + 1 < n) HG1_ISSUE(j + 1, (j + 1) & 1);
            LAS unsigned char* Lb = L + (j & 1) * HB_SZ;
            hg_update(Lb, w, S, r, q);
            if (tv < 128) dprod *= *(const LAS float*)(Lb + HG_DV + tv * 4);
        }
#undef HG1_ISSUE
        float* dst = DS + ((size_t)seg * 32 + chain) * 16384 + w * 2048 + lane;
#pragma unroll
        for (int kt = 0; kt < 8; ++kt)
#pragma unroll
            for (int e = 0; e < 4; ++e) dst[(kt * 4 + e) * 64] = S[kt][e];
        if (tv < 128) DSEG[((size_t)seg * 32 + chain) * 128 + tv] = dprod;
        __syncthreads();
    }
}
__device__ __forceinline__ void phase_hg_segscan(const Ctx& c, const Args& a) {
    float* DS = (float*)(a.ws + WS_R1 + R1_DS); const float* DSEG = (const float*)(a.ws + WS_R1 + R1_DSEG);
    for (int i = c.bid * NTHR + c.tid; i < 32 * 4096; i += c.nblk * NTHR) {
        const int chain = i >> 12, e4 = i & 4095, el = e4 * 4, ln = el & 63, e = (el >> 6) & 3, kt = (el >> 8) & 7, k = 16 * kt + 4 * (ln >> 4) + e, dir = chain >> 4;
        f32x4 run = (f32x4){0.f, 0.f, 0.f, 0.f};
        for (int j0 = 0; j0 < 32; j0 += 8) { f32x4 ds[8]; float d[8];
#pragma unroll
            for (int j = 0; j < 8; ++j) { const int sg = dir == 0 ? j0 + j : 31 - j0 - j; ds[j] = *((const f32x4*)(DS + ((size_t)sg * 32 + chain) * 16384) + e4); d[j] = DSEG[((size_t)sg * 32 + chain) * 128 + k]; }
#pragma unroll
            for (int j = 0; j < 8; ++j) { const int sg = dir == 0 ? j0 + j : 31 - j0 - j; *((f32x4*)(DS + ((size_t)sg * 32 + chain) * 16384) + e4) = run; run = run * d[j] + ds[j]; } }
    }
}
template <int DIR> __device__ __forceinline__ void phase_hg_pass2(const Ctx& c, const Args& a) {
    const unsigned char* IMG = a.ws + WS_R1 + R1_IMG;
    const float* DS = (const float*)(a.ws + WS_R1 + R1_DS);
    bf16* OBW = (bf16*)(a.ws + WS_R1 + R1_OBW); const bf16* GB = (const bf16*)(a.ws + WS_R1 + R1_GB); bf16* MI = (bf16*)(a.ws + WS_MIXIN);
    LAS unsigned char* L = c.lds;
    const int w = c.wave;
    for (int u = c.bid; u < 512; u += c.nblk) {
        int tv = c.tid; asm volatile("" : "+v"(tv));
        const int lane = tv & 63, r = lane & 15, q = lane >> 4;
        const int head = u & 15, seg = u >> 4, dir = DIR, chain = dir * 16 + head;
        int c0, n; hg_seg_range(seg, c0, n);
        f32x4 S[8];
        { const float* src = DS + ((size_t)seg * 32 + chain) * 16384 + w * 2048 + lane;
#pragma unroll
          for (int kt = 0; kt < 8; ++kt)
#pragma unroll
              for (int e = 0; e < 4; ++e) S[kt][e] = src[(kt * 4 + e) * 64]; }
#define HG2_ISSUE(step, buf) do { const int ci_ = dir == 0 ? c0 + (step) : c0 + n - 1 - (step); const unsigned char* img_ = IMG + ((size_t)ci_ * 16 + head) * IMG_SZ; LAS unsigned char* lb_ = L + (buf) * HB_SZ; \
            for (int p_ = w; p_ < 71; p_ += 8) { if (p_ < 18) glds16(img_ + p_ * 1024 + lane * 16, lb_ + HG_VT + p_ * 1024); \
                else glds16(img_ + 18432 + (size_t)dir * 54272 + (p_ - 18) * 1024 + lane * 16, lb_ + HG_QT + (p_ - 18) * 1024); } } while (0)
        HG2_ISSUE(0, 0);
        float ng = 0.f; if (DIR == 0) ng = a.in[I_NORMG][head * 128 + 16 * w + r];
        f32x4 po[4]; v2u pg[4]; int pci = 0;
#pragma unroll
        for (int tt = 0; tt < 4; ++tt) { po[tt] = (f32x4){0.f, 0.f, 0.f, 0.f}; pg[tt] = (v2u){0u, 0u}; }
#define HG2_FLUSH(par) do { if (DIR == 1) { v2u* ob_ = (v2u*)(OBW + ((size_t)pci * 16 + head) * 8192) + (w * 4) * 64 + lane; \
                _Pragma("unroll") for (int tt = 0; tt < 4; ++tt) { v2u w2; w2.x = pkbf(po[tt][0], po[tt][1]); w2.y = pkbf(po[tt][2], po[tt][3]); ob_[tt * 64] = w2; } \
            } else { const LAS float* RS_ = (const LAS float*)(L + HG_SCR + (par) * 2048); bf16* mi_ = MI + (size_t)(64 * pci) * D + head * 128 + 16 * w + r; unsigned char* m8_ = (unsigned char*)a.ws + WS_MI8 + (size_t)(64 * pci) * D + head * 128 + 16 * w + r; \
                _Pragma("unroll") for (int tt = 0; tt < 4; ++tt) { const f32x4 g4 = bf4(pg[tt]); \
                    _Pragma("unroll") for (int e = 0; e < 4; ++e) { const int t = 16 * tt + 4 * q + e; const f32x4 s0 = *(const LAS f32x4*)(RS_ + t * 8), s1 = *(const LAS f32x4*)(RS_ + t * 8 + 4); \
                        const float rs = 1.0f / sqrtf(((s0.x + s0.y) + (s0.z + s0.w) + (s1.x + s1.y) + (s1.z + s1.w)) * (1.0f / 128.0f) + 1e-6f); \
                        const float mv_ = 64 * pci + t >= ROWV ? po[tt][e] * rs * ng * g4[e] : 0.f; mi_[(size_t)t * D] = (bf16)f2bf(mv_); m8_[(size_t)t * D] = (unsigned char)__builtin_amdgcn_cvt_pk_fp8_f32(mv_, mv_, 0, false); } } } } while (0)
        for (int j = 0; j < n; ++j) {
            const int ci = dir == 0 ? c0 + j : c0 + n - 1 - j;
            asm volatile("s_waitcnt vmcnt(0)" ::: "memory"); __syncthreads();
            if (j + 1 < n) HG2_ISSUE(j + 1, (j + 1) & 1);
            if (j > 0) HG2_FLUSH((j - 1) & 1);
            LAS unsigned char* Lb = L + (j & 1) * HB_SZ;
            v2u obp[4], gtp[4];
            if (DIR == 0) { const v2u* ob_ = (const v2u*)(OBW + ((size_t)ci * 16 + head) * 8192) + (w * 4) * 64 + lane; const v2u* gt_ = (const v2u*)((const bf16*)(a.ws + WS_R1 + R1_GT) + ((size_t)ci * 16 + head) * 8192) + (w * 4) * 64 + lane;
#pragma unroll
                for (int tt = 0; tt < 4; ++tt) { obp[tt] = ob_[tt * 64]; gtp[tt] = gt_[tt * 64]; } }
            f32x4 o[4];
#pragma unroll
            for (int tt = 0; tt < 4; ++tt) {
                o[tt] = (f32x4){0.f, 0.f, 0.f, 0.f};
                bf16x8 qf[4];
#pragma unroll
                for (int ks = 0; ks < 4; ++ks) qf[ks] = ldfrag(Lb + HG_QT, 16 * tt + r, LD_K, (32 * ks + 8 * q) * 2);
                unsigned pp[4][2];
#pragma unroll
                for (int st = 0; st < 4; ++st) { f32x4 acc = (f32x4){0.f, 0.f, 0.f, 0.f};
#pragma unroll
                    for (int ks = 0; ks < 4; ++ks) { const bf16x8 kf = ldfrag(Lb + HG_KT, 16 * st + r, LD_K, (32 * ks + 8 * q) * 2); acc = MFMA16(kf, qf[ks], acc); }
                    const int s0 = 16 * st + 4 * q, t = 16 * tt + r;
                    const float m0 = (dir == 0 ? (s0 <= t) : (s0 >= t)) ? acc[0] : 0.f, m1 = (dir == 0 ? (s0 + 1 <= t) : (s0 + 1 >= t)) ? acc[1] : 0.f;
                    const float m2 = (dir == 0 ? (s0 + 2 <= t) : (s0 + 2 >= t)) ? acc[2] : 0.f, m3 = (dir == 0 ? (s0 + 3 <= t) : (s0 + 3 >= t)) ? acc[3] : 0.f;
                    pp[st][0] = pkbf(m0, m1); pp[st][1] = pkbf(m2, m3); }
#pragma unroll
                for (int ks = 0; ks < 2; ++ks) { const v4u af = (v4u){pp[2 * ks][0], pp[2 * ks][1], pp[2 * ks + 1][0], pp[2 * ks + 1][1]};
                    const LAS unsigned char* vp = Lb + HG_VT + (16 * w + r) * LD_T + (32 * ks + 4 * q) * 2; const v2u lo = *(const LAS v2u*)vp, hi = *(const LAS v2u*)(vp + 32);
                    const v4u vf = (v4u){lo.x, lo.y, hi.x, hi.y}; o[tt] = MFMA16(__builtin_bit_cast(bf16x8, af), __builtin_bit_cast(bf16x8, vf), o[tt]); }
            }
#pragma unroll
            for (int ks = 0; ks < 4; ++ks) { v4u sb; sb.x = pkbf(S[2 * ks][0], S[2 * ks][1]); sb.y = pkbf(S[2 * ks][2], S[2 * ks][3]); sb.z = pkbf(S[2 * ks + 1][0], S[2 * ks + 1][1]); sb.w = pkbf(S[2 * ks + 1][2], S[2 * ks + 1][3]);
                const bf16x8 bf = __builtin_bit_cast(bf16x8, sb);
#pragma unroll
                for (int tt = 0; tt < 4; ++tt) { const LAS unsigned char* qp = Lb + HG_QT + (16 * tt + r) * LD_K + (32 * ks + 4 * q) * 2; const v2u lo = *(const LAS v2u*)qp, hi = *(const LAS v2u*)(qp + 32);
                    const v4u t4 = (v4u){lo.x, lo.y, hi.x, hi.y}; o[tt] = MFMA16(__builtin_bit_cast(bf16x8, t4), bf, o[tt]); } }
            hg_update(Lb, w, S, r, q);
            pci = ci;
            if (DIR == 1) {
#pragma unroll
                for (int tt = 0; tt < 4; ++tt) po[tt] = o[tt];
            } else {
                LAS float* RS = (LAS float*)(L + HG_SCR + (j & 1) * 2048);
                float ss[16];
#pragma unroll
                for (int tt = 0; tt < 4; ++tt) { const f32x4 b4 = bf4(obp[tt]); o[tt] = o[tt] + b4;
#pragma unroll
                    for (int e = 0; e < 4; ++e) ss[tt * 4 + e] = o[tt][e] * o[tt][e]; }
                float b8[8], b4v[4], b2v[2], tot;
#pragma unroll
                for (int i = 0; i < 8; ++i) { const float keep = (r & 8) ? ss[i + 8] : ss[i], send = (r & 8) ? ss[i] : ss[i + 8]; b8[i] = keep + __shfl_xor(send, 8); }
#pragma unroll
                for (int i = 0; i < 4; ++i) { const float keep = (r & 4) ? b8[i + 4] : b8[i], send = (r & 4) ? b8[i] : b8[i + 4]; b4v[i] = keep + __shfl_xor(send, 4); }
#pragma unroll
                for (int i = 0; i < 2; ++i) { const float keep = (r & 2) ? b4v[i + 2] : b4v[i], send = (r & 2) ? b4v[i] : b4v[i + 2]; b2v[i] = keep + __shfl_xor(send, 2); }
                { const float keep = (r & 1) ? b2v[1] : b2v[0], send = (r & 1) ? b2v[0] : b2v[1]; tot = keep + __shfl_xor(send, 1); }
                RS[(16 * (r >> 2) + 4 * q + (r & 3)) * 8 + w] = tot;
#pragma unroll
                for (int tt = 0; tt < 4; ++tt) { po[tt] = o[tt]; pg[tt] = gtp[tt]; }
            }
        }
#undef HG2_ISSUE
        __syncthreads();
        HG2_FLUSH((n - 1) & 1);
#undef HG2_FLUSH
    }
    if (DIR == 0) { for (int i = c.bid * NTHR + c.tid; i < 192 * D / 8; i += c.nblk * NTHR) ((v4u*)MI)[i] = (v4u){0u, 0u, 0u, 0u}; }
}
constexpr int NPHASE = 40;
__global__ void __launch_bounds__(NTHR, 2) fwd(Args args) {
    extern __shared__ __attribute__((aligned(16))) unsigned char lds[];
    Ctx c; c.lds = (LAS unsigned char*)lds; c.ldsg = lds; c.tid = threadIdx.x; c.lane = c.tid & 63; c.wave = __builtin_amdgcn_readfirstlane(c.tid >> 6);
    c.bid = blockIdx.x; c.nblk = gridDim.x; c.gw = c.bid * NWAVES + c.wave; c.ngw = c.nblk * NWAVES;
    volatile LAS unsigned* MISC = (volatile LAS unsigned*)(c.lds + MISC_OFF);
    for (int u = c.tid; u < (LDS_BYTES - MISC_OFF) / 4; u += NTHR) ((LAS unsigned*)(c.lds + MISC_OFF))[u] = 0u;
    __syncthreads();
    const int lo = args.ph_lo, hi = args.ph_hi;
#ifdef PROBE_MASK
    float g_probe_scale = 1.0f;
#endif
    const bool multi = (hi - lo) > 1;
    XcdBarrier bar; bar.bar = (unsigned*)(args.ws + WS_CTL) + CW_BAR; bar.x = 0; bar.st = nullptr;
    if (multi) bar = xcd_barrier_post((unsigned*)(args.ws + WS_CTL) + CW_BAR, MISC + 8);
#define IN(k) (lo <= (k) && (k) < hi)
#ifdef PROBE_MASK
#define STAMP(k) do { if (c.bid == 0 && c.tid == 0) ((unsigned long long*)((unsigned*)(args.ws + WS_CTL) + CW_TS))[(k)] = __builtin_amdgcn_s_memrealtime(); } while (0)
#else
#define STAMP(k) do { } while (0)
#endif
#define SEAM(k) do { if (IN(k) && IN((k) + 1)) { STAMP(64 + (k)); xcd_barrier(bar); STAMP((k) + 1); } } while (0)
    STAMP(0);
    unsigned char* ws = args.ws;
    float* HA = (float*)(ws + WS_HA); float* HBuf = (float*)(ws + WS_HB);
    const pg8::bf16_t* HBF = (const pg8::bf16_t*)(ws + WS_HBF);
    const pg8::bf16_t* MIXIN = (const pg8::bf16_t*)(ws + WS_MIXIN);
    if (IN(0)) { phase_init(c, args);
#if defined(DUP_PHASE)
        if (DUP_PHASE == 0) { xcd_barrier(bar); phase_init(c, args); }
#endif
    } SEAM(0);
    if (IN(1)) { phase_s5_ktab(c, args);
#if defined(DUP_PHASE)
        if (DUP_PHASE == 1) { xcd_barrier(bar); phase_s5_ktab(c, args); }
#endif
    } SEAM(1);
    if (IN(2)) { phase_weights(c, args); phase_s5_fill(c, args);
#if defined(DUP_PHASE)
        if (DUP_PHASE == 2) { xcd_barrier(bar); phase_weights(c, args); phase_s5_fill(c, args); }
#endif
    } SEAM(2);
    if (IN(3)) { skinny_gemm2(c, (const bf16*)HBF, D, (const bf16*)(ws + WS_WAB), D, ABN, SkAB2{ws});
        zero_rows_bf16(c, (bf16*)(ws + WS_QB0), 1024, 192, ROWV); zero_rows_bf16(c, (bf16*)(ws + WS_KB0), 256, 192, ROWV); zero_rows_bf16(c, (bf16*)(ws + WS_VB0), 256, 192, ROWV);
        for (int i = c.bid * NTHR + c.tid; i < 64 * 256; i += c.nblk * NTHR) ((bf16*)(ws + WS_R1 + R1_UA))[(size_t)(i >> 8) * 768 * 768 + (i & 255)] = 0;
        pg8::Gemm g = pg8::mkgemm(HBF, ws + WS_WAB, SEQ, ABN, D); pg8::StaticOrder S; S.init(SEQ, ABN, c.nblk, c.bid, 1);
        pg8::EpiProjAB E{ws}; pg8::gemm_phase(c.lds, g, S, E);
        if (c.nblk == 256 && c.bid >= 128) conv_fill(c, args, 0, FILL3, c.bid - 128, c.nblk - 128);
    } SEAM(3);
    if (IN(4)) { phase_attn(c, args);
        if (c.nblk == 256 && c.bid >= 2) { __syncthreads(); conv_fill(c, args, FILL7, FILL4, c.bid - 2, c.nblk - 2); }
#if defined(DUP_PHASE)
        if (DUP_PHASE == 4) { xcd_barrier(bar); phase_attn(c, args); }
#endif
    } SEAM(4);
    if (IN(5)) { pg8::Gemm g = pg8::mkgemm(ws + WS_R1 + R1_UA, ws + WS_WST, 768, 256, 512, (size_t)256 * 512 * 2); g.lda = 768; g.astride = (size_t)768 * 768 * 2;
        pg8::GroupTileOrder S; S.init(64, 768, 256, c.nblk, c.bid); pg8::EpiF32 E{(float*)(ws + WS_R1 + R1_SALL), 256, (size_t)768 * 256}; pg8::gemm_phase(c.lds, g, S, E);
        if (c.nblk == 256 && c.bid >= 192) conv_fill(c, args, FILL3, FILL5, c.bid - 192, c.nblk - 192);
#if defined(DUP_PHASE)
        if (DUP_PHASE == 5) { xcd_barrier(bar); pg8::Gemm g = pg8::mkgemm(ws + WS_R1 + R1_UA, ws + WS_WST, 768, 256, 512, (size_t)256 * 512 * 2); g.lda = 768; g.astride = (size_t)768 * 768 * 2;
        pg8::GroupTileOrder S; S.init(64, 768, 256, c.nblk, c.bid); pg8::EpiF32 E{(float*)(ws + WS_R1 + R1_SALL), 256, (size_t)768 * 256}; pg8::gemm_phase(c.lds, g, S, E); }
#endif
    } SEAM(5);
    if (IN(6)) { phase_s5_chunkscan(c, args);
        if (c.nblk == 256 && c.bid >= 128) conv_fill(c, args, FILL5, FILL6, c.bid - 128, c.nblk - 128);
#if defined(DUP_PHASE)
        if (DUP_PHASE == 6) { xcd_barrier(bar); phase_s5_chunkscan(c, args); }
#endif
    } SEAM(6);
    if (IN(7)) { pg8::Gemm g = pg8::mkgemm(ws + WS_R1 + R1_UA, ws + WS_MWT, 768, 512, 768, (size_t)512 * 768 * 2); g.astride = (size_t)768 * 768 * 2;
        pg8::GroupTileOrder S; S.init(64, 768, 512, c.nblk, c.bid); pg8::EpiS5Y E{(pg8::bf16_t*)(ws + WS_ZB)}; pg8::gemm_phase(c.lds, g, S, E);
        if (c.nblk == 256 && c.bid >= 128) conv_fill(c, args, FILL6, FILL7, c.bid - 128, c.nblk - 128);
#if defined(DUP_PHASE)
        if (DUP_PHASE == 7) { xcd_barrier(bar); pg8::Gemm g = pg8::mkgemm(ws + WS_R1 + R1_UA, ws + WS_MWT, 768, 512, 768, (size_t)512 * 768 * 2); g.astride = (size_t)768 * 768 * 2;
        pg8::GroupTileOrder S; S.init(64, 768, 512, c.nblk, c.bid); pg8::EpiS5Y E{(pg8::bf16_t*)(ws + WS_ZB)}; pg8::gemm_phase(c.lds, g, S, E); }
#endif
    } SEAM(7);
    if (IN(8)) { skinny_gemm(c, (const bf16*)(ws + WS_ZB), 1024, (const bf16*)(ws + WS_WGLU), 1024, 1024, SkGlu{(const bf16*)(ws + WS_ZB), args.in[I_BGLU], (bf16*)(ws + WS_MIXIN)});
        pg8::Gemm g = pg8::mkgemm(ws + WS_ZB, ws + WS_WGLU, SEQ, 1024, 1024); pg8::StaticOrder S; S.init(SEQ, 1024, c.nblk, c.bid, 1);
        pg8::EpiGlu E{(const pg8::bf16_t*)(ws + WS_ZB), args.in[I_BGLU], (pg8::bf16_t*)(ws + WS_MIXIN)}; pg8::gemm_phase(c.lds, g, S, E);
#if defined(DUP_PHASE)
        if (DUP_PHASE == 8) { xcd_barrier(bar); skinny_gemm(c, (const bf16*)(ws + WS_ZB), 1024, (const bf16*)(ws + WS_WGLU), 1024, 1024, SkGlu{(const bf16*)(ws + WS_ZB), args.in[I_BGLU], (bf16*)(ws + WS_MIXIN)});
        pg8::Gemm g = pg8::mkgemm(ws + WS_ZB, ws + WS_WGLU, SEQ, 1024, 1024); pg8::StaticOrder S; S.init(SEQ, 1024, c.nblk, c.bid, 1);
        pg8::EpiGlu E{(const pg8::bf16_t*)(ws + WS_ZB), args.in[I_BGLU], (pg8::bf16_t*)(ws + WS_MIXIN)}; pg8::gemm_phase(c.lds, g, S, E); }
#endif
    } SEAM(8);
    if (IN(9)) { skinny_gemm(c, (const bf16*)MIXIN, D, (const bf16*)(ws + WS_WOAB), D, D, SkBf16{(bf16*)(ws + WS_MIX), D});
        pg8::Gemm g = pg8::mkgemm(MIXIN, ws + WS_WOAB, SEQ, D, D); pg8::StaticOrder S; S.init(SEQ, D, c.nblk, c.bid, 1);
        pg8::EpiBf16 E{(pg8::bf16_t*)(ws + WS_MIX), D}; pg8::gemm_phase(c.lds, g, S, E);
#if defined(DUP_PHASE)
        if (DUP_PHASE == 9) { xcd_barrier(bar); skinny_gemm(c, (const bf16*)MIXIN, D, (const bf16*)(ws + WS_WOAB), D, D, SkBf16{(bf16*)(ws + WS_MIX), D});
        pg8::Gemm g = pg8::mkgemm(MIXIN, ws + WS_WOAB, SEQ, D, D); pg8::StaticOrder S; S.init(SEQ, D, c.nblk, c.bid, 1);
        pg8::EpiBf16 E{(pg8::bf16_t*)(ws + WS_MIX), D}; pg8::gemm_phase(c.lds, g, S, E); }
#endif
    } SEAM(9);
    if (IN(10)) { phase_ln_mix(c, args, 0);
#if defined(DUP_PHASE)
        if (DUP_PHASE == 10) { xcd_barrier(bar); phase_ln_mix(c, args, 0); }
#endif
    } SEAM(10);
    if (IN(11)) { phase_router(c, args, 0);
        if (c.nblk == 256 && c.bid != 0) { __syncthreads(); conv_fill(c, args, R11_LO, R11_HI, c.bid - 1, 255); }
#if defined(DUP_PHASE)
        if (DUP_PHASE == 11) { xcd_barrier(bar); phase_router(c, args, 0); }
#endif
    } SEAM(11);
    if (IN(12)) { phase_gather(c, args, 0);
#if defined(DUP_PHASE)
        if (DUP_PHASE == 12) { xcd_barrier(bar); phase_gather(c, args, 0); }
#endif
    } SEAM(12);
    if (IN(13)) { pg8::Gemm g = pg8::mkgemm(ws + WS_H8, ws + WS_WGU, MPAD, 1024, D / 2, (size_t)1024 * D); pg8::GatherOrder S; S.init((const int*)(ws + WS_CTL) + CW_PLAN, 1024, c.nblk, c.bid, (const int*)(ws + WS_ROWLIST));
        pg8::EpiSwiGLU8 E{ws + WS_R1 + R1_ACT, DEXP}; pg8::gemm_phase<pg8::EpiSwiGLU8, pg8::GatherOrder, true>(c.lds, g, S, E, 0x79797979);
        if (c.nblk == 256) { const int nwg = ((const int*)(ws + WS_CTL))[CW_PLAN] * 4, rank = (c.bid % 8) * 32 + c.bid / 8 - (nwg - 512);
            if (nwg > 512 && nwg < 768 && rank >= 0 && rank < 128) { __syncthreads(); const int b0 = R13_LO + rank * 40; for (int it = b0 + c.wave; it < b0 + 40; it += NWAVES) conv_l1_item(c, args, it); __syncthreads(); } }
#if defined(DUP_PHASE)
        if (DUP_PHASE == 13) { xcd_barrier(bar); pg8::Gemm g = pg8::mkgemm(ws + WS_H8, ws + WS_WGU, MPAD, 1024, D / 2, (size_t)1024 * D); pg8::GatherOrder S; S.init((const int*)(ws + WS_CTL) + CW_PLAN, 1024, c.nblk, c.bid, (const int*)(ws + WS_ROWLIST));
        pg8::EpiSwiGLU8 E{ws + WS_R1 + R1_ACT, DEXP}; pg8::gemm_phase<pg8::EpiSwiGLU8, pg8::GatherOrder, true>(c.lds, g, S, E, 0x79797979); }
#endif
    } SEAM(13);
    if (IN(14)) { pg8::Gemm g = pg8::mkgemm(ws + WS_R1 + R1_ACT, ws + WS_WD, MPAD, D, DEXP / 2, (size_t)D * DEXP); pg8::GroupedOrder S; S.init((const int*)(ws + WS_CTL) + CW_PLAN, D, c.nblk, c.bid);
        pg8::EpiBf16 E{(pg8::bf16_t*)(ws + WS_R1 + R1_Y), D}; pg8::gemm_phase<pg8::EpiBf16, pg8::GroupedOrder, true>(c.lds, g, S, E, 0x79797979);
#if defined(DUP_PHASE)
        if (DUP_PHASE == 14) { xcd_barrier(bar); pg8::Gemm g = pg8::mkgemm(ws + WS_R1 + R1_ACT, ws + WS_WD, MPAD, D, DEXP / 2, (size_t)D * DEXP); pg8::GroupedOrder S; S.init((const int*)(ws + WS_CTL) + CW_PLAN, D, c.nblk, c.bid);
        pg8::EpiBf16 E{(pg8::bf16_t*)(ws + WS_R1 + R1_Y), D}; pg8::gemm_phase<pg8::EpiBf16, pg8::GroupedOrder, true>(c.lds, g, S, E, 0x79797979); }
#endif
    } SEAM(14);
    if (IN(15)) { phase_ln_ffn(c, args, 0, false PROBE_PASS);
#if defined(DUP_PHASE)
        if (DUP_PHASE == 15) { xcd_barrier(bar); phase_ln_ffn(c, args, 0, false PROBE_PASS); }
#endif
    } SEAM(15);
    if (IN(16)) { skinny_gemm(c, (const bf16*)HBF, D, (const bf16*)(ws + WS_WC), D, CN, SkC{(bf16*)(ws + WS_R1 + R1_QB), (bf16*)(ws + WS_R1 + R1_VB), (bf16*)(ws + WS_R1 + R1_GB), (bf16*)(ws + WS_R1 + R1_F), (const float*)(ws + WS_LBT)});
        zero_rows_bf16(c, (bf16*)(ws + WS_R1 + R1_F), 4096, 192, ROWV); zero_rows_bf16(c, (bf16*)(ws + WS_R1 + R1_QB), D, 192, ROWV); zero_rows_bf16(c, (bf16*)(ws + WS_R1 + R1_VB), D, 192, ROWV); zero_rows_bf16(c, (bf16*)(ws + WS_R1 + R1_GB), D, 192, ROWV);
        pg8::Gemm g = pg8::mkgemm(ws + WS_H8, ws + WS_WC8, SEQ, CN, D / 2); pg8::StaticOrder S; S.init(SEQ, 6144, c.nblk, c.bid, 1, 16);
        pg8::EpiProjC E{ws + WS_R1, (const float*)(ws + WS_LBT)}; pg8::gemm_phase<pg8::EpiProjC, pg8::StaticOrder, true>(c.lds, g, S, E, 0x79797979);
        pg8::Gemm g2 = pg8::mkgemm(HBF, ws + WS_WC, SEQ, CN, D); pg8::StaticOrder S2; S2.init(SEQ, 4096, c.nblk, c.bid, 1, 0);
        __syncthreads(); pg8::gemm_phase(c.lds, g2, S2, E);
#if defined(DUP_PHASE)
        if (DUP_PHASE == 16) { xcd_barrier(bar); pg8::gemm_phase<pg8::EpiProjC, pg8::StaticOrder, true>(c.lds, g, S, E, 0x79797979); __syncthreads(); pg8::gemm_phase(c.lds, g2, S2, E); }
#endif
    } SEAM(16);
    if (IN(17)) { phase_hg_build(c, args); if (c.nblk == 256 && c.bid >= 16) { __syncthreads(); conv_fill(c, args, R17_LO, R17_HI, c.bid - 16, 240); } xcd_barrier(bar); phase_hg_pass1(c, args); xcd_barrier(bar); phase_hg_segscan(c, args); xcd_barrier(bar); phase_hg_pass2<1>(c, args);
#if defined(DUP_PHASE)
        if (DUP_PHASE == 17) { xcd_barrier(bar); phase_hg_build(c, args); }
        if (DUP_PHASE == 170) { xcd_barrier(bar); phase_hg_pass1(c, args); xcd_barrier(bar); phase_hg_segscan(c, args); }
        if (DUP_PHASE == 171) { xcd_barrier(bar); phase_hg_pass2<1>(c, args); }
#endif
    } SEAM(17);
    if (IN(18)) { phase_hg_pass2<0>(c, args);
#if defined(DUP_PHASE)
        if (DUP_PHASE == 18) { xcd_barrier(bar); phase_hg_pass2<0>(c, args); }
#endif
    } SEAM(18);
    if (IN(19)) { skinny_gemm(c, (const bf16*)MIXIN, D, (const bf16*)(ws + WS_WOC), D, D, SkBf16{(bf16*)(ws + WS_MIX), D});
        pg8::Gemm g = pg8::mkgemm(ws + WS_MI8, ws + WS_WOC8, SEQ, D, D / 2); pg8::StaticOrder S; S.init(SEQ, D, c.nblk, c.bid, 1);
        pg8::EpiBf16 E{(pg8::bf16_t*)(ws + WS_MIX), D}; pg8::gemm_phase<pg8::EpiBf16, pg8::StaticOrder, true>(c.lds, g, S, E, 0x79797979);
#if defined(DUP_PHASE)
        if (DUP_PHASE == 19) { xcd_barrier(bar); skinny_gemm(c, (const bf16*)MIXIN, D, (const bf16*)(ws + WS_WOC), D, D, SkBf16{(bf16*)(ws + WS_MIX), D});
        pg8::Gemm g = pg8::mkgemm(MIXIN, ws + WS_WOC, SEQ, D, D); pg8::StaticOrder S; S.init(SEQ, D, c.nblk, c.bid, 1);
        pg8::EpiBf16 E{(pg8::bf16_t*)(ws + WS_MIX), D}; pg8::gemm_phase(c.lds, g, S, E); }
#endif

#if defined(DUP_PHASE)
        if (DUP_PHASE == 190) { xcd_barrier(bar); pg8::EpiNull EN{(float*)(ws + WS_CTL) + 70000}; pg8::gemm_phase(c.lds, g, S, EN); }
#endif
    } SEAM(19);
    if (IN(20)) { phase_ln_mix(c, args, 1);
#if defined(DUP_PHASE)
        if (DUP_PHASE == 20) { xcd_barrier(bar); phase_ln_mix(c, args, 1); }
#endif
    } SEAM(20);
    if (IN(21)) { phase_router(c, args, 1);
        if (c.nblk == 256 && c.bid != 0) { __syncthreads(); conv_fill(c, args, R21_LO, R21_HI, c.bid - 1, 255); }
#if defined(DUP_PHASE)
        if (DUP_PHASE == 21) { xcd_barrier(bar); phase_router(c, args, 1); }
#endif
    } SEAM(21);
    if (IN(22)) {
        if (c.nblk == 256) { const int nwg = ((const int*)(ws + WS_CTL))[CW_PLAN] * 4, done = (nwg > 512 && nwg < 768) ? ((768 - nwg) < 128 ? (768 - nwg) : 128) : 0;
            for (int it = R13_LO + done * 40 + c.gw; it < R13_HI; it += c.ngw) conv_l1_item(c, args, it);
            __syncthreads(); }
        phase_gather(c, args, 1);
#if defined(DUP_PHASE)
        if (DUP_PHASE == 22) { xcd_barrier(bar); phase_gather(c, args, 1); }
#endif
    } SEAM(22);
    if (IN(23)) { pg8::Gemm g = pg8::mkgemm(ws + WS_H8, ws + WS_WGU + (size_t)NEXP * 1024 * D, MPAD, 1024, D / 2, (size_t)1024 * D); pg8::GatherOrder S; S.init((const int*)(ws + WS_CTL) + CW_PLAN + 512, 1024, c.nblk, c.bid, (const int*)(ws + WS_ROWLIST));
        pg8::EpiSwiGLU8 E{ws + WS_R1 + R1_ACT, DEXP}; pg8::gemm_phase<pg8::EpiSwiGLU8, pg8::GatherOrder, true>(c.lds, g, S, E, 0x79797979);
#if defined(DUP_PHASE)
        if (DUP_PHASE == 23) { xcd_barrier(bar); pg8::Gemm g = pg8::mkgemm(ws + WS_H8, ws + WS_WGU + (size_t)NEXP * 1024 * D, MPAD, 1024, D / 2, (size_t)1024 * D); pg8::GatherOrder S; S.init((const int*)(ws + WS_CTL) + CW_PLAN + 512, 1024, c.nblk, c.bid, (const int*)(ws + WS_ROWLIST));
        pg8::EpiSwiGLU8 E{ws + WS_R1 + R1_ACT, DEXP}; pg8::gemm_phase<pg8::EpiSwiGLU8, pg8::GatherOrder, true>(c.lds, g, S, E, 0x79797979); }
#endif
    } SEAM(23);
    if (IN(24)) { pg8::Gemm g = pg8::mkgemm(ws + WS_R1 + R1_ACT, ws + WS_WD + (size_t)NEXP * D * DEXP, MPAD, D, DEXP / 2, (size_t)D * DEXP); pg8::GroupedOrder S; S.init((const int*)(ws + WS_CTL) + CW_PLAN + 512, D, c.nblk, c.bid);
        pg8::EpiBf16 E{(pg8::bf16_t*)(ws + WS_R1 + R1_Y), D}; pg8::gemm_phase<pg8::EpiBf16, pg8::GroupedOrder, true>(c.lds, g, S, E, 0x79797979);
#if defined(DUP_PHASE)
        if (DUP_PHASE == 24) { xcd_barrier(bar); pg8::Gemm g = pg8::mkgemm(ws + WS_R1 + R1_ACT, ws + WS_WD + (size_t)NEXP * D * DEXP, MPAD, D, DEXP / 2, (size_t)D * DEXP); pg8::GroupedOrder S; S.init((const int*)(ws + WS_CTL) + CW_PLAN + 512, D, c.nblk, c.bid);
        pg8::EpiBf16 E{(pg8::bf16_t*)(ws + WS_R1 + R1_Y), D}; pg8::gemm_phase<pg8::EpiBf16, pg8::GroupedOrder, true>(c.lds, g, S, E, 0x79797979); }
#endif
    } SEAM(24);
    if (IN(25)) {
#ifdef PROBE_MASK
        { const unsigned long long* ts = (const unsigned long long*)((unsigned*)(args.ws + WS_CTL) + CW_TS); const double tot = (double)(ts[25] - ts[0]); double acc = 0.0;
          for (int k = 0; k < 25; ++k) { if ((PROBE_MASK >> k) & 1ull) acc += (double)(ts[k + 1] - ts[k]); if ((PROBE_BARMASK >> k) & 1ull) acc += (double)(ts[k + 1] - ts[64 + k]); }
          g_probe_scale = 1.0f + 0.05f + 0.5f * (float)(acc / tot); }
#endif
        phase_ln_ffn(c, args, 1, true PROBE_PASS); }
#undef IN
#undef SEAM
}
constexpr int LAST_PHASE = 25;

extern "C" void kernel_launch(void* const* d_in, const int* in_sizes, int n_in, void* d_out, int out_size, void* d_ws, size_t ws_size, hipStream_t stream) {
    static int grid = 0;
    if (grid == 0) {
        if (n_in != 29 || ws_size < WS_END) { fprintf(stderr, "kernel_launch: expected 29 inputs and >= %zu bytes of workspace (got %d, %zu)\n", (size_t)WS_END, n_in, ws_size); grid = -1; return; }
        int dev = 0, cus = 0, per_cu = 0;
        if (hipGetDevice(&dev) != hipSuccess || hipDeviceGetAttribute(&cus, hipDeviceAttributeMultiprocessorCount, dev) != hipSuccess) { grid = -1; return; }
        if (hipFuncSetAttribute((const void*)fwd, hipFuncAttributeMaxDynamicSharedMemorySize, LDS_BYTES) != hipSuccess) { fprintf(stderr, "kernel_launch: hipFuncSetAttribute failed\n"); grid = -1; return; }
        if (hipOccupancyMaxActiveBlocksPerMultiprocessor(&per_cu, (const void*)fwd, NTHR, LDS_BYTES) != hipSuccess || per_cu < 1) fprintf(stderr, "kernel_launch: occupancy query says %d\n", per_cu);
        (void)hipGetLastError();
        grid = cus;
    }
    if (grid < 0) return;
    (void)hipMemsetAsync((char*)d_ws + WS_CTL, 0, CTL_BYTES, stream);
    Args a{};
    for (int i = 0; i < 29; ++i) a.in[i] = (const float*)d_in[i];
    a.out = (float*)d_out; a.ws = (unsigned char*)d_ws;
#ifndef MK_N_LAUNCHES
#define MK_N_LAUNCHES 1
#endif
    if (MK_N_LAUNCHES == 1) { a.ph_lo = 0; a.ph_hi = LAST_PHASE + 1; hipLaunchKernelGGL(fwd, dim3(grid), dim3(NTHR), LDS_BYTES, stream, a); }
    else for (int p = 0; p <= LAST_PHASE; ++p) {
        a.ph_lo = p; a.ph_hi = p + 1;
        hipLaunchKernelGGL(fwd, dim3(grid), dim3(NTHR), LDS_BYTES, stream, a);
    }
}
```

```cpp
#include <hip/hip_runtime.h>
#include <cstdio>
#include <cstdint>

namespace pg8 {
#define PG8_LAS __attribute__((address_space(3)))
typedef unsigned short bf16_t;
typedef short bf16x8 __attribute__((ext_vector_type(8)));
typedef float f32x4 __attribute__((ext_vector_type(4)));
typedef unsigned u32x4 __attribute__((ext_vector_type(4)));
constexpr int BM = 256, BK = 64, HALF = 128, HTB = HALF * BK * 2, STAGE_BYTES = 8 * HTB, NXCD = 8, WGM = 4;

__host__ __device__ __forceinline__ int lds_byte(int r, int c) { const int st = (r >> 4) * 2 + (c >> 5), rr = r & 15, cc = c & 31, ob = rr * 64 + cc * 2; return st * 1024 + (ob ^ (((ob >> 9) & 1) << 5)); }
__host__ __device__ __forceinline__ void stage_rc(int b, int& R, int& C) { const int st = b / 1024, sb = b % 1024, swz = sb ^ (((sb >> 9) & 1) << 5); R = (st >> 1) * 16 + swz / 64; C = (st & 1) * 32 + (swz % 64) / 2; }
__host__ __device__ __forceinline__ int perm32(int rho) { const int n = rho >> 4, i = rho & 15; return 8 * (i >> 2) + 4 * n + (i & 3); }

struct Unit { int pm, pn, eb; };
struct Gemm { const bf16_t* A; const bf16_t* Bt; int M, N, K, lda, ldb; size_t astride, bstride; };

struct StaticOrder {
    static constexpr bool GATHER = false;
    int nM, nN, nwg, G, c, pm_off, pn_off, gap_at, gap;
    __host__ __device__ __forceinline__ void init(int M, int N, int G_, int c_, int pm_off_ = 0, int pn_off_ = 0, int gap_at_ = 1 << 30, int gap_ = 0) { nM = M / BM; nN = N / BM; nwg = nM * nN; G = G_; c = c_; pm_off = pm_off_; pn_off = pn_off_; gap_at = gap_at_; gap = gap_; }
    __host__ __device__ __forceinline__ bool next(int i, Unit& u) const {
        const long L = (long)i * G + c; if (L >= nwg) return false;
        int wgid = (int)L; { const int q = nwg / NXCD, r = nwg % NXCD, xcd = wgid % NXCD, off = wgid / NXCD; wgid = (xcd < r ? xcd * (q + 1) : r * (q + 1) + (xcd - r) * q) + off; }
        const int nig = WGM * nN, gid = wgid / nig, fm = gid * WGM, gsz = (nM - fm) < WGM ? (nM - fm) : WGM;
        u.pm = fm + ((wgid % nig) % gsz) + pm_off; const int pn_ = (wgid % nig) / gsz; u.pn = pn_ + pn_off + (pn_ >= gap_at ? gap : 0); u.eb = 0; return true;
    }
    __device__ __forceinline__ void a_ready(const Unit&) const {}
    __device__ __forceinline__ void done(const Unit&) const {}
};
template <bool GATHER_> struct GroupedOrderT {
    static constexpr bool GATHER = GATHER_;
    int ntiles, nN, nwg, G, c; const int* tile_expert; const int* rowlist;
    __device__ __forceinline__ void init(const int* plan, int N, int G_, int c_, const int* rowlist_ = nullptr) { ntiles = plan[0]; tile_expert = plan + 128; nN = N / BM; nwg = ntiles * nN; G = G_; rowlist = rowlist_;
        c = (G_ % NXCD == 0) ? (c_ % NXCD) * (G_ / NXCD) + c_ / NXCD : c_; }
    __device__ __forceinline__ bool next(int i, Unit& u) const {
        const long L = (long)i * G + c; if (L >= nwg) return false;
        u.pm = (int)(L / nN); u.pn = (int)(L % nN); u.eb = tile_expert[u.pm]; return true;
    }
    __device__ __forceinline__ void a_ready(const Unit&) const {}
    __device__ __forceinline__ void done(const Unit&) const {}
};

typedef GroupedOrderT<false> GroupedOrder; typedef GroupedOrderT<true> GatherOrder;
struct GroupTileOrder {
    static constexpr bool GATHER = false;
    int nM, nN, nwg, G, c;
    __device__ __forceinline__ void init(int groups, int M, int N, int G_, int c_) { nM = M / BM; nN = N / BM; nwg = groups * nM * nN; G = G_; c = c_; }
    __device__ __forceinline__ bool next(int i, Unit& u) const {
        const long L = (long)i * G + c; if (L >= nwg) return false;
        const int per = nM * nN, rem = (int)(L % per); u.eb = (int)(L / per); u.pm = rem % nM; u.pn = rem / nM; return true;
    }
    __device__ __forceinline__ void a_ready(const Unit&) const {}
    __device__ __forceinline__ void done(const Unit&) const {}
};
__device__ __forceinline__ unsigned cvt_pk_bf16(float lo, float hi) { unsigned r; asm volatile("v_cvt_pk_bf16_f32 %0, %1, %2" : "=v"(r) : "v"(lo), "v"(hi)); return r; }

struct EpiF32 {
    static constexpr bool PERM = false, AFTER_DRAIN = false;
    float* C; int ldc; size_t cstride;
    __device__ __forceinline__ void operator()(const f32x4 (&acc)[2][2][4][2], const Unit& u, int wr, int wc, int fr, int fq) const {
        const int row0 = u.pm * BM + wr * 64 + fr, col0 = u.pn * BM + wc * 32 + 4 * fq;
#pragma unroll
        for (int ai = 0; ai < 2; ++ai)
#pragma unroll
            for (int m = 0; m < 4; ++m) { float* rowp = C + (size_t)u.eb * cstride + (size_t)(row0 + ai * HALF + m * 16) * ldc + col0;
#pragma unroll
                for (int bj = 0; bj < 2; ++bj)
#pragma unroll
                    for (int n = 0; n < 2; ++n) *(f32x4*)(rowp + bj * HALF + n * 16) = acc[ai][bj][m][n]; }
    }
};
struct EpiSwiGLU {
    static constexpr bool PERM = true, AFTER_DRAIN = false;
    bf16_t* O; int ldc;
    __device__ __forceinline__ void operator()(const f32x4 (&acc)[2][2][4][2], const Unit& u, int wr, int wc, int fr, int fq) const {
        const int row0 = u.pm * BM + wr * 64 + fr, col0 = u.pn * HALF + wc * 32 + 8 * fq;
#pragma unroll
        for (int ai = 0; ai < 2; ++ai)
#pragma unroll
            for (int m = 0; m < 4; ++m) { bf16_t* rowp = O + (size_t)(row0 + ai * HALF + m * 16) * ldc + col0;
                float r[8];
#pragma unroll
                for (int n = 0; n < 2; ++n)
#pragma unroll
                    for (int i = 0; i < 4; ++i) { const float g = acc[ai][0][m][n][i], up = acc[ai][1][m][n][i]; r[n * 4 + i] = g / (1.0f + __expf(-g)) * up; }
                u32x4 w; w.x = cvt_pk_bf16(r[0], r[1]); w.y = cvt_pk_bf16(r[2], r[3]); w.z = cvt_pk_bf16(r[4], r[5]); w.w = cvt_pk_bf16(r[6], r[7]);
                *(u32x4*)rowp = w; }
    }
};

struct EpiSwiGLU8 {
    static constexpr bool PERM = true, AFTER_DRAIN = false;
    unsigned char* O; int ldc;
    __device__ __forceinline__ void operator()(const f32x4 (&acc)[2][2][4][2], const Unit& u, int wr, int wc, int fr, int fq) const {
        typedef unsigned u32x2 __attribute__((ext_vector_type(2)));
        const int row0 = u.pm * BM + wr * 64 + fr, col0 = u.pn * HALF + wc * 32 + 8 * fq;
#pragma unroll
        for (int ai = 0; ai < 2; ++ai)
#pragma unroll
            for (int m = 0; m < 4; ++m) { unsigned char* rowp = O + (size_t)(row0 + ai * HALF + m * 16) * ldc + col0;
                float r[8];
#pragma unroll
                for (int n = 0; n < 2; ++n)
#pragma unroll
                    for (int i = 0; i < 4; ++i) { const float g = acc[ai][0][m][n][i], up = acc[ai][1][m][n][i]; r[n * 4 + i] = g / (1.0f + __expf(-g)) * up; }
                int w0 = 0, w1 = 0; w0 = __builtin_amdgcn_cvt_pk_fp8_f32(r[0], r[1], w0, false); w0 = __builtin_amdgcn_cvt_pk_fp8_f32(r[2], r[3], w0, true);
                w1 = __builtin_amdgcn_cvt_pk_fp8_f32(r[4], r[5], w1, false); w1 = __builtin_amdgcn_cvt_pk_fp8_f32(r[6], r[7], w1, true);
                *(u32x2*)rowp = (u32x2){(unsigned)w0, (unsigned)w1}; }
    }
};
__host__ __device__ __forceinline__ Gemm mkgemm(const void* A, const void* Bt, int M, int N, int K, size_t bstride = 0) { Gemm g; g.A = (const bf16_t*)A; g.Bt = (const bf16_t*)Bt; g.M = M; g.N = N; g.K = K; g.lda = K; g.ldb = K; g.astride = 0; g.bstride = bstride; return g; }
struct EpiS5Y {
    static constexpr bool PERM = false, AFTER_DRAIN = false;
    bf16_t* ZB;
    __device__ __forceinline__ void operator()(const f32x4 (&acc)[2][2][4][2], const Unit& u, int wr, int wc, int fr, int fq) const {
#pragma unroll
        for (int ai = 0; ai < 2; ++ai)
#pragma unroll
            for (int m = 0; m < 4; ++m) { const int chunk = u.pm * BM + ai * HALF + wr * 64 + m * 16 + fr;
                if (chunk <= 512) {
#pragma unroll
                    for (int bj = 0; bj < 2; ++bj)
#pragma unroll
                        for (int n = 0; n < 2; ++n) { const int t = 16 * u.pn + 8 * bj + 2 * wc + n, row = 224 + 32 * chunk + t; float z[4];
#pragma unroll
                            for (int i = 0; i < 4; ++i) { const float y = acc[ai][bj][m][n][i]; const float x2 = 1.5957691216057308f * (y + 0.044715f * y * y * y);
                                const float th = 1.0f - 2.0f / (1.0f + __expf(x2)); z[i] = 0.5f * y * (1.0f + th); }
                            typedef unsigned u32x2 __attribute__((ext_vector_type(2)));
                            u32x2 w; w.x = cvt_pk_bf16(z[0], z[1]); w.y = cvt_pk_bf16(z[2], z[3]);
                            *(u32x2*)(ZB + (size_t)row * 1024 + 16 * u.eb + 4 * fq) = w; } } }
    }
};
struct EpiGlu {
    static constexpr bool PERM = true, AFTER_DRAIN = false;
    const bf16_t* ZB; const float* bias; bf16_t* O;
    __device__ __forceinline__ void operator()(const f32x4 (&acc)[2][2][4][2], const Unit& u, int wr, int wc, int fr, int fq) const {
        const int row0 = u.pm * BM + wr * 64 + fr, col0 = u.pn * BM + wc * 32 + 8 * fq;
#pragma unroll
        for (int ai = 0; ai < 2; ++ai)
#pragma unroll
            for (int m = 0; m < 4; ++m) { const int row = row0 + ai * HALF + m * 16;
#pragma unroll
                for (int bj = 0; bj < 2; ++bj) { const int col = col0 + bj * HALF;
                    const u32x4 zw = *(const u32x4*)(ZB + (size_t)row * 1024 + col);
                    const f32x4 b0 = *(const f32x4*)(bias + col), b1 = *(const f32x4*)(bias + col + 4);
                    float r[8];
#pragma unroll
                    for (int i = 0; i < 4; ++i) { const unsigned zz = i < 2 ? (i == 0 ? zw.x : zw.y) : (i == 2 ? zw.z : zw.w);
                        const float z0 = __uint_as_float(zz << 16), z1 = __uint_as_float(zz & 0xffff0000u);
                        const int e0 = 2 * i, e1 = 2 * i + 1;
                        const float a0 = (e0 < 4 ? acc[ai][bj][m][0][e0] : acc[ai][bj][m][1][e0 - 4]) + (e0 < 4 ? b0[e0] : b1[e0 - 4]);
                        const float a1 = (e1 < 4 ? acc[ai][bj][m][0][e1] : acc[ai][bj][m][1][e1 - 4]) + (e1 < 4 ? b0[e1] : b1[e1 - 4]);
                        r[e0] = z0 / (1.0f + __expf(-a0)); r[e1] = z1 / (1.0f + __expf(-a1)); }
                    u32x4 w; w.x = cvt_pk_bf16(r[0], r[1]); w.y = cvt_pk_bf16(r[2], r[3]); w.z = cvt_pk_bf16(r[4], r[5]); w.w = cvt_pk_bf16(r[6], r[7]);
                    *(u32x4*)(O + (size_t)row * 2048 + 1024 + col) = w; } }
    }
};

struct EpiBf16 {
    static constexpr bool PERM = true, AFTER_DRAIN = false;
    bf16_t* O; int ldc;
    __device__ __forceinline__ void operator()(const f32x4 (&acc)[2][2][4][2], const Unit& u, int wr, int wc, int fr, int fq) const {
        const int row0 = u.pm * BM + wr * 64 + fr, col0 = u.pn * BM + wc * 32 + 8 * fq;
#pragma unroll
        for (int ai = 0; ai < 2; ++ai)
#pragma unroll
            for (int m = 0; m < 4; ++m) { bf16_t* rowp = O + (size_t)(row0 + ai * HALF + m * 16) * ldc + col0;
#pragma unroll
                for (int bj = 0; bj < 2; ++bj) { const f32x4 v0 = acc[ai][bj][m][0], v1 = acc[ai][bj][m][1];
                    u32x4 w; w.x = cvt_pk_bf16(v0[0], v0[1]); w.y = cvt_pk_bf16(v0[2], v0[3]); w.z = cvt_pk_bf16(v1[0], v1[1]); w.w = cvt_pk_bf16(v1[2], v1[3]);
                    *(u32x4*)(rowp + bj * HALF) = w; } }
    }
};
struct EpiNull { static constexpr bool PERM = true, AFTER_DRAIN = false; float* sink;
    __device__ __forceinline__ void operator()(const f32x4 (&acc)[2][2][4][2], const Unit& u, int wr, int wc, int fr, int fq) const {
        float t = 0.f;
#pragma unroll
        for (int ai = 0; ai < 2; ++ai)
#pragma unroll
            for (int bj = 0; bj < 2; ++bj)
#pragma unroll
                for (int m = 0; m < 4; ++m)
#pragma unroll
                    for (int n = 0; n < 2; ++n) t += acc[ai][bj][m][n][0] + acc[ai][bj][m][n][1] + acc[ai][bj][m][n][2] + acc[ai][bj][m][n][3];
        if (t == 123.456f) sink[0] = t; } };
#ifndef PG8_SP2
#define PG8_SP2 1
#endif
template <class Epi, class Sched, bool FP8 = false>
__device__ __forceinline__ void gemm_phase(PG8_LAS unsigned char* lds, const Gemm g, const Sched& S, const Epi& E, int scale_w = 0x7f7f7f7f) {
    const int tid = threadIdx.x, wid = __builtin_amdgcn_readfirstlane(tid >> 6), lane = tid & 63, wr = wid >> 2, wc = wid & 3, fr = lane & 15, fq = lane >> 4;
    const int K = g.K, nt = K / BK;
    unsigned voffA[2], voffB[2]; int stR[2], stC[2];
#pragma unroll
    for (int i = 0; i < 2; ++i) { int R, C; stage_rc(tid * 16 + i * 8192, R, C); const int Rb = Epi::PERM ? ((R & ~31) + perm32(R & 31)) : R;
        voffA[i] = (unsigned)(R * g.lda + C) * 2u; voffB[i] = (unsigned)(Rb * g.ldb + C) * 2u; stR[i] = R; stC[i] = C; }
    const size_t kstep = (size_t)(BK * 2);
    const size_t hstepA = (size_t)HALF * g.lda * 2, hstepB = (size_t)HALF * g.ldb * 2;
    const size_t tstepA = 2 * hstepA, tstepB = 2 * hstepB;
    const unsigned ldsw = (unsigned)wid * 1024u;
    const int aoff = lds_byte(wr * 64 + fr, fq * 8), boff = lds_byte(wc * 32 + fr, fq * 8);
#define PG8_SA(b, h) (((b) * 2 + (h)) * HTB)
#define PG8_SB(b, h) ((4 + (b) * 2 + (h)) * HTB)
#define PG8_STAGE(bufoff, gbase, voff) do { _Pragma("unroll") for (int _i = 0; _i < 2; ++_i) \
        __builtin_amdgcn_global_load_lds((const unsigned*)((const char*)(gbase) + (voff)[_i]), (PG8_LAS unsigned*)(lds + (bufoff) + ldsw + _i * 8192), 16, 0, 0); } while (0)
#define PG8_LD8(base_) __builtin_shufflevector(*(const PG8_LAS v4i_t*)(base_), *(const PG8_LAS v4i_t*)((base_) + 1024), 0, 1, 2, 3, 4, 5, 6, 7)
#define PG8_LDA(dst, b, h) do { if constexpr (FP8) { _Pragma("unroll") for (int m = 0; m < 4; ++m) dst##8[m] = PG8_LD8(lds + PG8_SA(b, h) + aoff + m * 2048); } \
        else { _Pragma("unroll") for (int m = 0; m < 4; ++m) _Pragma("unroll") for (int k = 0; k < 2; ++k) dst[m][k] = *(const PG8_LAS bf16x8*)(lds + PG8_SA(b, h) + aoff + m * 2048 + k * 1024); } } while (0)
#define PG8_LDB(dst, b, h) do { if constexpr (FP8) { _Pragma("unroll") for (int n = 0; n < 2; ++n) dst##8[n] = PG8_LD8(lds + PG8_SB(b, h) + boff + n * 2048); } \
        else { _Pragma("unroll") for (int n = 0; n < 2; ++n) _Pragma("unroll") for (int k = 0; k < 2; ++k) dst[n][k] = *(const PG8_LAS bf16x8*)(lds + PG8_SB(b, h) + boff + n * 2048 + k * 1024); } } while (0)
#define PG8_MMA(ai, bj, At, Bt) do { __builtin_amdgcn_s_setprio(1); _Pragma("unroll") for (int m = 0; m < 4; ++m) _Pragma("unroll") for (int n = 0; n < 2; ++n) { \
        if constexpr (FP8) asm volatile("v_mfma_scale_f32_16x16x128_f8f6f4 %0, %1, %2, %0, %3, %4 op_sel_hi:[0,0,0]" : "+v"(acc[ai][bj][m][n]) : "v"(Bt##8[n]), "v"(At##8[m]), "v"(scw_), "v"(sca_)); \
        else { _Pragma("unroll") for (int k = 0; k < 2; ++k) acc[ai][bj][m][n] = __builtin_amdgcn_mfma_f32_16x16x32_bf16(Bt[n][k], At[m][k], acc[ai][bj][m][n], 0, 0, 0); } } \
        __builtin_amdgcn_s_setprio(0); } while (0)
#define PG8_WAIT_V(n) asm volatile("s_waitcnt vmcnt(" #n ")" ::: "memory")
#define PG8_WAIT_L(n) asm volatile("s_waitcnt lgkmcnt(" #n ")" ::: "memory")
#define PG8_BAR __builtin_amdgcn_s_barrier()
#define PG8_SCHED __builtin_amdgcn_sched_barrier(0)
    unsigned vC[2][2], vN[2][2];
#define PG8_AOFF(dst, unit) do { _Pragma("unroll") for (int h_ = 0; h_ < 2; ++h_) _Pragma("unroll") for (int i_ = 0; i_ < 2; ++i_) { \
        if constexpr (Sched::GATHER) { const int row_ = S.rowlist[(unit).pm * BM + h_ * HALF + stR[i_]]; dst[h_][i_] = (unsigned)(row_ * g.lda + stC[i_]) * 2u; } \
        else dst[h_][i_] = voffA[i_] + (unsigned)(h_ * hstepA); } } while (0)
    Unit cur, nxt; int ui = 0;
    if (!S.next(0, cur)) return;
    f32x4 acc[2][2][4][2];
#pragma unroll
    for (int a = 0; a < 2; ++a)
#pragma unroll
        for (int b = 0; b < 2; ++b)
#pragma unroll
            for (int m = 0; m < 4; ++m)
#pragma unroll
                for (int n = 0; n < 2; ++n) acc[a][b][m][n] = (f32x4){0.f, 0.f, 0.f, 0.f};
    typedef int v8i_t __attribute__((ext_vector_type(8))); typedef int v4i_t __attribute__((ext_vector_type(4)));
    const int scw_ = scale_w, sca_ = 0x7f7f7f7f;
    bf16x8 At[4][2], B0[2][2], B1[2][2]; v8i_t At8[4], B08[2], B18[2];
    const char* cA = (const char*)g.A + (size_t)cur.eb * g.astride + (Sched::GATHER ? (size_t)0 : (size_t)cur.pm * tstepA); const char* cB = (const char*)g.Bt + (size_t)cur.eb * g.bstride + (size_t)cur.pn * tstepB;
    PG8_AOFF(vC, cur);
    S.a_ready(cur);
#if PG8_SP2
    PG8_STAGE(PG8_SB(0, 0), cB, voffB); PG8_STAGE(PG8_SB(0, 1), cB + hstepB, voffB); PG8_STAGE(PG8_SA(0, 0), cA, vC[0]); PG8_STAGE(PG8_SA(0, 1), cA, vC[1]);
    if (wr == 1) PG8_BAR;
    PG8_WAIT_V(2); PG8_BAR;
    PG8_STAGE(PG8_SB(1, 0), cB + kstep, voffB); PG8_STAGE(PG8_SA(1, 0), cA + kstep, vC[0]); PG8_STAGE(PG8_SB(1, 1), cB + hstepB + kstep, voffB);
    PG8_WAIT_V(6); PG8_BAR;
#else
    PG8_STAGE(PG8_SB(0, 0), cB, voffB); PG8_STAGE(PG8_SA(0, 0), cA, vC[0]); PG8_STAGE(PG8_SB(0, 1), cB + hstepB, voffB); PG8_STAGE(PG8_SA(0, 1), cA, vC[1]);
    if (wr == 1) PG8_BAR;
    PG8_WAIT_V(4); PG8_BAR;
    PG8_STAGE(PG8_SB(1, 0), cB + kstep, voffB); PG8_STAGE(PG8_SA(1, 0), cA + kstep, vC[0]); PG8_STAGE(PG8_SB(1, 1), cB + hstepB + kstep, voffB);
    PG8_WAIT_V(6); PG8_BAR;
#endif
    for (;;) {
        const bool has_next = S.next(ui + 1, nxt);
        const char* nA = has_next ? (const char*)g.A + (size_t)nxt.eb * g.astride + (Sched::GATHER ? (size_t)0 : (size_t)nxt.pm * tstepA) : cA;
        if constexpr (Sched::GATHER) { if (has_next) PG8_AOFF(vN, nxt); else { _Pragma("unroll") for (int h_ = 0; h_ < 2; ++h_) _Pragma("unroll") for (int i_ = 0; i_ < 2; ++i_) vN[h_][i_] = vC[h_][i_]; } }
        const char* nB = has_next ? (const char*)g.Bt + (size_t)nxt.eb * g.bstride + (size_t)nxt.pn * tstepB : cB;
        for (int t = 0; t < nt; t += 2) {
            const bool last = (t == nt - 2);
            const char* a1 = cA + (size_t)(t + 1) * kstep;
            const char* a2 = last ? nA : cA + (size_t)(t + 2) * kstep; const char* b2 = last ? nB : cB + (size_t)(t + 2) * kstep;
            const char* a3 = a2 + kstep; const char* b3 = b2 + kstep;
            if (last && has_next) S.a_ready(nxt);
            unsigned vs0[2], vs1[2];
            if constexpr (Sched::GATHER) { vs0[0] = last ? vN[0][0] : vC[0][0]; vs0[1] = last ? vN[0][1] : vC[0][1]; vs1[0] = last ? vN[1][0] : vC[1][0]; vs1[1] = last ? vN[1][1] : vC[1][1]; }
            else { vs0[0] = vC[0][0]; vs0[1] = vC[0][1]; vs1[0] = vC[1][0]; vs1[1] = vC[1][1]; }
#if PG8_SP2
            PG8_LDB(B0, 0, 0); PG8_LDB(B1, 0, 1); PG8_SCHED; PG8_LDA(At, 0, 0); PG8_STAGE(PG8_SA(1, 1), a1, vC[1]);
            PG8_WAIT_V(8); PG8_WAIT_L(0); PG8_BAR; PG8_MMA(0, 0, At, B0); PG8_MMA(0, 1, At, B1); PG8_BAR; PG8_SCHED;
            PG8_LDA(At, 0, 1); PG8_STAGE(PG8_SB(0, 0), b2, voffB); PG8_STAGE(PG8_SB(0, 1), b2 + hstepB, voffB); PG8_STAGE(PG8_SA(0, 0), a2, vs0);
            PG8_WAIT_V(8); PG8_WAIT_L(0); PG8_BAR; PG8_MMA(1, 0, At, B0); PG8_MMA(1, 1, At, B1); PG8_BAR; PG8_SCHED;
            PG8_LDB(B0, 1, 0); PG8_LDB(B1, 1, 1); PG8_SCHED; PG8_LDA(At, 1, 0); PG8_STAGE(PG8_SA(0, 1), a2, vs1);
            PG8_WAIT_V(8); PG8_WAIT_L(0); PG8_BAR; PG8_MMA(0, 0, At, B0); PG8_MMA(0, 1, At, B1); PG8_BAR; PG8_SCHED;
            PG8_LDA(At, 1, 1); PG8_STAGE(PG8_SB(1, 0), b3, voffB); PG8_STAGE(PG8_SB(1, 1), b3 + hstepB, voffB); PG8_STAGE(PG8_SA(1, 0), a3, vs0);
            PG8_WAIT_V(8); PG8_WAIT_L(0); PG8_BAR; PG8_MMA(1, 0, At, B0); PG8_MMA(1, 1, At, B1); PG8_BAR; PG8_SCHED;
#else
            PG8_LDB(B0, 0, 0); PG8_SCHED; PG8_LDA(At, 0, 0); PG8_STAGE(PG8_SA(1, 1), a1, vC[1]);
            PG8_WAIT_L(8); PG8_BAR; PG8_WAIT_L(0); PG8_MMA(0, 0, At, B0); PG8_BAR; PG8_SCHED;
            PG8_LDB(B1, 0, 1); PG8_STAGE(PG8_SB(0, 0), b2, voffB);
            PG8_BAR; PG8_WAIT_L(0); PG8_MMA(0, 1, At, B1); PG8_BAR;
            PG8_LDA(At, 0, 1); PG8_STAGE(PG8_SA(0, 0), a2, vs0);
            PG8_BAR; PG8_WAIT_L(0); PG8_MMA(1, 0, At, B0); PG8_BAR; PG8_SCHED;
            PG8_STAGE(PG8_SB(0, 1), b2 + hstepB, voffB);
            PG8_WAIT_V(6); PG8_BAR; PG8_MMA(1, 1, At, B1); PG8_BAR;
            PG8_LDB(B0, 1, 0); PG8_SCHED; PG8_LDA(At, 1, 0); PG8_STAGE(PG8_SA(0, 1), a2, vs1);
            PG8_WAIT_L(8); PG8_BAR; PG8_WAIT_L(0); PG8_MMA(0, 0, At, B0); PG8_BAR; PG8_SCHED;
            PG8_LDB(B1, 1, 1); PG8_STAGE(PG8_SB(1, 0), b3, voffB);
            PG8_BAR; PG8_WAIT_L(0); PG8_MMA(0, 1, At, B1); PG8_BAR;
            PG8_LDA(At, 1, 1); PG8_STAGE(PG8_SA(1, 0), a3, vs0);
            PG8_BAR; PG8_WAIT_L(0); PG8_MMA(1, 0, At, B0); PG8_BAR; PG8_SCHED;
            PG8_STAGE(PG8_SB(1, 1), b3 + hstepB, voffB);
            PG8_WAIT_V(6); PG8_BAR; PG8_MMA(1, 1, At, B1); PG8_BAR;
#endif
        }
        if constexpr (FP8) asm volatile("s_nop 15\n\ts_nop 15" ::: "memory");
        if (wr == 0) PG8_BAR;
        E(acc, cur, wr, wc, fr, fq); S.done(cur);
        if (!has_next) break;
#pragma unroll
        for (int a = 0; a < 2; ++a)
#pragma unroll
            for (int b = 0; b < 2; ++b)
#pragma unroll
                for (int m = 0; m < 4; ++m)
#pragma unroll
                    for (int n = 0; n < 2; ++n) acc[a][b][m][n] = (f32x4){0.f, 0.f, 0.f, 0.f};
        cur = nxt; cA = nA; cB = nB; ++ui;
        if constexpr (Sched::GATHER) {
#pragma unroll
            for (int h_ = 0; h_ < 2; ++h_)
#pragma unroll
                for (int i_ = 0; i_ < 2; ++i_) vC[h_][i_] = vN[h_][i_]; }
        if (wr == 1) PG8_BAR;
    }
    PG8_WAIT_V(0);
    PG8_BAR;
#undef PG8_AOFF
#undef PG8_SA
#undef PG8_SB
#undef PG8_STAGE
#undef PG8_LDA
#undef PG8_LD8
#undef PG8_LDB
#undef PG8_MMA
#undef PG8_WAIT_V
#undef PG8_WAIT_L
#undef PG8_BAR
#undef PG8_SCHED
}
}

constexpr int D = 2048, SEQ = 16384, NMETA = 16;
constexpr int LP = 16640;
constexpr int ROWV = 240;
constexpr int NVALID = 16400;
constexpr int ABN = 2560, CN = 10240;
constexpr int NEXP = 64, DEXP = 512;
constexpr int MAXTILES = 192, MPAD = MAXTILES * 256;
constexpr float DN_ALPHA = 1.4142135623730951f;
constexpr float LN_EPS = 1e-5f;
constexpr int NWAVES = 8, NTHR = 512;

constexpr size_t al(size_t x) { return (x + 0xFFFFFull) & ~(size_t)0xFFFFFull; }
constexpr size_t WS_CTL = 0, CTL_BYTES = 1u << 20;
constexpr size_t WS_WAB = al(WS_CTL + CTL_BYTES);
constexpr size_t WS_WOAB = al(WS_WAB + (size_t)ABN * D * 2);
constexpr size_t WS_WGLU = al(WS_WOAB + (size_t)D * D * 2);
constexpr size_t WS_WC = al(WS_WGLU + (size_t)1024 * 1024 * 2);
constexpr size_t WS_WOC = al(WS_WC + (size_t)CN * D * 2);
constexpr size_t WS_WGU = al(WS_WOC + (size_t)D * D * 2);
constexpr size_t WS_WD = al(WS_WGU + (size_t)2 * NEXP * 1024 * D * 2);
constexpr size_t WS_HA = al(WS_WD + (size_t)2 * NEXP * D * DEXP * 2);
constexpr size_t WS_HB = al(WS_HA + (size_t)LP * D * 4);
constexpr size_t WS_WC8 = WS_HB;
constexpr size_t WS_H8 = WS_HA;
constexpr size_t WS_HBF = al(WS_HB + (size_t)LP * D * 4);
constexpr size_t WS_PROJ0 = al(WS_HBF + (size_t)LP * D * 2);
constexpr size_t WS_QB0 = WS_PROJ0;
constexpr size_t WS_KB0 = al(WS_QB0 + (size_t)LP * 1024 * 2);
constexpr size_t WS_VB0 = al(WS_KB0 + (size_t)LP * 256 * 2);
constexpr size_t WS_MIXIN = al(WS_VB0 + (size_t)LP * 256 * 2);
constexpr size_t WS_MIX = al(WS_MIXIN + (size_t)LP * D * 2);
constexpr size_t WS_Z = al(WS_MIX + (size_t)LP * D * 4);
constexpr size_t WS_ZB = al(WS_Z + (size_t)LP * 1024 * 4);
constexpr size_t WS_GLU = al(WS_ZB + (size_t)LP * 1024 * 2);
constexpr size_t WS_S5P = al(WS_GLU + (size_t)LP * 1024 * 4);
constexpr size_t WS_APOW = al(WS_S5P + (size_t)(2 * 64 * 64 * 8 + 2 * 64 * 64 * 16 * 8));
constexpr size_t WS_KTAB = al(WS_APOW + (size_t)2 * 64 * 64 * 33 * 8);
constexpr size_t WS_MWT = al(WS_KTAB + (size_t)2 * 64 * 32 * 256 * 4);
constexpr size_t WS_WST = al(WS_MWT + (size_t)64 * 512 * 768 * 2);
constexpr size_t WS_ROPE = al(WS_WST + (size_t)64 * 256 * 512 * 2);
constexpr size_t WS_WRT = al(WS_ROPE + (size_t)LP * 64 * 8);
constexpr size_t WS_WRH = al(WS_WRT + (size_t)2 * 96 * 2048 * 4);
constexpr size_t WS_WRL = al(WS_WRH + (size_t)2 * 96 * 2048 * 2);
constexpr size_t WS_LBT = al(WS_WRL + (size_t)2 * 96 * 2048 * 2);
constexpr size_t WS_ROUTE = al(WS_LBT + (size_t)2048 * 4);
constexpr size_t WS_ROWLIST = al(WS_ROUTE + (size_t)LP * 32);
constexpr size_t WS_R1 = al(WS_ROWLIST + (size_t)MPAD * 4);
constexpr size_t R1_BYTES = (size_t)1200 << 20;
constexpr size_t WS_END = WS_R1 + R1_BYTES;
constexpr size_t R1_UA = 0;
constexpr size_t R1_SALL = al((size_t)64 * 768 * 768 * 2);
constexpr size_t R1_QB = 0;
constexpr size_t R1_VB = al(R1_QB + (size_t)LP * D * 2);
constexpr size_t R1_GB = al(R1_VB + (size_t)LP * D * 2);
constexpr size_t R1_F = al(R1_GB + (size_t)LP * D * 2);
constexpr size_t R1_OBW = al(R1_F + (size_t)LP * 4096 * 4);
constexpr size_t R1_DS = al(R1_OBW + (size_t)LP * D * 2);
constexpr size_t R1_DSEG = al(R1_DS + (size_t)32 * 32 * 16384 * 4);
constexpr size_t IMG_SZ = 18432 + 2 * 54272;
constexpr size_t R1_IMG = al(R1_DSEG + (size_t)32 * 32 * 128 * 4);
constexpr size_t R1_GT = al(R1_IMG + (size_t)260 * 16 * IMG_SZ);
constexpr size_t R1_HG_END = R1_GT + (size_t)260 * 16 * 16384;
constexpr size_t R1_XSRT = 0;
constexpr size_t R1_ACT = al((size_t)MPAD * D * 2);
constexpr size_t R1_Y = al(R1_ACT + (size_t)MPAD * DEXP * 2);
constexpr size_t R1_MOE_END = R1_Y + (size_t)MPAD * D * 2;
static_assert(R1_HG_END <= R1_BYTES && R1_MOE_END <= R1_BYTES, "R1 overlays");
static_assert(WS_END <= (size_t)4 << 30, "workspace map must fit 4 GiB");
constexpr int CW_BAR = 4096;
constexpr int CW_CNT = 16384;
constexpr int CW_TS = 65536;
constexpr int CW_PLAN = 32768;

namespace pg8 {
struct EpiProjC {
    static constexpr bool PERM = true, AFTER_DRAIN = false;
    unsigned char* R1; const float* lbt;
    __device__ __forceinline__ void operator()(const f32x4 (&acc)[2][2][4][2], const Unit& u, int wr, int wc, int fr, int fq) const {
        bf16_t* F = (bf16_t*)(R1 + R1_F);
        const int row0 = u.pm * BM + wr * 64 + fr, col0 = u.pn * BM + wc * 32 + 8 * fq;
        const int kind = u.pn < 8 ? 0 : (u.pn < 16 ? 1 : (u.pn < 32 ? 2 : 3));
        if (kind == 2) {
#pragma unroll
            for (int bj = 0; bj < 2; ++bj) { const int col = col0 + bj * HALF - 4096; const f32x4 l0 = *(const f32x4*)(lbt + (col & 2047)), l1 = *(const f32x4*)(lbt + (col & 2047) + 4);
#pragma unroll
                for (int ai = 0; ai < 2; ++ai)
#pragma unroll
                    for (int m = 0; m < 4; ++m) { bf16_t* rowp = F + (size_t)(row0 + ai * HALF + m * 16) * 4096 + col; f32x4 v0 = acc[ai][bj][m][0], v1 = acc[ai][bj][m][1];
#pragma unroll
                        for (int i = 0; i < 4; ++i) { v0[i] = (1.0f - l0[i]) / (1.0f + __expf(v0[i])); v1[i] = (1.0f - l1[i]) / (1.0f + __expf(v1[i])); }
                        u32x4 w; w.x = cvt_pk_bf16(v0[0], v0[1]); w.y = cvt_pk_bf16(v0[2], v0[3]); w.z = cvt_pk_bf16(v1[0], v1[1]); w.w = cvt_pk_bf16(v1[2], v1[3]);
                        *(u32x4*)rowp = w; } }
        } else {
            const size_t ob = kind == 0 ? R1_QB : (kind == 1 ? R1_VB : R1_GB); bf16_t* O = (bf16_t*)(R1 + ob); const int cbase = kind == 0 ? 0 : (kind == 1 ? 2048 : 8192);
#pragma unroll
            for (int ai = 0; ai < 2; ++ai)
#pragma unroll
                for (int m = 0; m < 4; ++m) { bf16_t* rowp = O + (size_t)(row0 + ai * HALF + m * 16) * 2048 + col0 - cbase;
#pragma unroll
                    for (int bj = 0; bj < 2; ++bj) { f32x4 v0 = acc[ai][bj][m][0], v1 = acc[ai][bj][m][1];
                        if (kind == 3) {
#pragma unroll
                            for (int i = 0; i < 4; ++i) { v0[i] = 1.0f / (1.0f + __expf(-v0[i])); v1[i] = 1.0f / (1.0f + __expf(-v1[i])); } }
                        u32x4 w; w.x = cvt_pk_bf16(v0[0], v0[1]); w.y = cvt_pk_bf16(v0[2], v0[3]); w.z = cvt_pk_bf16(v1[0], v1[1]); w.w = cvt_pk_bf16(v1[2], v1[3]);
                        *(u32x4*)(rowp + bj * HALF) = w; } }
        }
    }
};
}

namespace pg8 {
struct EpiProjAB {
    static constexpr bool PERM = false, AFTER_DRAIN = false;
    unsigned char* ws;
    __device__ __forceinline__ void operator()(const f32x4 (&acc)[2][2][4][2], const Unit& u, int wr, int wc, int fr, int fq) const {
        typedef unsigned u32x2 __attribute__((ext_vector_type(2)));
        const int row0 = u.pm * BM + wr * 64 + fr;
        if (u.pn < 5) {
            const float* rope = (const float*)(ws + WS_ROPE); const int d0 = 16 * wc + 4 * fq;
#pragma unroll
            for (int ai = 0; ai < 2; ++ai)
#pragma unroll
                for (int m = 0; m < 4; ++m) { const int row = row0 + ai * HALF + m * 16; const f32x4 cs0 = *(const f32x4*)(rope + ((size_t)row * 64 + d0) * 2), cs1 = *(const f32x4*)(rope + ((size_t)row * 64 + d0) * 2 + 4);
                    const float cc[4] = {cs0[0], cs0[2], cs1[0], cs1[2]}, sn[4] = {cs0[1], cs0[3], cs1[1], cs1[3]};
#pragma unroll
                    for (int bj = 0; bj < 2; ++bj) { const f32x4 x1 = acc[ai][bj][m][0], x2 = acc[ai][bj][m][1]; float o1[4], o2[4];
#pragma unroll
                        for (int i = 0; i < 4; ++i) { o1[i] = x1[i] * cc[i] - x2[i] * sn[i]; o2[i] = x2[i] * cc[i] + x1[i] * sn[i]; }
                        bf16_t* dst = u.pn < 4 ? (bf16_t*)(ws + WS_QB0) + (size_t)row * 1024 + (2 * u.pn + bj) * 128 + d0 : (bf16_t*)(ws + WS_KB0) + (size_t)row * 256 + bj * 128 + d0;
                        u32x2 w1, w2; w1.x = cvt_pk_bf16(o1[0], o1[1]); w1.y = cvt_pk_bf16(o1[2], o1[3]); w2.x = cvt_pk_bf16(o2[0], o2[1]); w2.y = cvt_pk_bf16(o2[2], o2[3]);
                        *(u32x2*)dst = w1; *(u32x2*)(dst + 64) = w2; } }
        } else if (u.pn == 5) {
            const int col0 = wc * 32 + 4 * fq;
#pragma unroll
            for (int ai = 0; ai < 2; ++ai)
#pragma unroll
                for (int m = 0; m < 4; ++m) { bf16_t* rowp = (bf16_t*)(ws + WS_VB0) + (size_t)(row0 + ai * HALF + m * 16) * 256 + col0;
#pragma unroll
                    for (int bj = 0; bj < 2; ++bj)
#pragma unroll
                        for (int n = 0; n < 2; ++n) { const f32x4 v = acc[ai][bj][m][n]; u32x2 w; w.x = cvt_pk_bf16(v[0], v[1]); w.y = cvt_pk_bf16(v[2], v[3]); *(u32x2*)(rowp + bj * HALF + n * 16) = w; } }
        } else {
            bf16_t* UA = (bf16_t*)(ws + WS_R1 + R1_UA); const int col0 = u.pn * BM + wc * 32 + 4 * fq;
#pragma unroll
            for (int ai = 0; ai < 2; ++ai)
#pragma unroll
                for (int m = 0; m < 4; ++m) { const int row = row0 + ai * HALF + m * 16;
                    if (row >= 224) { const int chunk = (row - 224) >> 5, t = (row - 224) & 31;
#pragma unroll
                        for (int bj = 0; bj < 2; ++bj)
#pragma unroll
                            for (int n = 0; n < 2; ++n) { const int ch = col0 + bj * HALF + n * 16 - 1536, g = ch >> 4, cc = ch & 15; const f32x4 v = acc[ai][bj][m][n];
                                u32x2 w; w.x = cvt_pk_bf16(v[0], v[1]); w.y = cvt_pk_bf16(v[2], v[3]);
                                *(u32x2*)(UA + ((size_t)g * 768 + chunk) * 768 + t * 16 + cc) = w; } } }
        }
    }
};
}

#define LAS __attribute__((address_space(3)))
typedef unsigned short bf16;
typedef unsigned v4u __attribute__((ext_vector_type(4)));
typedef unsigned v2u __attribute__((ext_vector_type(2)));
typedef float f32x4 __attribute__((ext_vector_type(4)));
#define LDS_WAIT() asm volatile("s_waitcnt lgkmcnt(0)" ::: "memory")
__device__ __forceinline__ unsigned f2bf(float f) { unsigned u = __builtin_bit_cast(unsigned, f); return (u + 0x7fffu + ((u >> 16) & 1u)) >> 16; }
__device__ __forceinline__ unsigned pk2(float lo, float hi) { return f2bf(lo) | (f2bf(hi) << 16); }
typedef __bf16 bf16x2_t __attribute__((ext_vector_type(2)));
__device__ __forceinline__ unsigned pkbf(float lo, float hi) { bf16x2_t v = {(__bf16)lo, (__bf16)hi}; return __builtin_bit_cast(unsigned, v); }
__device__ __forceinline__ float wave_sum(float v) {
#pragma unroll
    for (int o = 1; o < 64; o <<= 1) v += __shfl_xor(v, o);
    return v;
}
__device__ __forceinline__ float wave_max(float v) {
#pragma unroll
    for (int o = 1; o < 64; o <<= 1) v = fmaxf(v, __shfl_xor(v, o));
    return v;
}
__device__ __forceinline__ float sigmoidf_(float x) { return 1.0f / (1.0f + expf(-x)); }

#define XB_TMO      128
#define XB_XCNT(j)  (256  + 64 * (j))
#define XB_XSUB(j)  (1280 + 64 * (j))
#define XB_XGEN(j)  (2304 + 64 * (j))
#define XB_TOP      3328
#define XB_TOPGEN   3392
#define XCD_BAR_WORDS 3456
#define XB_SPIN_CAP (1u << 22)
__device__ __forceinline__ unsigned xb_ld(unsigned* p)              { return __hip_atomic_load(p, __ATOMIC_RELAXED, __HIP_MEMORY_SCOPE_AGENT); }
__device__ __forceinline__ unsigned xb_add(unsigned* p, unsigned v) { return __hip_atomic_fetch_add(p, v, __ATOMIC_RELAXED, __HIP_MEMORY_SCOPE_AGENT); }
__device__ __forceinline__ unsigned xb_xcc_id() { return (unsigned)__builtin_amdgcn_s_getreg((3 << 11) | 20) & 0xFu; }
#define XB_SPIN(cond, bar) do { unsigned _sp = 0; while (cond) { __builtin_amdgcn_s_sleep(1); \
    if ((++_sp & 255u) == 0u) { if (xb_ld(&(bar)[XB_TMO])) break; if (_sp > XB_SPIN_CAP) { atomicAdd(&(bar)[XB_TMO], 1u); break; } } } } while (0)
struct XcdBarrier { unsigned* bar; unsigned x; volatile LAS unsigned* st; };
__device__ __forceinline__ XcdBarrier xcd_barrier_post(unsigned* bar, volatile LAS unsigned* st) {
    XcdBarrier b; b.bar = bar; b.x = xb_xcc_id(); b.st = st;
    if (threadIdx.x == 0) (void)xb_add(&bar[XB_XCNT(b.x)], 1u);
    return b;
}
__device__ __forceinline__ void xcd_barrier_complete(unsigned* bar, unsigned x, unsigned& nloc, unsigned& nx) {
    const unsigned G = gridDim.x * gridDim.y * gridDim.z;
    unsigned sum, cnt, mine, sp = 0u;
    for (;;) {
        sum = 0u; cnt = 0u; mine = 0u;
#pragma unroll
        for (unsigned j = 0; j < 16; ++j) { const unsigned c = xb_ld(&bar[XB_XCNT(j)]); sum += c; cnt += (c > 0u) ? 1u : 0u; mine = (j == x) ? c : mine; }
        if (sum == G) break;
        __builtin_amdgcn_s_sleep(1);
        if ((++sp & 255u) == 0u) { if (xb_ld(&bar[XB_TMO])) break; if (sp > XB_SPIN_CAP) { atomicAdd(&bar[XB_TMO], 1u); break; } }
    }
    nloc = mine > 0u ? mine : 1u; nx = cnt > 0u ? cnt : 1u;
}
__device__ __forceinline__ void xcd_barrier(const XcdBarrier& b) {
    asm volatile("s_waitcnt vmcnt(0)" ::: "memory");
    __syncthreads();
    if (threadIdx.x == 0) {
        unsigned* bar = b.bar;
        __builtin_amdgcn_s_waitcnt(0);
        unsigned nloc = b.st[0], nx = b.st[1];
        if (nloc == 0u) { xcd_barrier_complete(bar, b.x, nloc, nx); b.st[0] = nloc; b.st[1] = nx; }
        const unsigned old = xb_add(&bar[XB_XSUB(b.x)], 1u);
        const unsigned gen = old / nloc;
        if (old + 1u == (gen + 1u) * nloc) {
            __builtin_amdgcn_fence(__ATOMIC_RELEASE, "agent");
            asm volatile("s_waitcnt vmcnt(0)" ::: "memory");
            const unsigned og = xb_add(&bar[XB_TOP], 1u);
            const unsigned tg = og / nx;
            if (og + 1u == (tg + 1u) * nx) xb_add(&bar[XB_TOPGEN], 1u);
            else XB_SPIN(xb_ld(&bar[XB_TOPGEN]) == tg, bar);
            __builtin_amdgcn_fence(__ATOMIC_ACQUIRE, "agent");
            xb_add(&bar[XB_XGEN(b.x)], 1u);
            asm volatile("s_waitcnt vmcnt(0)" ::: "memory");
        } else {
            XB_SPIN(xb_ld(&bar[XB_XGEN(b.x)]) == gen, bar);
            __builtin_amdgcn_fence(__ATOMIC_ACQUIRE, "agent");
            asm volatile("s_waitcnt vmcnt(0)" ::: "memory");
        }
    }
    __syncthreads();
}

constexpr int RING_BYTES = 131072, LDS_BYTES = 155648, MISC_OFF = 153600;
struct Args { const float* in[29]; float* out; unsigned char* ws; int ph_lo, ph_hi; };
enum In { I_X = 0, I_META, I_WAB, I_WOAB, I_SINK, I_LRE, I_LIM, I_LSTEP, I_BRE, I_BIM, I_CRE, I_CIM, I_S5D, I_WGLU, I_BGLU, I_WC, I_WOC, I_LB, I_NORMG,
          I_LNMG, I_LNMB, I_LNFG, I_LNFB, I_WGRP, I_BGRP, I_WEXP, I_BEXP, I_WGU, I_WD };
struct Ctx { LAS unsigned char* lds; unsigned char* ldsg; int tid, lane, wave, bid, nblk, gw, ngw; };

__device__ __forceinline__ int rowmap_rope(int n) { if (n >= 1280) return n; const int d = n & 127; return (n & ~127) + 32 * ((d & 63) >> 4) + 16 * (d >> 6) + (d & 15); }
__device__ __forceinline__ int rowmap_gu(int n) { return n < 512 ? ((n >> 7) * 256 + (n & 127)) : (((n - 512) >> 7) * 256 + 128 + ((n - 512) & 127)); }
__device__ __forceinline__ void transpose_out(bf16* WT, int ldw, const LAS float* scr, int kb, int nb, int lane, int mode, unsigned char* WT8);
__device__ __forceinline__ void transpose_item(const float* W, int K, int N, bf16* WT, int ldw, LAS float* scr, int kb, int nb, int lane, int mode, unsigned char* WT8 = nullptr) {
    const int k0 = 128 * kb, n0 = 32 * nb;
    const float* wp = W + (size_t)(k0 + (lane >> 5)) * N + n0 + (lane & 31);
#pragma unroll
    for (int hh = 0; hh < 2; ++hh) { float v[32];
#pragma unroll
        for (int i = 0; i < 32; ++i) v[i] = __builtin_nontemporal_load(wp + (size_t)(64 * hh + 2 * i) * N);
#pragma unroll
        for (int i = 0; i < 32; ++i) scr[(64 * hh + 2 * i + (lane >> 5)) * 33 + (lane & 31)] = v[i]; }
    LDS_WAIT(); asm volatile("" ::: "memory");
    transpose_out(WT, ldw, scr, kb, nb, lane, mode, WT8);
}
__device__ __forceinline__ void transpose_out(bf16* WT, int ldw, const LAS float* scr, int kb, int nb, int lane, int mode, unsigned char* WT8) {
    const int k0 = 128 * kb, n0 = 32 * nb;
    if (mode & 12) {
        const int c8 = lane & 7; unsigned char* W8 = (mode & 8) ? WT8 : (unsigned char*)WT;
#pragma unroll
        for (int j = 0; j < 4; ++j) { const int n = (lane >> 3) + 8 * j; const LAS float* sp = scr + (16 * c8) * 33 + n; int w4[4];
#pragma unroll
            for (int q4 = 0; q4 < 4; ++q4) { int t = 0; t = __builtin_amdgcn_cvt_pk_fp8_f32(sp[(4 * q4) * 33] * 64.0f, sp[(4 * q4 + 1) * 33] * 64.0f, t, false);
                t = __builtin_amdgcn_cvt_pk_fp8_f32(sp[(4 * q4 + 2) * 33] * 64.0f, sp[(4 * q4 + 3) * 33] * 64.0f, t, true); w4[q4] = t; }
            const int nn = n0 + n; const int row = (mode & 3) == 1 ? rowmap_gu(nn) : nn;
            *(v4u*)(W8 + (size_t)row * ldw + k0 + 16 * c8) = (v4u){(unsigned)w4[0], (unsigned)w4[1], (unsigned)w4[2], (unsigned)w4[3]}; }
        if (mode & 4) { LDS_WAIT(); asm volatile("" ::: "memory"); return; }
    }
    const int c = lane & 15;
#pragma unroll
    for (int j = 0; j < 8; ++j) { const int n = (lane >> 4) + 4 * j; const LAS float* sp = scr + (8 * c) * 33 + n;
        v4u o; o.x = pkbf(sp[0 * 33], sp[1 * 33]); o.y = pkbf(sp[2 * 33], sp[3 * 33]); o.z = pkbf(sp[4 * 33], sp[5 * 33]); o.w = pkbf(sp[6 * 33], sp[7 * 33]);
        const int nn = n0 + n; const int row = (mode & 3) == 1 ? rowmap_gu(nn) : ((mode & 3) == 2 ? rowmap_rope(nn) : nn);
        *(v4u*)(WT + (size_t)row * ldw + k0 + 8 * c) = o; }
    LDS_WAIT(); asm volatile("" ::: "memory");
}
__device__ __forceinline__ void conv_family(const Ctx& c, const float* src, bf16* dst, int B, int K, int N, int mode, int ldw = 0, unsigned char* dst8 = nullptr, long lo = 0, long hi = -1) {
    if (ldw == 0) ldw = K;
    LAS float* scr = (LAS float*)(c.lds + c.wave * 17408);
    const int nkb = K / 128, nnb = N / 32; const long per = (long)nkb * nnb; if (hi < 0) hi = per * B;
    long it = lo + c.gw; if (it >= hi) return;
    const int lane = c.lane;
    float v[64];
#define CF_ISSUE(IT) do { const int b_ = (int)((IT) / per), r_ = (int)((IT) % per), kb_ = r_ / nnb, nb_ = r_ % nnb; \
        const float* wp_ = src + (size_t)b_ * K * N + (size_t)(128 * kb_ + (lane >> 5)) * N + 32 * nb_ + (lane & 31); \
        _Pragma("unroll") for (int i = 0; i < 64; ++i) v[i] = __builtin_nontemporal_load(wp_ + (size_t)(2 * i) * N); } while (0)
    CF_ISSUE(it);
    for (;;) {
#pragma unroll
        for (int i = 0; i < 64; ++i) scr[(2 * i + (lane >> 5)) * 33 + (lane & 31)] = v[i];
        LDS_WAIT(); asm volatile("" ::: "memory");
        const long nx = it + c.ngw; const bool more = nx < hi;
        if (more) CF_ISSUE(nx);
        const int b = (int)(it / per), r = (int)(it % per), kb = r / nnb, nb = r % nnb;
        bf16* d2 = (mode & 4) ? (bf16*)((unsigned char*)dst + (size_t)b * N * ldw) : dst + (size_t)b * N * ldw;
        transpose_out(d2, ldw, scr, kb, nb, lane, mode, dst8);
        if (!more) break;
        it = nx;
    }
#undef CF_ISSUE
}
constexpr int L1_GU = 64 * 16 * 32, L1_ALL = L1_GU + 64 * 4 * 64;
constexpr int FILL3 = 8192, FILL5 = FILL3 + 1280, FILL6 = FILL5 + 3328, FILL7 = FILL6 + 5120, FILL4 = FILL7 + 254 * 48;
constexpr int R11_LO = FILL4, R11_HI = R11_LO + 255 * 8, R13_LO = R11_HI, R13_HI = R13_LO + 128 * 40, R17_LO = R13_HI, R17_HI = R17_LO + 240 * 8, R21_LO = R17_HI, R21_HI = R21_LO + 255 * 8, FILLX = R21_HI;
static_assert(FILL4 < L1_GU && FILLX > L1_GU && FILLX < L1_ALL, "filler ranges");
__device__ __forceinline__ void conv_l1_item(const Ctx& c, const Args& a, int it) {
    LAS float* scr = (LAS float*)(c.lds + c.wave * 17408);
    if (it < L1_GU) { const int b = it >> 9, r = it & 511; transpose_item(a.in[I_WGU] + (size_t)(NEXP + b) * D * 1024, D, 1024, (bf16*)(a.ws + WS_WGU + (size_t)(NEXP + b) * 1024 * D), D, scr, r >> 5, r & 31, c.lane, 5); }
    else { const int i2 = it - L1_GU, b = i2 >> 8, r = i2 & 255; transpose_item(a.in[I_WD] + (size_t)(NEXP + b) * DEXP * D, DEXP, D, (bf16*)(a.ws + WS_WD + (size_t)(NEXP + b) * D * DEXP), DEXP, scr, r >> 6, r & 63, c.lane, 4); }
}
__device__ __forceinline__ void conv_fill(const Ctx& c, const Args& a, int lo, int hi, int rank, int nranks) {
    const int q = (hi - lo + nranks - 1) / nranks, b0 = lo + rank * q, b1 = (b0 + q) < hi ? (b0 + q) : hi;
    for (int it = b0 + c.wave; it < b1; it += NWAVES) conv_l1_item(c, a, it);
    __syncthreads();
}
__device__ __forceinline__ void phase_weights(const Ctx& c, const Args& a) {
    unsigned char* ws = a.ws;
    conv_family(c, a.in[I_WAB], (bf16*)(ws + WS_WAB), 1, D, ABN, 2);
    conv_family(c, a.in[I_WOAB], (bf16*)(ws + WS_WOAB), 1, D, D, 0);
    conv_family(c, a.in[I_WGLU], (bf16*)(ws + WS_WGLU), 1, 1024, 1024, 0);
    conv_family(c, a.in[I_WC], (bf16*)(ws + WS_WC), 1, D, CN, 8, 0, ws + WS_WC8);
    conv_family(c, a.in[I_WOC], (bf16*)(ws + WS_WOC), 1, D, D, 0);
    conv_family(c, a.in[I_WGU], (bf16*)(ws + WS_WGU), NEXP, D, 1024, 5);
    conv_family(c, a.in[I_WD], (bf16*)(ws + WS_WD), NEXP, DEXP, D, 4);
    if (c.nblk != 256) conv_family(c, a.in[I_WGU] + (size_t)NEXP * D * 1024, (bf16*)(ws + WS_WGU + (size_t)NEXP * 1024 * D), NEXP, D, 1024, 5);
    conv_family(c, a.in[I_WD] + (size_t)NEXP * DEXP * D, (bf16*)(ws + WS_WD + (size_t)NEXP * D * DEXP), NEXP, DEXP, D, 4, 0, nullptr, c.nblk == 256 ? FILLX - L1_GU : 0);
}
__device__ __forceinline__ void phase_init(const Ctx& c, const Args& a) {
    bf16* HB = (bf16*)(a.ws + WS_HBF);
    for (int row = c.gw; row < LP; row += c.ngw) {
        const float* src = row < ROWV ? nullptr : (row < 256 ? a.in[I_META] + (size_t)(row - ROWV) * D : a.in[I_X] + (size_t)(row - 256) * D);
#pragma unroll
        for (int j = 0; j < 8; ++j) { const int idx = (j * 64 + c.lane) * 4; f32x4 v = src ? *(const f32x4*)(src + idx) : (f32x4){0.f, 0.f, 0.f, 0.f};
            v2u w; w.x = pkbf(v.x, v.y); w.y = pkbf(v.z, v.w); *(v2u*)(HB + (size_t)row * D + idx) = w; }
    }
    float2* rope = (float2*)(a.ws + WS_ROPE);
    for (long i = (long)c.bid * NTHR + c.tid; i < (long)LP * 64; i += (long)c.nblk * NTHR) {
        const int row = (int)(i >> 6), k = (int)(i & 63);
        const float inv = powf(10000.0f, -(float)k * 2.0f / 128.0f);
        const float ang = (float)(row - ROWV) * inv;
        float s, co; sincosf(ang, &s, &co); rope[i] = make_float2(co, s);
    }
    { float* wrt = (float*)(a.ws + WS_WRT);
      for (int i = c.bid * NTHR + c.tid; i < 2 * 96 * 2048; i += c.nblk * NTHR) { const int k = i & 2047, j = (i >> 11) % 96, layer = i / (96 * 2048);
          const float wv = j < 8 ? a.in[I_WGRP][((size_t)layer * D + k) * 8 + j] : (j < 72 ? a.in[I_WEXP][((size_t)layer * D + k) * 64 + (j - 8)] : 0.f); wrt[i] = wv;
          const unsigned hb = f2bf(wv); const float hf = __uint_as_float(hb << 16); ((bf16*)(a.ws + WS_WRH))[i] = (bf16)hb; ((bf16*)(a.ws + WS_WRL))[i] = (bf16)f2bf(wv - hf); } }
    { float* lbt = (float*)(a.ws + WS_LBT);
      for (int i = c.bid * NTHR + c.tid; i < D; i += c.nblk * NTHR) lbt[i] = 1.0f / (1.0f + expf(a.in[I_LB][i] - a.in[I_LB][D + i])); }
    float2* abar = (float2*)(a.ws + WS_S5P); float2* bbar = abar + 2 * 64 * 64;
    for (int i = c.bid * NTHR + c.tid; i < 2 * 64 * 64; i += c.nblk * NTHR) {
        const int dg = i >> 6;
        const double lr = fmin((double)a.in[I_LRE][i], -1e-4), li = (double)a.in[I_LIM][i], st = exp((double)a.in[I_LSTEP][dg]);
        const double er = exp(lr * st), ar = er * cos(li * st), ai = er * sin(li * st);
        const double den = lr * lr + li * li, cr = ((ar - 1.0) * lr + ai * li) / den, ci = (ai * lr - (ar - 1.0) * li) / den;
        abar[i] = make_float2((float)ar, (float)ai);
        for (int cc = 0; cc < 16; ++cc) { const double br = a.in[I_BRE][(size_t)i * 16 + cc], bi = a.in[I_BIM][(size_t)i * 16 + cc];
            bbar[(size_t)i * 16 + cc] = make_float2((float)(cr * br - ci * bi), (float)(cr * bi + ci * br)); }
    }
    for (int j = c.bid * NTHR + c.tid; j < 2 * 64 * 64 * 33; j += c.nblk * NTHR) { const int i = j / 33, tau = j % 33, dg = i >> 6;
        const double lr = fmin((double)a.in[I_LRE][i], -1e-4), li = (double)a.in[I_LIM][i], st = exp((double)a.in[I_LSTEP][dg]);
        const double m = exp(lr * st * tau); ((float2*)(a.ws + WS_APOW))[j] = make_float2((float)(m * cos(li * st * tau)), (float)(m * sin(li * st * tau))); }
}
typedef short bf16x8 __attribute__((ext_vector_type(8)));
constexpr int HG_VT = 0, HG_QT = 18432, HG_KT = 35840, HG_KH = 53248, HG_DV = 71680, HB_SZ = 72704, HG_SCR = 2 * HB_SZ;
constexpr int LD_K = 272, LD_T = 144;
__device__ __forceinline__ bf16x8 ldfrag(LAS unsigned char* base, int row, int pitch, int kbyte) { return *(const LAS bf16x8*)(base + row * pitch + kbyte); }
#define MFMA16(a, b, c) __builtin_amdgcn_mfma_f32_16x16x32_bf16((a), (b), (c), 0, 0, 0)
constexpr int AT_K = 0, AT_VT = 17408;
__device__ __forceinline__ void phase_attn(const Ctx& c, const Args& a) {
    const bf16* QB = (const bf16*)(a.ws + WS_QB0); const bf16* KB = (const bf16*)(a.ws + WS_KB0); const bf16* VB = (const bf16*)(a.ws + WS_VB0); bf16* MI = (bf16*)(a.ws + WS_MIXIN);
    LAS unsigned char* L = c.lds;
    const int w = c.wave, hr = w >> 1, qh = w & 1;
    const float C2 = 0.08838834764831845f * 1.4426950408889634f;
    for (int u = c.bid; u < 514; u += c.nblk) {
        int tv = c.tid; asm volatile("" : "+v"(tv));
        const int r = tv & 15, gq = (tv >> 4) & 3;
        const int skey = tv >> 3, sc16 = tv & 7;
        const int sd = tv & 127, skq = tv >> 7;
        const int g = u & 1, qb = u >> 1, r0 = 192 + 64 * qb, h = 4 * g + hr, rq0 = r0 + 32 * qh;
        const int klo = (r0 / 64 - 2) < 4 ? 4 : (r0 / 64 - 2), khi = (r0 / 64 + 2) > 259 ? 259 : (r0 / 64 + 2), ntile = 1 + (khi - klo + 1);
        bf16x8 qf[2][4];
#pragma unroll
        for (int qt = 0; qt < 2; ++qt)
#pragma unroll
            for (int ks = 0; ks < 4; ++ks) qf[qt][ks] = *(const bf16x8*)(QB + (size_t)(rq0 + 16 * qt + r) * 1024 + h * 128 + 32 * ks + 8 * gq);
        const float sink2 = a.in[I_SINK][h] * 1.4426950408889634f;
        float mrun[2] = {sink2, sink2}, lsum[2] = {gq == 0 ? 1.f : 0.f, gq == 0 ? 1.f : 0.f};
        f32x4 O[2][8];
#pragma unroll
        for (int qt = 0; qt < 2; ++qt)
#pragma unroll
            for (int dt = 0; dt < 8; ++dt) O[qt][dt] = (f32x4){0.f, 0.f, 0.f, 0.f};
        v4u kraw[2]; unsigned short vraw[16];
#define AT_LOAD(kt_) do { const bf16* kp = KB + (size_t)(64 * (kt_) + skey) * 256 + g * 128 + 16 * sc16; kraw[0] = *(const v4u*)kp; kraw[1] = *(const v4u*)(kp + 8); \
            const bf16* vp = VB + (size_t)(64 * (kt_) + 16 * skq) * 256 + g * 128 + sd; _Pragma("unroll") for (int i = 0; i < 16; ++i) vraw[i] = vp[(size_t)i * 256]; } while (0)
        AT_LOAD(3);
        for (int ti = 0; ti < ntile; ++ti) {
            const int kt = ti == 0 ? 3 : klo + ti - 1;
            { *(LAS v4u*)(L + AT_K + skey * LD_K + 32 * sc16) = kraw[0]; *(LAS v4u*)(L + AT_K + skey * LD_K + 32 * sc16 + 16) = kraw[1];
              v4u v0, v1; v0.x = vraw[0] | ((unsigned)vraw[1] << 16); v0.y = vraw[2] | ((unsigned)vraw[3] << 16); v0.z = vraw[4] | ((unsigned)vraw[5] << 16); v0.w = vraw[6] | ((unsigned)vraw[7] << 16);
              v1.x = vraw[8] | ((unsigned)vraw[9] << 16); v1.y = vraw[10] | ((unsigned)vraw[11] << 16); v1.z = vraw[12] | ((unsigned)vraw[13] << 16); v1.w = vraw[14] | ((unsigned)vraw[15] << 16);
              *(LAS v4u*)(L + AT_VT + sd * LD_T + 32 * skq) = v0; *(LAS v4u*)(L + AT_VT + sd * LD_T + 32 * skq + 16) = v1; }
            if (ti + 1 < ntile) AT_LOAD(klo + ti);
            __syncthreads();
            bf16x8 pf[2][2];
#pragma unroll
            for (int qt = 0; qt < 2; ++qt) {
                f32x4 sc[4];
#pragma unroll
                for (int ki = 0; ki < 4; ++ki) sc[ki] = (f32x4){0.f, 0.f, 0.f, 0.f};
#pragma unroll
                for (int ks = 0; ks < 4; ++ks)
#pragma unroll
                    for (int ki = 0; ki < 4; ++ki) { const bf16x8 kf = ldfrag(L + AT_K, 16 * ki + r, LD_K, (32 * ks + 8 * gq) * 2); sc[ki] = MFMA16(kf, qf[qt][ks], sc[ki]); }
                const int rq = rq0 + 16 * qt + r; float tmax = -3.0e38f;
#pragma unroll
                for (int ki = 0; ki < 4; ++ki)
#pragma unroll
                    for (int e = 0; e < 4; ++e) { const int rk = 64 * kt + 16 * ki + 4 * gq + e; const int dd = rq - rk;
                        const bool ok = ti == 0 ? (rk >= ROWV) : (rk >= 256 && dd <= 128 && dd >= -128);
                        const float v = ok ? sc[ki][e] * C2 : -3.0e38f; sc[ki][e] = v; tmax = fmaxf(tmax, v); }
                tmax = fmaxf(tmax, __shfl_xor(tmax, 16)); tmax = fmaxf(tmax, __shfl_xor(tmax, 32));
                const float mn = fmaxf(mrun[qt], tmax), alpha = exp2f(mrun[qt] - mn); mrun[qt] = mn;
                float ps = 0.f;
#pragma unroll
                for (int ki = 0; ki < 4; ++ki)
#pragma unroll
                    for (int e = 0; e < 4; ++e) { const float pv = exp2f(sc[ki][e] - mn); sc[ki][e] = pv; ps += pv; }
                lsum[qt] = lsum[qt] * alpha + ps;
#pragma unroll
                for (int dt = 0; dt < 8; ++dt) O[qt][dt] = O[qt][dt] * alpha;
#pragma unroll
                for (int kk = 0; kk < 2; ++kk) { v4u t; t.x = pkbf(sc[2 * kk][0], sc[2 * kk][1]); t.y = pkbf(sc[2 * kk][2], sc[2 * kk][3]);
                    t.z = pkbf(sc[2 * kk + 1][0], sc[2 * kk + 1][1]); t.w = pkbf(sc[2 * kk + 1][2], sc[2 * kk + 1][3]); pf[qt][kk] = __builtin_bit_cast(bf16x8, t); }
            }
#pragma unroll
            for (int dt = 0; dt < 8; ++dt)
#pragma unroll
                for (int kk = 0; kk < 2; ++kk) { const LAS unsigned char* vp = L + AT_VT + (16 * dt + r) * LD_T + (32 * kk + 4 * gq) * 2;
                    const v2u lo = *(const LAS v2u*)vp, hi = *(const LAS v2u*)(vp + 32); const v4u t = (v4u){lo.x, lo.y, hi.x, hi.y}; const bf16x8 vf = __builtin_bit_cast(bf16x8, t);
                    O[0][dt] = MFMA16(vf, pf[0][kk], O[0][dt]); O[1][dt] = MFMA16(vf, pf[1][kk], O[1][dt]); }
            __syncthreads();
        }
#undef AT_LOAD
#pragma unroll
        for (int qt = 0; qt < 2; ++qt) { float l = lsum[qt]; l += __shfl_xor(l, 16); l += __shfl_xor(l, 32); const float inv = 1.0f / l; const int rq = rq0 + 16 * qt + r;
            if (rq >= ROWV) {
#pragma unroll
                for (int dt = 0; dt < 8; ++dt) { v2u o; o.x = pkbf(O[qt][dt][0] * inv, O[qt][dt][1] * inv); o.y = pkbf(O[qt][dt][2] * inv, O[qt][dt][3] * inv);
                    *(v2u*)(MI + (size_t)rq * D + h * 128 + 16 * dt + 4 * gq) = o; } } }
    }
    for (int i = c.bid * NTHR + c.tid; i < ROWV * D / 8; i += c.nblk * NTHR) ((v4u*)MI)[i] = (v4u){0u, 0u, 0u, 0u};
}
__device__ __forceinline__ void phase_s5_ktab(const Ctx& c, const Args& a) {
    const float2* abar = (const float2*)(a.ws + WS_S5P); const float2* bbar = abar + 2 * 64 * 64; const float2* apow = (const float2*)(a.ws + WS_APOW);
    float* KT = (float*)(a.ws + WS_KTAB);
    LAS float* Lb = (LAS float*)c.lds;
    LAS float* La = Lb + 2048;
    LAS float* Lc = La + 2048;
    for (int u = c.bid; u < 256; u += c.nblk) {
        const int dg = u >> 1, th = u & 1;
        __syncthreads();
        for (int i = c.tid; i < 1024; i += NTHR) { const float2 v = bbar[(size_t)dg * 1024 + i]; Lb[2 * i] = v.x; Lb[2 * i + 1] = v.y; }
        for (int i = c.tid; i < 1024; i += NTHR) { const int p = i >> 4, tl = i & 15; const float2 v = apow[((size_t)dg * 64 + p) * 33 + 16 * th + tl]; La[2 * i] = v.x; La[2 * i + 1] = v.y; }
        for (int i = c.tid; i < 1024; i += NTHR) { Lc[i] = a.in[I_CRE][(size_t)dg * 1024 + i]; Lc[1024 + i] = a.in[I_CIM][(size_t)dg * 1024 + i]; }
        __syncthreads();
        const int tl = c.tid >> 5, c1 = (c.tid & 31) >> 1, c20 = (c.tid & 1) * 8;
        float sum[8];
#pragma unroll
        for (int j = 0; j < 8; ++j) sum[j] = 0.f;
        for (int p = 0; p < 64; ++p) { const float apx = La[(p * 16 + tl) * 2], apy = La[(p * 16 + tl) * 2 + 1], cr = Lc[c1 * 64 + p], ci = Lc[1024 + c1 * 64 + p];
            const float wr_ = cr * apx - ci * apy, wi_ = cr * apy + ci * apx;
#pragma unroll
            for (int j = 0; j < 8; ++j) sum[j] += wr_ * Lb[(p * 16 + c20 + j) * 2] - wi_ * Lb[(p * 16 + c20 + j) * 2 + 1]; }
        float* dst = KT + ((((size_t)dg * 32 + 16 * th + tl) * 16 + c1) * 16 + c20);
        *(f32x4*)dst = (f32x4){sum[0], sum[1], sum[2], sum[3]}; *(f32x4*)(dst + 4) = (f32x4){sum[4], sum[5], sum[6], sum[7]};
    }
    __syncthreads();
}
__device__ __forceinline__ void phase_s5_fill(const Ctx& c, const Args& a) {
    const float2* abar = (const float2*)(a.ws + WS_S5P); const float2* bbar = abar + 2 * 64 * 64; const float2* apow = (const float2*)(a.ws + WS_APOW);
    const float* KT = (const float*)(a.ws + WS_KTAB); bf16* MWT = (bf16*)(a.ws + WS_MWT); bf16* WST = (bf16*)(a.ws + WS_WST);
    for (long it = (long)c.bid * NTHR + c.tid; it < (long)64 * 512 * 96; it += (long)c.nblk * NTHR) {
        const int kb = (int)(it % 96), n = (int)((it / 96) % 512), g = (int)(it / (96 * 512)), t = n >> 4, c1 = n & 15;
        float v[8];
        if (kb < 64) { const int s2 = kb >> 1, c2 = (kb & 1) * 8;
            if (s2 < t) { const float* k0 = KT + ((((size_t)(0 * 64 + g)) * 32 + (t - s2)) * 16 + c1) * 16 + c2;
#pragma unroll
                for (int i = 0; i < 8; ++i) v[i] = k0[i]; }
            else if (s2 > t) { const float* k0 = KT + ((((size_t)(1 * 64 + g)) * 32 + (s2 - t)) * 16 + c1) * 16 + c2;
#pragma unroll
                for (int i = 0; i < 8; ++i) v[i] = k0[i]; }
            else { const float* k0 = KT + ((((size_t)(0 * 64 + g)) * 32) * 16 + c1) * 16 + c2; const float* k1 = KT + ((((size_t)(1 * 64 + g)) * 32) * 16 + c1) * 16 + c2;
#pragma unroll
                for (int i = 0; i < 8; ++i) v[i] = k0[i] + k1[i] + ((c2 + i) == c1 ? a.in[I_S5D][16 * g + c1] : 0.f); }
        } else { const int j0 = (kb - 64) * 8, qd = j0 >> 6, dir = qd >> 1, p0 = j0 & 63, tau = dir == 0 ? t + 1 : 32 - t;
            const float* cr = a.in[I_CRE] + ((size_t)(dir * 64 + g) * 16 + c1) * 64; const float* ci = a.in[I_CIM] + ((size_t)(dir * 64 + g) * 16 + c1) * 64;
#pragma unroll
            for (int i = 0; i < 8; ++i) { const int p = p0 + i; const float2 ap = apow[((size_t)(dir * 64 + g) * 64 + p) * 33 + tau];
                v[i] = (qd & 1) == 0 ? (cr[p] * ap.x - ci[p] * ap.y) : -(cr[p] * ap.y + ci[p] * ap.x); }
        }
        v4u o; o.x = pk2(v[0], v[1]); o.y = pk2(v[2], v[3]); o.z = pk2(v[4], v[5]); o.w = pk2(v[6], v[7]);
        *(v4u*)(MWT + ((size_t)g * 512 + n) * 768 + kb * 8) = o;
    }
    for (long it = (long)c.bid * NTHR + c.tid; it < (long)64 * 256 * 64; it += (long)c.nblk * NTHR) {
        const int kb = (int)(it & 63), n = (int)((it >> 6) & 255), g = (int)(it >> 14), s2 = kb >> 1, c2 = (kb & 1) * 8, qd = n >> 6, dir = qd >> 1, p = n & 63;
        const int tau = dir == 0 ? 31 - s2 : s2; const size_t i = (size_t)(dir * 64 + g) * 64 + p; const float2 ap = apow[i * 33 + tau];
        float v[8];
#pragma unroll
        for (int e = 0; e < 8; ++e) { const float2 bb = bbar[i * 16 + c2 + e]; v[e] = (qd & 1) == 0 ? (ap.x * bb.x - ap.y * bb.y) : (ap.x * bb.y + ap.y * bb.x); }
        v4u o; o.x = pk2(v[0], v[1]); o.y = pk2(v[2], v[3]); o.z = pk2(v[4], v[5]); o.w = pk2(v[6], v[7]);
        *(v4u*)(WST + ((size_t)g * 256 + n) * 512 + kb * 8) = o;
    }
    bf16* ZB = (bf16*)(a.ws + WS_ZB);
    for (int i = c.bid * NTHR + c.tid; i < 224 * 1024 / 8; i += c.nblk * NTHR) ((v4u*)ZB)[i] = (v4u){0u, 0u, 0u, 0u};
}
__device__ __forceinline__ void phase_s5_chunkscan(const Ctx& c, const Args& a) {
    if (c.bid >= 128) return;
    const int g = c.bid & 63, dir = c.bid >> 6, p = c.lane, w = c.wave;
    const float2 a32 = ((const float2*)(a.ws + WS_APOW))[((size_t)(dir * 64 + g) * 64 + p) * 33 + 32];
    const float* S = (const float*)(a.ws + WS_R1 + R1_SALL) + (size_t)g * 768 * 256 + dir * 128 + p;
    bf16* UA = (bf16*)(a.ws + WS_R1 + R1_UA) + (size_t)g * 768 * 768 + 512 + dir * 128 + p;
    LAS float* E = (LAS float*)c.lds; LAS float* PW = E + 2 * 8 * 64;
    const int j0 = 65 * w, j1 = (j0 + 65) < 513 ? (j0 + 65) : 513, len = j1 - j0;
    float xr = 0.f, xi = 0.f, pr = 1.f, pi = 0.f;
    for (int b = 0; b < 5; ++b) { float sr[13], si[13];
#pragma unroll
        for (int i = 0; i < 13; ++i) { const int o = b * 13 + i; const int j = dir == 0 ? j0 + o : j1 - 1 - o; const bool ok = o < len; sr[i] = ok ? S[(size_t)j * 256] : 0.f; si[i] = ok ? S[(size_t)j * 256 + 64] : 0.f; }
#pragma unroll
        for (int i = 0; i < 13; ++i) { if (b * 13 + i < len) { const float nr = a32.x * xr - a32.y * xi + sr[i], ni = a32.x * xi + a32.y * xr + si[i]; xr = nr; xi = ni;
                const float qr = a32.x * pr - a32.y * pi, qi = a32.x * pi + a32.y * pr; pr = qr; pi = qi; } }
    }
    E[w * 128 + p] = xr; E[w * 128 + 64 + p] = xi; PW[w * 128 + p] = pr; PW[w * 128 + 64 + p] = pi;
    __syncthreads();
    float cr = 0.f, ci = 0.f;
    if (dir == 0) { for (int w2 = 0; w2 < w; ++w2) { const float2 e = make_float2(E[w2 * 128 + p], E[w2 * 128 + 64 + p]), q = make_float2(PW[w2 * 128 + p], PW[w2 * 128 + 64 + p]); const float nr = q.x * cr - q.y * ci + e.x, ni = q.x * ci + q.y * cr + e.y; cr = nr; ci = ni; } }
    else { for (int w2 = 7; w2 > w; --w2) { const float2 e = make_float2(E[w2 * 128 + p], E[w2 * 128 + 64 + p]), q = make_float2(PW[w2 * 128 + p], PW[w2 * 128 + 64 + p]); const float nr = q.x * cr - q.y * ci + e.x, ni = q.x * ci + q.y * cr + e.y; cr = nr; ci = ni; } }
    xr = cr; xi = ci;
    for (int b = 0; b < 5; ++b) { float sr[13], si[13];
#pragma unroll
        for (int i = 0; i < 13; ++i) { const int o = b * 13 + i; const int j = dir == 0 ? j0 + o : j1 - 1 - o; const bool ok = o < len; sr[i] = ok ? S[(size_t)j * 256] : 0.f; si[i] = ok ? S[(size_t)j * 256 + 64] : 0.f; }
#pragma unroll
        for (int i = 0; i < 13; ++i) { const int o = b * 13 + i; if (o < len) { const int j = dir == 0 ? j0 + o : j1 - 1 - o;
                UA[(size_t)j * 768] = (bf16)f2bf(xr); UA[(size_t)j * 768 + 64] = (bf16)f2bf(xi);
                const float nr = a32.x * xr - a32.y * xi + sr[i], ni = a32.x * xi + a32.y * xr + si[i]; xr = nr; xi = ni; } }
    }
}
template <class F> __device__ __forceinline__ void skinny_gemm(const Ctx& c, const bf16* A, int lda, const bf16* Wt, int K, int N, const F& f) {
    int tv = c.tid; asm volatile("" : "+v"(tv));
    const int r = tv & 15, q = (tv >> 4) & 3;
    for (int tile = c.gw; tile < N / 16; tile += c.ngw) {
        f32x4 acc = (f32x4){0.f, 0.f, 0.f, 0.f};
        const bf16* ap = A + (size_t)(ROWV + r) * lda + 8 * q; const bf16* bp = Wt + (size_t)(16 * tile + r) * K + 8 * q;
        for (int ks = 0; ks < K / 32; ks += 8) { bf16x8 af[8], bfr[8];
#pragma unroll
            for (int i = 0; i < 8; ++i) { af[i] = *(const bf16x8*)(ap + (ks + i) * 32); bfr[i] = *(const bf16x8*)(bp + (ks + i) * 32); }
#pragma unroll
            for (int i = 0; i < 8; ++i) acc = MFMA16(af[i], bfr[i], acc); }
#pragma unroll
        for (int e = 0; e < 4; ++e) f(ROWV + 4 * q + e, 16 * tile + r, acc[e]);
    }
}
template <class F> __device__ __forceinline__ void skinny_gemm2(const Ctx& c, const bf16* A, int lda, const bf16* Wt, int K, int N, const F& f) {
    int tv = c.tid; asm volatile("" : "+v"(tv));
    const int r = tv & 15, q = (tv >> 4) & 3;
    for (int pt = c.gw; pt < N / 32; pt += c.ngw) {
        f32x4 acc0 = (f32x4){0.f, 0.f, 0.f, 0.f}, acc1 = (f32x4){0.f, 0.f, 0.f, 0.f};
        const bf16* ap = A + (size_t)(ROWV + r) * lda + 8 * q; const bf16* bp = Wt + (size_t)(32 * pt + r) * K + 8 * q;
        for (int ks = 0; ks < K / 32; ks += 4) { bf16x8 af[4], b0[4], b1[4];
#pragma unroll
            for (int i = 0; i < 4; ++i) { af[i] = *(const bf16x8*)(ap + (ks + i) * 32); b0[i] = *(const bf16x8*)(bp + (ks + i) * 32); b1[i] = *(const bf16x8*)(bp + (size_t)16 * K + (ks + i) * 32); }
#pragma unroll
            for (int i = 0; i < 4; ++i) { acc0 = MFMA16(af[i], b0[i], acc0); acc1 = MFMA16(af[i], b1[i], acc1); } }
#pragma unroll
        for (int e = 0; e < 4; ++e) f(ROWV + 4 * q + e, 32 * pt + r, acc0[e], acc1[e]);
    }
}
struct SkAB2 { unsigned char* ws; __device__ __forceinline__ void operator()(int row, int n0, float v0, float v1) const {
    if (n0 < 1280) { const int hb = n0 >> 7, d = 16 * ((n0 & 127) >> 5) + (n0 & 15); const float2 cs = ((const float2*)(ws + WS_ROPE))[(size_t)row * 64 + d];
        const float o1 = v0 * cs.x - v1 * cs.y, o2 = v1 * cs.x + v0 * cs.y;
        bf16* dst = hb < 8 ? (bf16*)(ws + WS_QB0) + (size_t)row * 1024 + hb * 128 + d : (bf16*)(ws + WS_KB0) + (size_t)row * 256 + (hb - 8) * 128 + d;
        dst[0] = (bf16)f2bf(o1); dst[64] = (bf16)f2bf(o2); }
    else if (n0 < 1536) { bf16* dst = (bf16*)(ws + WS_VB0) + (size_t)row * 256 + n0 - 1280; dst[0] = (bf16)f2bf(v0); dst[16] = (bf16)f2bf(v1); }
    else { bf16* UA = (bf16*)(ws + WS_R1 + R1_UA); const int ch = n0 - 1536, ch1 = ch + 16;
        UA[((size_t)(ch >> 4) * 768) * 768 + (16 + row - ROWV) * 16 + (ch & 15)] = (bf16)f2bf(v0); UA[((size_t)(ch1 >> 4) * 768) * 768 + (16 + row - ROWV) * 16 + (ch1 & 15)] = (bf16)f2bf(v1); } } };
struct SkAB { float* C; bf16* UA; __device__ __forceinline__ void operator()(int row, int n, float v) const {
    if (n < 1536) C[(size_t)row * ABN + n] = v; else { const int ch = n - 1536; UA[((size_t)(ch >> 4) * 768) * 768 + (16 + row - ROWV) * 16 + (ch & 15)] = (bf16)f2bf(v); } } };
struct SkGlu { const bf16* ZB; const float* bias; bf16* O; __device__ __forceinline__ void operator()(int row, int n, float v) const {
    const float z = __uint_as_float((unsigned)ZB[(size_t)row * 1024 + n] << 16); O[(size_t)row * D + 1024 + n] = (bf16)f2bf(z / (1.0f + __expf(-(v + bias[n])))); } };
struct SkBf16 { bf16* O; int ldc; __device__ __forceinline__ void operator()(int row, int n, float v) const { O[(size_t)row * ldc + n] = (bf16)f2bf(v); } };
struct SkC { bf16* QB; bf16* VB; bf16* GB; bf16* F; const float* lbt; __device__ __forceinline__ void operator()(int row, int n, float v) const {
    if (n < 2048) QB[(size_t)row * D + n] = (bf16)f2bf(v);
    else if (n < 4096) VB[(size_t)row * D + n - 2048] = (bf16)f2bf(v);
    else if (n < 8192) { const float lb = lbt[n & 2047]; F[(size_t)row * 4096 + n - 4096] = (bf16)f2bf((1.0f - lb) / (1.0f + __expf(v))); }
    else GB[(size_t)row * D + n - 8192] = (bf16)f2bf(1.0f / (1.0f + __expf(-v))); } };
__device__ __forceinline__ void zero_rows_bf16(const Ctx& c, bf16* B, int ld, int r0, int r1) {
    const int per = ld / 8;
    for (int i = c.bid * NTHR + c.tid; i < (r1 - r0) * per; i += c.nblk * NTHR) *(v4u*)(B + (size_t)(r0 + i / per) * ld + (i % per) * 8) = (v4u){0u, 0u, 0u, 0u};
}
__device__ __forceinline__ void zero_rows_f32(const Ctx& c, float* B, int ld, int r0, int r1, int ncols) {
    const int per = ncols / 4;
    for (int i = c.bid * NTHR + c.tid; i < (r1 - r0) * per; i += c.nblk * NTHR) *(f32x4*)(B + (size_t)(r0 + i / per) * ld + (i % per) * 4) = (f32x4){0.f, 0.f, 0.f, 0.f};
}
#ifdef PROBE_MASK
#ifndef PROBE_BARMASK
#define PROBE_BARMASK 0ull
#endif
#define PROBE_SCALE g_probe_scale
#define PROBE_DECL , float g_probe_scale
#define PROBE_PASS , g_probe_scale
#define PROBE_ONE , 1.0f
#else
#define PROBE_SCALE 1.0f
#define PROBE_DECL
#define PROBE_PASS
#define PROBE_ONE
#endif
typedef int v4i_ __attribute__((ext_vector_type(4)));
__device__ __forceinline__ f32x4 bf4(v2u w) { return (f32x4){__uint_as_float(w.x << 16), __uint_as_float(w.x & 0xffff0000u), __uint_as_float(w.y << 16), __uint_as_float(w.y & 0xffff0000u)}; }
struct LnSrc { const bf16* h; const bf16* add; const bf16* y0; const bf16* y1; float w0, w1; };
struct LnDst { bf16* hb; unsigned char* h8; float* dout; };
template <bool FFN> __device__ __forceinline__ void ln_pair(const LnSrc& A, const LnSrc& B, const float* gam, const float* bet, const LnDst& oA, const LnDst& oB, bool hasB, int lane PROBE_DECL) {
    f32x4 va[8], vb[8]; float sa = 0.f, sb = 0.f;
#pragma unroll
    for (int j = 0; j < 8; ++j) { const int idx = (j * 64 + lane) * 4;
        f32x4 xa = bf4(*(const v2u*)(A.h + idx)) * DN_ALPHA, xb = bf4(*(const v2u*)(B.h + idx)) * DN_ALPHA;
        if (FFN) { xa += bf4(*(const v2u*)(A.y0 + idx)) * A.w0 + bf4(*(const v2u*)(A.y1 + idx)) * A.w1; xb += bf4(*(const v2u*)(B.y0 + idx)) * B.w0 + bf4(*(const v2u*)(B.y1 + idx)) * B.w1; }
        else { xa += bf4(*(const v2u*)(A.add + idx)); xb += bf4(*(const v2u*)(B.add + idx)); }
        va[j] = xa; vb[j] = xb; sa += (xa.x + xa.y) + (xa.z + xa.w); sb += (xb.x + xb.y) + (xb.z + xb.w); }
    const float ma = wave_sum(sa) * (1.0f / D), mb = wave_sum(sb) * (1.0f / D); float qa = 0.f, qb = 0.f;
#pragma unroll
    for (int j = 0; j < 8; ++j) { va[j] = va[j] - ma; vb[j] = vb[j] - mb; qa += (va[j].x * va[j].x + va[j].y * va[j].y) + (va[j].z * va[j].z + va[j].w * va[j].w); qb += (vb[j].x * vb[j].x + vb[j].y * vb[j].y) + (vb[j].z * vb[j].z + vb[j].w * vb[j].w); }
    const float ra = 1.0f / sqrtf(wave_sum(qa) * (1.0f / D) + LN_EPS), rb = 1.0f / sqrtf(wave_sum(qb) * (1.0f / D) + LN_EPS);
#pragma unroll
    for (int j = 0; j < 8; ++j) { const int idx = (j * 64 + lane) * 4; const f32x4 g = *(const f32x4*)(gam + idx), b = *(const f32x4*)(bet + idx);
        const f32x4 o = va[j] * ra * g + b, p = vb[j] * rb * g + b;
        if (oA.hb) { v2u w; w.x = pk2(o.x, o.y); w.y = pk2(o.z, o.w); *(v2u*)(oA.hb + idx) = w; int t = 0; t = __builtin_amdgcn_cvt_pk_fp8_f32(o.x, o.y, t, false); t = __builtin_amdgcn_cvt_pk_fp8_f32(o.z, o.w, t, true); *(int*)(oA.h8 + idx) = t; }
        if (oA.dout) *(f32x4*)(oA.dout + idx) = o * PROBE_SCALE;
        if (hasB) {
            if (oB.hb) { v2u w; w.x = pk2(p.x, p.y); w.y = pk2(p.z, p.w); *(v2u*)(oB.hb + idx) = w; int t = 0; t = __builtin_amdgcn_cvt_pk_fp8_f32(p.x, p.y, t, false); t = __builtin_amdgcn_cvt_pk_fp8_f32(p.z, p.w, t, true); *(int*)(oB.h8 + idx) = t; }
            if (oB.dout) *(f32x4*)(oB.dout + idx) = p * PROBE_SCALE; } }
}
__device__ __forceinline__ void ln_zero_pad(const Ctx& c, bf16* HB, unsigned char* H8) {
    for (int row = c.gw; row < ROWV; row += c.ngw) {
#pragma unroll
        for (int j = 0; j < 8; ++j) { const int idx = (j * 64 + c.lane) * 4; *(v2u*)(HB + (size_t)row * D + idx) = (v2u){0u, 0u}; *(int*)(H8 + (size_t)row * D + idx) = 0; } }
}
__device__ __forceinline__ void phase_ln_mix(const Ctx& c, const Args& a, int layer) {
    const bf16* MIX = (const bf16*)(a.ws + WS_MIX); bf16* HB = (bf16*)(a.ws + WS_HBF); unsigned char* H8 = a.ws + WS_H8;
    ln_zero_pad(c, HB, H8);
    for (int i = c.gw; i < NVALID; i += 2 * c.ngw) {
        const int rowA = ROWV + i, rowB0 = rowA + c.ngw; const bool hasB = rowB0 < LP; const int rowB = hasB ? rowB0 : rowA;
        const LnSrc A{HB + (size_t)rowA * D, MIX + (size_t)rowA * D, nullptr, nullptr, 0.f, 0.f}, B{HB + (size_t)rowB * D, MIX + (size_t)rowB * D, nullptr, nullptr, 0.f, 0.f};
        ln_pair<false>(A, B, a.in[I_LNMG] + layer * D, a.in[I_LNMB] + layer * D, LnDst{HB + (size_t)rowA * D, H8 + (size_t)rowA * D, nullptr}, LnDst{HB + (size_t)rowB * D, H8 + (size_t)rowB * D, nullptr}, hasB, c.lane PROBE_ONE); }
}
__device__ __forceinline__ void phase_ln_ffn(const Ctx& c, const Args& a, int layer, bool last PROBE_DECL) {
    const bf16* Y = (const bf16*)(a.ws + WS_R1 + R1_Y); bf16* HB = (bf16*)(a.ws + WS_HBF); unsigned char* H8 = a.ws + WS_H8;
    const int* route = (const int*)(a.ws + WS_ROUTE);
    if (!last) ln_zero_pad(c, HB, H8);
    const int first = last ? 256 : ROWV;
    for (int i = c.gw; i < LP - first; i += 2 * c.ngw) {
        const int rowA = first + i, rowB0 = rowA + c.ngw; const bool hasB = rowB0 < LP; const int rowB = hasB ? rowB0 : rowA;
        const int* rA = route + (size_t)rowA * 8; const int* rB = route + (size_t)rowB * 8;
        const v4i_ qa = *(const v4i_*)(rA + 4), qb = *(const v4i_*)(rB + 4);
        const LnSrc A{HB + (size_t)rowA * D, nullptr, Y + (size_t)qa.x * D, Y + (size_t)qa.y * D, __int_as_float(qa.z), __int_as_float(qa.w)}, B{HB + (size_t)rowB * D, nullptr, Y + (size_t)qb.x * D, Y + (size_t)qb.y * D, __int_as_float(qb.z), __int_as_float(qb.w)};
        const LnDst oA{last ? nullptr : HB + (size_t)rowA * D, last ? nullptr : H8 + (size_t)rowA * D, last ? a.out + (size_t)(rowA - 256) * D : nullptr}, oB{last ? nullptr : HB + (size_t)rowB * D, last ? nullptr : H8 + (size_t)rowB * D, last ? a.out + (size_t)(rowB - 256) * D : nullptr};
        ln_pair<true>(A, B, a.in[I_LNFG] + layer * D, a.in[I_LNFB] + layer * D, oA, oB, hasB, c.lane PROBE_PASS); }
}
typedef float f32x16 __attribute__((ext_vector_type(16)));
__device__ __forceinline__ void phase_router(const Ctx& c, const Args& a, int layer) {
    const bf16* HBr = (const bf16*)(a.ws + WS_HBF);
    LAS float* part = (LAS float*)c.lds;
    LAS float* lg = (LAS float*)(c.lds + 98304);
    const bf16* wrh = (const bf16*)(a.ws + WS_WRH) + (size_t)layer * 96 * 2048; const bf16* wrl = (const bf16*)(a.ws + WS_WRL) + (size_t)layer * 96 * 2048;
    const float* bg = a.in[I_BGRP] + layer * 8; const float* be = a.in[I_BEXP] + layer * 64;
    int* route = (int*)(a.ws + WS_ROUTE); unsigned* cnt = (unsigned*)(a.ws + WS_CTL) + CW_CNT + layer * 64;
    const int li = c.lane & 31, kh = c.lane >> 5, w = c.wave;
    for (int task = c.bid; task < 513; task += c.nblk) {
        const int row0 = 224 + 32 * task;
        f32x16 acc[3];
#pragma unroll
        for (int ct = 0; ct < 3; ++ct)
#pragma unroll
            for (int e = 0; e < 16; ++e) acc[ct][e] = 0.f;
        const bf16* ap = HBr + (size_t)(row0 + li) * D + 256 * w + 8 * kh;
        const bf16* bh = wrh + (size_t)li * 2048 + 256 * w + 8 * kh; const bf16* bl = wrl + (size_t)li * 2048 + 256 * w + 8 * kh;
#pragma unroll 4
        for (int st = 0; st < 16; ++st) {
            const bf16x8 ah = *(const bf16x8*)(ap + 16 * st);
#pragma unroll
            for (int ct = 0; ct < 3; ++ct) { const bf16x8 wh = *(const bf16x8*)(bh + (size_t)ct * 32 * 2048 + 16 * st), wl = *(const bf16x8*)(bl + (size_t)ct * 32 * 2048 + 16 * st);
                acc[ct] = __builtin_amdgcn_mfma_f32_32x32x16_bf16(ah, wh, acc[ct], 0, 0, 0); acc[ct] = __builtin_amdgcn_mfma_f32_32x32x16_bf16(ah, wl, acc[ct], 0, 0, 0); }
        }
#pragma unroll
        for (int ct = 0; ct < 3; ++ct)
#pragma unroll
            for (int e = 0; e < 16; ++e) part[((ct * 8 + w) * 16 + e) * 64 + c.lane] = acc[ct][e];
        __syncthreads();
        for (int i = c.tid; i < 3072; i += NTHR) { const int ct = i >> 10, e = (i >> 6) & 15, ln = i & 63; float sum = 0.f;
#pragma unroll
            for (int w2 = 0; w2 < 8; ++w2) sum += part[((ct * 8 + w2) * 16 + e) * 64 + ln];
            const int col = 32 * ct + (ln & 31), row = (e & 3) + 8 * (e >> 2) + 4 * (ln >> 5);
            lg[row * 96 + col] = sum + (col < 8 ? bg[col] : (col < 72 ? be[col - 8] : 0.f)); }
        __syncthreads();
        if (c.tid < 32) { const int row2 = row0 + c.tid;
            if (row2 >= ROWV) { const LAS float* l = lg + c.tid * 96;
                int grp = 0; float gm = l[0];
                for (int q = 1; q < 8; ++q) if (l[q] > gm) { gm = l[q]; grp = q; }
                float gs = 0.f; for (int q = 0; q < 8; ++q) gs += expf(l[q] - gm);
                const float pg = 1.0f / gs;
                const LAS float* el = l + 8 + grp * 8;
                int i0 = 0; float v0 = el[0]; for (int q = 1; q < 8; ++q) if (el[q] > v0) { v0 = el[q]; i0 = q; }
                int i1 = -1; float v1 = -3.0e38f; for (int q = 0; q < 8; ++q) if (q != i0 && el[q] > v1) { v1 = el[q]; i1 = q; }
                const float e1 = expf(v1 - v0), w0 = pg / (1.0f + e1), w1 = pg * e1 / (1.0f + e1);
                const int ex0 = grp * 8 + i0, ex1 = grp * 8 + i1;
                const int p0 = (int)atomicAdd(cnt + ex0, 1u), p1 = (int)atomicAdd(cnt + ex1, 1u);
                int* r = route + (size_t)row2 * 8; r[0] = ex0; r[1] = ex1; r[2] = p0; r[3] = p1; r[6] = __float_as_int(w0); r[7] = __float_as_int(w1); } }
        __syncthreads();
    }
}
__device__ __forceinline__ void phase_gather(const Ctx& c, const Args& a, int layer) {
    LAS int* lbase = (LAS int*)c.lds; LAS int* lcnt = lbase + 64;
    if (c.tid == 0) {
        const unsigned* cnt = (const unsigned*)(a.ws + WS_CTL) + CW_CNT + layer * 64; int* plan = (int*)(a.ws + WS_CTL) + CW_PLAN + layer * 512;
        int t = 0;
        for (int e = 0; e < NEXP; ++e) { const int n = (int)__hip_atomic_load(cnt + e, __ATOMIC_RELAXED, __HIP_MEMORY_SCOPE_AGENT), nt = (n + 255) / 256; lbase[e] = t * 256; lcnt[e] = n;
            if (c.bid == 0) { plan[1 + e] = t * 256; for (int q = 0; q < nt; ++q) plan[128 + t + q] = e; }
            t += nt; }
        if (c.bid == 0) plan[0] = t;
    }
    __syncthreads();
    int* route = (int*)(a.ws + WS_ROUTE); int* rowlist = (int*)(a.ws + WS_ROWLIST);
    for (int T = c.bid * NTHR + c.tid; T < NVALID * 2; T += c.nblk * NTHR) {
        const int row = ROWV + (T >> 1), j = T & 1; int* r = route + (size_t)row * 8;
        const int slot = lbase[r[j]] + r[2 + j];
        r[4 + j] = slot; rowlist[slot] = row;
    }
    for (int e = c.bid; e < NEXP; e += c.nblk) { const int n = lcnt[e], end = ((n + 255) / 256) * 256;
        for (int i = n + c.tid; i < end; i += NTHR) rowlist[lbase[e] + i] = 0; }
    __syncthreads();
}
struct HgRaw { float f[16], q[16], v[16]; };
__device__ __forceinline__ float bf2f(bf16 x) { return __uint_as_float((unsigned)x << 16); }
template <bool NEEDQ> __device__ __forceinline__ void hg_load(HgRaw& r, const unsigned char* R1, int r0, int head, int dir, int k, int tq) {
    const bf16* fb = (const bf16*)(R1 + R1_F) + (size_t)(r0 + 16 * tq) * 4096 + 2048 * dir + head * 128 + k;
    const bf16* vb = (const bf16*)(R1 + R1_VB) + (size_t)(r0 + 16 * tq) * D + head * 128 + k; const bf16* qb = (const bf16*)(R1 + R1_QB) + (size_t)(r0 + 16 * tq) * D + head * 128 + k;
#pragma unroll
    for (int i = 0; i < 16; ++i) { r.f[i] = 1.0f - bf2f(fb[(size_t)i * 4096]); r.v[i] = bf2f(vb[(size_t)i * D]); if (NEEDQ) r.q[i] = bf2f(qb[(size_t)i * D]); }
}
constexpr int HG_T = HG_SCR;
template <bool NEEDQ> __device__ __forceinline__ float hg_prep(const Ctx& c, const HgRaw& r, int r0, int dir, int k, int tq, int lane) {
    LAS unsigned char* L = c.lds;
    float g[16], kk[16], cs[16];
#pragma unroll
    for (int i = 0; i < 16; ++i) { const bool valid = (r0 + 16 * tq + i) >= ROWV; g[i] = valid ? __logf(r.f[i]) : 0.f; kk[i] = valid ? 1.0f - r.f[i] : 0.f; }
    if (dir == 0) { cs[0] = g[0];
#pragma unroll
        for (int i = 1; i < 16; ++i) cs[i] = cs[i - 1] + g[i]; }
    else { cs[15] = g[15];
#pragma unroll
        for (int i = 14; i >= 0; --i) cs[i] = cs[i + 1] + g[i]; }
    LAS float* T = (LAS float*)(L + HG_T);
    T[tq * 128 + k] = dir == 0 ? cs[15] : cs[0];
    __syncthreads();
    const float t0 = T[k], t1 = T[128 + k], t2 = T[256 + k], t3 = T[384 + k];
    const float btot = (t0 + t1) + (t2 + t3);
    float off;
    if (dir == 0) off = tq == 0 ? 0.f : tq == 1 ? t0 : tq == 2 ? t0 + t1 : t0 + t1 + t2;
    else off = tq == 3 ? 0.f : tq == 2 ? t3 : tq == 1 ? t3 + t2 : t3 + t2 + t1;
    unsigned kh[8], vt[8];
#pragma unroll
    for (int i = 0; i < 16; i += 2) {
        const float b0 = off + cs[i], b1 = off + cs[i + 1];
        const unsigned pk = pkbf(kk[i] * __expf(-b0), kk[i + 1] * __expf(-b1));
        kh[i >> 1] = pk; vt[i >> 1] = pkbf(r.v[i], r.v[i + 1]);
        if (NEEDQ) { const int t = 16 * tq + i; const unsigned pq = pkbf(r.q[i] * __expf(b0), r.q[i + 1] * __expf(b1));
            *(LAS unsigned short*)(L + HG_QT + t * LD_K + 2 * k) = (unsigned short)pq; *(LAS unsigned short*)(L + HG_QT + (t + 1) * LD_K + 2 * k) = (unsigned short)(pq >> 16);
            *(LAS unsigned short*)(L + HG_KT + t * LD_K + 2 * k) = (unsigned short)pk; *(LAS unsigned short*)(L + HG_KT + (t + 1) * LD_K + 2 * k) = (unsigned short)(pk >> 16); }
    }
    *(LAS v4u*)(L + HG_KH + k * LD_T + 32 * tq) = (v4u){kh[0], kh[1], kh[2], kh[3]};
    *(LAS v4u*)(L + HG_KH + k * LD_T + 32 * tq + 16) = (v4u){kh[4], kh[5], kh[6], kh[7]};
    *(LAS v4u*)(L + HG_VT + k * LD_T + 32 * tq) = (v4u){vt[0], vt[1], vt[2], vt[3]};
    *(LAS v4u*)(L + HG_VT + k * LD_T + 32 * tq + 16) = (v4u){vt[4], vt[5], vt[6], vt[7]};
    if (tq == 0) ((LAS float*)(L + HG_DV))[k] = __expf(btot);
    return btot;
}
__device__ __forceinline__ void hg_update(LAS unsigned char* Lb, int w, f32x4 (&S)[8], int r, int q) {
#pragma unroll
    for (int ks = 0; ks < 2; ++ks) { const bf16x8 b = ldfrag(Lb + HG_VT, 16 * w + r, LD_T, (32 * ks + 8 * q) * 2);
#pragma unroll
        for (int kt = 0; kt < 8; ++kt) { const bf16x8 a2 = ldfrag(Lb + HG_KH, 16 * kt + r, LD_T, (32 * ks + 8 * q) * 2); S[kt] = MFMA16(a2, b, S[kt]); } }
#pragma unroll
    for (int kt = 0; kt < 8; ++kt) { const f32x4 d = *(const LAS f32x4*)(Lb + HG_DV + (16 * kt + 4 * q) * 4); S[kt] = S[kt] * d; }
}
__device__ __forceinline__ void hg_seg_range(int seg, int& c0, int& n) { if (seg == 0) { c0 = 3; n = 9; } else { c0 = 4 + 8 * seg; n = 8; } }
__device__ __forceinline__ void glds16(const unsigned char* gsrc_lane, LAS unsigned char* lds_wave) { __builtin_amdgcn_global_load_lds((const unsigned*)gsrc_lane, (LAS unsigned*)lds_wave, 16, 0, 0); }
__device__ __forceinline__ void phase_hg_build(const Ctx& c, const Args& a) {
    const unsigned char* R1 = a.ws + WS_R1; unsigned char* IMG = a.ws + WS_R1 + R1_IMG; LAS unsigned char* L = c.lds;
    for (int u = c.bid; u < 257 * 16; u += c.nblk) {
        int tv = c.tid; asm volatile("" : "+v"(tv));
        const int lane = tv & 63, k = tv & 127, tq = tv >> 7, ci = 3 + (u >> 4), head = u & 15, r0 = 64 * ci;
        unsigned char* img = IMG + ((size_t)ci * 16 + head) * IMG_SZ;
#pragma unroll 1
        for (int dir = 0; dir < 2; ++dir) {
            HgRaw raw; hg_load<true>(raw, R1, r0, head, dir, k, tq);
            (void)hg_prep<true>(c, raw, r0, dir, k, tq, lane);
            __syncthreads();
            for (int i = tv; i < 3392; i += NTHR) *(v4u*)(img + 18432 + (size_t)dir * 54272 + (size_t)i * 16) = *(const LAS v4u*)(L + HG_QT + i * 16);
            if (dir == 0) for (int i = tv; i < 1152; i += NTHR) *(v4u*)(img + (size_t)i * 16) = *(const LAS v4u*)(L + HG_VT + i * 16);
            if (dir == 0) { const bf16* gp = (const bf16*)(R1 + R1_GB) + (size_t)(r0 + 16 * tq) * D + head * 128 + k; float gv[16];
#pragma unroll
                for (int i = 0; i < 16; ++i) gv[i] = bf2f(gp[(size_t)i * D]);
                bf16* gt = (bf16*)(a.ws + WS_R1 + R1_GT) + ((size_t)ci * 16 + head) * 8192 + (size_t)(((k >> 4) * 4 + tq) * 64 + (k & 15)) * 4;
#pragma unroll
                for (int qq = 0; qq < 4; ++qq) { v2u w2; w2.x = pkbf(gv[4 * qq], gv[4 * qq + 1]); w2.y = pkbf(gv[4 * qq + 2], gv[4 * qq + 3]); *(v2u*)(gt + qq * 64) = w2; } }
            __syncthreads();
        }
    }
}
__device__ __forceinline__ void phase_hg_pass1(const Ctx& c, const Args& a) {
    const unsigned char* IMG = a.ws + WS_R1 + R1_IMG; LAS unsigned char* L = c.lds;
    float* DS = (float*)(a.ws + WS_R1 + R1_DS); float* DSEG = (float*)(a.ws + WS_R1 + R1_DSEG);
    const int w = c.wave;
    for (int u = c.bid; u < 1024; u += c.nblk) {
        int tv = c.tid; asm volatile("" : "+v"(tv));
        const int lane = tv & 63, r = lane & 15, q = lane >> 4;
        const int chain = u & 31, seg = u >> 5, dir = chain >> 4, head = chain & 15;
        int c0, n; hg_seg_range(seg, c0, n);
        f32x4 S[8];
#pragma unroll
        for (int kt = 0; kt < 8; ++kt) S[kt] = (f32x4){0.f, 0.f, 0.f, 0.f};
        float dprod = 1.0f;
#define HG1_ISSUE(step, buf) do { const int ci_ = dir == 0 ? c0 + (step) : c0 + n - 1 - (step); const unsigned char* img_ = IMG + ((size_t)ci_ * 16 + head) * IMG_SZ; LAS unsigned char* lb_ = L + (buf) * HB_SZ; \
            for (int p_ = w; p_ < 37; p_ += 8) { if (p_ < 18) glds16(img_ + p_ * 1024 + lane * 16, lb_ + HG_VT + p_ * 1024); \
                else glds16(img_ + 18432 + (size_t)dir * 54272 + (HG_KH - HG_QT) + (p_ - 18) * 1024 + lane * 16, lb_ + HG_KH + (p_ - 18) * 1024); } } while (0)
        HG1_ISSUE(0, 0);
        for (int j = 0; j < n; ++j) {
            asm volatile("s_waitcnt vmcnt(0)" ::: "memory"); __syncthreads();
            if (j + 1 < n) HG1_ISSUE(j + 1, (j + 1) & 1);
            LAS unsigned char* Lb = L + (j & 1) * HB_SZ;
            hg_update(Lb, w, S, r, q);
            if (tv < 128) dprod *= *(const LAS float*)(Lb + HG_DV + tv * 4);
        }
#undef HG1_ISSUE
        float* dst = DS + ((size_t)seg * 32 + chain) * 16384 + w * 2048 + lane;
#pragma unroll
        for (int kt = 0; kt < 8; ++kt)
#pragma unroll
            for (int e = 0; e < 4; ++e) dst[(kt * 4 + e) * 64] = S[kt][e];
        if (tv < 128) DSEG[((size_t)seg * 32 + chain) * 128 + tv] = dprod;
        __syncthreads();
    }
}
__device__ __forceinline__ void phase_hg_segscan(const Ctx& c, const Args& a) {
    float* DS = (float*)(a.ws + WS_R1 + R1_DS); const float* DSEG = (const float*)(a.ws + WS_R1 + R1_DSEG);
    for (int i = c.bid * NTHR + c.tid; i < 32 * 4096; i += c.nblk * NTHR) {
        const int chain = i >> 12, e4 = i & 4095, el = e4 * 4, ln = el & 63, e = (el >> 6) & 3, kt = (el >> 8) & 7, k = 16 * kt + 4 * (ln >> 4) + e, dir = chain >> 4;
        f32x4 run = (f32x4){0.f, 0.f, 0.f, 0.f};
        for (int j0 = 0; j0 < 32; j0 += 8) { f32x4 ds[8]; float d[8];
#pragma unroll
            for (int j = 0; j < 8; ++j) { const int sg = dir == 0 ? j0 + j : 31 - j0 - j; ds[j] = *((const f32x4*)(DS + ((size_t)sg * 32 + chain) * 16384) + e4); d[j] = DSEG[((size_t)sg * 32 + chain) * 128 + k]; }
#pragma unroll
            for (int j = 0; j < 8; ++j) { const int sg = dir == 0 ? j0 + j : 31 - j0 - j; *((f32x4*)(DS + ((size_t)sg * 32 + chain) * 16384) + e4) = run; run = run * d[j] + ds[j]; } }
    }
}
template <int DIR> __device__ __forceinline__ void phase_hg_pass2(const Ctx& c, const Args& a) {
    const unsigned char* IMG = a.ws + WS_R1 + R1_IMG;
    const float* DS = (const float*)(a.ws + WS_R1 + R1_DS);
    bf16* OBW = (bf16*)(a.ws + WS_R1 + R1_OBW); const bf16* GB = (const bf16*)(a.ws + WS_R1 + R1_GB); bf16* MI = (bf16*)(a.ws + WS_MIXIN);
    LAS unsigned char* L = c.lds;
    const int w = c.wave;
    for (int u = c.bid; u < 512; u += c.nblk) {
        int tv = c.tid; asm volatile("" : "+v"(tv));
        const int lane = tv & 63, r = lane & 15, q = lane >> 4;
        const int head = u & 15, seg = u >> 4, dir = DIR, chain = dir * 16 + head;
        int c0, n; hg_seg_range(seg, c0, n);
        f32x4 S[8];
        { const float* src = DS + ((size_t)seg * 32 + chain) * 16384 + w * 2048 + lane;
#pragma unroll
          for (int kt = 0; kt < 8; ++kt)
#pragma unroll
              for (int e = 0; e < 4; ++e) S[kt][e] = src[(kt * 4 + e) * 64]; }
#define HG2_ISSUE(step, buf) do { const int ci_ = dir == 0 ? c0 + (step) : c0 + n - 1 - (step); const unsigned char* img_ = IMG + ((size_t)ci_ * 16 + head) * IMG_SZ; LAS unsigned char* lb_ = L + (buf) * HB_SZ; \
            for (int p_ = w; p_ < 71; p_ += 8) { if (p_ < 18) glds16(img_ + p_ * 1024 + lane * 16, lb_ + HG_VT + p_ * 1024); \
                else glds16(img_ + 18432 + (size_t)dir * 54272 + (p_ - 18) * 1024 + lane * 16, lb_ + HG_QT + (p_ - 18) * 1024); } } while (0)
        HG2_ISSUE(0, 0);
        float ng = 0.f; if (DIR == 0) ng = a.in[I_NORMG][head * 128 + 16 * w + r];
        f32x4 po[4]; v2u pg[4]; int pci = 0;
#pragma unroll
        for (int tt = 0; tt < 4; ++tt) { po[tt] = (f32x4){0.f, 0.f, 0.f, 0.f}; pg[tt] = (v2u){0u, 0u}; }
#define HG2_FLUSH(par) do { if (DIR == 1) { v2u* ob_ = (v2u*)(OBW + ((size_t)pci * 16 + head) * 8192) + (w * 4) * 64 + lane; \
                _Pragma("unroll") for (int tt = 0; tt < 4; ++tt) { v2u w2; w2.x = pkbf(po[tt][0], po[tt][1]); w2.y = pkbf(po[tt][2], po[tt][3]); ob_[tt * 64] = w2; } \
            } else { const LAS float* RS_ = (const LAS float*)(L + HG_SCR + (par) * 2048); bf16* mi_ = MI + (size_t)(64 * pci) * D + head * 128 + 16 * w + r; \
                  \
                const int town_ = 16 * (r >> 2) + 4 * q + (r & 3); const f32x4 s0 = *(const LAS f32x4*)(RS_ + town_ * 8), s1 = *(const LAS f32x4*)(RS_ + town_ * 8 + 4); \
                const float rsown_ = 1.0f / sqrtf(((s0.x + s0.y) + (s0.z + s0.w) + (s1.x + s1.y) + (s1.z + s1.w)) * (1.0f / 128.0f) + 1e-6f); \
                _Pragma("unroll") for (int tt = 0; tt < 4; ++tt) { const f32x4 g4 = bf4(pg[tt]); \
                    _Pragma("unroll") for (int e = 0; e < 4; ++e) { const int t = 16 * tt + 4 * q + e; const float rs = __shfl(rsown_, (lane & 48) + 4 * tt + e); \
                        mi_[(size_t)t * D] = (bf16)f2bf(64 * pci + t >= ROWV ? po[tt][e] * rs * ng * g4[e] : 0.f); } } } } while (0)
        for (int j = 0; j < n; ++j) {
            const int ci = dir == 0 ? c0 + j : c0 + n - 1 - j;
            asm volatile("s_waitcnt vmcnt(0)" ::: "memory"); __syncthreads();
            if (j + 1 < n) HG2_ISSUE(j + 1, (j + 1) & 1);
            if (j > 0) HG2_FLUSH((j - 1) & 1);
            LAS unsigned char* Lb = L + (j & 1) * HB_SZ;
            v2u obp[4], gtp[4];
            if (DIR == 0) { const v2u* ob_ = (const v2u*)(OBW + ((size_t)ci * 16 + head) * 8192) + (w * 4) * 64 + lane; const v2u* gt_ = (const v2u*)((const bf16*)(a.ws + WS_R1 + R1_GT) + ((size_t)ci * 16 + head) * 8192) + (w * 4) * 64 + lane;
#pragma unroll
                for (int tt = 0; tt < 4; ++tt) { obp[tt] = ob_[tt * 64]; gtp[tt] = gt_[tt * 64]; } }
            f32x4 o[4];
#pragma unroll
            for (int tt = 0; tt < 4; ++tt) {
                o[tt] = (f32x4){0.f, 0.f, 0.f, 0.f};
                bf16x8 qf[4];
#pragma unroll
                for (int ks = 0; ks < 4; ++ks) qf[ks] = ldfrag(Lb + HG_QT, 16 * tt + r, LD_K, (32 * ks + 8 * q) * 2);
                unsigned pp[4][2];
#pragma unroll
                for (int st = 0; st < 4; ++st) { f32x4 acc = (f32x4){0.f, 0.f, 0.f, 0.f};
#pragma unroll
                    for (int ks = 0; ks < 4; ++ks) { const bf16x8 kf = ldfrag(Lb + HG_KT, 16 * st + r, LD_K, (32 * ks + 8 * q) * 2); acc = MFMA16(kf, qf[ks], acc); }
                    const int s0 = 16 * st + 4 * q, t = 16 * tt + r;
                    const float m0 = (dir == 0 ? (s0 <= t) : (s0 >= t)) ? acc[0] : 0.f, m1 = (dir == 0 ? (s0 + 1 <= t) : (s0 + 1 >= t)) ? acc[1] : 0.f;
                    const float m2 = (dir == 0 ? (s0 + 2 <= t) : (s0 + 2 >= t)) ? acc[2] : 0.f, m3 = (dir == 0 ? (s0 + 3 <= t) : (s0 + 3 >= t)) ? acc[3] : 0.f;
                    pp[st][0] = pkbf(m0, m1); pp[st][1] = pkbf(m2, m3); }
#pragma unroll
                for (int ks = 0; ks < 2; ++ks) { const v4u af = (v4u){pp[2 * ks][0], pp[2 * ks][1], pp[2 * ks + 1][0], pp[2 * ks + 1][1]};
                    const LAS unsigned char* vp = Lb + HG_VT + (16 * w + r) * LD_T + (32 * ks + 4 * q) * 2; const v2u lo = *(const LAS v2u*)vp, hi = *(const LAS v2u*)(vp + 32);
                    const v4u vf = (v4u){lo.x, lo.y, hi.x, hi.y}; o[tt] = MFMA16(__builtin_bit_cast(bf16x8, af), __builtin_bit_cast(bf16x8, vf), o[tt]); }
            }
#pragma unroll
            for (int ks = 0; ks < 4; ++ks) { v4u sb; sb.x = pkbf(S[2 * ks][0], S[2 * ks][1]); sb.y = pkbf(S[2 * ks][2], S[2 * ks][3]); sb.z = pkbf(S[2 * ks + 1][0], S[2 * ks + 1][1]); sb.w = pkbf(S[2 * ks + 1][2], S[2 * ks + 1][3]);
                const bf16x8 bf = __builtin_bit_cast(bf16x8, sb);
#pragma unroll
                for (int tt = 0; tt < 4; ++tt) { const LAS unsigned char* qp = Lb + HG_QT + (16 * tt + r) * LD_K + (32 * ks + 4 * q) * 2; const v2u lo = *(const LAS v2u*)qp, hi = *(const LAS v2u*)(qp + 32);
                    const v4u t4 = (v4u){lo.x, lo.y, hi.x, hi.y}; o[tt] = MFMA16(__builtin_bit_cast(bf16x8, t4), bf, o[tt]); } }
            hg_update(Lb, w, S, r, q);
            pci = ci;
            if (DIR == 1) {
#pragma unroll
                for (int tt = 0; tt < 4; ++tt) po[tt] = o[tt];
            } else {
                LAS float* RS = (LAS float*)(L + HG_SCR + (j & 1) * 2048);
                float ss[16];
#pragma unroll
                for (int tt = 0; tt < 4; ++tt) { const f32x4 b4 = bf4(obp[tt]); o[tt] = o[tt] + b4;
#pragma unroll
                    for (int e = 0; e < 4; ++e) ss[tt * 4 + e] = o[tt][e] * o[tt][e]; }
                float b8[8], b4v[4], b2v[2], tot;
#pragma unroll
                for (int i = 0; i < 8; ++i) { const float keep = (r & 8) ? ss[i + 8] : ss[i], send = (r & 8) ? ss[i] : ss[i + 8]; b8[i] = keep + __shfl_xor(send, 8); }
#pragma unroll
                for (int i = 0; i < 4; ++i) { const float keep = (r & 4) ? b8[i + 4] : b8[i], send = (r & 4) ? b8[i] : b8[i + 4]; b4v[i] = keep + __shfl_xor(send, 4); }
#pragma unroll
                for (int i = 0; i < 2; ++i) { const float keep = (r & 2) ? b4v[i + 2] : b4v[i], send = (r & 2) ? b4v[i] : b4v[i + 2]; b2v[i] = keep + __shfl_xor(send, 2); }
                { const float keep = (r & 1) ? b2v[1] : b2v[0], send = (r & 1) ? b2v[0] : b2v[1]; tot = keep + __shfl_xor(send, 1); }
                RS[(16 * (r >> 2) + 4 * q + (r & 3)) * 8 + w] = tot;
#pragma unroll
                for (int tt = 0; tt < 4; ++tt) { po[tt] = o[tt]; pg[tt] = gtp[tt]; }
            }
        }
#undef HG2_ISSUE
        __syncthreads();
        HG2_FLUSH((n - 1) & 1);
#undef HG2_FLUSH
    }
    if (DIR == 0) { for (int i = c.bid * NTHR + c.tid; i < 192 * D / 8; i += c.nblk * NTHR) ((v4u*)MI)[i] = (v4u){0u, 0u, 0u, 0u}; }
}
constexpr int NPHASE = 40;
__global__ void __launch_bounds__(NTHR, 2) fwd(Args args) {
    extern __shared__ __attribute__((aligned(16))) unsigned char lds[];
    Ctx c; c.lds = (LAS unsigned char*)lds; c.ldsg = lds; c.tid = threadIdx.x; c.lane = c.tid & 63; c.wave = __builtin_amdgcn_readfirstlane(c.tid >> 6);
    c.bid = blockIdx.x; c.nblk = gridDim.x; c.gw = c.bid * NWAVES + c.wave; c.ngw = c.nblk * NWAVES;
    volatile LAS unsigned* MISC = (volatile LAS unsigned*)(c.lds + MISC_OFF);
    for (int u = c.tid; u < (LDS_BYTES - MISC_OFF) / 4; u += NTHR) ((LAS unsigned*)(c.lds + MISC_OFF))[u] = 0u;
    __syncthreads();
    const int lo = args.ph_lo, hi = args.ph_hi;
#ifdef PROBE_MASK
    float g_probe_scale = 1.0f;
#endif
    const bool multi = (hi - lo) > 1;
    XcdBarrier bar; bar.bar = (unsigned*)(args.ws + WS_CTL) + CW_BAR; bar.x = 0; bar.st = nullptr;
    if (multi) bar = xcd_barrier_post((unsigned*)(args.ws + WS_CTL) + CW_BAR, MISC + 8);
#define IN(k) (lo <= (k) && (k) < hi)
#ifdef PROBE_MASK
#define STAMP(k) do { if (c.bid == 0 && c.tid == 0) ((unsigned long long*)((unsigned*)(args.ws + WS_CTL) + CW_TS))[(k)] = __builtin_amdgcn_s_memrealtime(); } while (0)
#else
#define STAMP(k) do { } while (0)
#endif
#define SEAM(k) do { if (IN(k) && IN((k) + 1)) { STAMP(64 + (k)); xcd_barrier(bar); STAMP((k) + 1); } } while (0)
    STAMP(0);
    unsigned char* ws = args.ws;
    float* HA = (float*)(ws + WS_HA); float* HBuf = (float*)(ws + WS_HB);
    const pg8::bf16_t* HBF = (const pg8::bf16_t*)(ws + WS_HBF);
    const pg8::bf16_t* MIXIN = (const pg8::bf16_t*)(ws + WS_MIXIN);
    if (IN(0)) { phase_init(c, args);
#if defined(DUP_PHASE)
        if (DUP_PHASE == 0) { xcd_barrier(bar); phase_init(c, args); }
#endif
    } SEAM(0);
    if (IN(1)) { phase_s5_ktab(c, args);
#if defined(DUP_PHASE)
        if (DUP_PHASE == 1) { xcd_barrier(bar); phase_s5_ktab(c, args); }
#endif
    } SEAM(1);
    if (IN(2)) { phase_weights(c, args); phase_s5_fill(c, args);
#if defined(DUP_PHASE)
        if (DUP_PHASE == 2) { xcd_barrier(bar); phase_weights(c, args); phase_s5_fill(c, args); }
#endif
    } SEAM(2);
    if (IN(3)) { skinny_gemm2(c, (const bf16*)HBF, D, (const bf16*)(ws + WS_WAB), D, ABN, SkAB2{ws});
        zero_rows_bf16(c, (bf16*)(ws + WS_QB0), 1024, 192, ROWV); zero_rows_bf16(c, (bf16*)(ws + WS_KB0), 256, 192, ROWV); zero_rows_bf16(c, (bf16*)(ws + WS_VB0), 256, 192, ROWV);
        for (int i = c.bid * NTHR + c.tid; i < 64 * 256; i += c.nblk * NTHR) ((bf16*)(ws + WS_R1 + R1_UA))[(size_t)(i >> 8) * 768 * 768 + (i & 255)] = 0;
        pg8::Gemm g = pg8::mkgemm(HBF, ws + WS_WAB, SEQ, ABN, D); pg8::StaticOrder S; S.init(SEQ, ABN, c.nblk, c.bid, 1);
        pg8::EpiProjAB E{ws}; pg8::gemm_phase(c.lds, g, S, E);
        if (c.nblk == 256 && c.bid >= 128) conv_fill(c, args, 0, FILL3, c.bid - 128, c.nblk - 128);
    } SEAM(3);
    if (IN(4)) { phase_attn(c, args);
        if (c.nblk == 256 && c.bid >= 2) { __syncthreads(); conv_fill(c, args, FILL7, FILL4, c.bid - 2, c.nblk - 2); }
#if defined(DUP_PHASE)
        if (DUP_PHASE == 4) { xcd_barrier(bar); phase_attn(c, args); }
#endif
    } SEAM(4);
    if (IN(5)) { pg8::Gemm g = pg8::mkgemm(ws + WS_R1 + R1_UA, ws + WS_WST, 768, 256, 512, (size_t)256 * 512 * 2); g.lda = 768; g.astride = (size_t)768 * 768 * 2;
        pg8::GroupTileOrder S; S.init(64, 768, 256, c.nblk, c.bid); pg8::EpiF32 E{(float*)(ws + WS_R1 + R1_SALL), 256, (size_t)768 * 256}; pg8::gemm_phase(c.lds, g, S, E);
        if (c.nblk == 256 && c.bid >= 192) conv_fill(c, args, FILL3, FILL5, c.bid - 192, c.nblk - 192);
#if defined(DUP_PHASE)
        if (DUP_PHASE == 5) { xcd_barrier(bar); pg8::Gemm g = pg8::mkgemm(ws + WS_R1 + R1_UA, ws + WS_WST, 768, 256, 512, (size_t)256 * 512 * 2); g.lda = 768; g.astride = (size_t)768 * 768 * 2;
        pg8::GroupTileOrder S; S.init(64, 768, 256, c.nblk, c.bid); pg8::EpiF32 E{(float*)(ws + WS_R1 + R1_SALL), 256, (size_t)768 * 256}; pg8::gemm_phase(c.lds, g, S, E); }
#endif
    } SEAM(5);
    if (IN(6)) { phase_s5_chunkscan(c, args);
        if (c.nblk == 256 && c.bid >= 128) conv_fill(c, args, FILL5, FILL6, c.bid - 128, c.nblk - 128);
#if defined(DUP_PHASE)
        if (DUP_PHASE == 6) { xcd_barrier(bar); phase_s5_chunkscan(c, args); }
#endif
    } SEAM(6);
    if (IN(7)) { pg8::Gemm g = pg8::mkgemm(ws + WS_R1 + R1_UA, ws + WS_MWT, 768, 512, 768, (size_t)512 * 768 * 2); g.astride = (size_t)768 * 768 * 2;
        pg8::GroupTileOrder S; S.init(64, 768, 512, c.nblk, c.bid); pg8::EpiS5Y E{(pg8::bf16_t*)(ws + WS_ZB)}; pg8::gemm_phase(c.lds, g, S, E);
        if (c.nblk == 256 && c.bid >= 128) conv_fill(c, args, FILL6, FILL7, c.bid - 128, c.nblk - 128);
#if defined(DUP_PHASE)
        if (DUP_PHASE == 7) { xcd_barrier(bar); pg8::Gemm g = pg8::mkgemm(ws + WS_R1 + R1_UA, ws + WS_MWT, 768, 512, 768, (size_t)512 * 768 * 2); g.astride = (size_t)768 * 768 * 2;
        pg8::GroupTileOrder S; S.init(64, 768, 512, c.nblk, c.bid); pg8::EpiS5Y E{(pg8::bf16_t*)(ws + WS_ZB)}; pg8::gemm_phase(c.lds, g, S, E); }
#endif
    } SEAM(7);
    if (IN(8)) { skinny_gemm(c, (const bf16*)(ws + WS_ZB), 1024, (const bf16*)(ws + WS_WGLU), 1024, 1024, SkGlu{(const bf16*)(ws + WS_ZB), args.in[I_BGLU], (bf16*)(ws + WS_MIXIN)});
        pg8::Gemm g = pg8::mkgemm(ws + WS_ZB, ws + WS_WGLU, SEQ, 1024, 1024); pg8::StaticOrder S; S.init(SEQ, 1024, c.nblk, c.bid, 1);
        pg8::EpiGlu E{(const pg8::bf16_t*)(ws + WS_ZB), args.in[I_BGLU], (pg8::bf16_t*)(ws + WS_MIXIN)}; pg8::gemm_phase(c.lds, g, S, E);
#if defined(DUP_PHASE)
        if (DUP_PHASE == 8) { xcd_barrier(bar); skinny_gemm(c, (const bf16*)(ws + WS_ZB), 1024, (const bf16*)(ws + WS_WGLU), 1024, 1024, SkGlu{(const bf16*)(ws + WS_ZB), args.in[I_BGLU], (bf16*)(ws + WS_MIXIN)});
        pg8::Gemm g = pg8::mkgemm(ws + WS_ZB, ws + WS_WGLU, SEQ, 1024, 1024); pg8::StaticOrder S; S.init(SEQ, 1024, c.nblk, c.bid, 1);
        pg8::EpiGlu E{(const pg8::bf16_t*)(ws + WS_ZB), args.in[I_BGLU], (pg8::bf16_t*)(ws + WS_MIXIN)}; pg8::gemm_phase(c.lds, g, S, E); }
#endif
    } SEAM(8);
    if (IN(9)) { skinny_gemm(c, (const bf16*)MIXIN, D, (const bf16*)(ws + WS_WOAB), D, D, SkBf16{(bf16*)(ws + WS_MIX), D});
        pg8::Gemm g = pg8::mkgemm(MIXIN, ws + WS_WOAB, SEQ, D, D); pg8::StaticOrder S; S.init(SEQ, D, c.nblk, c.bid, 1);
        pg8::EpiBf16 E{(pg8::bf16_t*)(ws + WS_MIX), D}; pg8::gemm_phase(c.lds, g, S, E);
#if defined(DUP_PHASE)
        if (DUP_PHASE == 9) { xcd_barrier(bar); skinny_gemm(c, (const bf16*)MIXIN, D, (const bf16*)(ws + WS_WOAB), D, D, SkBf16{(bf16*)(ws + WS_MIX), D});
        pg8::Gemm g = pg8::mkgemm(MIXIN, ws + WS_WOAB, SEQ, D, D); pg8::StaticOrder S; S.init(SEQ, D, c.nblk, c.bid, 1);
        pg8::EpiBf16 E{(pg8::bf16_t*)(ws + WS_MIX), D}; pg8::gemm_phase(c.lds, g, S, E); }
#endif
    } SEAM(9);
    if (IN(10)) { phase_ln_mix(c, args, 0);
#if defined(DUP_PHASE)
        if (DUP_PHASE == 10) { xcd_barrier(bar); phase_ln_mix(c, args, 0); }
#endif
    } SEAM(10);
    if (IN(11)) { phase_router(c, args, 0);
        if (c.nblk == 256 && c.bid != 0) { __syncthreads(); conv_fill(c, args, R11_LO, R11_HI, c.bid - 1, 255); }
#if defined(DUP_PHASE)
        if (DUP_PHASE == 11) { xcd_barrier(bar); phase_router(c, args, 0); }
#endif
    } SEAM(11);
    if (IN(12)) { phase_gather(c, args, 0);
#if defined(DUP_PHASE)
        if (DUP_PHASE == 12) { xcd_barrier(bar); phase_gather(c, args, 0); }
#endif
    } SEAM(12);
    if (IN(13)) { pg8::Gemm g = pg8::mkgemm(ws + WS_H8, ws + WS_WGU, MPAD, 1024, D / 2, (size_t)1024 * D); pg8::GatherOrder S; S.init((const int*)(ws + WS_CTL) + CW_PLAN, 1024, c.nblk, c.bid, (const int*)(ws + WS_ROWLIST));
        pg8::EpiSwiGLU8 E{ws + WS_R1 + R1_ACT, DEXP}; pg8::gemm_phase<pg8::EpiSwiGLU8, pg8::GatherOrder, true>(c.lds, g, S, E, 0x79797979);
        if (c.nblk == 256) { const int nwg = ((const int*)(ws + WS_CTL))[CW_PLAN] * 4, rank = (c.bid % 8) * 32 + c.bid / 8 - (nwg - 512);
            if (nwg > 512 && nwg < 768 && rank >= 0 && rank < 128) { __syncthreads(); const int b0 = R13_LO + rank * 40; for (int it = b0 + c.wave; it < b0 + 40; it += NWAVES) conv_l1_item(c, args, it); __syncthreads(); } }
#if defined(DUP_PHASE)
        if (DUP_PHASE == 13) { xcd_barrier(bar); pg8::Gemm g = pg8::mkgemm(ws + WS_H8, ws + WS_WGU, MPAD, 1024, D / 2, (size_t)1024 * D); pg8::GatherOrder S; S.init((const int*)(ws + WS_CTL) + CW_PLAN, 1024, c.nblk, c.bid, (const int*)(ws + WS_ROWLIST));
        pg8::EpiSwiGLU8 E{ws + WS_R1 + R1_ACT, DEXP}; pg8::gemm_phase<pg8::EpiSwiGLU8, pg8::GatherOrder, true>(c.lds, g, S, E, 0x79797979); }
#endif
    } SEAM(13);
    if (IN(14)) { pg8::Gemm g = pg8::mkgemm(ws + WS_R1 + R1_ACT, ws + WS_WD, MPAD, D, DEXP / 2, (size_t)D * DEXP); pg8::GroupedOrder S; S.init((const int*)(ws + WS_CTL) + CW_PLAN, D, c.nblk, c.bid);
        pg8::EpiBf16 E{(pg8::bf16_t*)(ws + WS_R1 + R1_Y), D}; pg8::gemm_phase<pg8::EpiBf16, pg8::GroupedOrder, true>(c.lds, g, S, E, 0x79797979);
#if defined(DUP_PHASE)
        if (DUP_PHASE == 14) { xcd_barrier(bar); pg8::Gemm g = pg8::mkgemm(ws + WS_R1 + R1_ACT, ws + WS_WD, MPAD, D, DEXP / 2, (size_t)D * DEXP); pg8::GroupedOrder S; S.init((const int*)(ws + WS_CTL) + CW_PLAN, D, c.nblk, c.bid);
        pg8::EpiBf16 E{(pg8::bf16_t*)(ws + WS_R1 + R1_Y), D}; pg8::gemm_phase<pg8::EpiBf16, pg8::GroupedOrder, true>(c.lds, g, S, E, 0x79797979); }
#endif
    } SEAM(14);
    if (IN(15)) { phase_ln_ffn(c, args, 0, false PROBE_PASS);
#if defined(DUP_PHASE)
        if (DUP_PHASE == 15) { xcd_barrier(bar); phase_ln_ffn(c, args, 0, false PROBE_PASS); }
#endif
    } SEAM(15);
    if (IN(16)) { skinny_gemm(c, (const bf16*)HBF, D, (const bf16*)(ws + WS_WC), D, CN, SkC{(bf16*)(ws + WS_R1 + R1_QB), (bf16*)(ws + WS_R1 + R1_VB), (bf16*)(ws + WS_R1 + R1_GB), (bf16*)(ws + WS_R1 + R1_F), (const float*)(ws + WS_LBT)});
        zero_rows_bf16(c, (bf16*)(ws + WS_R1 + R1_F), 4096, 192, ROWV); zero_rows_bf16(c, (bf16*)(ws + WS_R1 + R1_QB), D, 192, ROWV); zero_rows_bf16(c, (bf16*)(ws + WS_R1 + R1_VB), D, 192, ROWV); zero_rows_bf16(c, (bf16*)(ws + WS_R1 + R1_GB), D, 192, ROWV);
        pg8::Gemm g = pg8::mkgemm(ws + WS_H8, ws + WS_WC8, SEQ, CN, D / 2); pg8::StaticOrder S; S.init(SEQ, 6144, c.nblk, c.bid, 1, 16);
        pg8::EpiProjC E{ws + WS_R1, (const float*)(ws + WS_LBT)}; pg8::gemm_phase<pg8::EpiProjC, pg8::StaticOrder, true>(c.lds, g, S, E, 0x79797979);
        pg8::Gemm g2 = pg8::mkgemm(HBF, ws + WS_WC, SEQ, CN, D); pg8::StaticOrder S2; S2.init(SEQ, 4096, c.nblk, c.bid, 1, 0);
        __syncthreads(); pg8::gemm_phase(c.lds, g2, S2, E);
#if defined(DUP_PHASE)
        if (DUP_PHASE == 16) { xcd_barrier(bar); pg8::gemm_phase<pg8::EpiProjC, pg8::StaticOrder, true>(c.lds, g, S, E, 0x79797979); __syncthreads(); pg8::gemm_phase(c.lds, g2, S2, E); }
#endif
    } SEAM(16);
    if (IN(17)) { phase_hg_build(c, args); if (c.nblk == 256 && c.bid >= 16) { __syncthreads(); conv_fill(c, args, R17_LO, R17_HI, c.bid - 16, 240); } xcd_barrier(bar); phase_hg_pass1(c, args); xcd_barrier(bar); phase_hg_segscan(c, args); xcd_barrier(bar); phase_hg_pass2<1>(c, args);
#if defined(DUP_PHASE)
        if (DUP_PHASE == 17) { xcd_barrier(bar); phase_hg_build(c, args); }
        if (DUP_PHASE == 170) { xcd_barrier(bar); phase_hg_pass1(c, args); xcd_barrier(bar); phase_hg_segscan(c, args); }
        if (DUP_PHASE == 171) { xcd_barrier(bar); phase_hg_pass2<1>(c, args); }
#endif
    } SEAM(17);
    if (IN(18)) { phase_hg_pass2<0>(c, args);
#if defined(DUP_PHASE)
        if (DUP_PHASE == 18) { xcd_barrier(bar); phase_hg_pass2<0>(c, args); }
#endif
    } SEAM(18);
    if (IN(19)) { skinny_gemm(c, (const bf16*)MIXIN, D, (const bf16*)(ws + WS_WOC), D, D, SkBf16{(bf16*)(ws + WS_MIX), D});
        pg8::Gemm g = pg8::mkgemm(MIXIN, ws + WS_WOC, SEQ, D, D); pg8::StaticOrder S; S.init(SEQ, D, c.nblk, c.bid, 1);
        pg8::EpiBf16 E{(pg8::bf16_t*)(ws + WS_MIX), D}; pg8::gemm_phase(c.lds, g, S, E);
#if defined(DUP_PHASE)
        if (DUP_PHASE == 19) { xcd_barrier(bar); skinny_gemm(c, (const bf16*)MIXIN, D, (const bf16*)(ws + WS_WOC), D, D, SkBf16{(bf16*)(ws + WS_MIX), D});
        pg8::Gemm g = pg8::mkgemm(MIXIN, ws + WS_WOC, SEQ, D, D); pg8::StaticOrder S; S.init(SEQ, D, c.nblk, c.bid, 1);
        pg8::EpiBf16 E{(pg8::bf16_t*)(ws + WS_MIX), D}; pg8::gemm_phase(c.lds, g, S, E); }
#endif

#if defined(DUP_PHASE)
        if (DUP_PHASE == 190) { xcd_barrier(bar); pg8::EpiNull EN{(float*)(ws + WS_CTL) + 70000}; pg8::gemm_phase(c.lds, g, S, EN); }
#endif
    } SEAM(19);
    if (IN(20)) { phase_ln_mix(c, args, 1);
#if defined(DUP_PHASE)
        if (DUP_PHASE == 20) { xcd_barrier(bar); phase_ln_mix(c, args, 1); }
#endif
    } SEAM(20);
    if (IN(21)) { phase_router(c, args, 1);
        if (c.nblk == 256 && c.bid != 0) { __syncthreads(); conv_fill(c, args, R21_LO, R21_HI, c.bid - 1, 255); }
#if defined(DUP_PHASE)
        if (DUP_PHASE == 21) { xcd_barrier(bar); phase_router(c, args, 1); }
#endif
    } SEAM(21);
    if (IN(22)) {
        if (c.nblk == 256) { const int nwg = ((const int*)(ws + WS_CTL))[CW_PLAN] * 4, done = (nwg > 512 && nwg < 768) ? ((768 - nwg) < 128 ? (768 - nwg) : 128) : 0;
            for (int it = R13_LO + done * 40 + c.gw; it < R13_HI; it += c.ngw) conv_l1_item(c, args, it);
            __syncthreads(); }
        phase_gather(c, args, 1);
#if defined(DUP_PHASE)
        if (DUP_PHASE == 22) { xcd_barrier(bar); phase_gather(c, args, 1); }
#endif
    } SEAM(22);
    if (IN(23)) { pg8::Gemm g = pg8::mkgemm(ws + WS_H8, ws + WS_WGU + (size_t)NEXP * 1024 * D, MPAD, 1024, D / 2, (size_t)1024 * D); pg8::GatherOrder S; S.init((const int*)(ws + WS_CTL) + CW_PLAN + 512, 1024, c.nblk, c.bid, (const int*)(ws + WS_ROWLIST));
        pg8::EpiSwiGLU8 E{ws + WS_R1 + R1_ACT, DEXP}; pg8::gemm_phase<pg8::EpiSwiGLU8, pg8::GatherOrder, true>(c.lds, g, S, E, 0x79797979);
#if defined(DUP_PHASE)
        if (DUP_PHASE == 23) { xcd_barrier(bar); pg8::Gemm g = pg8::mkgemm(ws + WS_H8, ws + WS_WGU + (size_t)NEXP * 1024 * D, MPAD, 1024, D / 2, (size_t)1024 * D); pg8::GatherOrder S; S.init((const int*)(ws + WS_CTL) + CW_PLAN + 512, 1024, c.nblk, c.bid, (const int*)(ws + WS_ROWLIST));
        pg8::EpiSwiGLU8 E{ws + WS_R1 + R1_ACT, DEXP}; pg8::gemm_phase<pg8::EpiSwiGLU8, pg8::GatherOrder, true>(c.lds, g, S, E, 0x79797979); }
#endif
    } SEAM(23);
    if (IN(24)) { pg8::Gemm g = pg8::mkgemm(ws + WS_R1 + R1_ACT, ws + WS_WD + (size_t)NEXP * D * DEXP, MPAD, D, DEXP / 2, (size_t)D * DEXP); pg8::GroupedOrder S; S.init((const int*)(ws + WS_CTL) + CW_PLAN + 512, D, c.nblk, c.bid);
        pg8::EpiBf16 E{(pg8::bf16_t*)(ws + WS_R1 + R1_Y), D}; pg8::gemm_phase<pg8::EpiBf16, pg8::GroupedOrder, true>(c.lds, g, S, E, 0x79797979);
#if defined(DUP_PHASE)
        if (DUP_PHASE == 24) { xcd_barrier(bar); pg8::Gemm g = pg8::mkgemm(ws + WS_R1 + R1_ACT, ws + WS_WD + (size_t)NEXP * D * DEXP, MPAD, D, DEXP / 2, (size_t)D * DEXP); pg8::GroupedOrder S; S.init((const int*)(ws + WS_CTL) + CW_PLAN + 512, D, c.nblk, c.bid);
        pg8::EpiBf16 E{(pg8::bf16_t*)(ws + WS_R1 + R1_Y), D}; pg8::gemm_phase<pg8::EpiBf16, pg8::GroupedOrder, true>(c.lds, g, S, E, 0x79797979); }
#endif
    } SEAM(24);
    if (IN(25)) {
#ifdef PROBE_MASK
        { const unsigned long long* ts = (const unsigned long long*)((unsigned*)(args.ws + WS_CTL) + CW_TS); const double tot = (double)(ts[25] - ts[0]); double acc = 0.0;
          for (int k = 0; k < 25; ++k) { if ((PROBE_MASK >> k) & 1ull) acc += (double)(ts[k + 1] - ts[k]); if ((PROBE_BARMASK >> k) & 1ull) acc += (double)(ts[k + 1] - ts[64 + k]); }
          g_probe_scale = 1.0f + 0.05f + 0.5f * (float)(acc / tot); }
#endif
        phase_ln_ffn(c, args, 1, true PROBE_PASS); }
#undef IN
#undef SEAM
}
constexpr int LAST_PHASE = 25;

extern "C" void kernel_launch(void* const* d_in, const int* in_sizes, int n_in, void* d_out, int out_size, void* d_ws, size_t ws_size, hipStream_t stream) {
    static int grid = 0;
    if (grid == 0) {
        if (n_in != 29 || ws_size < WS_END) { fprintf(stderr, "kernel_launch: expected 29 inputs and >= %zu bytes of workspace (got %d, %zu)\n", (size_t)WS_END, n_in, ws_size); grid = -1; return; }
        int dev = 0, cus = 0, per_cu = 0;
        if (hipGetDevice(&dev) != hipSuccess || hipDeviceGetAttribute(&cus, hipDeviceAttributeMultiprocessorCount, dev) != hipSuccess) { grid = -1; return; }
        if (hipFuncSetAttribute((const void*)fwd, hipFuncAttributeMaxDynamicSharedMemorySize, LDS_BYTES) != hipSuccess) { fprintf(stderr, "kernel_launch: hipFuncSetAttribute failed\n"); grid = -1; return; }
        if (hipOccupancyMaxActiveBlocksPerMultiprocessor(&per_cu, (const void*)fwd, NTHR, LDS_BYTES) != hipSuccess || per_cu < 1) fprintf(stderr, "kernel_launch: occupancy query says %d\n", per_cu);
        (void)hipGetLastError();
        grid = cus;
    }
    if (grid < 0) return;
    (void)hipMemsetAsync((char*)d_ws + WS_CTL, 0, CTL_BYTES, stream);
    Args a{};
    for (int i = 0; i < 29; ++i) a.in[i] = (const float*)d_in[i];
    a.out = (float*)d_out; a.ws = (unsigned char*)d_ws;
#ifndef MK_N_LAUNCHES
#define MK_N_LAUNCHES 1
#endif
    if (MK_N_LAUNCHES == 1) { a.ph_lo = 0; a.ph_hi = LAST_PHASE + 1; hipLaunchKernelGGL(fwd, dim3(grid), dim3(NTHR), LDS_BYTES, stream, a); }
    else for (int p = 0; p <= LAST_PHASE; ++p) {
        a.ph_lo = p; a.ph_hi = p + 1;
        hipLaunchKernelGGL(fwd, dim3(grid), dim3(NTHR), LDS_BYTES, stream, a);
    }
}
```

```cpp
#include <hip/hip_runtime.h>
#include <cstdio>
#include <cstdint>

namespace pg8 {
#define PG8_LAS __attribute__((address_space(3)))
typedef unsigned short bf16_t;
typedef short bf16x8 __attribute__((ext_vector_type(8)));
typedef float f32x4 __attribute__((ext_vector_type(4)));
typedef unsigned u32x4 __attribute__((ext_vector_type(4)));
constexpr int BM = 256, BK = 64, HALF = 128, HTB = HALF * BK * 2, STAGE_BYTES = 8 * HTB, NXCD = 8, WGM = 4;

__host__ __device__ __forceinline__ int lds_byte(int r, int c) { const int st = (r >> 4) * 2 + (c >> 5), rr = r & 15, cc = c & 31, ob = rr * 64 + cc * 2; return st * 1024 + (ob ^ (((ob >> 9) & 1) << 5)); }
__host__ __device__ __forceinline__ void stage_rc(int b, int& R, int& C) { const int st = b / 1024, sb = b % 1024, swz = sb ^ (((sb >> 9) & 1) << 5); R = (st >> 1) * 16 + swz / 64; C = (st & 1) * 32 + (swz % 64) / 2; }
__host__ __device__ __forceinline__ int perm32(int rho) { const int n = rho >> 4, i = rho & 15; return 8 * (i >> 2) + 4 * n + (i & 3); }

struct Unit { int pm, pn, eb; };
struct Gemm { const bf16_t* A; const bf16_t* Bt; int M, N, K, lda, ldb; size_t astride, bstride; };

struct StaticOrder {
    static constexpr bool GATHER = false;
    int nM, nN, nwg, G, c, pm_off, pn_off, gap_at, gap;
    __host__ __device__ __forceinline__ void init(int M, int N, int G_, int c_, int pm_off_ = 0, int pn_off_ = 0, int gap_at_ = 1 << 30, int gap_ = 0) { nM = M / BM; nN = N / BM; nwg = nM * nN; G = G_; c = c_; pm_off = pm_off_; pn_off = pn_off_; gap_at = gap_at_; gap = gap_; }
    __host__ __device__ __forceinline__ bool next(int i, Unit& u) const {
        const long L = (long)i * G + c; if (L >= nwg) return false;
        int wgid = (int)L; { const int q = nwg / NXCD, r = nwg % NXCD, xcd = wgid % NXCD, off = wgid / NXCD; wgid = (xcd < r ? xcd * (q + 1) : r * (q + 1) + (xcd - r) * q) + off; }
        const int nig = WGM * nN, gid = wgid / nig, fm = gid * WGM, gsz = (nM - fm) < WGM ? (nM - fm) : WGM;
        u.pm = fm + ((wgid % nig) % gsz) + pm_off; const int pn_ = (wgid % nig) / gsz; u.pn = pn_ + pn_off + (pn_ >= gap_at ? gap : 0); u.eb = 0; return true;
    }
    __device__ __forceinline__ void a_ready(const Unit&) const {}
    __device__ __forceinline__ void done(const Unit&) const {}
};
template <bool GATHER_> struct GroupedOrderT {
    static constexpr bool GATHER = GATHER_;
    int ntiles, nN, nwg, G, c; const int* tile_expert; const int* rowlist;
    __device__ __forceinline__ void init(const int* plan, int N, int G_, int c_, const int* rowlist_ = nullptr) { ntiles = plan[0]; tile_expert = plan + 128; nN = N / BM; nwg = ntiles * nN; G = G_; rowlist = rowlist_;
        c = (G_ % NXCD == 0) ? (c_ % NXCD) * (G_ / NXCD) + c_ / NXCD : c_; }
    __device__ __forceinline__ bool next(int i, Unit& u) const {
        const long L = (long)i * G + c; if (L >= nwg) return false;
        u.pm = (int)(L / nN); u.pn = (int)(L % nN); u.eb = tile_expert[u.pm]; return true;
    }
    __device__ __forceinline__ void a_ready(const Unit&) const {}
    __device__ __forceinline__ void done(const Unit&) const {}
};

typedef GroupedOrderT<false> GroupedOrder; typedef GroupedOrderT<true> GatherOrder;
struct GroupTileOrder {
    static constexpr bool GATHER = false;
    int nM, nN, nwg, G, c;
    __device__ __forceinline__ void init(int groups, int M, int N, int G_, int c_) { nM = M / BM; nN = N / BM; nwg = groups * nM * nN; G = G_; c = c_; }
    __device__ __forceinline__ bool next(int i, Unit& u) const {
        const long L = (long)i * G + c; if (L >= nwg) return false;
        const int per = nM * nN, rem = (int)(L % per); u.eb = (int)(L / per); u.pm = rem % nM; u.pn = rem / nM; return true;
    }
    __device__ __forceinline__ void a_ready(const Unit&) const {}
    __device__ __forceinline__ void done(const Unit&) const {}
};
__device__ __forceinline__ unsigned cvt_pk_bf16(float lo, float hi) { unsigned r; asm volatile("v_cvt_pk_bf16_f32 %0, %1, %2" : "=v"(r) : "v"(lo), "v"(hi)); return r; }

struct EpiF32 {
    static constexpr bool PERM = false, AFTER_DRAIN = false;
    float* C; int ldc; size_t cstride;
    __device__ __forceinline__ void operator()(const f32x4 (&acc)[2][2][4][2], const Unit& u, int wr, int wc, int fr, int fq) const {
        const int row0 = u.pm * BM + wr * 64 + fr, col0 = u.pn * BM + wc * 32 + 4 * fq;
#pragma unroll
        for (int ai = 0; ai < 2; ++ai)
#pragma unroll
            for (int m = 0; m < 4; ++m) { float* rowp = C + (size_t)u.eb * cstride + (size_t)(row0 + ai * HALF + m * 16) * ldc + col0;
#pragma unroll
                for (int bj = 0; bj < 2; ++bj)
#pragma unroll
                    for (int n = 0; n < 2; ++n) *(f32x4*)(rowp + bj * HALF + n * 16) = acc[ai][bj][m][n]; }
    }
};
struct EpiSwiGLU {
    static constexpr bool PERM = true, AFTER_DRAIN = false;
    bf16_t* O; int ldc;
    __device__ __forceinline__ void operator()(const f32x4 (&acc)[2][2][4][2], const Unit& u, int wr, int wc, int fr, int fq) const {
        const int row0 = u.pm * BM + wr * 64 + fr, col0 = u.pn * HALF + wc * 32 + 8 * fq;
#pragma unroll
        for (int ai = 0; ai < 2; ++ai)
#pragma unroll
            for (int m = 0; m < 4; ++m) { bf16_t* rowp = O + (size_t)(row0 + ai * HALF + m * 16) * ldc + col0;
                float r[8];
#pragma unroll
                for (int n = 0; n < 2; ++n)
#pragma unroll
                    for (int i = 0; i < 4; ++i) { const float g = acc[ai][0][m][n][i], up = acc[ai][1][m][n][i]; r[n * 4 + i] = g / (1.0f + __expf(-g)) * up; }
                u32x4 w; w.x = cvt_pk_bf16(r[0], r[1]); w.y = cvt_pk_bf16(r[2], r[3]); w.z = cvt_pk_bf16(r[4], r[5]); w.w = cvt_pk_bf16(r[6], r[7]);
                *(u32x4*)rowp = w; }
    }
};

struct EpiSwiGLU8 {
    static constexpr bool PERM = true, AFTER_DRAIN = false;
    unsigned char* O; int ldc;
    __device__ __forceinline__ void operator()(const f32x4 (&acc)[2][2][4][2], const Unit& u, int wr, int wc, int fr, int fq) const {
        typedef unsigned u32x2 __attribute__((ext_vector_type(2)));
        const int row0 = u.pm * BM + wr * 64 + fr, col0 = u.pn * HALF + wc * 32 + 8 * fq;
#pragma unroll
        for (int ai = 0; ai < 2; ++ai)
#pragma unroll
            for (int m = 0; m < 4; ++m) { unsigned char* rowp = O + (size_t)(row0 + ai * HALF + m * 16) * ldc + col0;
                float r[8];
#pragma unroll
                for (int n = 0; n < 2; ++n)
#pragma unroll
                    for (int i = 0; i < 4; ++i) { const float g = acc[ai][0][m][n][i], up = acc[ai][1][m][n][i]; r[n * 4 + i] = g / (1.0f + __expf(-g)) * up; }
                int w0 = 0, w1 = 0; w0 = __builtin_amdgcn_cvt_pk_fp8_f32(r[0], r[1], w0, false); w0 = __builtin_amdgcn_cvt_pk_fp8_f32(r[2], r[3], w0, true);
                w1 = __builtin_amdgcn_cvt_pk_fp8_f32(r[4], r[5], w1, false); w1 = __builtin_amdgcn_cvt_pk_fp8_f32(r[6], r[7], w1, true);
                *(u32x2*)rowp = (u32x2){(unsigned)w0, (unsigned)w1}; }
    }
};
__host__ __device__ __forceinline__ Gemm mkgemm(const void* A, const void* Bt, int M, int N, int K, size_t bstride = 0) { Gemm g; g.A = (const bf16_t*)A; g.Bt = (const bf16_t*)Bt; g.M = M; g.N = N; g.K = K; g.lda = K; g.ldb = K; g.astride = 0; g.bstride = bstride; return g; }
struct EpiS5Y {
    static constexpr bool PERM = false, AFTER_DRAIN = false;
    bf16_t* ZB;
    __device__ __forceinline__ void operator()(const f32x4 (&acc)[2][2][4][2], const Unit& u, int wr, int wc, int fr, int fq) const {
#pragma unroll
        for (int ai = 0; ai < 2; ++ai)
#pragma unroll
            for (int m = 0; m < 4; ++m) { const int chunk = u.pm * BM + ai * HALF + wr * 64 + m * 16 + fr;
                if (chunk <= 512) {
#pragma unroll
                    for (int bj = 0; bj < 2; ++bj)
#pragma unroll
                        for (int n = 0; n < 2; ++n) { const int t = 16 * u.pn + 8 * bj + 2 * wc + n, row = 224 + 32 * chunk + t; float z[4];
#pragma unroll
                            for (int i = 0; i < 4; ++i) { const float y = acc[ai][bj][m][n][i]; const float x2 = 1.5957691216057308f * (y + 0.044715f * y * y * y);
                                const float th = 1.0f - 2.0f / (1.0f + __expf(x2)); z[i] = 0.5f * y * (1.0f + th); }
                            typedef unsigned u32x2 __attribute__((ext_vector_type(2)));
                            u32x2 w; w.x = cvt_pk_bf16(z[0], z[1]); w.y = cvt_pk_bf16(z[2], z[3]);
                            *(u32x2*)(ZB + (size_t)row * 1024 + 16 * u.eb + 4 * fq) = w; } } }
    }
};
struct EpiGlu {
    static constexpr bool PERM = true, AFTER_DRAIN = false;
    const bf16_t* ZB; const float* bias; bf16_t* O;
    __device__ __forceinline__ void operator()(const f32x4 (&acc)[2][2][4][2], const Unit& u, int wr, int wc, int fr, int fq) const {
        const int row0 = u.pm * BM + wr * 64 + fr, col0 = u.pn * BM + wc * 32 + 8 * fq;
#pragma unroll
        for (int ai = 0; ai < 2; ++ai)
#pragma unroll
            for (int m = 0; m < 4; ++m) { const int row = row0 + ai * HALF + m * 16;
#pragma unroll
                for (int bj = 0; bj < 2; ++bj) { const int col = col0 + bj * HALF;
                    const u32x4 zw = *(const u32x4*)(ZB + (size_t)row * 1024 + col);
                    const f32x4 b0 = *(const f32x4*)(bias + col), b1 = *(const f32x4*)(bias + col + 4);
                    float r[8];
#pragma unroll
                    for (int i = 0; i < 4; ++i) { const unsigned zz = i < 2 ? (i == 0 ? zw.x : zw.y) : (i == 2 ? zw.z : zw.w);
                        const float z0 = __uint_as_float(zz << 16), z1 = __uint_as_float(zz & 0xffff0000u);
                        const int e0 = 2 * i, e1 = 2 * i + 1;
                        const float a0 = (e0 < 4 ? acc[ai][bj][m][0][e0] : acc[ai][bj][m][1][e0 - 4]) + (e0 < 4 ? b0[e0] : b1[e0 - 4]);
                        const float a1 = (e1 < 4 ? acc[ai][bj][m][0][e1] : acc[ai][bj][m][1][e1 - 4]) + (e1 < 4 ? b0[e1] : b1[e1 - 4]);
                        r[e0] = z0 / (1.0f + __expf(-a0)); r[e1] = z1 / (1.0f + __expf(-a1)); }
                    u32x4 w; w.x = cvt_pk_bf16(r[0], r[1]); w.y = cvt_pk_bf16(r[2], r[3]); w.z = cvt_pk_bf16(r[4], r[5]); w.w = cvt_pk_bf16(r[6], r[7]);
                    *(u32x4*)(O + (size_t)row * 2048 + 1024 + col) = w; } }
    }
};

struct EpiBf16 {
    static constexpr bool PERM = true, AFTER_DRAIN = false;
    bf16_t* O; int ldc;
    __device__ __forceinline__ void operator()(const f32x4 (&acc)[2][2][4][2], const Unit& u, int wr, int wc, int fr, int fq) const {
        const int row0 = u.pm * BM + wr * 64 + fr, col0 = u.pn * BM + wc * 32 + 8 * fq;
#pragma unroll
        for (int ai = 0; ai < 2; ++ai)
#pragma unroll
            for (int m = 0; m < 4; ++m) { bf16_t* rowp = O + (size_t)(row0 + ai * HALF + m * 16) * ldc + col0;
#pragma unroll
                for (int bj = 0; bj < 2; ++bj) { const f32x4 v0 = acc[ai][bj][m][0], v1 = acc[ai][bj][m][1];
                    u32x4 w; w.x = cvt_pk_bf16(v0[0], v0[1]); w.y = cvt_pk_bf16(v0[2], v0[3]); w.z = cvt_pk_bf16(v1[0], v1[1]); w.w = cvt_pk_bf16(v1[2], v1[3]);
                    *(u32x4*)(rowp + bj * HALF) = w; } }
    }
};
struct EpiNull { static constexpr bool PERM = true, AFTER_DRAIN = false; float* sink;
    __device__ __forceinline__ void operator()(const f32x4 (&acc)[2][2][4][2], const Unit& u, int wr, int wc, int fr, int fq) const {
        float t = 0.f;
#pragma unroll
        for (int ai = 0; ai < 2; ++ai)
#pragma unroll
            for (int bj = 0; bj < 2; ++bj)
#pragma unroll
                for (int m = 0; m < 4; ++m)
#pragma unroll
                    for (int n = 0; n < 2; ++n) t += acc[ai][bj][m][n][0] + acc[ai][bj][m][n][1] + acc[ai][bj][m][n][2] + acc[ai][bj][m][n][3];
        if (t == 123.456f) sink[0] = t; } };
#ifndef PG8_SP2
#define PG8_SP2 1
#endif
template <class Epi, class Sched, bool FP8 = false>
__device__ __forceinline__ void gemm_phase(PG8_LAS unsigned char* lds, const Gemm g, const Sched& S, const Epi& E, int scale_w = 0x7f7f7f7f) {
    const int tid = threadIdx.x, wid = __builtin_amdgcn_readfirstlane(tid >> 6), lane = tid & 63, wr = wid >> 2, wc = wid & 3, fr = lane & 15, fq = lane >> 4;
    const int K = g.K, nt = K / BK;
    unsigned voffA[2], voffB[2]; int stR[2], stC[2];
#pragma unroll
    for (int i = 0; i < 2; ++i) { int R, C; stage_rc(tid * 16 + i * 8192, R, C); const int Rb = Epi::PERM ? ((R & ~31) + perm32(R & 31)) : R;
        voffA[i] = (unsigned)(R * g.lda + C) * 2u; voffB[i] = (unsigned)(Rb * g.ldb + C) * 2u; stR[i] = R; stC[i] = C; }
    const size_t kstep = (size_t)(BK * 2);
    const size_t hstepA = (size_t)HALF * g.lda * 2, hstepB = (size_t)HALF * g.ldb * 2;
    const size_t tstepA = 2 * hstepA, tstepB = 2 * hstepB;
    const unsigned ldsw = (unsigned)wid * 1024u;
    const int aoff = lds_byte(wr * 64 + fr, fq * 8), boff = lds_byte(wc * 32 + fr, fq * 8);
#define PG8_SA(b, h) (((b) * 2 + (h)) * HTB)
#define PG8_SB(b, h) ((4 + (b) * 2 + (h)) * HTB)
#define PG8_STAGE(bufoff, gbase, voff) do { _Pragma("unroll") for (int _i = 0; _i < 2; ++_i) \
        __builtin_amdgcn_global_load_lds((const unsigned*)((const char*)(gbase) + (voff)[_i]), (PG8_LAS unsigned*)(lds + (bufoff) + ldsw + _i * 8192), 16, 0, 0); } while (0)
#define PG8_LD8(base_) __builtin_shufflevector(*(const PG8_LAS v4i_t*)(base_), *(const PG8_LAS v4i_t*)((base_) + 1024), 0, 1, 2, 3, 4, 5, 6, 7)
#define PG8_LDA(dst, b, h) do { if constexpr (FP8) { _Pragma("unroll") for (int m = 0; m < 4; ++m) dst##8[m] = PG8_LD8(lds + PG8_SA(b, h) + aoff + m * 2048); } \
        else { _Pragma("unroll") for (int m = 0; m < 4; ++m) _Pragma("unroll") for (int k = 0; k < 2; ++k) dst[m][k] = *(const PG8_LAS bf16x8*)(lds + PG8_SA(b, h) + aoff + m * 2048 + k * 1024); } } while (0)
#define PG8_LDB(dst, b, h) do { if constexpr (FP8) { _Pragma("unroll") for (int n = 0; n < 2; ++n) dst##8[n] = PG8_LD8(lds + PG8_SB(b, h) + boff + n * 2048); } \
        else { _Pragma("unroll") for (int n = 0; n < 2; ++n) _Pragma("unroll") for (int k = 0; k < 2; ++k) dst[n][k] = *(const PG8_LAS bf16x8*)(lds + PG8_SB(b, h) + boff + n * 2048 + k * 1024); } } while (0)
#define PG8_MMA(ai, bj, At, Bt) do { __builtin_amdgcn_s_setprio(1); _Pragma("unroll") for (int m = 0; m < 4; ++m) _Pragma("unroll") for (int n = 0; n < 2; ++n) { \
        if constexpr (FP8) asm volatile("v_mfma_scale_f32_16x16x128_f8f6f4 %0, %1, %2, %0, %3, %4 op_sel_hi:[0,0,0]" : "+v"(acc[ai][bj][m][n]) : "v"(Bt##8[n]), "v"(At##8[m]), "v"(scw_), "v"(sca_)); \
        else { _Pragma("unroll") for (int k = 0; k < 2; ++k) acc[ai][bj][m][n] = __builtin_amdgcn_mfma_f32_16x16x32_bf16(Bt[n][k], At[m][k], acc[ai][bj][m][n], 0, 0, 0); } } \
        __builtin_amdgcn_s_setprio(0); } while (0)
#define PG8_WAIT_V(n) asm volatile("s_waitcnt vmcnt(" #n ")" ::: "memory")
#define PG8_WAIT_L(n) asm volatile("s_waitcnt lgkmcnt(" #n ")" ::: "memory")
#define PG8_BAR __builtin_amdgcn_s_barrier()
#define PG8_SCHED __builtin_amdgcn_sched_barrier(0)
    unsigned vC[2][2], vN[2][2];
#define PG8_AOFF(dst, unit) do { _Pragma("unroll") for (int h_ = 0; h_ < 2; ++h_) _Pragma("unroll") for (int i_ = 0; i_ < 2; ++i_) { \
        if constexpr (Sched::GATHER) { const int row_ = S.rowlist[(unit).pm * BM + h_ * HALF + stR[i_]]; dst[h_][i_] = (unsigned)(row_ * g.lda + stC[i_]) * 2u; } \
        else dst[h_][i_] = voffA[i_] + (unsigned)(h_ * hstepA); } } while (0)
    Unit cur, nxt; int ui = 0;
    if (!S.next(0, cur)) return;
    f32x4 acc[2][2][4][2];
#pragma unroll
    for (int a = 0; a < 2; ++a)
#pragma unroll
        for (int b = 0; b < 2; ++b)
#pragma unroll
            for (int m = 0; m < 4; ++m)
#pragma unroll
                for (int n = 0; n < 2; ++n) acc[a][b][m][n] = (f32x4){0.f, 0.f, 0.f, 0.f};
    typedef int v8i_t __attribute__((ext_vector_type(8))); typedef int v4i_t __attribute__((ext_vector_type(4)));
    const int scw_ = scale_w, sca_ = 0x7f7f7f7f;
    bf16x8 At[4][2], B0[2][2], B1[2][2]; v8i_t At8[4], B08[2], B18[2];
    const char* cA = (const char*)g.A + (size_t)cur.eb * g.astride + (Sched::GATHER ? (size_t)0 : (size_t)cur.pm * tstepA); const char* cB = (const char*)g.Bt + (size_t)cur.eb * g.bstride + (size_t)cur.pn * tstepB;
    PG8_AOFF(vC, cur);
    S.a_ready(cur);
#if PG8_SP2
    PG8_STAGE(PG8_SB(0, 0), cB, voffB); PG8_STAGE(PG8_SB(0, 1), cB + hstepB, voffB); PG8_STAGE(PG8_SA(0, 0), cA, vC[0]); PG8_STAGE(PG8_SA(0, 1), cA, vC[1]);
    if (wr == 1) PG8_BAR;
    PG8_WAIT_V(2); PG8_BAR;
    PG8_STAGE(PG8_SB(1, 0), cB + kstep, voffB); PG8_STAGE(PG8_SA(1, 0), cA + kstep, vC[0]); PG8_STAGE(PG8_SB(1, 1), cB + hstepB + kstep, voffB);
    PG8_WAIT_V(6); PG8_BAR;
#else
    PG8_STAGE(PG8_SB(0, 0), cB, voffB); PG8_STAGE(PG8_SA(0, 0), cA, vC[0]); PG8_STAGE(PG8_SB(0, 1), cB + hstepB, voffB); PG8_STAGE(PG8_SA(0, 1), cA, vC[1]);
    if (wr == 1) PG8_BAR;
    PG8_WAIT_V(4); PG8_BAR;
    PG8_STAGE(PG8_SB(1, 0), cB + kstep, voffB); PG8_STAGE(PG8_SA(1, 0), cA + kstep, vC[0]); PG8_STAGE(PG8_SB(1, 1), cB + hstepB + kstep, voffB);
    PG8_WAIT_V(6); PG8_BAR;
#endif
    for (;;) {
        const bool has_next = S.next(ui + 1, nxt);
        const char* nA = has_next ? (const char*)g.A + (size_t)nxt.eb * g.astride + (Sched::GATHER ? (size_t)0 : (size_t)nxt.pm * tstepA) : cA;
        if constexpr (Sched::GATHER) { if (has_next) PG8_AOFF(vN, nxt); else { _Pragma("unroll") for (int h_ = 0; h_ < 2; ++h_) _Pragma("unroll") for (int i_ = 0; i_ < 2; ++i_) vN[h_][i_] = vC[h_][i_]; } }
        const char* nB = has_next ? (const char*)g.Bt + (size_t)nxt.eb * g.bstride + (size_t)nxt.pn * tstepB : cB;
        for (int t = 0; t < nt; t += 2) {
            const bool last = (t == nt - 2);
            const char* a1 = cA + (size_t)(t + 1) * kstep;
            const char* a2 = last ? nA : cA + (size_t)(t + 2) * kstep; const char* b2 = last ? nB : cB + (size_t)(t + 2) * kstep;
            const char* a3 = a2 + kstep; const char* b3 = b2 + kstep;
            if (last && has_next) S.a_ready(nxt);
            unsigned vs0[2], vs1[2];
            if constexpr (Sched::GATHER) { vs0[0] = last ? vN[0][0] : vC[0][0]; vs0[1] = last ? vN[0][1] : vC[0][1]; vs1[0] = last ? vN[1][0] : vC[1][0]; vs1[1] = last ? vN[1][1] : vC[1][1]; }
            else { vs0[0] = vC[0][0]; vs0[1] = vC[0][1]; vs1[0] = vC[1][0]; vs1[1] = vC[1][1]; }
#if PG8_SP2
            PG8_LDB(B0, 0, 0); PG8_LDB(B1, 0, 1); PG8_SCHED; PG8_LDA(At, 0, 0); PG8_STAGE(PG8_SA(1, 1), a1, vC[1]);
            PG8_WAIT_V(8); PG8_WAIT_L(0); PG8_BAR; PG8_MMA(0, 0, At, B0); PG8_MMA(0, 1, At, B1); PG8_BAR; PG8_SCHED;
            PG8_LDA(At, 0, 1); PG8_STAGE(PG8_SB(0, 0), b2, voffB); PG8_STAGE(PG8_SB(0, 1), b2 + hstepB, voffB); PG8_STAGE(PG8_SA(0, 0), a2, vs0);
            PG8_WAIT_V(8); PG8_WAIT_L(0); PG8_BAR; PG8_MMA(1, 0, At, B0); PG8_MMA(1, 1, At, B1); PG8_BAR; PG8_SCHED;
            PG8_LDB(B0, 1, 0); PG8_LDB(B1, 1, 1); PG8_SCHED; PG8_LDA(At, 1, 0); PG8_STAGE(PG8_SA(0, 1), a2, vs1);
            PG8_WAIT_V(8); PG8_WAIT_L(0); PG8_BAR; PG8_MMA(0, 0, At, B0); PG8_MMA(0, 1, At, B1); PG8_BAR; PG8_SCHED;
            PG8_LDA(At, 1, 1); PG8_STAGE(PG8_SB(1, 0), b3, voffB); PG8_STAGE(PG8_SB(1, 1), b3 + hstepB, voffB); PG8_STAGE(PG8_SA(1, 0), a3, vs0);
            PG8_WAIT_V(8); PG8_WAIT_L(0); PG8_BAR; PG8_MMA(1, 0, At, B0); PG8_MMA(1, 1, At, B1); PG8_BAR; PG8_SCHED;
#else
            PG8_LDB(B0, 0, 0); PG8_SCHED; PG8_LDA(At, 0, 0); PG8_STAGE(PG8_SA(1, 1), a1, vC[1]);
            PG8_WAIT_L(8); PG8_BAR; PG8_WAIT_L(0); PG8_MMA(0, 0, At, B0); PG8_BAR; PG8_SCHED;
            PG8_LDB(B1, 0, 1); PG8_STAGE(PG8_SB(0, 0), b2, voffB);
            PG8_BAR; PG8_WAIT_L(0); PG8_MMA(0, 1, At, B1); PG8_BAR;
            PG8_LDA(At, 0, 1); PG8_STAGE(PG8_SA(0, 0), a2, vs0);
            PG8_BAR; PG8_WAIT_L(0); PG8_MMA(1, 0, At, B0); PG8_BAR; PG8_SCHED;
            PG8_STAGE(PG8_SB(0, 1), b2 + hstepB, voffB);
            PG8_WAIT_V(6); PG8_BAR; PG8_MMA(1, 1, At, B1); PG8_BAR;
            PG8_LDB(B0, 1, 0); PG8_SCHED; PG8_LDA(At, 1, 0); PG8_STAGE(PG8_SA(0, 1), a2, vs1);
            PG8_WAIT_L(8); PG8_BAR; PG8_WAIT_L(0); PG8_MMA(0, 0, At, B0); PG8_BAR; PG8_SCHED;
            PG8_LDB(B1, 1, 1); PG8_STAGE(PG8_SB(1, 0), b3, voffB);
            PG8_BAR; PG8_WAIT_L(0); PG8_MMA(0, 1, At, B1); PG8_BAR;
            PG8_LDA(At, 1, 1); PG8_STAGE(PG8_SA(1, 0), a3, vs0);
            PG8_BAR; PG8_WAIT_L(0); PG8_MMA(1, 0, At, B0); PG8_BAR; PG8_SCHED;
            PG8_STAGE(PG8_SB(1, 1), b3 + hstepB, voffB);
            PG8_WAIT_V(6); PG8_BAR; PG8_MMA(1, 1, At, B1); PG8_BAR;
#endif
        }
        if constexpr (FP8) asm volatile("s_nop 15\n\ts_nop 15" ::: "memory");
        if (wr == 0) PG8_BAR;
        E(acc, cur, wr, wc, fr, fq); S.done(cur);
        if (!has_next) break;
#pragma unroll
        for (int a = 0; a < 2; ++a)
#pragma unroll
            for (int b = 0; b < 2; ++b)
#pragma unroll
                for (int m = 0; m < 4; ++m)
#pragma unroll
                    for (int n = 0; n < 2; ++n) acc[a][b][m][n] = (f32x4){0.f, 0.f, 0.f, 0.f};
        cur = nxt; cA = nA; cB = nB; ++ui;
        if constexpr (Sched::GATHER) {
#pragma unroll
            for (int h_ = 0; h_ < 2; ++h_)
#pragma unroll
                for (int i_ = 0; i_ < 2; ++i_) vC[h_][i_] = vN[h_][i_]; }
        if (wr == 1) PG8_BAR;
    }
    PG8_WAIT_V(0);
    PG8_BAR;
#undef PG8_AOFF
#undef PG8_SA
#undef PG8_SB
#undef PG8_STAGE
#undef PG8_LDA
#undef PG8_LD8
#undef PG8_LDB
#undef PG8_MMA
#undef PG8_WAIT_V
#undef PG8_WAIT_L
#undef PG8_BAR
#undef PG8_SCHED
}
}

constexpr int D = 2048, SEQ = 16384, NMETA = 16;
constexpr int LP = 16640;
constexpr int ROWV = 240;
constexpr int NVALID = 16400;
constexpr int ABN = 2560, CN = 10240;
constexpr int NEXP = 64, DEXP = 512;
constexpr int MAXTILES = 192, MPAD = MAXTILES * 256;
constexpr float DN_ALPHA = 1.4142135623730951f;
constexpr float LN_EPS = 1e-5f;
constexpr int NWAVES = 8, NTHR = 512;

constexpr size_t al(size_t x) { return (x + 0xFFFFFull) & ~(size_t)0xFFFFFull; }
constexpr size_t WS_CTL = 0, CTL_BYTES = 1u << 20;
constexpr size_t WS_WAB = al(WS_CTL + CTL_BYTES);
constexpr size_t WS_WOAB = al(WS_WAB + (size_t)ABN * D * 2);
constexpr size_t WS_WGLU = al(WS_WOAB + (size_t)D * D * 2);
constexpr size_t WS_WC = al(WS_WGLU + (size_t)1024 * 1024 * 2);
constexpr size_t WS_WOC = al(WS_WC + (size_t)CN * D * 2);
constexpr size_t WS_WGU = al(WS_WOC + (size_t)D * D * 2);
constexpr size_t WS_WD = al(WS_WGU + (size_t)2 * NEXP * 1024 * D * 2);
constexpr size_t WS_HA = al(WS_WD + (size_t)2 * NEXP * D * DEXP * 2);
constexpr size_t WS_HB = al(WS_HA + (size_t)LP * D * 4);
constexpr size_t WS_WC8 = WS_HB;
constexpr size_t WS_H8 = WS_HA;
constexpr size_t WS_HBF = al(WS_HB + (size_t)LP * D * 4);
constexpr size_t WS_PROJ0 = al(WS_HBF + (size_t)LP * D * 2);
constexpr size_t WS_QB0 = WS_PROJ0;
constexpr size_t WS_KB0 = al(WS_QB0 + (size_t)LP * 1024 * 2);
constexpr size_t WS_VB0 = al(WS_KB0 + (size_t)LP * 256 * 2);
constexpr size_t WS_MIXIN = al(WS_VB0 + (size_t)LP * 256 * 2);
constexpr size_t WS_MIX = al(WS_MIXIN + (size_t)LP * D * 2);
constexpr size_t WS_Z = al(WS_MIX + (size_t)LP * D * 4);
constexpr size_t WS_ZB = al(WS_Z + (size_t)LP * 1024 * 4);
constexpr size_t WS_GLU = al(WS_ZB + (size_t)LP * 1024 * 2);
constexpr size_t WS_S5P = al(WS_GLU + (size_t)LP * 1024 * 4);
constexpr size_t WS_APOW = al(WS_S5P + (size_t)(2 * 64 * 64 * 8 + 2 * 64 * 64 * 16 * 8));
constexpr size_t WS_KTAB = al(WS_APOW + (size_t)2 * 64 * 64 * 33 * 8);
constexpr size_t WS_MWT = al(WS_KTAB + (size_t)2 * 64 * 32 * 256 * 4);
constexpr size_t WS_WST = al(WS_MWT + (size_t)64 * 512 * 768 * 2);
constexpr size_t WS_ROPE = al(WS_WST + (size_t)64 * 256 * 512 * 2);
constexpr size_t WS_WRT = al(WS_ROPE + (size_t)LP * 64 * 8);
constexpr size_t WS_WRH = al(WS_WRT + (size_t)2 * 96 * 2048 * 4);
constexpr size_t WS_WRL = al(WS_WRH + (size_t)2 * 96 * 2048 * 2);
constexpr size_t WS_LBT = al(WS_WRL + (size_t)2 * 96 * 2048 * 2);
constexpr size_t WS_ROUTE = al(WS_LBT + (size_t)2048 * 4);
constexpr size_t WS_ROWLIST = al(WS_ROUTE + (size_t)LP * 32);
constexpr size_t WS_R1 = al(WS_ROWLIST + (size_t)MPAD * 4);
constexpr size_t R1_BYTES = (size_t)1200 << 20;
constexpr size_t WS_END = WS_R1 + R1_BYTES;
constexpr size_t R1_UA = 0;
constexpr size_t R1_SALL = al((size_t)64 * 768 * 768 * 2);
constexpr size_t R1_QB = 0;
constexpr size_t R1_VB = al(R1_QB + (size_t)LP * D * 2);
constexpr size_t R1_GB = al(R1_VB + (size_t)LP * D * 2);
constexpr size_t R1_F = al(R1_GB + (size_t)LP * D * 2);
constexpr size_t R1_OBW = al(R1_F + (size_t)LP * 4096 * 4);
constexpr size_t R1_DS = al(R1_OBW + (size_t)LP * D * 2);
constexpr size_t R1_DSEG = al(R1_DS + (size_t)32 * 32 * 16384 * 4);
constexpr size_t IMG_SZ = 18432 + 2 * 54272;
constexpr size_t R1_IMG = al(R1_DSEG + (size_t)32 * 32 * 128 * 4);
constexpr size_t R1_GT = al(R1_IMG + (size_t)260 * 16 * IMG_SZ);
constexpr size_t R1_HG_END = R1_GT + (size_t)260 * 16 * 16384;
constexpr size_t R1_XSRT = 0;
constexpr size_t R1_ACT = al((size_t)MPAD * D * 2);
constexpr size_t R1_Y = al(R1_ACT + (size_t)MPAD * DEXP * 2);
constexpr size_t R1_MOE_END = R1_Y + (size_t)MPAD * D * 2;
static_assert(R1_HG_END <= R1_BYTES && R1_MOE_END <= R1_BYTES, "R1 overlays");
static_assert(WS_END <= (size_t)4 << 30, "workspace map must fit 4 GiB");
constexpr int CW_BAR = 4096;
constexpr int CW_CNT = 16384;
constexpr int CW_TS = 65536;
constexpr int CW_PLAN = 32768;

namespace pg8 {
struct EpiProjC {
    static constexpr bool PERM = true, AFTER_DRAIN = false;
    unsigned char* R1; const float* lbt;
    __device__ __forceinline__ void operator()(const f32x4 (&acc)[2][2][4][2], const Unit& u, int wr, int wc, int fr, int fq) const {
        bf16_t* F = (bf16_t*)(R1 + R1_F);
        const int row0 = u.pm * BM + wr * 64 + fr, col0 = u.pn * BM + wc * 32 + 8 * fq;
        const int kind = u.pn < 8 ? 0 : (u.pn < 16 ? 1 : (u.pn < 32 ? 2 : 3));
        if (kind == 2) {
#pragma unroll
            for (int bj = 0; bj < 2; ++bj) { const int col = col0 + bj * HALF - 4096; const f32x4 l0 = *(const f32x4*)(lbt + (col & 2047)), l1 = *(const f32x4*)(lbt + (col & 2047) + 4);
#pragma unroll
                for (int ai = 0; ai < 2; ++ai)
#pragma unroll
                    for (int m = 0; m < 4; ++m) { bf16_t* rowp = F + (size_t)(row0 + ai * HALF + m * 16) * 4096 + col; f32x4 v0 = acc[ai][bj][m][0], v1 = acc[ai][bj][m][1];
#pragma unroll
                        for (int i = 0; i < 4; ++i) { v0[i] = (1.0f - l0[i]) / (1.0f + __expf(v0[i])); v1[i] = (1.0f - l1[i]) / (1.0f + __expf(v1[i])); }
                        u32x4 w; w.x = cvt_pk_bf16(v0[0], v0[1]); w.y = cvt_pk_bf16(v0[2], v0[3]); w.z = cvt_pk_bf16(v1[0], v1[1]); w.w = cvt_pk_bf16(v1[2], v1[3]);
                        *(u32x4*)rowp = w; } }
        } else {
            const size_t ob = kind == 0 ? R1_QB : (kind == 1 ? R1_VB : R1_GB); bf16_t* O = (bf16_t*)(R1 + ob); const int cbase = kind == 0 ? 0 : (kind == 1 ? 2048 : 8192);
#pragma unroll
            for (int ai = 0; ai < 2; ++ai)
#pragma unroll
                for (int m = 0; m < 4; ++m) { bf16_t* rowp = O + (size_t)(row0 + ai * HALF + m * 16) * 2048 + col0 - cbase;
#pragma unroll
                    for (int bj = 0; bj < 2; ++bj) { f32x4 v0 = acc[ai][bj][m][0], v1 = acc[ai][bj][m][1];
                        if (kind == 3) {
#pragma unroll
                            for (int i = 0; i < 4; ++i) { v0[i] = 1.0f / (1.0f + __expf(-v0[i])); v1[i] = 1.0f / (1.0f + __expf(-v1[i])); } }
                        u32x4 w; w.x = cvt_pk_bf16(v0[0], v0[1]); w.y = cvt_pk_bf16(v0[2], v0[3]); w.z = cvt_pk_bf16(v1[0], v1[1]); w.w = cvt_pk_bf16(v1[2], v1[3]);
                        *(u32x4*)(rowp + bj * HALF) = w; } }
        }
    }
};
}

namespace pg8 {
struct EpiProjAB {
    static constexpr bool PERM = false, AFTER_DRAIN = false;
    unsigned char* ws;
    __device__ __forceinline__ void operator()(const f32x4 (&acc)[2][2][4][2], const Unit& u, int wr, int wc, int fr, int fq) const {
        typedef unsigned u32x2 __attribute__((ext_vector_type(2)));
        const int row0 = u.pm * BM + wr * 64 + fr;
        if (u.pn < 5) {
            const float* rope = (const float*)(ws + WS_ROPE); const int d0 = 16 * wc + 4 * fq;
#pragma unroll
            for (int ai = 0; ai < 2; ++ai)
#pragma unroll
                for (int m = 0; m < 4; ++m) { const int row = row0 + ai * HALF + m * 16; const f32x4 cs0 = *(const f32x4*)(rope + ((size_t)row * 64 + d0) * 2), cs1 = *(const f32x4*)(rope + ((size_t)row * 64 + d0) * 2 + 4);
                    const float cc[4] = {cs0[0], cs0[2], cs1[0], cs1[2]}, sn[4] = {cs0[1], cs0[3], cs1[1], cs1[3]};
#pragma unroll
                    for (int bj = 0; bj < 2; ++bj) { const f32x4 x1 = acc[ai][bj][m][0], x2 = acc[ai][bj][m][1]; float o1[4], o2[4];
#pragma unroll
                        for (int i = 0; i < 4; ++i) { o1[i] = x1[i] * cc[i] - x2[i] * sn[i]; o2[i] = x2[i] * cc[i] + x1[i] * sn[i]; }
                        bf16_t* dst = u.pn < 4 ? (bf16_t*)(ws + WS_QB0) + (size_t)row * 1024 + (2 * u.pn + bj) * 128 + d0 : (bf16_t*)(ws + WS_KB0) + (size_t)row * 256 + bj * 128 + d0;
                        u32x2 w1, w2; w1.x = cvt_pk_bf16(o1[0], o1[1]); w1.y = cvt_pk_bf16(o1[2], o1[3]); w2.x = cvt_pk_bf16(o2[0], o2[1]); w2.y = cvt_pk_bf16(o2[2], o2[3]);
                        *(u32x2*)dst = w1; *(u32x2*)(dst + 64) = w2; } }
        } else if (u.pn == 5) {
            const int col0 = wc * 32 + 4 * fq;
#pragma unroll
            for (int ai = 0; ai < 2; ++ai)
#pragma unroll
                for (int m = 0; m < 4; ++m) { bf16_t* rowp = (bf16_t*)(ws + WS_VB0) + (size_t)(row0 + ai * HALF + m * 16) * 256 + col0;
#pragma unroll
                    for (int bj = 0; bj < 2; ++bj)
#pragma unroll
                        for (int n = 0; n < 2; ++n) { const f32x4 v = acc[ai][bj][m][n]; u32x2 w; w.x = cvt_pk_bf16(v[0], v[1]); w.y = cvt_pk_bf16(v[2], v[3]); *(u32x2*)(rowp + bj * HALF + n * 16) = w; } }
        } else {
            bf16_t* UA = (bf16_t*)(ws + WS_R1 + R1_UA); const int col0 = u.pn * BM + wc * 32 + 4 * fq;
#pragma unroll
            for (int ai = 0; ai < 2; ++ai)
#pragma unroll
                for (int m = 0; m < 4; ++m) { const int row = row0 + ai * HALF + m * 16;
                    if (row >= 224) { const int chunk = (row - 224) >> 5, t = (row - 224) & 31;
#pragma unroll
                        for (int bj = 0; bj < 2; ++bj)
#pragma unroll
                            for (int n = 0; n < 2; ++n) { const int ch = col0 + bj * HALF + n * 16 - 1536, g = ch >> 4, cc = ch & 15; const f32x4 v = acc[ai][bj][m][n];
                                u32x2 w; w.x = cvt_pk_bf16(v[0], v[1]); w.y = cvt_pk_bf16(v[2], v[3]);
                                *(u32x2*)(UA + ((size_t)g * 768 + chunk) * 768 + t * 16 + cc) = w; } } }
        }
    }
};
}

#define LAS __attribute__((address_space(3)))
typedef unsigned short bf16;
typedef unsigned v4u __attribute__((ext_vector_type(4)));
typedef unsigned v2u __attribute__((ext_vector_type(2)));
typedef float f32x4 __attribute__((ext_vector_type(4)));
#define LDS_WAIT() asm volatile("s_waitcnt lgkmcnt(0)" ::: "memory")
__device__ __forceinline__ unsigned f2bf(float f) { unsigned u = __builtin_bit_cast(unsigned, f); return (u + 0x7fffu + ((u >> 16) & 1u)) >> 16; }
__device__ __forceinline__ unsigned pk2(float lo, float hi) { return f2bf(lo) | (f2bf(hi) << 16); }
typedef __bf16 bf16x2_t __attribute__((ext_vector_type(2)));
__device__ __forceinline__ unsigned pkbf(float lo, float hi) { bf16x2_t v = {(__bf16)lo, (__bf16)hi}; return __builtin_bit_cast(unsigned, v); }
__device__ __forceinline__ float wave_sum(float v) {
#pragma unroll
    for (int o = 1; o < 64; o <<= 1) v += __shfl_xor(v, o);
    return v;
}
__device__ __forceinline__ float wave_max(float v) {
#pragma unroll
    for (int o = 1; o < 64; o <<= 1) v = fmaxf(v, __shfl_xor(v, o));
    return v;
}
__device__ __forceinline__ float sigmoidf_(float x) { return 1.0f / (1.0f + expf(-x)); }

#define XB_TMO      128
#define XB_XCNT(j)  (256  + 64 * (j))
#define XB_XSUB(j)  (1280 + 64 * (j))
#define XB_XGEN(j)  (2304 + 64 * (j))
#define XB_TOP      3328
#define XB_TOPGEN   3392
#define XCD_BAR_WORDS 3456
#define XB_SPIN_CAP (1u << 22)
__device__ __forceinline__ unsigned xb_ld(unsigned* p)              { return __hip_atomic_load(p, __ATOMIC_RELAXED, __HIP_MEMORY_SCOPE_AGENT); }
__device__ __forceinline__ unsigned xb_add(unsigned* p, unsigned v) { return __hip_atomic_fetch_add(p, v, __ATOMIC_RELAXED, __HIP_MEMORY_SCOPE_AGENT); }
__device__ __forceinline__ unsigned xb_xcc_id() { return (unsigned)__builtin_amdgcn_s_getreg((3 << 11) | 20) & 0xFu; }
#define XB_SPIN(cond, bar) do { unsigned _sp = 0; while (cond) { __builtin_amdgcn_s_sleep(1); \
    if ((++_sp & 255u) == 0u) { if (xb_ld(&(bar)[XB_TMO])) break; if (_sp > XB_SPIN_CAP) { atomicAdd(&(bar)[XB_TMO], 1u); break; } } } } while (0)
struct XcdBarrier { unsigned* bar; unsigned x; volatile LAS unsigned* st; };
__device__ __forceinline__ XcdBarrier xcd_barrier_post(unsigned* bar, volatile LAS unsigned* st) {
    XcdBarrier b; b.bar = bar; b.x = xb_xcc_id(); b.st = st;
    if (threadIdx.x == 0) (void)xb_add(&bar[XB_XCNT(b.x)], 1u);
    return b;
}
__device__ __forceinline__ void xcd_barrier_complete(unsigned* bar, unsigned x, unsigned& nloc, unsigned& nx) {
    const unsigned G = gridDim.x * gridDim.y * gridDim.z;
    unsigned sum, cnt, mine, sp = 0u;
    for (;;) {
        sum = 0u; cnt = 0u; mine = 0u;
#pragma unroll
        for (unsigned j = 0; j < 16; ++j) { const unsigned c = xb_ld(&bar[XB_XCNT(j)]); sum += c; cnt += (c > 0u) ? 1u : 0u; mine = (j == x) ? c : mine; }
        if (sum == G) break;
        __builtin_amdgcn_s_sleep(1);
        if ((++sp & 255u) == 0u) { if (xb_ld(&bar[XB_TMO])) break; if (sp > XB_SPIN_CAP) { atomicAdd(&bar[XB_TMO], 1u); break; } }
    }
    nloc = mine > 0u ? mine : 1u; nx = cnt > 0u ? cnt : 1u;
}
__device__ __forceinline__ void xcd_barrier(const XcdBarrier& b) {
    asm volatile("s_waitcnt vmcnt(0)" ::: "memory");
    __syncthreads();
    if (threadIdx.x == 0) {
        unsigned* bar = b.bar;
        __builtin_amdgcn_s_waitcnt(0);
        unsigned nloc = b.st[0], nx = b.st[1];
        if (nloc == 0u) { xcd_barrier_complete(bar, b.x, nloc, nx); b.st[0] = nloc; b.st[1] = nx; }
        const unsigned old = xb_add(&bar[XB_XSUB(b.x)], 1u);
        const unsigned gen = old / nloc;
        if (old + 1u == (gen + 1u) * nloc) {
            __builtin_amdgcn_fence(__ATOMIC_RELEASE, "agent");
            asm volatile("s_waitcnt vmcnt(0)" ::: "memory");
            const unsigned og = xb_add(&bar[XB_TOP], 1u);
            const unsigned tg = og / nx;
            if (og + 1u == (tg + 1u) * nx) xb_add(&bar[XB_TOPGEN], 1u);
            else XB_SPIN(xb_ld(&bar[XB_TOPGEN]) == tg, bar);
            __builtin_amdgcn_fence(__ATOMIC_ACQUIRE, "agent");
            xb_add(&bar[XB_XGEN(b.x)], 1u);
            asm volatile("s_waitcnt vmcnt(0)" ::: "memory");
        } else {
            XB_SPIN(xb_ld(&bar[XB_XGEN(b.x)]) == gen, bar);
            __builtin_amdgcn_fence(__ATOMIC_ACQUIRE, "agent");
            asm volatile("s_waitcnt vmcnt(0)" ::: "memory");
        }
    }
    __syncthreads();
}

constexpr int RING_BYTES = 131072, LDS_BYTES = 155648, MISC_OFF = 153600;
struct Args { const float* in[29]; float* out; unsigned char* ws; int ph_lo, ph_hi; };
enum In { I_X = 0, I_META, I_WAB, I_WOAB, I_SINK, I_LRE, I_LIM, I_LSTEP, I_BRE, I_BIM, I_CRE, I_CIM, I_S5D, I_WGLU, I_BGLU, I_WC, I_WOC, I_LB, I_NORMG,
          I_LNMG, I_LNMB, I_LNFG, I_LNFB, I_WGRP, I_BGRP, I_WEXP, I_BEXP, I_WGU, I_WD };
struct Ctx { LAS unsigned char* lds; unsigned char* ldsg; int tid, lane, wave, bid, nblk, gw, ngw; };

__device__ __forceinline__ int rowmap_rope(int n) { if (n >= 1280) return n; const int d = n & 127; return (n & ~127) + 32 * ((d & 63) >> 4) + 16 * (d >> 6) + (d & 15); }
__device__ __forceinline__ int rowmap_gu(int n) { return n < 512 ? ((n >> 7) * 256 + (n & 127)) : (((n - 512) >> 7) * 256 + 128 + ((n - 512) & 127)); }
__device__ __forceinline__ void transpose_out(bf16* WT, int ldw, const LAS float* scr, int kb, int nb, int lane, int mode, unsigned char* WT8);
__device__ __forceinline__ void transpose_item(const float* W, int K, int N, bf16* WT, int ldw, LAS float* scr, int kb, int nb, int lane, int mode, unsigned char* WT8 = nullptr) {
    const int k0 = 128 * kb, n0 = 32 * nb;
    const float* wp = W + (size_t)(k0 + (lane >> 5)) * N + n0 + (lane & 31);
#pragma unroll
    for (int hh = 0; hh < 2; ++hh) { float v[32];
#pragma unroll
        for (int i = 0; i < 32; ++i) v[i] = __builtin_nontemporal_load(wp + (size_t)(64 * hh + 2 * i) * N);
#pragma unroll
        for (int i = 0; i < 32; ++i) scr[(64 * hh + 2 * i + (lane >> 5)) * 33 + (lane & 31)] = v[i]; }
    LDS_WAIT(); asm volatile("" ::: "memory");
    transpose_out(WT, ldw, scr, kb, nb, lane, mode, WT8);
}
__device__ __forceinline__ void transpose_out(bf16* WT, int ldw, const LAS float* scr, int kb, int nb, int lane, int mode, unsigned char* WT8) {
    const int k0 = 128 * kb, n0 = 32 * nb;
    if (mode & 12) {
        const int c8 = lane & 7; unsigned char* W8 = (mode & 8) ? WT8 : (unsigned char*)WT;
#pragma unroll
        for (int j = 0; j < 4; ++j) { const int n = (lane >> 3) + 8 * j; const LAS float* sp = scr + (16 * c8) * 33 + n; int w4[4];
#pragma unroll
            for (int q4 = 0; q4 < 4; ++q4) { int t = 0; t = __builtin_amdgcn_cvt_pk_fp8_f32(sp[(4 * q4) * 33] * 64.0f, sp[(4 * q4 + 1) * 33] * 64.0f, t, false);
                t = __builtin_amdgcn_cvt_pk_fp8_f32(sp[(4 * q4 + 2) * 33] * 64.0f, sp[(4 * q4 + 3) * 33] * 64.0f, t, true); w4[q4] = t; }
            const int nn = n0 + n; const int row = (mode & 3) == 1 ? rowmap_gu(nn) : nn;
            *(v4u*)(W8 + (size_t)row * ldw + k0 + 16 * c8) = (v4u){(unsigned)w4[0], (unsigned)w4[1], (unsigned)w4[2], (unsigned)w4[3]}; }
        if (mode & 4) { LDS_WAIT(); asm volatile("" ::: "memory"); return; }
    }
    const int c = lane & 15;
#pragma unroll
    for (int j = 0; j < 8; ++j) { const int n = (lane >> 4) + 4 * j; const LAS float* sp = scr + (8 * c) * 33 + n;
        v4u o; o.x = pkbf(sp[0 * 33], sp[1 * 33]); o.y = pkbf(sp[2 * 33], sp[3 * 33]); o.z = pkbf(sp[4 * 33], sp[5 * 33]); o.w = pkbf(sp[6 * 33], sp[7 * 33]);
        const int nn = n0 + n; const int row = (mode & 3) == 1 ? rowmap_gu(nn) : ((mode & 3) == 2 ? rowmap_rope(nn) : nn);
        *(v4u*)(WT + (size_t)row * ldw + k0 + 8 * c) = o; }
    LDS_WAIT(); asm volatile("" ::: "memory");
}
__device__ __forceinline__ void conv_family(const Ctx& c, const float* src, bf16* dst, int B, int K, int N, int mode, int ldw = 0, unsigned char* dst8 = nullptr, long lo = 0, long hi = -1) {
    if (ldw == 0) ldw = K;
    LAS float* scr = (LAS float*)(c.lds + c.wave * 17408);
    const int nkb = K / 128, nnb = N / 32; const long per = (long)nkb * nnb; if (hi < 0) hi = per * B;
    long it = lo + c.gw; if (it >= hi) return;
    const int lane = c.lane;
    float v[64];
#define CF_ISSUE(IT) do { const int b_ = (int)((IT) / per), r_ = (int)((IT) % per), kb_ = r_ / nnb, nb_ = r_ % nnb; \
        const float* wp_ = src + (size_t)b_ * K * N + (size_t)(128 * kb_ + (lane >> 5)) * N + 32 * nb_ + (lane & 31); \
        _Pragma("unroll") for (int i = 0; i < 64; ++i) v[i] = __builtin_nontemporal_load(wp_ + (size_t)(2 * i) * N); } while (0)
    CF_ISSUE(it);
    for (;;) {
#pragma unroll
        for (int i = 0; i < 64; ++i) scr[(2 * i + (lane >> 5)) * 33 + (lane & 31)] = v[i];
        LDS_WAIT(); asm volatile("" ::: "memory");
        const long nx = it + c.ngw; const bool more = nx < hi;
        if (more) CF_ISSUE(nx);
        const int b = (int)(it / per), r = (int)(it % per), kb = r / nnb, nb = r % nnb;
        bf16* d2 = (mode & 4) ? (bf16*)((unsigned char*)dst + (size_t)b * N * ldw) : dst + (size_t)b * N * ldw;
        transpose_out(d2, ldw, scr, kb, nb, lane, mode, dst8);
        if (!more) break;
        it = nx;
    }
#undef CF_ISSUE
}
constexpr int L1_GU = 64 * 16 * 32, L1_ALL = L1_GU + 64 * 4 * 64;
constexpr int FILL3 = 8192, FILL5 = FILL3 + 1280, FILL6 = FILL5 + 3328, FILL7 = FILL6 + 5120, FILL4 = FILL7 + 254 * 48;
constexpr int R11_LO = FILL4, R11_HI = R11_LO + 255 * 8, R13_LO = R11_HI, R13_HI = R13_LO + 128 * 40, R17_LO = R13_HI, R17_HI = R17_LO + 240 * 8, R21_LO = R17_HI, R21_HI = R21_LO + 255 * 8, FILLX = R21_HI;
static_assert(FILL4 < L1_GU && FILLX > L1_GU && FILLX < L1_ALL, "filler ranges");
__device__ __forceinline__ void conv_l1_item(const Ctx& c, const Args& a, int it) {
    LAS float* scr = (LAS float*)(c.lds + c.wave * 17408);
    if (it < L1_GU) { const int b = it >> 9, r = it & 511; transpose_item(a.in[I_WGU] + (size_t)(NEXP + b) * D * 1024, D, 1024, (bf16*)(a.ws + WS_WGU + (size_t)(NEXP + b) * 1024 * D), D, scr, r >> 5, r & 31, c.lane, 5); }
    else { const int i2 = it - L1_GU, b = i2 >> 8, r = i2 & 255; transpose_item(a.in[I_WD] + (size_t)(NEXP + b) * DEXP * D, DEXP, D, (bf16*)(a.ws + WS_WD + (size_t)(NEXP + b) * D * DEXP), DEXP, scr, r >> 6, r & 63, c.lane, 4); }
}
__device__ __forceinline__ void conv_fill(const Ctx& c, const Args& a, int lo, int hi, int rank, int nranks) {
    const int q = (hi - lo + nranks - 1) / nranks, b0 = lo + rank * q, b1 = (b0 + q) < hi ? (b0 + q) : hi;
    for (int it = b0 + c.wave; it < b1; it += NWAVES) conv_l1_item(c, a, it);
    __syncthreads();
}
__device__ __forceinline__ void phase_weights(const Ctx& c, const Args& a) {
    unsigned char* ws = a.ws;
    conv_family(c, a.in[I_WAB], (bf16*)(ws + WS_WAB), 1, D, ABN, 2);
    conv_family(c, a.in[I_WOAB], (bf16*)(ws + WS_WOAB), 1, D, D, 0);
    conv_family(c, a.in[I_WGLU], (bf16*)(ws + WS_WGLU), 1, 1024, 1024, 0);
    conv_family(c, a.in[I_WC], (bf16*)(ws + WS_WC), 1, D, CN, 8, 0, ws + WS_WC8);
    conv_family(c, a.in[I_WOC], (bf16*)(ws + WS_WOC), 1, D, D, 0);
    conv_family(c, a.in[I_WGU], (bf16*)(ws + WS_WGU), NEXP, D, 1024, 5);
    conv_family(c, a.in[I_WD], (bf16*)(ws + WS_WD), NEXP, DEXP, D, 4);
    if (c.nblk != 256) conv_family(c, a.in[I_WGU] + (size_t)NEXP * D * 1024, (bf16*)(ws + WS_WGU + (size_t)NEXP * 1024 * D), NEXP, D, 1024, 5);
    conv_family(c, a.in[I_WD] + (size_t)NEXP * DEXP * D, (bf16*)(ws + WS_WD + (size_t)NEXP * D * DEXP), NEXP, DEXP, D, 4, 0, nullptr, c.nblk == 256 ? FILLX - L1_GU : 0);
}
__device__ __forceinline__ void phase_init(const Ctx& c, const Args& a) {
    bf16* HB = (bf16*)(a.ws + WS_HBF);
    for (int row = c.gw; row < LP; row += c.ngw) {
        const float* src = row < ROWV ? nullptr : (row < 256 ? a.in[I_META] + (size_t)(row - ROWV) * D : a.in[I_X] + (size_t)(row - 256) * D);
#pragma unroll
        for (int j = 0; j < 8; ++j) { const int idx = (j * 64 + c.lane) * 4; f32x4 v = src ? *(const f32x4*)(src + idx) : (f32x4){0.f, 0.f, 0.f, 0.f};
            v2u w; w.x = pkbf(v.x, v.y); w.y = pkbf(v.z, v.w); *(v2u*)(HB + (size_t)row * D + idx) = w; }
    }
    float2* rope = (float2*)(a.ws + WS_ROPE);
    for (long i = (long)c.bid * NTHR + c.tid; i < (long)LP * 64; i += (long)c.nblk * NTHR) {
        const int row = (int)(i >> 6), k = (int)(i & 63);
        const float inv = powf(10000.0f, -(float)k * 2.0f / 128.0f);
        const float ang = (float)(row - ROWV) * inv;
        float s, co; sincosf(ang, &s, &co); rope[i] = make_float2(co, s);
    }
    { float* wrt = (float*)(a.ws + WS_WRT);
      for (int i = c.bid * NTHR + c.tid; i < 2 * 96 * 2048; i += c.nblk * NTHR) { const int k = i & 2047, j = (i >> 11) % 96, layer = i / (96 * 2048);
          const float wv = j < 8 ? a.in[I_WGRP][((size_t)layer * D + k) * 8 + j] : (j < 72 ? a.in[I_WEXP][((size_t)layer * D + k) * 64 + (j - 8)] : 0.f); wrt[i] = wv;
          const unsigned hb = f2bf(wv); const float hf = __uint_as_float(hb << 16); ((bf16*)(a.ws + WS_WRH))[i] = (bf16)hb; ((bf16*)(a.ws + WS_WRL))[i] = (bf16)f2bf(wv - hf); } }
    { float* lbt = (float*)(a.ws + WS_LBT);
      for (int i = c.bid * NTHR + c.tid; i < D; i += c.nblk * NTHR) lbt[i] = 1.0f / (1.0f + expf(a.in[I_LB][i] - a.in[I_LB][D + i])); }
    float2* abar = (float2*)(a.ws + WS_S5P); float2* bbar = abar + 2 * 64 * 64;
    for (int i = c.bid * NTHR + c.tid; i < 2 * 64 * 64; i += c.nblk * NTHR) {
        const int dg = i >> 6;
        const double lr = fmin((double)a.in[I_LRE][i], -1e-4), li = (double)a.in[I_LIM][i], st = exp((double)a.in[I_LSTEP][dg]);
        const double er = exp(lr * st), ar = er * cos(li * st), ai = er * sin(li * st);
        const double den = lr * lr + li * li, cr = ((ar - 1.0) * lr + ai * li) / den, ci = (ai * lr - (ar - 1.0) * li) / den;
        abar[i] = make_float2((float)ar, (float)ai);
        for (int cc = 0; cc < 16; ++cc) { const double br = a.in[I_BRE][(size_t)i * 16 + cc], bi = a.in[I_BIM][(size_t)i * 16 + cc];
            bbar[(size_t)i * 16 + cc] = make_float2((float)(cr * br - ci * bi), (float)(cr * bi + ci * br)); }
    }
    for (int j = c.bid * NTHR + c.tid; j < 2 * 64 * 64 * 33; j += c.nblk * NTHR) { const int i = j / 33, tau = j % 33, dg = i >> 6;
        const double lr = fmin((double)a.in[I_LRE][i], -1e-4), li = (double)a.in[I_LIM][i], st = exp((double)a.in[I_LSTEP][dg]);
        const double m = exp(lr * st * tau); ((float2*)(a.ws + WS_APOW))[j] = make_float2((float)(m * cos(li * st * tau)), (float)(m * sin(li * st * tau))); }
}
typedef short bf16x8 __attribute__((ext_vector_type(8)));
constexpr int HG_VT = 0, HG_QT = 18432, HG_KT = 35840, HG_KH = 53248, HG_DV = 71680, HB_SZ = 72704, HG_SCR = 2 * HB_SZ;
constexpr int LD_K = 272, LD_T = 144;
__device__ __forceinline__ bf16x8 ldfrag(LAS unsigned char* base, int row, int pitch, int kbyte) { return *(const LAS bf16x8*)(base + row * pitch + kbyte); }
#define MFMA16(a, b, c) __builtin_amdgcn_mfma_f32_16x16x32_bf16((a), (b), (c), 0, 0, 0)
constexpr int AT_K = 0, AT_VT = 17408;
__device__ __forceinline__ void phase_attn(const Ctx& c, const Args& a) {
    const bf16* QB = (const bf16*)(a.ws + WS_QB0); const bf16* KB = (const bf16*)(a.ws + WS_KB0); const bf16* VB = (const bf16*)(a.ws + WS_VB0); bf16* MI = (bf16*)(a.ws + WS_MIXIN);
    LAS unsigned char* L = c.lds;
    const int w = c.wave, hr = w >> 1, qh = w & 1;
    const float C2 = 0.08838834764831845f * 1.4426950408889634f;
    for (int u = c.bid; u < 514; u += c.nblk) {
        int tv = c.tid; asm volatile("" : "+v"(tv));
        const int r = tv & 15, gq = (tv >> 4) & 3;
        const int skey = tv >> 3, sc16 = tv & 7;
        const int sd = tv & 127, skq = tv >> 7;
        const int g = u & 1, qb = u >> 1, r0 = 192 + 64 * qb, h = 4 * g + hr, rq0 = r0 + 32 * qh;
        const int klo = (r0 / 64 - 2) < 4 ? 4 : (r0 / 64 - 2), khi = (r0 / 64 + 2) > 259 ? 259 : (r0 / 64 + 2), ntile = 1 + (khi - klo + 1);
        bf16x8 qf[2][4];
#pragma unroll
        for (int qt = 0; qt < 2; ++qt)
#pragma unroll
            for (int ks = 0; ks < 4; ++ks) qf[qt][ks] = *(const bf16x8*)(QB + (size_t)(rq0 + 16 * qt + r) * 1024 + h * 128 + 32 * ks + 8 * gq);
        const float sink2 = a.in[I_SINK][h] * 1.4426950408889634f;
        float mrun[2] = {sink2, sink2}, lsum[2] = {gq == 0 ? 1.f : 0.f, gq == 0 ? 1.f : 0.f};
        f32x4 O[2][8];
#pragma unroll
        for (int qt = 0; qt < 2; ++qt)
#pragma unroll
            for (int dt = 0; dt < 8; ++dt) O[qt][dt] = (f32x4){0.f, 0.f, 0.f, 0.f};
        v4u kraw[2]; unsigned short vraw[16];
#define AT_LOAD(kt_) do { const bf16* kp = KB + (size_t)(64 * (kt_) + skey) * 256 + g * 128 + 16 * sc16; kraw[0] = *(const v4u*)kp; kraw[1] = *(const v4u*)(kp + 8); \
            const bf16* vp = VB + (size_t)(64 * (kt_) + 16 * skq) * 256 + g * 128 + sd; _Pragma("unroll") for (int i = 0; i < 16; ++i) vraw[i] = vp[(size_t)i * 256]; } while (0)
        AT_LOAD(3);
        for (int ti = 0; ti < ntile; ++ti) {
            const int kt = ti == 0 ? 3 : klo + ti - 1;
            { *(LAS v4u*)(L + AT_K + skey * LD_K + 32 * sc16) = kraw[0]; *(LAS v4u*)(L + AT_K + skey * LD_K + 32 * sc16 + 16) = kraw[1];
              v4u v0, v1; v0.x = vraw[0] | ((unsigned)vraw[1] << 16); v0.y = vraw[2] | ((unsigned)vraw[3] << 16); v0.z = vraw[4] | ((unsigned)vraw[5] << 16); v0.w = vraw[6] | ((unsigned)vraw[7] << 16);
              v1.x = vraw[8] | ((unsigned)vraw[9] << 16); v1.y = vraw[10] | ((unsigned)vraw[11] << 16); v1.z = vraw[12] | ((unsigned)vraw[13] << 16); v1.w = vraw[14] | ((unsigned)vraw[15] << 16);
              *(LAS v4u*)(L + AT_VT + sd * LD_T + 32 * skq) = v0; *(LAS v4u*)(L + AT_VT + sd * LD_T + 32 * skq + 16) = v1; }
            if (ti + 1 < ntile) AT_LOAD(klo + ti);
            __syncthreads();
            bf16x8 pf[2][2];
#pragma unroll
            for (int qt = 0; qt < 2; ++qt) {
                f32x4 sc[4];
#pragma unroll
                for (int ki = 0; ki < 4; ++ki) sc[ki] = (f32x4){0.f, 0.f, 0.f, 0.f};
#pragma unroll
                for (int ks = 0; ks < 4; ++ks)
#pragma unroll
                    for (int ki = 0; ki < 4; ++ki) { const bf16x8 kf = ldfrag(L + AT_K, 16 * ki + r, LD_K, (32 * ks + 8 * gq) * 2); sc[ki] = MFMA16(kf, qf[qt][ks], sc[ki]); }
                const int rq = rq0 + 16 * qt + r; float tmax = -3.0e38f;
#pragma unroll
                for (int ki = 0; ki < 4; ++ki)
#pragma unroll
                    for (int e = 0; e < 4; ++e) { const int rk = 64 * kt + 16 * ki + 4 * gq + e; const int dd = rq - rk;
                        const bool ok = ti == 0 ? (rk >= ROWV) : (rk >= 256 && dd <= 128 && dd >= -128);
                        const float v = ok ? sc[ki][e] * C2 : -3.0e38f; sc[ki][e] = v; tmax = fmaxf(tmax, v); }
                tmax = fmaxf(tmax, __shfl_xor(tmax, 16)); tmax = fmaxf(tmax, __shfl_xor(tmax, 32));
                const float mn = fmaxf(mrun[qt], tmax), alpha = exp2f(mrun[qt] - mn); mrun[qt] = mn;
                float ps = 0.f;
#pragma unroll
                for (int ki = 0; ki < 4; ++ki)
#pragma unroll
                    for (int e = 0; e < 4; ++e) { const float pv = exp2f(sc[ki][e] - mn); sc[ki][e] = pv; ps += pv; }
                lsum[qt] = lsum[qt] * alpha + ps;
#pragma unroll
                for (int dt = 0; dt < 8; ++dt) O[qt][dt] = O[qt][dt] * alpha;
#pragma unroll
                for (int kk = 0; kk < 2; ++kk) { v4u t; t.x = pkbf(sc[2 * kk][0], sc[2 * kk][1]); t.y = pkbf(sc[2 * kk][2], sc[2 * kk][3]);
                    t.z = pkbf(sc[2 * kk + 1][0], sc[2 * kk + 1][1]); t.w = pkbf(sc[2 * kk + 1][2], sc[2 * kk + 1][3]); pf[qt][kk] = __builtin_bit_cast(bf16x8, t); }
            }
#pragma unroll
            for (int dt = 0; dt < 8; ++dt)
#pragma unroll
                for (int kk = 0; kk < 2; ++kk) { const LAS unsigned char* vp = L + AT_VT + (16 * dt + r) * LD_T + (32 * kk + 4 * gq) * 2;
                    const v2u lo = *(const LAS v2u*)vp, hi = *(const LAS v2u*)(vp + 32); const v4u t = (v4u){lo.x, lo.y, hi.x, hi.y}; const bf16x8 vf = __builtin_bit_cast(bf16x8, t);
                    O[0][dt] = MFMA16(vf, pf[0][kk], O[0][dt]); O[1][dt] = MFMA16(vf, pf[1][kk], O[1][dt]); }
            __syncthreads();
        }
#undef AT_LOAD
#pragma unroll
        for (int qt = 0; qt < 2; ++qt) { float l = lsum[qt]; l += __shfl_xor(l, 16); l += __shfl_xor(l, 32); const float inv = 1.0f / l; const int rq = rq0 + 16 * qt + r;
            if (rq >= ROWV) {
#pragma unroll
                for (int dt = 0; dt < 8; ++dt) { v2u o; o.x = pkbf(O[qt][dt][0] * inv, O[qt][dt][1] * inv); o.y = pkbf(O[qt][dt][2] * inv, O[qt][dt][3] * inv);
                    *(v2u*)(MI + (size_t)rq * D + h * 128 + 16 * dt + 4 * gq) = o; } } }
    }
    for (int i = c.bid * NTHR + c.tid; i < ROWV * D / 8; i += c.nblk * NTHR) ((v4u*)MI)[i] = (v4u){0u, 0u, 0u, 0u};
}
__device__ __forceinline__ void phase_s5_ktab(const Ctx& c, const Args& a) {
    const float2* abar = (const float2*)(a.ws + WS_S5P); const float2* bbar = abar + 2 * 64 * 64; const float2* apow = (const float2*)(a.ws + WS_APOW);
    float* KT = (float*)(a.ws + WS_KTAB);
    LAS float* Lb = (LAS float*)c.lds;
    LAS float* La = Lb + 2048;
    LAS float* Lc = La + 2048;
    for (int u = c.bid; u < 256; u += c.nblk) {
        const int dg = u >> 1, th = u & 1;
        __syncthreads();
        for (int i = c.tid; i < 1024; i += NTHR) { const float2 v = bbar[(size_t)dg * 1024 + i]; Lb[2 * i] = v.x; Lb[2 * i + 1] = v.y; }
        for (int i = c.tid; i < 1024; i += NTHR) { const int p = i >> 4, tl = i & 15; const float2 v = apow[((size_t)dg * 64 + p) * 33 + 16 * th + tl]; La[2 * i] = v.x; La[2 * i + 1] = v.y; }
        for (int i = c.tid; i < 1024; i += NTHR) { Lc[i] = a.in[I_CRE][(size_t)dg * 1024 + i]; Lc[1024 + i] = a.in[I_CIM][(size_t)dg * 1024 + i]; }
        __syncthreads();
        const int tl = c.tid >> 5, c1 = (c.tid & 31) >> 1, c20 = (c.tid & 1) * 8;
        float sum[8];
#pragma unroll
        for (int j = 0; j < 8; ++j) sum[j] = 0.f;
        for (int p = 0; p < 64; ++p) { const float apx = La[(p * 16 + tl) * 2], apy = La[(p * 16 + tl) * 2 + 1], cr = Lc[c1 * 64 + p], ci = Lc[1024 + c1 * 64 + p];
            const float wr_ = cr * apx - ci * apy, wi_ = cr * apy + ci * apx;
#pragma unroll
            for (int j = 0; j < 8; ++j) sum[j] += wr_ * Lb[(p * 16 + c20 + j) * 2] - wi_ * Lb[(p * 16 + c20 + j) * 2 + 1]; }
        float* dst = KT + ((((size_t)dg * 32 + 16 * th + tl) * 16 + c1) * 16 + c20);
        *(f32x4*)dst = (f32x4){sum[0], sum[1], sum[2], sum[3]}; *(f32x4*)(dst + 4) = (f32x4){sum[4], sum[5], sum[6], sum[7]};
    }
    __syncthreads();
}
__device__ __forceinline__ void phase_s5_fill(const Ctx& c, const Args& a) {
    const float2* abar = (const float2*)(a.ws + WS_S5P); const float2* bbar = abar + 2 * 64 * 64; const float2* apow = (const float2*)(a.ws + WS_APOW);
    const float* KT = (const float*)(a.ws + WS_KTAB); bf16* MWT = (bf16*)(a.ws + WS_MWT); bf16* WST = (bf16*)(a.ws + WS_WST);
    for (long it = (long)c.bid * NTHR + c.tid; it < (long)64 * 512 * 96; it += (long)c.nblk * NTHR) {
        const int kb = (int)(it % 96), n = (int)((it / 96) % 512), g = (int)(it / (96 * 512)), t = n >> 4, c1 = n & 15;
        float v[8];
        if (kb < 64) { const int s2 = kb >> 1, c2 = (kb & 1) * 8;
            if (s2 < t) { const float* k0 = KT + ((((size_t)(0 * 64 + g)) * 32 + (t - s2)) * 16 + c1) * 16 + c2;
#pragma unroll
                for (int i = 0; i < 8; ++i) v[i] = k0[i]; }
            else if (s2 > t) { const float* k0 = KT + ((((size_t)(1 * 64 + g)) * 32 + (s2 - t)) * 16 + c1) * 16 + c2;
#pragma unroll
                for (int i = 0; i < 8; ++i) v[i] = k0[i]; }
            else { const float* k0 = KT + ((((size_t)(0 * 64 + g)) * 32) * 16 + c1) * 16 + c2; const float* k1 = KT + ((((size_t)(1 * 64 + g)) * 32) * 16 + c1) * 16 + c2;
#pragma unroll
                for (int i = 0; i < 8; ++i) v[i] = k0[i] + k1[i] + ((c2 + i) == c1 ? a.in[I_S5D][16 * g + c1] : 0.f); }
        } else { const int j0 = (kb - 64) * 8, qd = j0 >> 6, dir = qd >> 1, p0 = j0 & 63, tau = dir == 0 ? t + 1 : 32 - t;
            const float* cr = a.in[I_CRE] + ((size_t)(dir * 64 + g) * 16 + c1) * 64; const float* ci = a.in[I_CIM] + ((size_t)(dir * 64 + g) * 16 + c1) * 64;
#pragma unroll
            for (int i = 0; i < 8; ++i) { const int p = p0 + i; const float2 ap = apow[((size_t)(dir * 64 + g) * 64 + p) * 33 + tau];
                v[i] = (qd & 1) == 0 ? (cr[p] * ap.x - ci[p] * ap.y) : -(cr[p] * ap.y + ci[p] * ap.x); }
        }
        v4u o; o.x = pk2(v[0], v[1]); o.y = pk2(v[2], v[3]); o.z = pk2(v[4], v[5]); o.w = pk2(v[6], v[7]);
        *(v4u*)(MWT + ((size_t)g * 512 + n) * 768 + kb * 8) = o;
    }
    for (long it = (long)c.bid * NTHR + c.tid; it < (long)64 * 256 * 64; it += (long)c.nblk * NTHR) {
        const int kb = (int)(it & 63), n = (int)((it >> 6) & 255), g = (int)(it >> 14), s2 = kb >> 1, c2 = (kb & 1) * 8, qd = n >> 6, dir = qd >> 1, p = n & 63;
        const int tau = dir == 0 ? 31 - s2 : s2; const size_t i = (size_t)(dir * 64 + g) * 64 + p; const float2 ap = apow[i * 33 + tau];
        float v[8];
#pragma unroll
        for (int e = 0; e < 8; ++e) { const float2 bb = bbar[i * 16 + c2 + e]; v[e] = (qd & 1) == 0 ? (ap.x * bb.x - ap.y * bb.y) : (ap.x * bb.y + ap.y * bb.x); }
        v4u o; o.x = pk2(v[0], v[1]); o.y = pk2(v[2], v[3]); o.z = pk2(v[4], v[5]); o.w = pk2(v[6], v[7]);
        *(v4u*)(WST + ((size_t)g * 256 + n) * 512 + kb * 8) = o;
    }
    bf16* ZB = (bf16*)(a.ws + WS_ZB);
    for (int i = c.bid * NTHR + c.tid; i < 224 * 1024 / 8; i += c.nblk * NTHR) ((v4u*)ZB)[i] = (v4u){0u, 0u, 0u, 0u};
}
__device__ __forceinline__ void phase_s5_chunkscan(const Ctx& c, const Args& a) {
    if (c.bid >= 128) return;
    const int g = c.bid & 63, dir = c.bid >> 6, p = c.lane, w = c.wave;
    const float2 a32 = ((const float2*)(a.ws + WS_APOW))[((size_t)(dir * 64 + g) * 64 + p) * 33 + 32];
    const float* S = (const float*)(a.ws + WS_R1 + R1_SALL) + (size_t)g * 768 * 256 + dir * 128 + p;
    bf16* UA = (bf16*)(a.ws + WS_R1 + R1_UA) + (size_t)g * 768 * 768 + 512 + dir * 128 + p;
    LAS float* E = (LAS float*)c.lds; LAS float* PW = E + 2 * 8 * 64;
    const int j0 = 65 * w, j1 = (j0 + 65) < 513 ? (j0 + 65) : 513, len = j1 - j0;
    float xr = 0.f, xi = 0.f, pr = 1.f, pi = 0.f;
    for (int b = 0; b < 5; ++b) { float sr[13], si[13];
#pragma unroll
        for (int i = 0; i < 13; ++i) { const int o = b * 13 + i; const int j = dir == 0 ? j0 + o : j1 - 1 - o; const bool ok = o < len; sr[i] = ok ? S[(size_t)j * 256] : 0.f; si[i] = ok ? S[(size_t)j * 256 + 64] : 0.f; }
#pragma unroll
        for (int i = 0; i < 13; ++i) { if (b * 13 + i < len) { const float nr = a32.x * xr - a32.y * xi + sr[i], ni = a32.x * xi + a32.y * xr + si[i]; xr = nr; xi = ni;
                const float qr = a32.x * pr - a32.y * pi, qi = a32.x * pi + a32.y * pr; pr = qr; pi = qi; } }
    }
    E[w * 128 + p] = xr; E[w * 128 + 64 + p] = xi; PW[w * 128 + p] = pr; PW[w * 128 + 64 + p] = pi;
    __syncthreads();
    float cr = 0.f, ci = 0.f;
    if (dir == 0) { for (int w2 = 0; w2 < w; ++w2) { const float2 e = make_float2(E[w2 * 128 + p], E[w2 * 128 + 64 + p]), q = make_float2(PW[w2 * 128 + p], PW[w2 * 128 + 64 + p]); const float nr = q.x * cr - q.y * ci + e.x, ni = q.x * ci + q.y * cr + e.y; cr = nr; ci = ni; } }
    else { for (int w2 = 7; w2 > w; --w2) { const float2 e = make_float2(E[w2 * 128 + p], E[w2 * 128 + 64 + p]), q = make_float2(PW[w2 * 128 + p], PW[w2 * 128 + 64 + p]); const float nr = q.x * cr - q.y * ci + e.x, ni = q.x * ci + q.y * cr + e.y; cr = nr; ci = ni; } }
    xr = cr; xi = ci;
    for (int b = 0; b < 5; ++b) { float sr[13], si[13];
#pragma unroll
        for (int i = 0; i < 13; ++i) { const int o = b * 13 + i; const int j = dir == 0 ? j0 + o : j1 - 1 - o; const bool ok = o < len; sr[i] = ok ? S[(size_t)j * 256] : 0.f; si[i] = ok ? S[(size_t)j * 256 + 64] : 0.f; }
#pragma unroll
        for (int i = 0; i < 13; ++i) { const int o = b * 13 + i; if (o < len) { const int j = dir == 0 ? j0 + o : j1 - 1 - o;
                UA[(size_t)j * 768] = (bf16)f2bf(xr); UA[(size_t)j * 768 + 64] = (bf16)f2bf(xi);
                const float nr = a32.x * xr - a32.y * xi + sr[i], ni = a32.x * xi + a32.y * xr + si[i]; xr = nr; xi = ni; } }
    }
}
template <class F> __device__ __forceinline__ void skinny_gemm(const Ctx& c, const bf16* A, int lda, const bf16* Wt, int K, int N, const F& f) {
    int tv = c.tid; asm volatile("" : "+v"(tv));
    const int r = tv & 15, q = (tv >> 4) & 3;
    for (int tile = c.gw; tile < N / 16; tile += c.ngw) {
        f32x4 acc = (f32x4){0.f, 0.f, 0.f, 0.f};
        const bf16* ap = A + (size_t)(ROWV + r) * lda + 8 * q; const bf16* bp = Wt + (size_t)(16 * tile + r) * K + 8 * q;
        for (int ks = 0; ks < K / 32; ks += 8) { bf16x8 af[8], bfr[8];
#pragma unroll
            for (int i = 0; i < 8; ++i) { af[i] = *(const bf16x8*)(ap + (ks + i) * 32); bfr[i] = *(const bf16x8*)(bp + (ks + i) * 32); }
#pragma unroll
            for (int i = 0; i < 8; ++i) acc = MFMA16(af[i], bfr[i], acc); }
#pragma unroll
        for (int e = 0; e < 4; ++e) f(ROWV + 4 * q + e, 16 * tile + r, acc[e]);
    }
}
template <class F> __device__ __forceinline__ void skinny_gemm2(const Ctx& c, const bf16* A, int lda, const bf16* Wt, int K, int N, const F& f) {
    int tv = c.tid; asm volatile("" : "+v"(tv));
    const int r = tv & 15, q = (tv >> 4) & 3;
    for (int pt = c.gw; pt < N / 32; pt += c.ngw) {
        f32x4 acc0 = (f32x4){0.f, 0.f, 0.f, 0.f}, acc1 = (f32x4){0.f, 0.f, 0.f, 0.f};
        const bf16* ap = A + (size_t)(ROWV + r) * lda + 8 * q; const bf16* bp = Wt + (size_t)(32 * pt + r) * K + 8 * q;
        for (int ks = 0; ks < K / 32; ks += 4) { bf16x8 af[4], b0[4], b1[4];
#pragma unroll
            for (int i = 0; i < 4; ++i) { af[i] = *(const bf16x8*)(ap + (ks + i) * 32); b0[i] = *(const bf16x8*)(bp + (ks + i) * 32); b1[i] = *(const bf16x8*)(bp + (size_t)16 * K + (ks + i) * 32); }
#pragma unroll
            for (int i = 0; i < 4; ++i) { acc0 = MFMA16(af[i], b0[i], acc0); acc1 = MFMA16(af[i], b1[i], acc1); } }
#pragma unroll
        for (int e = 0; e < 4; ++e) f(ROWV + 4 * q + e, 32 * pt + r, acc0[e], acc1[e]);
    }
}
struct SkAB2 { unsigned char* ws; __device__ __forceinline__ void operator()(int row, int n0, float v0, float v1) const {
    if (n0 < 1280) { const int hb = n0 >> 7, d = 16 * ((n0 & 127) >> 5) + (n0 & 15); const float2 cs = ((const float2*)(ws + WS_ROPE))[(size_t)row * 64 + d];
        const float o1 = v0 * cs.x - v1 * cs.y, o2 = v1 * cs.x + v0 * cs.y;
        bf16* dst = hb < 8 ? (bf16*)(ws + WS_QB0) + (size_t)row * 1024 + hb * 128 + d : (bf16*)(ws + WS_KB0) + (size_t)row * 256 + (hb - 8) * 128 + d;
        dst[0] = (bf16)f2bf(o1); dst[64] = (bf16)f2bf(o2); }
    else if (n0 < 1536) { bf16* dst = (bf16*)(ws + WS_VB0) + (size_t)row * 256 + n0 - 1280; dst[0] = (bf16)f2bf(v0); dst[16] = (bf16)f2bf(v1); }
    else { bf16* UA = (bf16*)(ws + WS_R1 + R1_UA); const int ch = n0 - 1536, ch1 = ch + 16;
        UA[((size_t)(ch >> 4) * 768) * 768 + (16 + row - ROWV) * 16 + (ch & 15)] = (bf16)f2bf(v0); UA[((size_t)(ch1 >> 4) * 768) * 768 + (16 + row - ROWV) * 16 + (ch1 & 15)] = (bf16)f2bf(v1); } } };
struct SkAB { float* C; bf16* UA; __device__ __forceinline__ void operator()(int row, int n, float v) const {
    if (n < 1536) C[(size_t)row * ABN + n] = v; else { const int ch = n - 1536; UA[((size_t)(ch >> 4) * 768) * 768 + (16 + row - ROWV) * 16 + (ch & 15)] = (bf16)f2bf(v); } } };
struct SkGlu { const bf16* ZB; const float* bias; bf16* O; __device__ __forceinline__ void operator()(int row, int n, float v) const {
    const float z = __uint_as_float((unsigned)ZB[(size_t)row * 1024 + n] << 16); O[(size_t)row * D + 1024 + n] = (bf16)f2bf(z / (1.0f + __expf(-(v + bias[n])))); } };
struct SkBf16 { bf16* O; int ldc; __device__ __forceinline__ void operator()(int row, int n, float v) const { O[(size_t)row * ldc + n] = (bf16)f2bf(v); } };
struct SkC { bf16* QB; bf16* VB; bf16* GB; bf16* F; const float* lbt; __device__ __forceinline__ void operator()(int row, int n, float v) const {
    if (n < 2048) QB[(size_t)row * D + n] = (bf16)f2bf(v);
    else if (n < 4096) VB[(size_t)row * D + n - 2048] = (bf16)f2bf(v);
    else if (n < 8192) { const float lb = lbt[n & 2047]; F[(size_t)row * 4096 + n - 4096] = (bf16)f2bf((1.0f - lb) / (1.0f + __expf(v))); }
    else GB[(size_t)row * D + n - 8192] = (bf16)f2bf(1.0f / (1.0f + __expf(-v))); } };
__device__ __forceinline__ void zero_rows_bf16(const Ctx& c, bf16* B, int ld, int r0, int r1) {
    const int per = ld / 8;
    for (int i = c.bid * NTHR + c.tid; i < (r1 - r0) * per; i += c.nblk * NTHR) *(v4u*)(B + (size_t)(r0 + i / per) * ld + (i % per) * 8) = (v4u){0u, 0u, 0u, 0u};
}
__device__ __forceinline__ void zero_rows_f32(const Ctx& c, float* B, int ld, int r0, int r1, int ncols) {
    const int per = ncols / 4;
    for (int i = c.bid * NTHR + c.tid; i < (r1 - r0) * per; i += c.nblk * NTHR) *(f32x4*)(B + (size_t)(r0 + i / per) * ld + (i % per) * 4) = (f32x4){0.f, 0.f, 0.f, 0.f};
}
#ifdef PROBE_MASK
#ifndef PROBE_BARMASK
#define PROBE_BARMASK 0ull
#endif
#define PROBE_SCALE g_probe_scale
#define PROBE_DECL , float g_probe_scale
#define PROBE_PASS , g_probe_scale
#define PROBE_ONE , 1.0f
#else
#define PROBE_SCALE 1.0f
#define PROBE_DECL
#define PROBE_PASS
#define PROBE_ONE
#endif
typedef int v4i_ __attribute__((ext_vector_type(4)));
__device__ __forceinline__ f32x4 bf4(v2u w) { return (f32x4){__uint_as_float(w.x << 16), __uint_as_float(w.x & 0xffff0000u), __uint_as_float(w.y << 16), __uint_as_float(w.y & 0xffff0000u)}; }
struct LnSrc { const bf16* h; const bf16* add; const bf16* y0; const bf16* y1; float w0, w1; };
struct LnDst { bf16* hb; unsigned char* h8; float* dout; };
template <bool FFN> __device__ __forceinline__ void ln_pair(const LnSrc& A, const LnSrc& B, const float* gam, const float* bet, const LnDst& oA, const LnDst& oB, bool hasB, int lane PROBE_DECL) {
    f32x4 va[8], vb[8]; float sa = 0.f, sb = 0.f;
#pragma unroll
    for (int j = 0; j < 8; ++j) { const int idx = (j * 64 + lane) * 4;
        f32x4 xa = bf4(*(const v2u*)(A.h + idx)) * DN_ALPHA, xb = bf4(*(const v2u*)(B.h + idx)) * DN_ALPHA;
        if (FFN) { xa += bf4(*(const v2u*)(A.y0 + idx)) * A.w0 + bf4(*(const v2u*)(A.y1 + idx)) * A.w1; xb += bf4(*(const v2u*)(B.y0 + idx)) * B.w0 + bf4(*(const v2u*)(B.y1 + idx)) * B.w1; }
        else { xa += bf4(*(const v2u*)(A.add + idx)); xb += bf4(*(const v2u*)(B.add + idx)); }
        va[j] = xa; vb[j] = xb; sa += (xa.x + xa.y) + (xa.z + xa.w); sb += (xb.x + xb.y) + (xb.z + xb.w); }
    const float ma = wave_sum(sa) * (1.0f / D), mb = wave_sum(sb) * (1.0f / D); float qa = 0.f, qb = 0.f;
#pragma unroll
    for (int j = 0; j < 8; ++j) { va[j] = va[j] - ma; vb[j] = vb[j] - mb; qa += (va[j].x * va[j].x + va[j].y * va[j].y) + (va[j].z * va[j].z + va[j].w * va[j].w); qb += (vb[j].x * vb[j].x + vb[j].y * vb[j].y) + (vb[j].z * vb[j].z + vb[j].w * vb[j].w); }
    const float ra = 1.0f / sqrtf(wave_sum(qa) * (1.0f / D) + LN_EPS), rb = 1.0f / sqrtf(wave_sum(qb) * (1.0f / D) + LN_EPS);
#pragma unroll
    for (int j = 0; j < 8; ++j) { const int idx = (j * 64 + lane) * 4; const f32x4 g = *(const f32x4*)(gam + idx), b = *(const f32x4*)(bet + idx);
        const f32x4 o = va[j] * ra * g + b, p = vb[j] * rb * g + b;
        if (oA.hb) { v2u w; w.x = pk2(o.x, o.y); w.y = pk2(o.z, o.w); *(v2u*)(oA.hb + idx) = w; int t = 0; t = __builtin_amdgcn_cvt_pk_fp8_f32(o.x, o.y, t, false); t = __builtin_amdgcn_cvt_pk_fp8_f32(o.z, o.w, t, true); *(int*)(oA.h8 + idx) = t; }
        if (oA.dout) *(f32x4*)(oA.dout + idx) = o * PROBE_SCALE;
        if (hasB) {
            if (oB.hb) { v2u w; w.x = pk2(p.x, p.y); w.y = pk2(p.z, p.w); *(v2u*)(oB.hb + idx) = w; int t = 0; t = __builtin_amdgcn_cvt_pk_fp8_f32(p.x, p.y, t, false); t = __builtin_amdgcn_cvt_pk_fp8_f32(p.z, p.w, t, true); *(int*)(oB.h8 + idx) = t; }
            if (oB.dout) *(f32x4*)(oB.dout + idx) = p * PROBE_SCALE; } }
}
__device__ __forceinline__ void ln_zero_pad(const Ctx& c, bf16* HB, unsigned char* H8) {
    for (int row = c.gw; row < ROWV; row += c.ngw) {
#pragma unroll
        for (int j = 0; j < 8; ++j) { const int idx = (j * 64 + c.lane) * 4; *(v2u*)(HB + (size_t)row * D + idx) = (v2u){0u, 0u}; *(int*)(H8 + (size_t)row * D + idx) = 0; } }
}
__device__ __forceinline__ void phase_ln_mix(const Ctx& c, const Args& a, int layer) {
    const bf16* MIX = (const bf16*)(a.ws + WS_MIX); bf16* HB = (bf16*)(a.ws + WS_HBF); unsigned char* H8 = a.ws + WS_H8;
    ln_zero_pad(c, HB, H8);
    for (int i = c.gw; i < NVALID; i += 2 * c.ngw) {
        const int rowA = ROWV + i, rowB0 = rowA + c.ngw; const bool hasB = rowB0 < LP; const int rowB = hasB ? rowB0 : rowA;
        const LnSrc A{HB + (size_t)rowA * D, MIX + (size_t)rowA * D, nullptr, nullptr, 0.f, 0.f}, B{HB + (size_t)rowB * D, MIX + (size_t)rowB * D, nullptr, nullptr, 0.f, 0.f};
        ln_pair<false>(A, B, a.in[I_LNMG] + layer * D, a.in[I_LNMB] + layer * D, LnDst{HB + (size_t)rowA * D, H8 + (size_t)rowA * D, nullptr}, LnDst{HB + (size_t)rowB * D, H8 + (size_t)rowB * D, nullptr}, hasB, c.lane PROBE_ONE); }
}
__device__ __forceinline__ void phase_ln_ffn(const Ctx& c, const Args& a, int layer, bool last PROBE_DECL) {
    const bf16* Y = (const bf16*)(a.ws + WS_R1 + R1_Y); bf16* HB = (bf16*)(a.ws + WS_HBF); unsigned char* H8 = a.ws + WS_H8;
    const int* route = (const int*)(a.ws + WS_ROUTE);
    if (!last) ln_zero_pad(c, HB, H8);
    const int first = last ? 256 : ROWV;
    for (int i = c.gw; i < LP - first; i += 2 * c.ngw) {
        const int rowA = first + i, rowB0 = rowA + c.ngw; const bool hasB = rowB0 < LP; const int rowB = hasB ? rowB0 : rowA;
        const int* rA = route + (size_t)rowA * 8; const int* rB = route + (size_t)rowB * 8;
        const v4i_ qa = *(const v4i_*)(rA + 4), qb = *(const v4i_*)(rB + 4);
        const LnSrc A{HB + (size_t)rowA * D, nullptr, Y + (size_t)qa.x * D, Y + (size_t)qa.y * D, __int_as_float(qa.z), __int_as_float(qa.w)}, B{HB + (size_t)rowB * D, nullptr, Y + (size_t)qb.x * D, Y + (size_t)qb.y * D, __int_as_float(qb.z), __int_as_float(qb.w)};
        const LnDst oA{last ? nullptr : HB + (size_t)rowA * D, last ? nullptr : H8 + (size_t)rowA * D, last ? a.out + (size_t)(rowA - 256) * D : nullptr}, oB{last ? nullptr : HB + (size_t)rowB * D, last ? nullptr : H8 + (size_t)rowB * D, last ? a.out + (size_t)(rowB - 256) * D : nullptr};
        ln_pair<true>(A, B, a.in[I_LNFG] + layer * D, a.in[I_LNFB] + layer * D, oA, oB, hasB, c.lane PROBE_PASS); }
}
typedef float f32x16 __attribute__((ext_vector_type(16)));
__device__ __forceinline__ void phase_router(const Ctx& c, const Args& a, int layer) {
    const bf16* HBr = (const bf16*)(a.ws + WS_HBF);
    LAS float* part = (LAS float*)c.lds;
    LAS float* lg = (LAS float*)(c.lds + 98304);
    const bf16* wrh = (const bf16*)(a.ws + WS_WRH) + (size_t)layer * 96 * 2048; const bf16* wrl = (const bf16*)(a.ws + WS_WRL) + (size_t)layer * 96 * 2048;
    const float* bg = a.in[I_BGRP] + layer * 8; const float* be = a.in[I_BEXP] + layer * 64;
    int* route = (int*)(a.ws + WS_ROUTE); unsigned* cnt = (unsigned*)(a.ws + WS_CTL) + CW_CNT + layer * 64;
    const int li = c.lane & 31, kh = c.lane >> 5, w = c.wave;
    for (int task = c.bid; task < 513; task += c.nblk) {
        const int row0 = 224 + 32 * task;
        f32x16 acc[3];
#pragma unroll
        for (int ct = 0; ct < 3; ++ct)
#pragma unroll
            for (int e = 0; e < 16; ++e) acc[ct][e] = 0.f;
        const bf16* ap = HBr + (size_t)(row0 + li) * D + 256 * w + 8 * kh;
        const bf16* bh = wrh + (size_t)li * 2048 + 256 * w + 8 * kh; const bf16* bl = wrl + (size_t)li * 2048 + 256 * w + 8 * kh;
#pragma unroll 4
        for (int st = 0; st < 16; ++st) {
            const bf16x8 ah = *(const bf16x8*)(ap + 16 * st);
#pragma unroll
            for (int ct = 0; ct < 3; ++ct) { const bf16x8 wh = *(const bf16x8*)(bh + (size_t)ct * 32 * 2048 + 16 * st), wl = *(const bf16x8*)(bl + (size_t)ct * 32 * 2048 + 16 * st);
                acc[ct] = __builtin_amdgcn_mfma_f32_32x32x16_bf16(ah, wh, acc[ct], 0, 0, 0); acc[ct] = __builtin_amdgcn_mfma_f32_32x32x16_bf16(ah, wl, acc[ct], 0, 0, 0); }
        }
#pragma unroll
        for (int ct = 0; ct < 3; ++ct)
#pragma unroll
            for (int e = 0; e < 16; ++e) part[((ct * 8 + w) * 16 + e) * 64 + c.lane] = acc[ct][e];
        __syncthreads();
        for (int i = c.tid; i < 3072; i += NTHR) { const int ct = i >> 10, e = (i >> 6) & 15, ln = i & 63; float sum = 0.f;
#pragma unroll
            for (int w2 = 0; w2 < 8; ++w2) sum += part[((ct * 8 + w2) * 16 + e) * 64 + ln];
            const int col = 32 * ct + (ln & 31), row = (e & 3) + 8 * (e >> 2) + 4 * (ln >> 5);
            lg[row * 96 + col] = sum + (col < 8 ? bg[col] : (col < 72 ? be[col - 8] : 0.f)); }
        __syncthreads();
        if (c.tid < 32) { const int row2 = row0 + c.tid;
            if (row2 >= ROWV) { const LAS float* l = lg + c.tid * 96;
                int grp = 0; float gm = l[0];
                for (int q = 1; q < 8; ++q) if (l[q] > gm) { gm = l[q]; grp = q; }
                float gs = 0.f; for (int q = 0; q < 8; ++q) gs += expf(l[q] - gm);
                const float pg = 1.0f / gs;
                const LAS float* el = l + 8 + grp * 8;
                int i0 = 0; float v0 = el[0]; for (int q = 1; q < 8; ++q) if (el[q] > v0) { v0 = el[q]; i0 = q; }
                int i1 = -1; float v1 = -3.0e38f; for (int q = 0; q < 8; ++q) if (q != i0 && el[q] > v1) { v1 = el[q]; i1 = q; }
                const float e1 = expf(v1 - v0), w0 = pg / (1.0f + e1), w1 = pg * e1 / (1.0f + e1);
                const int ex0 = grp * 8 + i0, ex1 = grp * 8 + i1;
                const int p0 = (int)atomicAdd(cnt + ex0, 1u), p1 = (int)atomicAdd(cnt + ex1, 1u);
                int* r = route + (size_t)row2 * 8; r[0] = ex0; r[1] = ex1; r[2] = p0; r[3] = p1; r[6] = __float_as_int(w0); r[7] = __float_as_int(w1); } }
        __syncthreads();
    }
}
__device__ __forceinline__ void phase_gather(const Ctx& c, const Args& a, int layer) {
    LAS int* lbase = (LAS int*)c.lds; LAS int* lcnt = lbase + 64;
    if (c.tid == 0) {
        const unsigned* cnt = (const unsigned*)(a.ws + WS_CTL) + CW_CNT + layer * 64; int* plan = (int*)(a.ws + WS_CTL) + CW_PLAN + layer * 512;
        int t = 0;
        for (int e = 0; e < NEXP; ++e) { const int n = (int)__hip_atomic_load(cnt + e, __ATOMIC_RELAXED, __HIP_MEMORY_SCOPE_AGENT), nt = (n + 255) / 256; lbase[e] = t * 256; lcnt[e] = n;
            if (c.bid == 0) { plan[1 + e] = t * 256; for (int q = 0; q < nt; ++q) plan[128 + t + q] = e; }
            t += nt; }
        if (c.bid == 0) plan[0] = t;
    }
    __syncthreads();
    int* route = (int*)(a.ws + WS_ROUTE); int* rowlist = (int*)(a.ws + WS_ROWLIST);
    for (int T = c.bid * NTHR + c.tid; T < NVALID * 2; T += c.nblk * NTHR) {
        const int row = ROWV + (T >> 1), j = T & 1; int* r = route + (size_t)row * 8;
        const int slot = lbase[r[j]] + r[2 + j];
        r[4 + j] = slot; rowlist[slot] = row;
    }
    for (int e = c.bid; e < NEXP; e += c.nblk) { const int n = lcnt[e], end = ((n + 255) / 256) * 256;
        for (int i = n + c.tid; i < end; i += NTHR) rowlist[lbase[e] + i] = 0; }
    __syncthreads();
}
struct HgRaw { float f[16], q[16], v[16]; };
__device__ __forceinline__ float bf2f(bf16 x) { return __uint_as_float((unsigned)x << 16); }
template <bool NEEDQ> __device__ __forceinline__ void hg_load(HgRaw& r, const unsigned char* R1, int r0, int head, int dir, int k, int tq) {
    const bf16* fb = (const bf16*)(R1 + R1_F) + (size_t)(r0 + 16 * tq) * 4096 + 2048 * dir + head * 128 + k;
    const bf16* vb = (const bf16*)(R1 + R1_VB) + (size_t)(r0 + 16 * tq) * D + head * 128 + k; const bf16* qb = (const bf16*)(R1 + R1_QB) + (size_t)(r0 + 16 * tq) * D + head * 128 + k;
#pragma unroll
    for (int i = 0; i < 16; ++i) { r.f[i] = 1.0f - bf2f(fb[(size_t)i * 4096]); r.v[i] = bf2f(vb[(size_t)i * D]); if (NEEDQ) r.q[i] = bf2f(qb[(size_t)i * D]); }
}
constexpr int HG_T = HG_SCR;
template <bool NEEDQ> __device__ __forceinline__ float hg_prep(const Ctx& c, const HgRaw& r, int r0, int dir, int k, int tq, int lane) {
    LAS unsigned char* L = c.lds;
    float g[16], kk[16], cs[16];
#pragma unroll
    for (int i = 0; i < 16; ++i) { const bool valid = (r0 + 16 * tq + i) >= ROWV; g[i] = valid ? __logf(r.f[i]) : 0.f; kk[i] = valid ? 1.0f - r.f[i] : 0.f; }
    if (dir == 0) { cs[0] = g[0];
#pragma unroll
        for (int i = 1; i < 16; ++i) cs[i] = cs[i - 1] + g[i]; }
    else { cs[15] = g[15];
#pragma unroll
        for (int i = 14; i >= 0; --i) cs[i] = cs[i + 1] + g[i]; }
    LAS float* T = (LAS float*)(L + HG_T);
    T[tq * 128 + k] = dir == 0 ? cs[15] : cs[0];
    __syncthreads();
    const float t0 = T[k], t1 = T[128 + k], t2 = T[256 + k], t3 = T[384 + k];
    const float btot = (t0 + t1) + (t2 + t3);
    float off;
    if (dir == 0) off = tq == 0 ? 0.f : tq == 1 ? t0 : tq == 2 ? t0 + t1 : t0 + t1 + t2;
    else off = tq == 3 ? 0.f : tq == 2 ? t3 : tq == 1 ? t3 + t2 : t3 + t2 + t1;
    unsigned kh[8], vt[8];
#pragma unroll
    for (int i = 0; i < 16; i += 2) {
        const float b0 = off + cs[i], b1 = off + cs[i + 1];
        const unsigned pk = pkbf(kk[i] * __expf(-b0), kk[i + 1] * __expf(-b1));
        kh[i >> 1] = pk; vt[i >> 1] = pkbf(r.v[i], r.v[i + 1]);
        if (NEEDQ) { const int t = 16 * tq + i; const unsigned pq = pkbf(r.q[i] * __expf(b0), r.q[i + 1] * __expf(b1));
            *(LAS unsigned short*)(L + HG_QT + t * LD_K + 2 * k) = (unsigned short)pq; *(LAS unsigned short*)(L + HG_QT + (t + 1) * LD_K + 2 * k) = (unsigned short)(pq >> 16);
            *(LAS unsigned short*)(L + HG_KT + t * LD_K + 2 * k) = (unsigned short)pk; *(LAS unsigned short*)(L + HG_KT + (t + 1) * LD_K + 2 * k) = (unsigned short)(pk >> 16); }
    }
    *(LAS v4u*)(L + HG_KH + k * LD_T + 32 * tq) = (v4u){kh[0], kh[1], kh[2], kh[3]};
    *(LAS v4u*)(L + HG_KH + k * LD_T + 32 * tq + 16) = (v4u){kh[4], kh[5], kh[6], kh[7]};
    *(LAS v4u*)(L + HG_VT + k * LD_T + 32 * tq) = (v4u){vt[0], vt[1], vt[2], vt[3]};
    *(LAS v4u*)(L + HG_VT + k * LD_T + 32 * tq + 16) = (v4u){vt[4], vt[5], vt[6], vt[7]};
    if (tq == 0) ((LAS float*)(L + HG_DV))[k] = __expf(btot);
    return btot;
}
__device__ __forceinline__ void hg_update(LAS unsigned char* Lb, int w, f32x4 (&S)[8], int r, int q) {
#pragma unroll
    for (int ks = 0; ks < 2; ++ks) { const bf16x8 b = ldfrag(Lb + HG_VT, 16 * w + r, LD_T, (32 * ks + 8 * q) * 2);
#pragma unroll
        for (int kt = 0; kt < 8; ++kt) { const bf16x8 a2 = ldfrag(Lb + HG_KH, 16 * kt + r, LD_T, (32 * ks + 8 * q) * 2); S[kt] = MFMA16(a2, b, S[kt]); } }
#pragma unroll
    for (int kt = 0; kt < 8; ++kt) { const f32x4 d = *(const LAS f32x4*)(Lb + HG_DV + (16 * kt + 4 * q) * 4); S[kt] = S[kt] * d; }
}
__device__ __forceinline__ void hg_seg_range(int seg, int& c0, int& n) { if (seg == 0) { c0 = 3; n = 9; } else { c0 = 4 + 8 * seg; n = 8; } }
__device__ __forceinline__ void glds16(const unsigned char* gsrc_lane, LAS unsigned char* lds_wave) { __builtin_amdgcn_global_load_lds((const unsigned*)gsrc_lane, (LAS unsigned*)lds_wave, 16, 0, 0); }
__device__ __forceinline__ void phase_hg_build(const Ctx& c, const Args& a) {
    const unsigned char* R1 = a.ws + WS_R1; unsigned char* IMG = a.ws + WS_R1 + R1_IMG; LAS unsigned char* L = c.lds;
    for (int u = c.bid; u < 257 * 16; u += c.nblk) {
        int tv = c.tid; asm volatile("" : "+v"(tv));
        const int lane = tv & 63, k = tv & 127, tq = tv >> 7, ci = 3 + (u >> 4), head = u & 15, r0 = 64 * ci;
        unsigned char* img = IMG + ((size_t)ci * 16 + head) * IMG_SZ;
#pragma unroll 1
        for (int dir = 0; dir < 2; ++dir) {
            HgRaw raw; hg_load<true>(raw, R1, r0, head, dir, k, tq);
            (void)hg_prep<true>(c, raw, r0, dir, k, tq, lane);
            __syncthreads();
            for (int i = tv; i < 3392; i += NTHR) *(v4u*)(img + 18432 + (size_t)dir * 54272 + (size_t)i * 16) = *(const LAS v4u*)(L + HG_QT + i * 16);
            if (dir == 0) for (int i = tv; i < 1152; i += NTHR) *(v4u*)(img + (size_t)i * 16) = *(const LAS v4u*)(L + HG_VT + i * 16);
            if (dir == 0) { const bf16* gp = (const bf16*)(R1 + R1_GB) + (size_t)(r0 + 16 * tq) * D + head * 128 + k; float gv[16];
#pragma unroll
                for (int i = 0; i < 16; ++i) gv[i] = bf2f(gp[(size_t)i * D]);
                bf16* gt = (bf16*)(a.ws + WS_R1 + R1_GT) + ((size_t)ci * 16 + head) * 8192 + (size_t)(((k >> 4) * 4 + tq) * 64 + (k & 15)) * 4;
#pragma unroll
                for (int qq = 0; qq < 4; ++qq) { v2u w2; w2.x = pkbf(gv[4 * qq], gv[4 * qq + 1]); w2.y = pkbf(gv[4 * qq + 2], gv[4 * qq + 3]); *(v2u*)(gt + qq * 64) = w2; } }
            __syncthreads();
        }
    }
}
__device__ __forceinline__ void phase_hg_pass1(const Ctx& c, const Args& a) {
    const unsigned char* IMG = a.ws + WS_R1 + R1_IMG; LAS unsigned char* L = c.lds;
    float* DS = (float*)(a.ws + WS_R1 + R1_DS); float* DSEG = (float*)(a.ws + WS_R1 + R1_DSEG);
    const int w = c.wave;
    for (int u = c.bid; u < 1024; u += c.nblk) {
        int tv = c.tid; asm volatile("" : "+v"(tv));
        const int lane = tv & 63, r = lane & 15, q = lane >> 4;
        const int chain = u & 31, seg = u >> 5, dir = chain >> 4, head = chain & 15;
        int c0, n; hg_seg_range(seg, c0, n);
        f32x4 S[8];
#pragma unroll
        for (int kt = 0; kt < 8; ++kt) S[kt] = (f32x4){0.f, 0.f, 0.f, 0.f};
        float dprod = 1.0f;
#define HG1_ISSUE(step, buf) do { const int ci_ = dir == 0 ? c0 + (step) : c0 + n - 1 - (step); const unsigned char* img_ = IMG + ((size_t)ci_ * 16 + head) * IMG_SZ; LAS unsigned char* lb_ = L + (buf) * HB_SZ; \
            for (int p_ = w; p_ < 37; p_ += 8) { if (p_ < 18) glds16(img_ + p_ * 1024 + lane * 16, lb_ + HG_VT + p_ * 1024); \
                else glds16(img_ + 18432 + (size_t)dir * 54272 + (HG_KH - HG_QT) + (p_ - 18) * 1024 + lane * 16, lb_ + HG_KH + (p_ - 18) * 1024); } } while (0)
        HG1_ISSUE(0, 0);
        for (int j = 0; j < n; ++j) {
            asm volatile("s_waitcnt vmcnt(0)" ::: "memory"); __syncthreads();
            if (j + 1 < n) HG1_ISSUE(j + 1, (j + 1) & 1);
            LAS unsigned char* Lb = L + (j & 1) * HB_SZ;
            hg_update(Lb, w, S, r, q);
            if (tv < 128) dprod *= *(const LAS float*)(Lb + HG_DV + tv * 4);
        }
#undef HG1_ISSUE
        float* dst = DS + ((size_t)seg * 32 + chain) * 16384 + w * 2048 + lane;
#pragma unroll
        for (int kt = 0; kt < 8; ++kt)
#pragma unroll
            for (int e = 0; e < 4; ++e) dst[(kt * 4 + e) * 64] = S[kt][e];
        if (tv < 128) DSEG[((size_t)seg * 32 + chain) * 128 + tv] = dprod;
        __syncthreads();
    }
}
__device__ __forceinline__ void phase_hg_segscan(const Ctx& c, const Args& a) {
    float* DS = (float*)(a.ws + WS_R1 + R1_DS); const float* DSEG = (const float*)(a.ws + WS_R1 + R1_DSEG);
    for (int i = c.bid * NTHR + c.tid; i < 32 * 4096; i += c.nblk * NTHR) {
        const int chain = i >> 12, e4 = i & 4095, el = e4 * 4, ln = el & 63, e = (el >> 6) & 3, kt = (el >> 8) & 7, k = 16 * kt + 4 * (ln >> 4) + e, dir = chain >> 4;
        f32x4 run = (f32x4){0.f, 0.f, 0.f, 0.f};
        for (int j0 = 0; j0 < 32; j0 += 8) { f32x4 ds[8]; float d[8];
#pragma unroll
            for (int j = 0; j < 8; ++j) { const int sg = dir == 0 ? j0 + j : 31 - j0 - j; ds[j] = *((const f32x4*)(DS + ((size_t)sg * 32 + chain) * 16384) + e4); d[j] = DSEG[((size_t)sg * 32 + chain) * 128 + k]; }
#pragma unroll
            for (int j = 0; j < 8; ++j) { const int sg = dir == 0 ? j0 + j : 31 - j0 - j; *((f32x4*)(DS + ((size_t)sg * 32 + chain) * 16384) + e4) = run; run = run * d[j] + ds[j]; } }
    }
}
template <int DIR> __device__ __forceinline__ void phase_hg_pass2(const Ctx& c, const Args& a) {
    const unsigned char* IMG = a.ws + WS_R1 + R1_IMG;
    const float* DS = (const float*)(a.ws + WS_R1 + R1_DS);
    bf16* OBW = (bf16*)(a.ws + WS_R1 + R1_OBW); const bf16* GB = (const bf16*)(a.ws + WS_R1 + R1_GB); bf16* MI = (bf16*)(a.ws + WS_MIXIN);
    LAS unsigned char* L = c.lds;
    const int w = c.wave;
    for (int u = c.bid; u < 512; u += c.nblk) {
        int tv = c.tid; asm volatile("" : "+v"(tv));
        const int lane = tv & 63, r = lane & 15, q = lane >> 4;
        const int head = u & 15, seg = u >> 4, dir = DIR, chain = dir * 16 + head;
        int c0, n; hg_seg_range(seg, c0, n);
        f32x4 S[8];
        { const float* src = DS + ((size_t)seg * 32 + chain) * 16384 + w * 2048 + lane;
#pragma unroll
          for (int kt = 0; kt < 8; ++kt)
#pragma unroll
              for (int e = 0; e < 4; ++e) S[kt][e] = src[(kt * 4 + e) * 64]; }
#define HG2_ISSUE(step, buf) do { const int ci_ = dir == 0 ? c0 + (step) : c0 + n - 1 - (step); const unsigned char* img_ = IMG + ((size_t)ci_ * 16 + head) * IMG_SZ; LAS unsigned char* lb_ = L + (buf) * HB_SZ; \
            for (int p_ = w; p_ < 71; p_ += 8) { if (p_ < 18) glds16(img_ + p_ * 1024 + lane * 16, lb_ + HG_VT + p_ * 1024); \
                else glds16(img_ + 18432 + (size_t)dir * 54272 + (p_ - 18) * 1024 + lane * 16, lb_ + HG_QT + (p_ - 18) * 1024); } } while (0)
        HG2_ISSUE(0, 0);
        float ng = 0.f; if (DIR == 0) ng = a.in[I_NORMG][head * 128 + 16 * w + r];
        f32x4 po[4]; v2u pg[4]; int pci = 0;
#pragma unroll
        for (int tt = 0; tt < 4; ++tt) { po[tt] = (f32x4){0.f, 0.f, 0.f, 0.f}; pg[tt] = (v2u){0u, 0u}; }
#define HG2_FLUSH(par) do { if (DIR == 1) { v2u* ob_ = (v2u*)(OBW + ((size_t)pci * 16 + head) * 8192) + (w * 4) * 64 + lane; \
                _Pragma("unroll") for (int tt = 0; tt < 4; ++tt) { v2u w2; w2.x = pkbf(po[tt][0], po[tt][1]); w2.y = pkbf(po[tt][2], po[tt][3]); ob_[tt * 64] = w2; } \
            } else { const LAS float* RS_ = (const LAS float*)(L + HG_SCR + (par) * 2048); bf16* mi_ = MI + (size_t)(64 * pci) * D + head * 128 + 16 * w + r; \
                  \
                const int town_ = 16 * (r >> 2) + 4 * q + (r & 3); const f32x4 s0 = *(const LAS f32x4*)(RS_ + town_ * 8), s1 = *(const LAS f32x4*)(RS_ + town_ * 8 + 4); \
                const float rsown_ = 1.0f / sqrtf(((s0.x + s0.y) + (s0.z + s0.w) + (s1.x + s1.y) + (s1.z + s1.w)) * (1.0f / 128.0f) + 1e-6f); \
                _Pragma("unroll") for (int tt = 0; tt < 4; ++tt) { const f32x4 g4 = bf4(pg[tt]); \
                    _Pragma("unroll") for (int e = 0; e < 4; ++e) { const int t = 16 * tt + 4 * q + e; const float rs = __shfl(rsown_, (lane & 48) + 4 * tt + e); \
                        mi_[(size_t)t * D] = (bf16)f2bf(64 * pci + t >= ROWV ? po[tt][e] * rs * ng * g4[e] : 0.f); } } } } while (0)
        for (int j = 0; j < n; ++j) {
            const int ci = dir == 0 ? c0 + j : c0 + n - 1 - j;
            asm volatile("s_waitcnt vmcnt(0)" ::: "memory"); __syncthreads();
            if (j + 1 < n) HG2_ISSUE(j + 1, (j + 1) & 1);
            if (j > 0) HG2_FLUSH((j - 1) & 1);
            LAS unsigned char* Lb = L + (j & 1) * HB_SZ;
            v2u obp[4], gtp[4];
            if (DIR == 0) { const v2u* ob_ = (const v2u*)(OBW + ((size_t)ci * 16 + head) * 8192) + (w * 4) * 64 + lane; const v2u* gt_ = (const v2u*)((const bf16*)(a.ws + WS_R1 + R1_GT) + ((size_t)ci * 16 + head) * 8192) + (w * 4) * 64 + lane;
#pragma unroll
                for (int tt = 0; tt < 4; ++tt) { obp[tt] = ob_[tt * 64]; gtp[tt] = gt_[tt * 64]; } }
            f32x4 o[4];
#pragma unroll
            for (int tp = 0; tp < 2; ++tp) {
                o[2 * tp] = (f32x4){0.f, 0.f, 0.f, 0.f}; o[2 * tp + 1] = (f32x4){0.f, 0.f, 0.f, 0.f};
                bf16x8 qf[2][4];
#pragma unroll
                for (int h = 0; h < 2; ++h)
#pragma unroll
                    for (int ks = 0; ks < 4; ++ks) qf[h][ks] = ldfrag(Lb + HG_QT, 16 * (2 * tp + h) + r, LD_K, (32 * ks + 8 * q) * 2);
                unsigned pp[2][4][2];
#pragma unroll
                for (int st = 0; st < 4; ++st) { f32x4 acc[2] = {(f32x4){0.f, 0.f, 0.f, 0.f}, (f32x4){0.f, 0.f, 0.f, 0.f}};
#pragma unroll
                    for (int ks = 0; ks < 4; ++ks) { const bf16x8 kf = ldfrag(Lb + HG_KT, 16 * st + r, LD_K, (32 * ks + 8 * q) * 2); acc[0] = MFMA16(kf, qf[0][ks], acc[0]); acc[1] = MFMA16(kf, qf[1][ks], acc[1]); }
#pragma unroll
                    for (int h = 0; h < 2; ++h) { const int s0 = 16 * st + 4 * q, t = 16 * (2 * tp + h) + r;
                        const float m0 = (dir == 0 ? (s0 <= t) : (s0 >= t)) ? acc[h][0] : 0.f, m1 = (dir == 0 ? (s0 + 1 <= t) : (s0 + 1 >= t)) ? acc[h][1] : 0.f;
                        const float m2 = (dir == 0 ? (s0 + 2 <= t) : (s0 + 2 >= t)) ? acc[h][2] : 0.f, m3 = (dir == 0 ? (s0 + 3 <= t) : (s0 + 3 >= t)) ? acc[h][3] : 0.f;
                        pp[h][st][0] = pkbf(m0, m1); pp[h][st][1] = pkbf(m2, m3); } }
#pragma unroll
                for (int ks = 0; ks < 2; ++ks) {
                    const LAS unsigned char* vp = Lb + HG_VT + (16 * w + r) * LD_T + (32 * ks + 4 * q) * 2; const v2u lo = *(const LAS v2u*)vp, hi = *(const LAS v2u*)(vp + 32);
                    const v4u vf = (v4u){lo.x, lo.y, hi.x, hi.y};
#pragma unroll
                    for (int h = 0; h < 2; ++h) { const v4u af = (v4u){pp[h][2 * ks][0], pp[h][2 * ks][1], pp[h][2 * ks + 1][0], pp[h][2 * ks + 1][1]};
                        o[2 * tp + h] = MFMA16(__builtin_bit_cast(bf16x8, af), __builtin_bit_cast(bf16x8, vf), o[2 * tp + h]); } }
            }
#pragma unroll
            for (int ks = 0; ks < 4; ++ks) { v4u sb; sb.x = pkbf(S[2 * ks][0], S[2 * ks][1]); sb.y = pkbf(S[2 * ks][2], S[2 * ks][3]); sb.z = pkbf(S[2 * ks + 1][0], S[2 * ks + 1][1]); sb.w = pkbf(S[2 * ks + 1][2], S[2 * ks + 1][3]);
                const bf16x8 bf = __builtin_bit_cast(bf16x8, sb);
#pragma unroll
                for (int tt = 0; tt < 4; ++tt) { const LAS unsigned char* qp = Lb + HG_QT + (16 * tt + r) * LD_K + (32 * ks + 4 * q) * 2; const v2u lo = *(const LAS v2u*)qp, hi = *(const LAS v2u*)(qp + 32);
                    const v4u t4 = (v4u){lo.x, lo.y, hi.x, hi.y}; o[tt] = MFMA16(__builtin_bit_cast(bf16x8, t4), bf, o[tt]); } }
            hg_update(Lb, w, S, r, q);
            pci = ci;
            if (DIR == 1) {
#pragma unroll
                for (int tt = 0; tt < 4; ++tt) po[tt] = o[tt];
            } else {
                LAS float* RS = (LAS float*)(L + HG_SCR + (j & 1) * 2048);
                float ss[16];
#pragma unroll
                for (int tt = 0; tt < 4; ++tt) { const f32x4 b4 = bf4(obp[tt]); o[tt] = o[tt] + b4;
#pragma unroll
                    for (int e = 0; e < 4; ++e) ss[tt * 4 + e] = o[tt][e] * o[tt][e]; }
                float b8[8], b4v[4], b2v[2], tot;
#pragma unroll
                for (int i = 0; i < 8; ++i) { const float keep = (r & 8) ? ss[i + 8] : ss[i], send = (r & 8) ? ss[i] : ss[i + 8]; b8[i] = keep + __shfl_xor(send, 8); }
#pragma unroll
                for (int i = 0; i < 4; ++i) { const float keep = (r & 4) ? b8[i + 4] : b8[i], send = (r & 4) ? b8[i] : b8[i + 4]; b4v[i] = keep + __shfl_xor(send, 4); }
#pragma unroll
                for (int i = 0; i < 2; ++i) { const float keep = (r & 2) ? b4v[i + 2] : b4v[i], send = (r & 2) ? b4v[i] : b4v[i + 2]; b2v[i] = keep + __shfl_xor(send, 2); }
                { const float keep = (r & 1) ? b2v[1] : b2v[0], send = (r & 1) ? b2v[0] : b2v[1]; tot = keep + __shfl_xor(send, 1); }
                RS[(16 * (r >> 2) + 4 * q + (r & 3)) * 8 + w] = tot;
#pragma unroll
                for (int tt = 0; tt < 4; ++tt) { po[tt] = o[tt]; pg[tt] = gtp[tt]; }
            }
        }
#undef HG2_ISSUE
        __syncthreads();
        HG2_FLUSH((n - 1) & 1);
#undef HG2_FLUSH
    }
    if (DIR == 0) { for (int i = c.bid * NTHR + c.tid; i < 192 * D / 8; i += c.nblk * NTHR) ((v4u*)MI)[i] = (v4u){0u, 0u, 0u, 0u}; }
}
constexpr int NPHASE = 40;
__global__ void __launch_bounds__(NTHR, 2) fwd(Args args) {
    extern __shared__ __attribute__((aligned(16))) unsigned char lds[];
    Ctx c; c.lds = (LAS unsigned char*)lds; c.ldsg = lds; c.tid = threadIdx.x; c.lane = c.tid & 63; c.wave = __builtin_amdgcn_readfirstlane(c.tid >> 6);
    c.bid = blockIdx.x; c.nblk = gridDim.x; c.gw = c.bid * NWAVES + c.wave; c.ngw = c.nblk * NWAVES;
    volatile LAS unsigned* MISC = (volatile LAS unsigned*)(c.lds + MISC_OFF);
    for (int u = c.tid; u < (LDS_BYTES - MISC_OFF) / 4; u += NTHR) ((LAS unsigned*)(c.lds + MISC_OFF))[u] = 0u;
    __syncthreads();
    const int lo = args.ph_lo, hi = args.ph_hi;
#ifdef PROBE_MASK
    float g_probe_scale = 1.0f;
#endif
    const bool multi = (hi - lo) > 1;
    XcdBarrier bar; bar.bar = (unsigned*)(args.ws + WS_CTL) + CW_BAR; bar.x = 0; bar.st = nullptr;
    if (multi) bar = xcd_barrier_post((unsigned*)(args.ws + WS_CTL) + CW_BAR, MISC + 8);
#define IN(k) (lo <= (k) && (k) < hi)
#ifdef PROBE_MASK
#define STAMP(k) do { if (c.bid == 0 && c.tid == 0) ((unsigned long long*)((unsigned*)(args.ws + WS_CTL) + CW_TS))[(k)] = __builtin_amdgcn_s_memrealtime(); } while (0)
#else
#define STAMP(k) do { } while (0)
#endif
#define SEAM(k) do { if (IN(k) && IN((k) + 1)) { STAMP(64 + (k)); xcd_barrier(bar); STAMP((k) + 1); } } while (0)
    STAMP(0);
    unsigned char* ws = args.ws;
    float* HA = (float*)(ws + WS_HA); float* HBuf = (float*)(ws + WS_HB);
    const pg8::bf16_t* HBF = (const pg8::bf16_t*)(ws + WS_HBF);
    const pg8::bf16_t* MIXIN = (const pg8::bf16_t*)(ws + WS_MIXIN);
    if (IN(0)) { phase_init(c, args);
#if defined(DUP_PHASE)
        if (DUP_PHASE == 0) { xcd_barrier(bar); phase_init(c, args); }
#endif
    } SEAM(0);
    if (IN(1)) { phase_s5_ktab(c, args);
#if defined(DUP_PHASE)
        if (DUP_PHASE == 1) { xcd_barrier(bar); phase_s5_ktab(c, args); }
#endif
    } SEAM(1);
    if (IN(2)) { phase_weights(c, args); phase_s5_fill(c, args);
#if defined(DUP_PHASE)
        if (DUP_PHASE == 2) { xcd_barrier(bar); phase_weights(c, args); phase_s5_fill(c, args); }
#endif
    } SEAM(2);
    if (IN(3)) { skinny_gemm2(c, (const bf16*)HBF, D, (const bf16*)(ws + WS_WAB), D, ABN, SkAB2{ws});
        zero_rows_bf16(c, (bf16*)(ws + WS_QB0), 1024, 192, ROWV); zero_rows_bf16(c, (bf16*)(ws + WS_KB0), 256, 192, ROWV); zero_rows_bf16(c, (bf16*)(ws + WS_VB0), 256, 192, ROWV);
        for (int i = c.bid * NTHR + c.tid; i < 64 * 256; i += c.nblk * NTHR) ((bf16*)(ws + WS_R1 + R1_UA))[(size_t)(i >> 8) * 768 * 768 + (i & 255)] = 0;
        pg8::Gemm g = pg8::mkgemm(HBF, ws + WS_WAB, SEQ, ABN, D); pg8::StaticOrder S; S.init(SEQ, ABN, c.nblk, c.bid, 1);
        pg8::EpiProjAB E{ws}; pg8::gemm_phase(c.lds, g, S, E);
        if (c.nblk == 256 && c.bid >= 128) conv_fill(c, args, 0, FILL3, c.bid - 128, c.nblk - 128);
    } SEAM(3);
    if (IN(4)) { phase_attn(c, args);
        if (c.nblk == 256 && c.bid >= 2) { __syncthreads(); conv_fill(c, args, FILL7, FILL4, c.bid - 2, c.nblk - 2); }
#if defined(DUP_PHASE)
        if (DUP_PHASE == 4) { xcd_barrier(bar); phase_attn(c, args); }
#endif
    } SEAM(4);
    if (IN(5)) { pg8::Gemm g = pg8::mkgemm(ws + WS_R1 + R1_UA, ws + WS_WST, 768, 256, 512, (size_t)256 * 512 * 2); g.lda = 768; g.astride = (size_t)768 * 768 * 2;
        pg8::GroupTileOrder S; S.init(64, 768, 256, c.nblk, c.bid); pg8::EpiF32 E{(float*)(ws + WS_R1 + R1_SALL), 256, (size_t)768 * 256}; pg8::gemm_phase(c.lds, g, S, E);
        if (c.nblk == 256 && c.bid >= 192) conv_fill(c, args, FILL3, FILL5, c.bid - 192, c.nblk - 192);
#if defined(DUP_PHASE)
        if (DUP_PHASE == 5) { xcd_barrier(bar); pg8::Gemm g = pg8::mkgemm(ws + WS_R1 + R1_UA, ws + WS_WST, 768, 256, 512, (size_t)256 * 512 * 2); g.lda = 768; g.astride = (size_t)768 * 768 * 2;
        pg8::GroupTileOrder S; S.init(64, 768, 256, c.nblk, c.bid); pg8::EpiF32 E{(float*)(ws + WS_R1 + R1_SALL), 256, (size_t)768 * 256}; pg8::gemm_phase(c.lds, g, S, E); }
#endif
    } SEAM(5);
    if (IN(6)) { phase_s5_chunkscan(c, args);
        if (c.nblk == 256 && c.bid >= 128) conv_fill(c, args, FILL5, FILL6, c.bid - 128, c.nblk - 128);
#if defined(DUP_PHASE)
        if (DUP_PHASE == 6) { xcd_barrier(bar); phase_s5_chunkscan(c, args); }
#endif
    } SEAM(6);
    if (IN(7)) { pg8::Gemm g = pg8::mkgemm(ws + WS_R1 + R1_UA, ws + WS_MWT, 768, 512, 768, (size_t)512 * 768 * 2); g.astride = (size_t)768 * 768 * 2;
        pg8::GroupTileOrder S; S.init(64, 768, 512, c.nblk, c.bid); pg8::EpiS5Y E{(pg8::bf16_t*)(ws + WS_ZB)}; pg8::gemm_phase(c.lds, g, S, E);
        if (c.nblk == 256 && c.bid >= 128) conv_fill(c, args, FILL6, FILL7, c.bid - 128, c.nblk - 128);
#if defined(DUP_PHASE)
        if (DUP_PHASE == 7) { xcd_barrier(bar); pg8::Gemm g = pg8::mkgemm(ws + WS_R1 + R1_UA, ws + WS_MWT, 768, 512, 768, (size_t)512 * 768 * 2); g.astride = (size_t)768 * 768 * 2;
        pg8::GroupTileOrder S; S.init(64, 768, 512, c.nblk, c.bid); pg8::EpiS5Y E{(pg8::bf16_t*)(ws + WS_ZB)}; pg8::gemm_phase(c.lds, g, S, E); }
#endif
    } SEAM(7);
    if (IN(8)) { skinny_gemm(c, (const bf16*)(ws + WS_ZB), 1024, (const bf16*)(ws + WS_WGLU), 1024, 1024, SkGlu{(const bf16*)(ws + WS_ZB), args.in[I_BGLU], (bf16*)(ws + WS_MIXIN)});
        pg8::Gemm g = pg8::mkgemm(ws + WS_ZB, ws + WS_WGLU, SEQ, 1024, 1024); pg8::StaticOrder S; S.init(SEQ, 1024, c.nblk, c.bid, 1);
        pg8::EpiGlu E{(const pg8::bf16_t*)(ws + WS_ZB), args.in[I_BGLU], (pg8::bf16_t*)(ws + WS_MIXIN)}; pg8::gemm_phase(c.lds, g, S, E);
#if defined(DUP_PHASE)
        if (DUP_PHASE == 8) { xcd_barrier(bar); skinny_gemm(c, (const bf16*)(ws + WS_ZB), 1024, (const bf16*)(ws + WS_WGLU), 1024, 1024, SkGlu{(const bf16*)(ws + WS_ZB), args.in[I_BGLU], (bf16*)(ws + WS_MIXIN)});
        pg8::Gemm g = pg8::mkgemm(ws + WS_ZB, ws + WS_WGLU, SEQ, 1024, 1024); pg8::StaticOrder S; S.init(SEQ, 1024, c.nblk, c.bid, 1);
        pg8::EpiGlu E{(const pg8::bf16_t*)(ws + WS_ZB), args.in[I_BGLU], (pg8::bf16_t*)(ws + WS_MIXIN)}; pg8::gemm_phase(c.lds, g, S, E); }
#endif
    } SEAM(8);
    if (IN(9)) { skinny_gemm(c, (const bf16*)MIXIN, D, (const bf16*)(ws + WS_WOAB), D, D, SkBf16{(bf16*)(ws + WS_MIX), D});
        pg8::Gemm g = pg8::mkgemm(MIXIN, ws + WS_WOAB, SEQ, D, D); pg8::StaticOrder S; S.init(SEQ, D, c.nblk, c.bid, 1);
        pg8::EpiBf16 E{(pg8::bf16_t*)(ws + WS_MIX), D}; pg8::gemm_phase(c.lds, g, S, E);
#if defined(DUP_PHASE)
        if (DUP_PHASE == 9) { xcd_barrier(bar); skinny_gemm(c, (const bf16*)MIXIN, D, (const bf16*)(ws + WS_WOAB), D, D, SkBf16{(bf16*)(ws + WS_MIX), D});
        pg8::Gemm g = pg8::mkgemm(MIXIN, ws + WS_WOAB, SEQ, D, D); pg8::StaticOrder S; S.init(SEQ, D, c.nblk, c.bid, 1);
        pg8::EpiBf16 E{(pg8::bf16_t*)(ws + WS_MIX), D}; pg8::gemm_phase(c.lds, g, S, E); }
#endif
    } SEAM(9);
    if (IN(10)) { phase_ln_mix(c, args, 0);
#if defined(DUP_PHASE)
        if (DUP_PHASE == 10) { xcd_barrier(bar); phase_ln_mix(c, args, 0); }
#endif
    } SEAM(10);
    if (IN(11)) { phase_router(c, args, 0);
        if (c.nblk == 256 && c.bid != 0) { __syncthreads(); conv_fill(c, args, R11_LO, R11_HI, c.bid - 1, 255); }
#if defined(DUP_PHASE)
        if (DUP_PHASE == 11) { xcd_barrier(bar); phase_router(c, args, 0); }
#endif
    } SEAM(11);
    if (IN(12)) { phase_gather(c, args, 0);
#if defined(DUP_PHASE)
        if (DUP_PHASE == 12) { xcd_barrier(bar); phase_gather(c, args, 0); }
#endif
    } SEAM(12);
    if (IN(13)) { pg8::Gemm g = pg8::mkgemm(ws + WS_H8, ws + WS_WGU, MPAD, 1024, D / 2, (size_t)1024 * D); pg8::GatherOrder S; S.init((const int*)(ws + WS_CTL) + CW_PLAN, 1024, c.nblk, c.bid, (const int*)(ws + WS_ROWLIST));
        pg8::EpiSwiGLU8 E{ws + WS_R1 + R1_ACT, DEXP}; pg8::gemm_phase<pg8::EpiSwiGLU8, pg8::GatherOrder, true>(c.lds, g, S, E, 0x79797979);
        if (c.nblk == 256) { const int nwg = ((const int*)(ws + WS_CTL))[CW_PLAN] * 4, rank = (c.bid % 8) * 32 + c.bid / 8 - (nwg - 512);
            if (nwg > 512 && nwg < 768 && rank >= 0 && rank < 128) { __syncthreads(); const int b0 = R13_LO + rank * 40; for (int it = b0 + c.wave; it < b0 + 40; it += NWAVES) conv_l1_item(c, args, it); __syncthreads(); } }
#if defined(DUP_PHASE)
        if (DUP_PHASE == 13) { xcd_barrier(bar); pg8::Gemm g = pg8::mkgemm(ws + WS_H8, ws + WS_WGU, MPAD, 1024, D / 2, (size_t)1024 * D); pg8::GatherOrder S; S.init((const int*)(ws + WS_CTL) + CW_PLAN, 1024, c.nblk, c.bid, (const int*)(ws + WS_ROWLIST));
        pg8::EpiSwiGLU8 E{ws + WS_R1 + R1_ACT, DEXP}; pg8::gemm_phase<pg8::EpiSwiGLU8, pg8::GatherOrder, true>(c.lds, g, S, E, 0x79797979); }
#endif
    } SEAM(13);
    if (IN(14)) { pg8::Gemm g = pg8::mkgemm(ws + WS_R1 + R1_ACT, ws + WS_WD, MPAD, D, DEXP / 2, (size_t)D * DEXP); pg8::GroupedOrder S; S.init((const int*)(ws + WS_CTL) + CW_PLAN, D, c.nblk, c.bid);
        pg8::EpiBf16 E{(pg8::bf16_t*)(ws + WS_R1 + R1_Y), D}; pg8::gemm_phase<pg8::EpiBf16, pg8::GroupedOrder, true>(c.lds, g, S, E, 0x79797979);
#if defined(DUP_PHASE)
        if (DUP_PHASE == 14) { xcd_barrier(bar); pg8::Gemm g = pg8::mkgemm(ws + WS_R1 + R1_ACT, ws + WS_WD, MPAD, D, DEXP / 2, (size_t)D * DEXP); pg8::GroupedOrder S; S.init((const int*)(ws + WS_CTL) + CW_PLAN, D, c.nblk, c.bid);
        pg8::EpiBf16 E{(pg8::bf16_t*)(ws + WS_R1 + R1_Y), D}; pg8::gemm_phase<pg8::EpiBf16, pg8::GroupedOrder, true>(c.lds, g, S, E, 0x79797979); }
#endif
    } SEAM(14);
    if (IN(15)) { phase_ln_ffn(c, args, 0, false PROBE_PASS);
#if defined(DUP_PHASE)
        if (DUP_PHASE == 15) { xcd_barrier(bar); phase_ln_ffn(c, args, 0, false PROBE_PASS); }
#endif
    } SEAM(15);
    if (IN(16)) { skinny_gemm(c, (const bf16*)HBF, D, (const bf16*)(ws + WS_WC), D, CN, SkC{(bf16*)(ws + WS_R1 + R1_QB), (bf16*)(ws + WS_R1 + R1_VB), (bf16*)(ws + WS_R1 + R1_GB), (bf16*)(ws + WS_R1 + R1_F), (const float*)(ws + WS_LBT)});
        zero_rows_bf16(c, (bf16*)(ws + WS_R1 + R1_F), 4096, 192, ROWV); zero_rows_bf16(c, (bf16*)(ws + WS_R1 + R1_QB), D, 192, ROWV); zero_rows_bf16(c, (bf16*)(ws + WS_R1 + R1_VB), D, 192, ROWV); zero_rows_bf16(c, (bf16*)(ws + WS_R1 + R1_GB), D, 192, ROWV);
        pg8::Gemm g = pg8::mkgemm(ws + WS_H8, ws + WS_WC8, SEQ, CN, D / 2); pg8::StaticOrder S; S.init(SEQ, 6144, c.nblk, c.bid, 1, 16);
        pg8::EpiProjC E{ws + WS_R1, (const float*)(ws + WS_LBT)}; pg8::gemm_phase<pg8::EpiProjC, pg8::StaticOrder, true>(c.lds, g, S, E, 0x79797979);
        pg8::Gemm g2 = pg8::mkgemm(HBF, ws + WS_WC, SEQ, CN, D); pg8::StaticOrder S2; S2.init(SEQ, 4096, c.nblk, c.bid, 1, 0);
        __syncthreads(); pg8::gemm_phase(c.lds, g2, S2, E);
#if defined(DUP_PHASE)
        if (DUP_PHASE == 16) { xcd_barrier(bar); pg8::gemm_phase<pg8::EpiProjC, pg8::StaticOrder, true>(c.lds, g, S, E, 0x79797979); __syncthreads(); pg8::gemm_phase(c.lds, g2, S2, E); }
#endif
    } SEAM(16);
    if (IN(17)) { phase_hg_build(c, args); if (c.nblk == 256 && c.bid >= 16) { __syncthreads(); conv_fill(c, args, R17_LO, R17_HI, c.bid - 16, 240); } xcd_barrier(bar); phase_hg_pass1(c, args); xcd_barrier(bar); phase_hg_segscan(c, args); xcd_barrier(bar); phase_hg_pass2<1>(c, args);
#if defined(DUP_PHASE)
        if (DUP_PHASE == 17) { xcd_barrier(bar); phase_hg_build(c, args); }
        if (DUP_PHASE == 170) { xcd_barrier(bar); phase_hg_pass1(c, args); xcd_barrier(bar); phase_hg_segscan(c, args); }
        if (DUP_PHASE == 171) { xcd_barrier(bar); phase_hg_pass2<1>(c, args); }
#endif
    } SEAM(17);
    if (IN(18)) { phase_hg_pass2<0>(c, args);
#if defined(DUP_PHASE)
        if (DUP_PHASE == 18) { xcd_barrier(bar); phase_hg_pass2<0>(c, args); }
#endif
    } SEAM(18);
    if (IN(19)) { skinny_gemm(c, (const bf16*)MIXIN, D, (const bf16*)(ws + WS_WOC), D, D, SkBf16{(bf16*)(ws + WS_MIX), D});
        pg8::Gemm g = pg8::mkgemm(MIXIN, ws + WS_WOC, SEQ, D, D); pg8::StaticOrder S; S.init(SEQ, D, c.nblk, c.bid, 1);
        pg8::EpiBf16 E{(pg8::bf16_t*)(ws + WS_MIX), D}; pg8::gemm_phase(c.lds, g, S, E);
#if defined(DUP_PHASE)
        if (DUP_PHASE == 19) { xcd_barrier(bar); skinny_gemm(c, (const bf16*)MIXIN, D, (const bf16*)(ws + WS_WOC), D, D, SkBf16{(bf16*)(ws + WS_MIX), D});
        pg8::Gemm g = pg8::mkgemm(MIXIN, ws + WS_WOC, SEQ, D, D); pg8::StaticOrder S; S.init(SEQ, D, c.nblk, c.bid, 1);
        pg8::EpiBf16 E{(pg8::bf16_t*)(ws + WS_MIX), D}; pg8::gemm_phase(c.lds, g, S, E); }
#endif

#if defined(DUP_PHASE)
        if (DUP_PHASE == 190) { xcd_barrier(bar); pg8::EpiNull EN{(float*)(ws + WS_CTL) + 70000}; pg8::gemm_phase(c.lds, g, S, EN); }
#endif
    } SEAM(19);
    if (IN(20)) { phase_ln_mix(c, args, 1);
#if defined(DUP_PHASE)
        if (DUP_PHASE == 20) { xcd_barrier(bar); phase_ln_mix(c, args, 1); }
#endif
    } SEAM(20);
    if (IN(21)) { phase_router(c, args, 1);
        if (c.nblk == 256 && c.bid != 0) { __syncthreads(); conv_fill(c, args, R21_LO, R21_HI, c.bid - 1, 255); }
#if defined(DUP_PHASE)
        if (DUP_PHASE == 21) { xcd_barrier(bar); phase_router(c, args, 1); }
#endif
    } SEAM(21);
    if (IN(22)) {
        if (c.nblk == 256) { const int nwg = ((const int*)(ws + WS_CTL))[CW_PLAN] * 4, done = (nwg > 512 && nwg < 768) ? ((768 - nwg) < 128 ? (768 - nwg) : 128) : 0;
            for (int it = R13_LO + done * 40 + c.gw; it < R13_HI; it += c.ngw) conv_l1_item(c, args, it);
            __syncthreads(); }
        phase_gather(c, args, 1);
#if defined(DUP_PHASE)
        if (DUP_PHASE == 22) { xcd_barrier(bar); phase_gather(c, args, 1); }
#endif
    } SEAM(22);
    if (IN(23)) { pg8::Gemm g = pg8::mkgemm(ws + WS_H8, ws + WS_WGU + (size_t)NEXP * 1024 * D, MPAD, 1024, D / 2, (size_t)1024 * D); pg8::GatherOrder S; S.init((const int*)(ws + WS_CTL) + CW_PLAN + 512, 1024, c.nblk, c.bid, (const int*)(ws + WS_ROWLIST));
        pg8::EpiSwiGLU8 E{ws + WS_R1 + R1_ACT, DEXP}; pg8::gemm_phase<pg8::EpiSwiGLU8, pg8::GatherOrder, true>(c.lds, g, S, E, 0x79797979);
#if defined(DUP_PHASE)
        if (DUP_PHASE == 23) { xcd_barrier(bar); pg8::Gemm g = pg8::mkgemm(ws + WS_H8, ws + WS_WGU + (size_t)NEXP * 1024 * D, MPAD, 1024, D / 2, (size_t)1024 * D); pg8::GatherOrder S; S.init((const int*)(ws + WS_CTL) + CW_PLAN + 512, 1024, c.nblk, c.bid, (const int*)(ws + WS_ROWLIST));
        pg8::EpiSwiGLU8 E{ws + WS_R1 + R1_ACT, DEXP}; pg8::gemm_phase<pg8::EpiSwiGLU8, pg8::GatherOrder, true>(c.lds, g, S, E, 0x79797979); }
#endif
    } SEAM(23);
    if (IN(24)) { pg8::Gemm g = pg8::mkgemm(ws + WS_R1 + R1_ACT, ws + WS_WD + (size_t)NEXP * D * DEXP, MPAD, D, DEXP / 2, (size_t)D * DEXP); pg8::GroupedOrder S; S.init((const int*)(ws + WS_CTL) + CW_PLAN + 512, D, c.nblk, c.bid);
        pg8::EpiBf16 E{(pg8::bf16_t*)(ws + WS_R1 + R1_Y), D}; pg8::gemm_phase<pg8::EpiBf16, pg8::GroupedOrder, true>(c.lds, g, S, E, 0x79797979);
#if defined(DUP_PHASE)
        if (DUP_PHASE == 24) { xcd_barrier(bar); pg8::Gemm g = pg8::mkgemm(ws + WS_R1 + R1_ACT, ws + WS_WD + (size_t)NEXP * D * DEXP, MPAD, D, DEXP / 2, (size_t)D * DEXP); pg8::GroupedOrder S; S.init((const int*)(ws + WS_CTL) + CW_PLAN + 512, D, c.nblk, c.bid);
        pg8::EpiBf16 E{(pg8::bf16_t*)(ws + WS_R1 + R1_Y), D}; pg8::gemm_phase<pg8::EpiBf16, pg8::GroupedOrder, true>(c.lds, g, S, E, 0x79797979); }
#endif
    } SEAM(24);
    if (IN(25)) {
#ifdef PROBE_MASK
        { const unsigned long long* ts = (const unsigned long long*)((unsigned*)(args.ws + WS_CTL) + CW_TS); const double tot = (double)(ts[25] - ts[0]); double acc = 0.0;
          for (int k = 0; k < 25; ++k) { if ((PROBE_MASK >> k) & 1ull) acc += (double)(ts[k + 1] - ts[k]); if ((PROBE_BARMASK >> k) & 1ull) acc += (double)(ts[k + 1] - ts[64 + k]); }
          g_probe_scale = 1.0f + 0.05f + 0.5f * (float)(acc / tot); }
#endif
        phase_ln_ffn(c, args, 1, true PROBE_PASS); }
#undef IN
#undef SEAM
}
constexpr int LAST_PHASE = 25;

extern "C" void kernel_launch(void* const* d_in, const int* in_sizes, int n_in, void* d_out, int out_size, void* d_ws, size_t ws_size, hipStream_t stream) {
    static int grid = 0;
    if (grid == 0) {
        if (n_in != 29 || ws_size < WS_END) { fprintf(stderr, "kernel_launch: expected 29 inputs and >= %zu bytes of workspace (got %d, %zu)\n", (size_t)WS_END, n_in, ws_size); grid = -1; return; }
        int dev = 0, cus = 0, per_cu = 0;
        if (hipGetDevice(&dev) != hipSuccess || hipDeviceGetAttribute(&cus, hipDeviceAttributeMultiprocessorCount, dev) != hipSuccess) { grid = -1; return; }
        if (hipFuncSetAttribute((const void*)fwd, hipFuncAttributeMaxDynamicSharedMemorySize, LDS_BYTES) != hipSuccess) { fprintf(stderr, "kernel_launch: hipFuncSetAttribute failed\n"); grid = -1; return; }
        if (hipOccupancyMaxActiveBlocksPerMultiprocessor(&per_cu, (const void*)fwd, NTHR, LDS_BYTES) != hipSuccess || per_cu < 1) fprintf(stderr, "kernel_launch: occupancy query says %d\n", per_cu);
        (void)hipGetLastError();
        grid = cus;
    }
    if (grid < 0) return;
    (void)hipMemsetAsync((char*)d_ws + WS_CTL, 0, CTL_BYTES, stream);
    Args a{};
    for (int i = 0; i < 29; ++i) a.in[i] = (const float*)d_in[i];
    a.out = (float*)d_out; a.ws = (unsigned char*)d_ws;
#ifndef MK_N_LAUNCHES
#define MK_N_LAUNCHES 1
#endif
    if (MK_N_LAUNCHES == 1) { a.ph_lo = 0; a.ph_hi = LAST_PHASE + 1; hipLaunchKernelGGL(fwd, dim3(grid), dim3(NTHR), LDS_BYTES, stream, a); }
    else for (int p = 0; p <= LAST_PHASE; ++p) {
        a.ph_lo = p; a.ph_hi = p + 1;
        hipLaunchKernelGGL(fwd, dim3(grid), dim3(NTHR), LDS_BYTES, stream, a);
    }
}
```
